# Optimizing an MI355X kernel written in HIP

```python
import math
import jax, jax.numpy as jnp
from jax import lax
import numpy as np

D_MODEL = 1024
BATCH = 4
SEQ = 4096
DEPTH = 2

CHUNK = 64
N_EVEN = (DEPTH + 1) // 2
N_ODD = DEPTH // 2
EPS = 1e-6

ATT_HEADS = 8
ATT_HEAD_DIM = 64
ATT_WIDTH = ATT_HEADS * ATT_HEAD_DIM
ATT_LEFT_CHUNKS = 8
ATT_BAND = (ATT_LEFT_CHUNKS + 1) * CHUNK
ATT_MAX_REL = 128

POOL_WINDOWS = (2, 4, 8, 16)
POOL_GROUPS = 4
POOL_GROUP_DIM = 128
POOL_WIDTH = POOL_GROUPS * POOL_GROUP_DIM

SGU_BLOCK = 128
SGU_GROUPS = 4
SGU_GROUP_DIM = 128
SGU_WIDTH = SGU_GROUPS * SGU_GROUP_DIM

SB_HEADS = 8
SB_HEAD_DIM = 64
SB_WIDTH = SB_HEADS * SB_HEAD_DIM
SB_QBLOCK = 128

EVEN_IN = 3 * ATT_WIDTH + POOL_WIDTH
EVEN_MIX = ATT_WIDTH + POOL_WIDTH
ODD_IN = 2 * SGU_WIDTH + 3 * SB_WIDTH
ODD_MIX = SGU_WIDTH + SB_WIDTH

N_GROUPS = 4
N_EXP_PER_GROUP = 8
TOP_K = 2
EXPERT_FF = 256

kernel_name = "hybrid_chunk_stream_hmoe"


def rms_norm(x, g):
    xf = x.astype(jnp.float32)
    y = xf * lax.rsqrt(jnp.mean(xf * xf, axis=-1, keepdims=True) + EPS)
    return (y * g.astype(jnp.float32)).astype(x.dtype)


def chunk_band_attention(q, k, v, q_gain, k_gain, rel_bias):
    b, s, h, dh = q.shape
    nc = s // CHUNK
    L = ATT_LEFT_CHUNKS
    q = rms_norm(q, q_gain)
    k = rms_norm(k, k_gain)
    pad = ((0, 0), (L * CHUNK, 0), (0, 0), (0, 0))
    kp = jnp.pad(k, pad).reshape(b, nc + L, CHUNK, h, dh)
    vp = jnp.pad(v, pad).reshape(b, nc + L, CHUNK, h, dh)
    band_idx = jnp.arange(nc)[:, None] + jnp.arange(L + 1)[None, :]
    kb = kp[:, band_idx].reshape(b, nc, ATT_BAND, h, dh)
    vb = vp[:, band_idx].reshape(b, nc, ATT_BAND, h, dh)
    qc = q.reshape(b, nc, CHUNK, h, dh)
    scores = jnp.einsum('bcihd,bcjhd->bhcij', qc, kb,
                        preferred_element_type=jnp.float32) * (1.0 / math.sqrt(dh))
    dist = (jnp.arange(CHUNK)[:, None] + L * CHUNK) - jnp.arange(ATT_BAND)[None, :]
    ridx = jnp.clip(dist, -ATT_MAX_REL, ATT_MAX_REL) + ATT_MAX_REL
    bias = rel_bias[:, ridx].astype(jnp.float32)
    key_chunk = jnp.arange(nc)[:, None] - L + jnp.arange(ATT_BAND)[None, :] // CHUNK
    valid = key_chunk >= 0
    scores = jnp.where(valid[None, None, :, None, :], scores + bias[None, :, None], -1e30)
    probs = jax.nn.softmax(scores, axis=-1)
    out = jnp.einsum('bhcij,bcjhd->bcihd', probs.astype(v.dtype), vb)
    return out.reshape(b, s, h * dh)


def multiscale_pool(p, w_group, scale):
    b, s, _ = p.shape
    pg = p.reshape(b, s, POOL_GROUPS, POOL_GROUP_DIM).astype(jnp.float32)
    cs = jnp.pad(jnp.cumsum(pg, axis=1), ((0, 0), (1, 0), (0, 0), (0, 0)))
    t = jnp.arange(s)[:, None]
    win = jnp.array(POOL_WINDOWS, dtype=jnp.int32)[None, :]
    lo = jnp.maximum(t + 1 - win, 0)
    gidx = jnp.arange(POOL_GROUPS)[None, :]
    win_sum = cs[:, 1:] - cs[:, lo, gidx]
    count = jnp.minimum(t + 1, win).astype(jnp.float32)
    mixed = (win_sum / count[None, :, :, None] - pg).astype(p.dtype)
    y = jnp.einsum('bsgc,gcd->bsgd', mixed, w_group).reshape(b, s, POOL_WIDTH)
    return y * scale


def spatial_gating(u, vv, v_gain, w_s, b_s):
    b, s, _ = u.shape
    nb = s // SGU_BLOCK
    vv = rms_norm(vv, v_gain)
    vb = vv.reshape(b, nb, SGU_BLOCK, SGU_GROUPS, SGU_GROUP_DIM)
    tri = jnp.tril(jnp.ones((SGU_BLOCK, SGU_BLOCK), dtype=bool))
    ws = jnp.where(tri[None], w_s, jnp.zeros_like(w_s))
    mixed = jnp.einsum('gts,bnsgc->bntgc', ws, vb) + b_s.T[:, :, None]
    return u * mixed.reshape(b, s, SGU_WIDTH)


def stick_breaking_attention(q, k, v):
    b, s, h, dh = q.shape
    nq = s // SB_QBLOCK
    qb = q.reshape(b, nq, SB_QBLOCK, h, dh).transpose(1, 0, 2, 3, 4)
    kpos = jnp.arange(s)
    inv = 1.0 / math.sqrt(dh)

    def block(args):
        qblk, i = args
        z = jnp.einsum('bthd,bshd->bhts', qblk, k,
                       preferred_element_type=jnp.float32) * inv
        qpos = i * SB_QBLOCK + jnp.arange(SB_QBLOCK)
        causal = kpos[None, :] < qpos[:, None]
        log_beta = jax.nn.log_sigmoid(z)
        log_rest = jnp.where(causal, jax.nn.log_sigmoid(-z), 0.0)
        tail = lax.cumsum(log_rest, axis=3, reverse=True) - log_rest
        a = jnp.where(causal, jnp.exp(log_beta + tail), 0.0)
        return jnp.einsum('bhts,bshd->bthd', a.astype(v.dtype), v)

    out = lax.map(block, (qb, jnp.arange(nq)))
    return out.transpose(1, 0, 2, 3, 4).reshape(b, s, h * dh)


def hierarchical_moe(x, w_rg, w_re, w_gate, w_up, w_down):
    b, s, d = x.shape
    xt = x.reshape(-1, d)
    n = xt.shape[0]
    g_logits = jnp.einsum('nd,dg->ng', xt, w_rg, preferred_element_type=jnp.float32)
    g_prob = jax.nn.softmax(g_logits, axis=-1)
    g_sel = jnp.argmax(g_logits, axis=-1)
    g_weight = jnp.take_along_axis(g_prob, g_sel[:, None], axis=-1)
    e_logits = jnp.einsum('nd,de->ne', xt, w_re,
                          preferred_element_type=jnp.float32).reshape(n, N_GROUPS, N_EXP_PER_GROUP)
    e_in_group = jnp.take_along_axis(e_logits, g_sel[:, None, None], axis=1)[:, 0]
    top_val, top_idx = lax.top_k(e_in_group, TOP_K)
    top_w = jax.nn.softmax(top_val, axis=-1) * g_weight
    flat_idx = g_sel[:, None] * N_EXP_PER_GROUP + top_idx
    combine = jnp.einsum('nk,nke->ne', top_w,
                         jax.nn.one_hot(flat_idx, N_GROUPS * N_EXP_PER_GROUP, dtype=jnp.float32))
    combine = combine.reshape(n, N_GROUPS, N_EXP_PER_GROUP)
    out = jnp.zeros((n, d), jnp.float32)
    for g in range(N_GROUPS):
        hid = jax.nn.silu(jnp.einsum('nd,edf->nef', xt, w_gate[g])) * \
            jnp.einsum('nd,edf->nef', xt, w_up[g])
        hid = hid * combine[:, g, :, None].astype(hid.dtype)
        out = out + jnp.einsum('nef,efd->nd', hid, w_down[g],
                               preferred_element_type=jnp.float32)
    return out.astype(x.dtype).reshape(b, s, d)


def setup_inputs(seed: int = 0) -> dict:
    key = jax.random.key(seed)
    ks = jax.random.split(key, 24)
    f32 = jnp.float32

    def nrm(k, shape, scale):
        return jax.random.normal(k, shape, f32) * scale

    def gain(k, shape):
        return 1.0 + 0.1 * jax.random.normal(k, shape, f32)

    G, E, F = N_GROUPS, N_EXP_PER_GROUP, EXPERT_FF
    return {
        "x": jax.random.normal(ks[0], (BATCH, SEQ, D_MODEL), f32),
        "mix_norm_even": gain(ks[1], (N_EVEN, D_MODEL)),
        "w_in_even": nrm(ks[2], (N_EVEN, D_MODEL, EVEN_IN), D_MODEL ** -0.5),
        "att_q_norm": gain(ks[3], (N_EVEN, ATT_HEAD_DIM)),
        "att_k_norm": gain(ks[4], (N_EVEN, ATT_HEAD_DIM)),
        "att_rel_bias": nrm(ks[5], (N_EVEN, ATT_HEADS, 2 * ATT_MAX_REL + 1), 0.5),
        "pool_w": nrm(ks[6], (N_EVEN, POOL_GROUPS, POOL_GROUP_DIM, POOL_GROUP_DIM), POOL_GROUP_DIM ** -0.5),
        "pool_scale": gain(ks[7], (N_EVEN, POOL_WIDTH)),
        "w_out_even": nrm(ks[8], (N_EVEN, EVEN_MIX, D_MODEL), EVEN_MIX ** -0.5),
        "mix_norm_odd": gain(ks[9], (N_ODD, D_MODEL)),
        "w_in_odd": nrm(ks[10], (N_ODD, D_MODEL, ODD_IN), D_MODEL ** -0.5),
        "sgu_v_norm": gain(ks[11], (N_ODD, SGU_WIDTH)),
        "sgu_w": nrm(ks[12], (N_ODD, SGU_GROUPS, SGU_BLOCK, SGU_BLOCK), SGU_BLOCK ** -0.5),
        "sgu_b": gain(ks[13], (N_ODD, SGU_GROUPS, SGU_BLOCK)),
        "w_out_odd": nrm(ks[14], (N_ODD, ODD_MIX, D_MODEL), ODD_MIX ** -0.5),
        "ffn_norm": gain(ks[15], (DEPTH, D_MODEL)),
        "w_router_group": nrm(ks[16], (DEPTH, D_MODEL, G), D_MODEL ** -0.5),
        "w_router_expert": nrm(ks[17], (DEPTH, D_MODEL, G * E), D_MODEL ** -0.5),
        "w_exp_gate": nrm(ks[18], (DEPTH, G, E, D_MODEL, F), D_MODEL ** -0.5),
        "w_exp_up": nrm(ks[19], (DEPTH, G, E, D_MODEL, F), D_MODEL ** -0.5),
        "w_exp_down": nrm(ks[20], (DEPTH, G, E, F, D_MODEL), F ** -0.5),
    }


def reference(x, mix_norm_even, w_in_even, att_q_norm, att_k_norm, att_rel_bias,
              pool_w, pool_scale, w_out_even, mix_norm_odd, w_in_odd, sgu_v_norm,
              sgu_w, sgu_b, w_out_odd, ffn_norm, w_router_group, w_router_expert,
              w_exp_gate, w_exp_up, w_exp_down):
    b, s, _ = x.shape
    h = x
    for layer in range(DEPTH):
        i = layer // 2
        if layer % 2 == 0:
            hn = rms_norm(h, mix_norm_even[i])
            proj = jnp.einsum('bsd,de->bse', hn, w_in_even[i])
            q, k, v, p = jnp.split(proj, [ATT_WIDTH, 2 * ATT_WIDTH, 3 * ATT_WIDTH], axis=-1)
            hs = (b, s, ATT_HEADS, ATT_HEAD_DIM)
            ya = chunk_band_attention(q.reshape(hs), k.reshape(hs), v.reshape(hs),
                                      att_q_norm[i], att_k_norm[i], att_rel_bias[i])
            yb = multiscale_pool(p, pool_w[i], pool_scale[i])
            mixed = jnp.concatenate([ya, yb], axis=-1)
            h = h + jnp.einsum('bse,ed->bsd', mixed, w_out_even[i])
        else:
            hn = rms_norm(h, mix_norm_odd[i])
            proj = jnp.einsum('bsd,de->bse', hn, w_in_odd[i])
            u, vv, q, k, v = jnp.split(
                proj, [SGU_WIDTH, 2 * SGU_WIDTH, 2 * SGU_WIDTH + SB_WIDTH,
                       2 * SGU_WIDTH + 2 * SB_WIDTH], axis=-1)
            yc = spatial_gating(jax.nn.gelu(u, approximate=False),
                                jax.nn.gelu(vv, approximate=False),
                                sgu_v_norm[i], sgu_w[i], sgu_b[i])
            hs = (b, s, SB_HEADS, SB_HEAD_DIM)
            yd = stick_breaking_attention(q.reshape(hs), k.reshape(hs), v.reshape(hs))
            mixed = jnp.concatenate([yc, yd], axis=-1)
            h = h + jnp.einsum('bse,ed->bsd', mixed, w_out_odd[i])
        h = h + hierarchical_moe(rms_norm(h, ffn_norm[layer]), w_router_group[layer],
                                 w_router_expert[layer], w_exp_gate[layer],
                                 w_exp_up[layer], w_exp_down[layer])
    return h
```

```cpp
#include <hip/hip_runtime.h>
#include <stdint.h>

typedef unsigned short bf16_t;
typedef short bf16x8 __attribute__((ext_vector_type(8)));
typedef float f32x4 __attribute__((ext_vector_type(4)));
typedef unsigned u32x4 __attribute__((ext_vector_type(4)));
typedef unsigned u32x2 __attribute__((ext_vector_type(2)));

#define DI __device__ __forceinline__

constexpr int NB = 4, NS = 4096, NTOK = NB * NS, DM = 1024;
constexpr int EVEN_IN = 2048, ODD_IN = 2560;
constexpr int NEXP = 32, FF = 256;
constexpr int LISTCAP = NTOK;
constexpr float EPS = 1e-6f;

DI bf16_t f2bf(float x) { unsigned u = __float_as_uint(x); u += 0x7fffu + ((u >> 16) & 1u); return (bf16_t)(u >> 16); }
DI float bf2f(bf16_t b) { return __uint_as_float(((unsigned)b) << 16); }
DI unsigned pack2(float lo, float hi) { return (unsigned)f2bf(lo) | ((unsigned)f2bf(hi) << 16); }
DI float wave_sum(float v) { for (int o = 32; o > 0; o >>= 1) v += __shfl_xor(v, o); return v; }
DI float wave_max(float v) { for (int o = 32; o > 0; o >>= 1) v = fmaxf(v, __shfl_xor(v, o)); return v; }
DI float gelu_exact(float x) { return 0.5f * x * (1.0f + erff(x * 0.70710678118654752f)); }

struct P {
    const float *x, *mix_norm_even, *w_in_even, *att_q_norm, *att_k_norm, *att_rel_bias, *pool_w, *pool_scale, *w_out_even;
    const float *mix_norm_odd, *w_in_odd, *sgu_v_norm, *sgu_w, *sgu_b, *w_out_odd, *ffn_norm, *w_rg, *w_re, *w_gate, *w_up, *w_down;
    float* out;
    bf16_t *wt_in_even, *wt_out_even, *wt_in_odd, *wt_out_odd, *wt_gu, *wt_d;
    bf16_t *xn, *proj, *mixed, *hid, *y, *vvn;
    float* pw; int* plist; int* cnt;
};

__global__ __launch_bounds__(256) void k_transpose(const float* __restrict__ src, bf16_t* __restrict__ dst, int K, int N, int rowblk, int rowoff, size_t dst_bstride) {
    __shared__ float tile[64][65];
    const int nt = N / 64, kt = K / 64;
    int bid = blockIdx.x;
    const int b = bid / (nt * kt); bid -= b * nt * kt;
    const int k0 = (bid / nt) * 64, n0 = (bid % nt) * 64;
    const float* s = src + (size_t)b * K * N;
    bf16_t* d = dst + (size_t)b * dst_bstride;
    for (int i = 0; i < 16; ++i) { int idx = threadIdx.x + 256 * i; int k = idx >> 6, n = idx & 63; tile[k][n] = s[(size_t)(k0 + k) * N + n0 + n]; }
    __syncthreads();
    for (int i = 0; i < 16; ++i) { int idx = threadIdx.x + 256 * i; int n = idx >> 6, k = idx & 63; int nn = n0 + n;
        int dr = (nn >> 5) * rowblk + (nn & 31) + rowoff; d[(size_t)dr * K + k0 + k] = f2bf(tile[k][n]); }
}

__global__ __launch_bounds__(256) void k_rmsnorm(const float* __restrict__ src, const float* __restrict__ gain, bf16_t* __restrict__ dst) {
    const int wave = threadIdx.x >> 6, lane = threadIdx.x & 63;
    const int tok = blockIdx.x * 4 + wave;
    const float* hr = src + (size_t)tok * DM;
    f32x4 v[4]; float ss = 0.f;
#pragma unroll
    for (int i = 0; i < 4; ++i) { v[i] = *(const f32x4*)(hr + i * 256 + lane * 4); ss += v[i][0] * v[i][0] + v[i][1] * v[i][1] + v[i][2] * v[i][2] + v[i][3] * v[i][3]; }
    ss = wave_sum(ss);
    const float rstd = rsqrtf(ss * (1.0f / DM) + EPS);
#pragma unroll
    for (int i = 0; i < 4; ++i) { const f32x4 g = *(const f32x4*)(gain + i * 256 + lane * 4);
        u32x2 w; w.x = pack2(v[i][0] * rstd * g[0], v[i][1] * rstd * g[1]); w.y = pack2(v[i][2] * rstd * g[2], v[i][3] * rstd * g[3]);
        *(u32x2*)(dst + (size_t)tok * DM + i * 256 + lane * 4) = w; }
}

enum { EPI_IN_EVEN = 0, EPI_IN_ODD = 1, EPI_OUT = 2, EPI_GU = 3, EPI_DOWN = 4 };
constexpr int GEMM_LDS = 2 * 2 * 128 * 128 + 512;

struct GemmArgs {
    const bf16_t* A; int lda; const int* gather; int mvalid;
    int gshift;
    const bf16_t* Bt; int K;
    int m0, n0;
};

template <int EPI>
DI void gemm_tile(const P& p, char* smem, const GemmArgs& g, int layer) {
    const int tid = threadIdx.x, lane = tid & 63, wid = tid >> 6, wm = wid >> 1, wn = wid & 1, fr = lane & 15, fq = lane >> 4;
    char* As = smem; char* Bs = smem + 2 * 16384; int* rowid = (int*)(smem + 4 * 16384);
    const int kc = tid & 7, r0 = tid >> 3;
    const bf16_t* ap[4]; const bf16_t* bp[4];
    if (g.gather) { if (tid < 128) rowid[tid] = (tid < g.mvalid) ? g.gather[tid] : -1; __syncthreads(); }
#pragma unroll
    for (int i = 0; i < 4; ++i) {
        const int r = r0 + 32 * i;
        size_t arow;
        if (g.gather) { int id = rowid[r]; if (id < 0) id = rowid[0]; arow = (size_t)(id >> g.gshift); } else arow = (size_t)(g.m0 + r);
        ap[i] = g.A + arow * g.lda + kc * 8;
        bp[i] = g.Bt + (size_t)(g.n0 + r) * g.K + kc * 8;
    }
    f32x4 acc[4][4];
#pragma unroll
    for (int a = 0; a < 4; ++a)
#pragma unroll
        for (int b = 0; b < 4; ++b) acc[a][b] = (f32x4){0.f, 0.f, 0.f, 0.f};
    u32x4 ra[4], rb[4];
    const int nk = g.K / 64;
#pragma unroll
    for (int i = 0; i < 4; ++i) { ra[i] = *(const u32x4*)(ap[i]); rb[i] = *(const u32x4*)(bp[i]); }
#pragma unroll
    for (int i = 0; i < 4; ++i) { const int r = r0 + 32 * i; const int off = r * 128 + ((kc ^ (r & 7)) << 4); *(u32x4*)(As + off) = ra[i]; *(u32x4*)(Bs + off) = rb[i]; }
    __syncthreads();
    for (int kt = 0; kt < nk; ++kt) {
        const int cur = kt & 1;
        if (kt + 1 < nk) {
#pragma unroll
            for (int i = 0; i < 4; ++i) { ra[i] = *(const u32x4*)(ap[i] + (kt + 1) * 64); rb[i] = *(const u32x4*)(bp[i] + (kt + 1) * 64); }
        }
        const char* Ac = As + cur * 16384; const char* Bc = Bs + cur * 16384;
#pragma unroll
        for (int s = 0; s < 2; ++s) {
            bf16x8 af[4], bfv[4];
#pragma unroll
            for (int i = 0; i < 4; ++i) {
                const int ra_ = wm * 64 + i * 16 + fr, rb_ = wn * 64 + i * 16 + fr;
                af[i] = *(const bf16x8*)(Ac + ra_ * 128 + (((s * 4 + fq) ^ (fr & 7)) << 4));
                bfv[i] = *(const bf16x8*)(Bc + rb_ * 128 + (((s * 4 + fq) ^ (fr & 7)) << 4));
            }
#pragma unroll
            for (int mi = 0; mi < 4; ++mi)
#pragma unroll
                for (int ni = 0; ni < 4; ++ni) acc[mi][ni] = __builtin_amdgcn_mfma_f32_16x16x32_bf16(bfv[ni], af[mi], acc[mi][ni], 0, 0, 0);
        }
        if (kt + 1 < nk) {
            char* An = As + (cur ^ 1) * 16384; char* Bn = Bs + (cur ^ 1) * 16384;
#pragma unroll
            for (int i = 0; i < 4; ++i) { const int r = r0 + 32 * i; const int off = r * 128 + ((kc ^ (r & 7)) << 4); *(u32x4*)(An + off) = ra[i]; *(u32x4*)(Bn + off) = rb[i]; }
        }
        __syncthreads();
    }
    const int colw = g.n0 + wn * 64;
    if (EPI == EPI_IN_EVEN) {
        const int region = colw >> 9;
        const float* gn = region == 0 ? p.att_q_norm : p.att_k_norm;
#pragma unroll
        for (int mi = 0; mi < 4; ++mi) {
            const int row = g.m0 + wm * 64 + mi * 16 + fr;
            float sc = 1.f;
            if (region < 2) {
                float ss = 0.f;
#pragma unroll
                for (int ni = 0; ni < 4; ++ni) ss += acc[mi][ni][0] * acc[mi][ni][0] + acc[mi][ni][1] * acc[mi][ni][1] + acc[mi][ni][2] * acc[mi][ni][2] + acc[mi][ni][3] * acc[mi][ni][3];
                ss += __shfl_xor(ss, 16); ss += __shfl_xor(ss, 32);
                sc = rsqrtf(ss * (1.0f / 64.0f) + EPS) * (region == 0 ? 0.125f : 1.0f);
            }
#pragma unroll
            for (int ni = 0; ni < 4; ++ni) {
                f32x4 v = acc[mi][ni];
                if (region < 2) { const f32x4 gg = *(const f32x4*)(gn + ni * 16 + fq * 4); v = v * sc * gg; }
                u32x2 w; w.x = pack2(v[0], v[1]); w.y = pack2(v[2], v[3]);
                *(u32x2*)(p.proj + (size_t)row * EVEN_IN + colw + ni * 16 + fq * 4) = w;
            }
        }
    } else if (EPI == EPI_IN_ODD) {
        const bool act = colw < 1024;
#pragma unroll
        for (int mi = 0; mi < 4; ++mi) {
            const int row = g.m0 + wm * 64 + mi * 16 + fr;
#pragma unroll
            for (int ni = 0; ni < 4; ++ni) {
                f32x4 v = acc[mi][ni];
                if (act) { v[0] = gelu_exact(v[0]); v[1] = gelu_exact(v[1]); v[2] = gelu_exact(v[2]); v[3] = gelu_exact(v[3]); }
                u32x2 w; w.x = pack2(v[0], v[1]); w.y = pack2(v[2], v[3]);
                *(u32x2*)(p.proj + (size_t)row * ODD_IN + colw + ni * 16 + fq * 4) = w;
            }
        }
    } else if (EPI == EPI_OUT) {
        const float* res = layer == 0 ? p.x : p.out;
#pragma unroll
        for (int mi = 0; mi < 4; ++mi) {
            const int row = g.m0 + wm * 64 + mi * 16 + fr;
#pragma unroll
            for (int ni = 0; ni < 4; ++ni) {
                const size_t off = (size_t)row * DM + colw + ni * 16 + fq * 4;
                const f32x4 r = *(const f32x4*)(res + off);
                *(f32x4*)(p.out + off) = r + acc[mi][ni];
            }
        }
    } else if (EPI == EPI_GU) {
        const int f0 = (colw >> 6) * 32;
#pragma unroll
        for (int mi = 0; mi < 4; ++mi) {
            const int id = rowid[wm * 64 + mi * 16 + fr];
            if (id >= 0) {
                const float w = p.pw[id];
#pragma unroll
                for (int ni = 0; ni < 2; ++ni) {
                    f32x4 gt = acc[mi][ni], up = acc[mi][ni + 2], h;
#pragma unroll
                    for (int j = 0; j < 4; ++j) h[j] = gt[j] / (1.0f + __expf(-gt[j])) * up[j] * w;
                    u32x2 ww; ww.x = pack2(h[0], h[1]); ww.y = pack2(h[2], h[3]);
                    *(u32x2*)(p.hid + (size_t)id * FF + f0 + ni * 16 + fq * 4) = ww;
                }
            }
        }
    } else if (EPI == EPI_DOWN) {
#pragma unroll
        for (int mi = 0; mi < 4; ++mi) {
            const int id = rowid[wm * 64 + mi * 16 + fr];
            if (id >= 0) {
#pragma unroll
                for (int ni = 0; ni < 4; ++ni) {
                    const f32x4 v = acc[mi][ni];
                    u32x2 ww; ww.x = pack2(v[0], v[1]); ww.y = pack2(v[2], v[3]);
                    *(u32x2*)(p.y + (size_t)id * DM + colw + ni * 16 + fq * 4) = ww;
                }
            }
        }
    }
    __syncthreads();
}

template <int EPI>
__global__ __launch_bounds__(256, 2) void k_gemm_dense(P p, const bf16_t* A, int lda, const bf16_t* Bt, int K, int N, int layer) {
    __shared__ __attribute__((aligned(16))) char smem[GEMM_LDS];
    const int ntn = N / 128;
    GemmArgs g; g.A = A; g.lda = lda; g.gather = nullptr; g.mvalid = 128; g.gshift = 0; g.Bt = Bt; g.K = K;
    g.m0 = (blockIdx.x / ntn) * 128; g.n0 = (blockIdx.x % ntn) * 128;
    gemm_tile<EPI>(p, smem, g, layer);
}

template <int EPI>
__global__ __launch_bounds__(256, 2) void k_gemm_moe(P p, int layer) {
    __shared__ __attribute__((aligned(16))) char smem[GEMM_LDS];
    const int ntn = (EPI == EPI_GU) ? 4 : 8;
    int mt = blockIdx.x / ntn; const int nt = blockIdx.x % ntn;
    int e = 0, c = 0;
    for (; e < NEXP; ++e) { c = p.cnt[e]; const int t = (c + 127) >> 7; if (mt < t) break; mt -= t; }
    if (e >= NEXP) return;
    GemmArgs g; g.gather = p.plist + (size_t)e * LISTCAP + mt * 128; g.mvalid = c - mt * 128 < 128 ? c - mt * 128 : 128;
    g.m0 = 0; g.n0 = nt * 128;
    const int ex = layer * NEXP + e;
    if (EPI == EPI_GU) { g.A = p.xn; g.lda = DM; g.gshift = 1; g.Bt = p.wt_gu + (size_t)ex * 512 * DM; g.K = DM; }
    else { g.A = p.hid; g.lda = FF; g.gshift = 0; g.Bt = p.wt_d + (size_t)ex * DM * FF; g.K = FF; }
    gemm_tile<EPI>(p, smem, g, layer);
}

__global__ __launch_bounds__(256) void k_band_attn(P p) {
    __shared__ float sq[4][64];
    __shared__ float sp[4][576];
    const int wave = threadIdx.x >> 6, lane = threadIdx.x & 63;
    const int c = blockIdx.x & 63, h = (blockIdx.x >> 6) & 7, b = blockIdx.x >> 9;
    const float* bias = p.att_rel_bias + h * 257;
    for (int i = wave; i < 64; i += 4) {
        const int tq = c * 64 + i; const size_t tok = (size_t)b * NS + tq;
        sq[wave][lane] = bf2f(p.proj[tok * EVEN_IN + h * 64 + lane]);
        float sc[9]; float mx = -3.0e38f;
#pragma unroll
        for (int r = 0; r < 9; ++r) {
            const int j = lane + 64 * r; const int tk = (c - 8) * 64 + j;
            float s = -1e30f;
            if (tk >= 0) {
                const bf16_t* kr = p.proj + ((size_t)b * NS + tk) * EVEN_IN + 512 + h * 64;
                float d = 0.f;
                for (int dd = 0; dd < 64; ++dd) d += sq[wave][dd] * bf2f(kr[dd]);
                int dist = tq - tk; if (dist > 128) dist = 128;
                s = d + bias[dist + 128];
            }
            sc[r] = s; mx = fmaxf(mx, s);
        }
        mx = wave_max(mx);
        float sum = 0.f;
#pragma unroll
        for (int r = 0; r < 9; ++r) { const float e = __expf(sc[r] - mx); sum += e; sp[wave][lane + 64 * r] = e; }
        sum = wave_sum(sum);
        float o = 0.f;
        for (int j = 0; j < 576; ++j) {
            const int tk = (c - 8) * 64 + j;
            if (tk >= 0) o += sp[wave][j] * bf2f(p.proj[((size_t)b * NS + tk) * EVEN_IN + 1024 + h * 64 + lane]);
        }
        p.mixed[tok * DM + h * 64 + lane] = f2bf(o / sum);
    }
}

__global__ __launch_bounds__(256) void k_pool(P p) {
    __shared__ float sm[512];
    const int tok = blockIdx.x, s = tok & (NS - 1);
    for (int ch = threadIdx.x; ch < 512; ch += 256) {
        const int g = ch >> 7, w = 2 << g;
        int lo = s + 1 - w; if (lo < 0) lo = 0;
        float sum = 0.f;
        for (int t = lo; t <= s; ++t) sum += bf2f(p.proj[(size_t)(tok - s + t) * EVEN_IN + 1536 + ch]);
        sm[ch] = sum / (float)(s + 1 - lo) - bf2f(p.proj[(size_t)tok * EVEN_IN + 1536 + ch]);
    }
    __syncthreads();
    for (int ch = threadIdx.x; ch < 512; ch += 256) {
        const int g = ch >> 7, d = ch & 127;
        float y = 0.f;
        for (int c = 0; c < 128; ++c) y += sm[g * 128 + c] * p.pool_w[(g * 128 + c) * 128 + d];
        p.mixed[(size_t)tok * DM + 512 + ch] = f2bf(y * p.pool_scale[ch]);
    }
}

__global__ __launch_bounds__(256) void k_sgu_norm(P p) {
    const int wave = threadIdx.x >> 6, lane = threadIdx.x & 63;
    const int tok = blockIdx.x * 4 + wave;
    float v[8]; float ss = 0.f;
#pragma unroll
    for (int i = 0; i < 8; ++i) { v[i] = bf2f(p.proj[(size_t)tok * ODD_IN + 512 + i * 64 + lane]); ss += v[i] * v[i]; }
    ss = wave_sum(ss);
    const float rstd = rsqrtf(ss * (1.0f / 512.0f) + EPS);
#pragma unroll
    for (int i = 0; i < 8; ++i) p.vvn[(size_t)tok * 512 + i * 64 + lane] = f2bf(v[i] * rstd * p.sgu_v_norm[i * 64 + lane]);
}

__global__ __launch_bounds__(256) void k_sgu_mix(P p) {
    const int tok = blockIdx.x, tt = tok & 127, base = tok - tt;
    for (int ch = threadIdx.x; ch < 512; ch += 256) {
        const int g = ch >> 7;
        const float* wr = p.sgu_w + ((size_t)g * 128 + tt) * 128;
        float a = 0.f;
        for (int ss = 0; ss <= tt; ++ss) a += wr[ss] * bf2f(p.vvn[(size_t)(base + ss) * 512 + ch]);
        a += p.sgu_b[g * 128 + tt];
        p.mixed[(size_t)tok * DM + ch] = f2bf(bf2f(p.proj[(size_t)tok * ODD_IN + ch]) * a);
    }
}

__global__ __launch_bounds__(256) void k_sb_attn(P p) {
    __shared__ float sq[4][64];
    const int wave = threadIdx.x >> 6, lane = threadIdx.x & 63;
    const int gw = blockIdx.x * 4 + wave;
    const int h = gw & 7; const int tok = gw >> 3; const int t = tok & (NS - 1); const size_t tb = (size_t)(tok - t);
    sq[wave][lane] = bf2f(p.proj[(size_t)tok * ODD_IN + 1024 + h * 64 + lane]);
    float o = 0.f, carry = 0.f;
    for (int it = 0; it * 64 < t; ++it) {
        const int s = t - 1 - (it * 64 + lane);
        const bool valid = s >= 0;
        float z = 0.f, L = 0.f;
        if (valid) {
            const bf16_t* kr = p.proj + (tb + s) * ODD_IN + 1536 + h * 64;
            float d = 0.f;
            for (int dd = 0; dd < 64; ++dd) d += sq[wave][dd] * bf2f(kr[dd]);
            z = d * 0.125f;
            L = -(fmaxf(z, 0.f) + log1pf(__expf(-fabsf(z))));
        }
        float inc = L;
#pragma unroll
        for (int off = 1; off < 64; off <<= 1) { const float n = __shfl_up(inc, off); if (lane >= off) inc += n; }
        const float a = valid ? __expf(z + carry + inc) : 0.f;
        carry += __shfl(inc, 63);
        for (int jj = 0; jj < 64; ++jj) {
            const int sj = t - 1 - (it * 64 + jj);
            if (sj < 0) break;
            const float aj = __shfl(a, jj);
            o += aj * bf2f(p.proj[(tb + sj) * ODD_IN + 2048 + h * 64 + lane]);
        }
        if (carry < -104.0f) break;
    }
    p.mixed[(size_t)tok * DM + 512 + h * 64 + lane] = f2bf(o);
}

__global__ __launch_bounds__(256) void k_router(P p, int layer) {
    const int wave = threadIdx.x >> 6, lane = threadIdx.x & 63;
    const int tok = blockIdx.x * 4 + wave;
    const float* hr = p.out + (size_t)tok * DM;
    const float* gn = p.ffn_norm + layer * DM;
    f32x4 v[4]; float ss = 0.f;
#pragma unroll
    for (int i = 0; i < 4; ++i) { v[i] = *(const f32x4*)(hr + i * 256 + lane * 4); ss += v[i][0] * v[i][0] + v[i][1] * v[i][1] + v[i][2] * v[i][2] + v[i][3] * v[i][3]; }
    ss = wave_sum(ss);
    const float rstd = rsqrtf(ss * (1.0f / DM) + EPS);
#pragma unroll
    for (int i = 0; i < 4; ++i) { const f32x4 g = *(const f32x4*)(gn + i * 256 + lane * 4); v[i] = v[i] * rstd * g;
        u32x2 w; w.x = pack2(v[i][0], v[i][1]); w.y = pack2(v[i][2], v[i][3]);
        *(u32x2*)(p.xn + (size_t)tok * DM + i * 256 + lane * 4) = w; }
    const float* wg = p.w_rg + (size_t)layer * DM * 4;
    const float* we = p.w_re + (size_t)layer * DM * 32;
    float mylogit = 0.f;
    {
        f32x4 a = (f32x4){0.f, 0.f, 0.f, 0.f};
#pragma unroll
        for (int i = 0; i < 4; ++i)
#pragma unroll
            for (int j = 0; j < 4; ++j) { const int k = i * 256 + lane * 4 + j; a += v[i][j] * *(const f32x4*)(wg + k * 4); }
#pragma unroll
        for (int o = 0; o < 4; ++o) { const float s = wave_sum(a[o]); if (lane == o) mylogit = s; }
    }
    for (int ob = 0; ob < 8; ++ob) {
        f32x4 a = (f32x4){0.f, 0.f, 0.f, 0.f};
#pragma unroll
        for (int i = 0; i < 4; ++i)
#pragma unroll
            for (int j = 0; j < 4; ++j) { const int k = i * 256 + lane * 4 + j; a += v[i][j] * *(const f32x4*)(we + k * 32 + ob * 4); }
#pragma unroll
        for (int o = 0; o < 4; ++o) { const float s = wave_sum(a[o]); if (lane == 4 + ob * 4 + o) mylogit = s; }
    }
    const float g0 = __shfl(mylogit, 0), g1 = __shfl(mylogit, 1), g2 = __shfl(mylogit, 2), g3 = __shfl(mylogit, 3);
    int gs = 0; float gm = g0;
    if (g1 > gm) { gm = g1; gs = 1; }
    if (g2 > gm) { gm = g2; gs = 2; }
    if (g3 > gm) { gm = g3; gs = 3; }
    const float gw = 1.0f / (__expf(g0 - gm) + __expf(g1 - gm) + __expf(g2 - gm) + __expf(g3 - gm));
    float ev[8];
#pragma unroll
    for (int j = 0; j < 8; ++j) ev[j] = __shfl(mylogit, 4 + gs * 8 + j);
    int i1 = 0; float v1 = ev[0];
#pragma unroll
    for (int j = 1; j < 8; ++j) if (ev[j] > v1) { v1 = ev[j]; i1 = j; }
    int i2 = -1; float v2 = -3.0e38f;
#pragma unroll
    for (int j = 0; j < 8; ++j) if (j != i1 && ev[j] > v2) { v2 = ev[j]; i2 = j; }
    const float w1 = 1.0f / (1.0f + __expf(v2 - v1));
    const float w2 = 1.0f - w1;
    if (lane == 0) {
        const int e1 = gs * 8 + i1, e2 = gs * 8 + i2;
        int pos = atomicAdd(p.cnt + e1, 1); p.plist[(size_t)e1 * LISTCAP + pos] = tok * 2;
        pos = atomicAdd(p.cnt + e2, 1); p.plist[(size_t)e2 * LISTCAP + pos] = tok * 2 + 1;
        p.pw[tok * 2] = w1 * gw; p.pw[tok * 2 + 1] = w2 * gw;
    }
}

__global__ __launch_bounds__(256) void k_combine(P p) {
    const size_t i = ((size_t)blockIdx.x * 256 + threadIdx.x) * 4;
    const size_t tok = i >> 10, c = i & 1023;
    f32x4 h = *(const f32x4*)(p.out + i);
    const u32x2 a = *(const u32x2*)(p.y + (tok * 2) * DM + c), b = *(const u32x2*)(p.y + (tok * 2 + 1) * DM + c);
    h[0] += bf2f((bf16_t)(a.x & 0xffff)) + bf2f((bf16_t)(b.x & 0xffff));
    h[1] += bf2f((bf16_t)(a.x >> 16)) + bf2f((bf16_t)(b.x >> 16));
    h[2] += bf2f((bf16_t)(a.y & 0xffff)) + bf2f((bf16_t)(b.y & 0xffff));
    h[3] += bf2f((bf16_t)(a.y >> 16)) + bf2f((bf16_t)(b.y >> 16));
    *(f32x4*)(p.out + i) = h;
}

extern "C" void kernel_launch(void* const* d_in, const int* in_sizes, int n_in, void* d_out, int out_size, void* d_ws, size_t ws_size, hipStream_t stream) {
    P p{};
    p.x = (const float*)d_in[0]; p.mix_norm_even = (const float*)d_in[1]; p.w_in_even = (const float*)d_in[2]; p.att_q_norm = (const float*)d_in[3];
    p.att_k_norm = (const float*)d_in[4]; p.att_rel_bias = (const float*)d_in[5]; p.pool_w = (const float*)d_in[6]; p.pool_scale = (const float*)d_in[7];
    p.w_out_even = (const float*)d_in[8]; p.mix_norm_odd = (const float*)d_in[9]; p.w_in_odd = (const float*)d_in[10]; p.sgu_v_norm = (const float*)d_in[11];
    p.sgu_w = (const float*)d_in[12]; p.sgu_b = (const float*)d_in[13]; p.w_out_odd = (const float*)d_in[14]; p.ffn_norm = (const float*)d_in[15];
    p.w_rg = (const float*)d_in[16]; p.w_re = (const float*)d_in[17]; p.w_gate = (const float*)d_in[18]; p.w_up = (const float*)d_in[19]; p.w_down = (const float*)d_in[20];
    p.out = (float*)d_out;
    char* ws = (char*)d_ws; size_t off = 0;
    auto take = [&](size_t bytes) { char* r = ws + off; off += (bytes + 255) & ~(size_t)255; return r; };
    p.wt_in_even = (bf16_t*)take((size_t)EVEN_IN * DM * 2);
    p.wt_out_even = (bf16_t*)take((size_t)DM * DM * 2);
    p.wt_in_odd = (bf16_t*)take((size_t)ODD_IN * DM * 2);
    p.wt_out_odd = (bf16_t*)take((size_t)DM * DM * 2);
    p.wt_gu = (bf16_t*)take((size_t)2 * NEXP * 512 * DM * 2);
    p.wt_d = (bf16_t*)take((size_t)2 * NEXP * DM * FF * 2);
    p.xn = (bf16_t*)take((size_t)NTOK * DM * 2);
    p.proj = (bf16_t*)take((size_t)NTOK * ODD_IN * 2);
    p.y = p.proj;
    p.mixed = (bf16_t*)take((size_t)NTOK * DM * 2);
    p.hid = p.mixed;
    p.vvn = p.xn;
    p.pw = (float*)take((size_t)NTOK * 2 * 4);
    p.plist = (int*)take((size_t)NEXP * LISTCAP * 4);
    p.cnt = (int*)take(256);

    k_transpose<<<(DM / 64) * (EVEN_IN / 64), 256, 0, stream>>>(p.w_in_even, p.wt_in_even, DM, EVEN_IN, 32, 0, 0);
    k_transpose<<<(DM / 64) * (DM / 64), 256, 0, stream>>>(p.w_out_even, p.wt_out_even, DM, DM, 32, 0, 0);
    k_transpose<<<(DM / 64) * (ODD_IN / 64), 256, 0, stream>>>(p.w_in_odd, p.wt_in_odd, DM, ODD_IN, 32, 0, 0);
    k_transpose<<<(DM / 64) * (DM / 64), 256, 0, stream>>>(p.w_out_odd, p.wt_out_odd, DM, DM, 32, 0, 0);
    k_transpose<<<64 * (DM / 64) * (FF / 64), 256, 0, stream>>>(p.w_gate, p.wt_gu, DM, FF, 64, 0, (size_t)512 * DM);
    k_transpose<<<64 * (DM / 64) * (FF / 64), 256, 0, stream>>>(p.w_up, p.wt_gu, DM, FF, 64, 32, (size_t)512 * DM);
    k_transpose<<<64 * (FF / 64) * (DM / 64), 256, 0, stream>>>(p.w_down, p.wt_d, FF, DM, 32, 0, (size_t)DM * FF);

    for (int layer = 0; layer < 2; ++layer) {
        if (layer == 0) {
            k_rmsnorm<<<NTOK / 4, 256, 0, stream>>>(p.x, p.mix_norm_even, p.xn);
            k_gemm_dense<EPI_IN_EVEN><<<(NTOK / 128) * (EVEN_IN / 128), 256, 0, stream>>>(p, p.xn, DM, p.wt_in_even, DM, EVEN_IN, 0);
            k_band_attn<<<NB * 8 * 64, 256, 0, stream>>>(p);
            k_pool<<<NTOK, 256, 0, stream>>>(p);
            k_gemm_dense<EPI_OUT><<<(NTOK / 128) * (DM / 128), 256, 0, stream>>>(p, p.mixed, DM, p.wt_out_even, DM, DM, 0);
        } else {
            k_rmsnorm<<<NTOK / 4, 256, 0, stream>>>(p.out, p.mix_norm_odd, p.xn);
            k_gemm_dense<EPI_IN_ODD><<<(NTOK / 128) * (ODD_IN / 128), 256, 0, stream>>>(p, p.xn, DM, p.wt_in_odd, DM, ODD_IN, 1);
            k_sgu_norm<<<NTOK / 4, 256, 0, stream>>>(p);
            k_sgu_mix<<<NTOK, 256, 0, stream>>>(p);
            k_sb_attn<<<NTOK * 8 / 4, 256, 0, stream>>>(p);
            k_gemm_dense<EPI_OUT><<<(NTOK / 128) * (DM / 128), 256, 0, stream>>>(p, p.mixed, DM, p.wt_out_odd, DM, DM, 1);
        }
        hipMemsetAsync(p.cnt, 0, 256, stream);
        k_router<<<NTOK / 4, 256, 0, stream>>>(p, layer);
        k_gemm_moe<EPI_GU><<<288 * 4, 256, 0, stream>>>(p, layer);
        k_gemm_moe<EPI_DOWN><<<288 * 8, 256, 0, stream>>>(p, layer);
        k_combine<<<NTOK * DM / 1024, 256, 0, stream>>>(p);
    }
}
```

```cpp
#include <hip/hip_runtime.h>
#include <hip/hip_cooperative_groups.h>
#include <stdint.h>
#include <stdio.h>
namespace cg = cooperative_groups;

typedef unsigned short bf16_t;
typedef short bf16x8 __attribute__((ext_vector_type(8)));
typedef float f32x4 __attribute__((ext_vector_type(4)));
typedef unsigned u32x4 __attribute__((ext_vector_type(4)));
typedef unsigned u32x2 __attribute__((ext_vector_type(2)));

#define DI __device__ __forceinline__

constexpr int NB = 4, NS = 4096, NTOK = NB * NS, DM = 1024;
constexpr int EVEN_IN = 2048, ODD_IN = 2560;
constexpr int NEXP = 32, FF = 256;
constexpr int LISTCAP = NTOK;
constexpr float EPS = 1e-6f;

DI bf16_t f2bf(float x) { unsigned u = __float_as_uint(x); u += 0x7fffu + ((u >> 16) & 1u); return (bf16_t)(u >> 16); }
DI float bf2f(bf16_t b) { return __uint_as_float(((unsigned)b) << 16); }
DI unsigned pack2(float lo, float hi) { return (unsigned)f2bf(lo) | ((unsigned)f2bf(hi) << 16); }
DI float wave_sum(float v) { for (int o = 32; o > 0; o >>= 1) v += __shfl_xor(v, o); return v; }
DI float wave_max(float v) { for (int o = 32; o > 0; o >>= 1) v = fmaxf(v, __shfl_xor(v, o)); return v; }
DI float gelu_exact(float x) { return 0.5f * x * (1.0f + erff(x * 0.70710678118654752f)); }

struct P {
    const float *x, *mix_norm_even, *w_in_even, *att_q_norm, *att_k_norm, *att_rel_bias, *pool_w, *pool_scale, *w_out_even;
    const float *mix_norm_odd, *w_in_odd, *sgu_v_norm, *sgu_w, *sgu_b, *w_out_odd, *ffn_norm, *w_rg, *w_re, *w_gate, *w_up, *w_down;
    float* out;
    bf16_t *wt_in_even, *wt_out_even, *wt_in_odd, *wt_out_odd, *wt_gu, *wt_d;
    bf16_t *xn, *proj, *mixed, *hid, *y, *vvn;
    float* pw; int* plist; int* cnt;
};

enum { EPI_IN_EVEN = 0, EPI_IN_ODD = 1, EPI_OUT = 2, EPI_GU = 3, EPI_DOWN = 4 };
constexpr int GEMM_LDS = 2 * 2 * 128 * 128 + 512;

struct GemmArgs {
    const bf16_t* A; int lda; const int* gather; int mvalid;
    int gshift;
    const bf16_t* Bt; int K;
    int m0, n0;
};

template <int EPI>
DI void gemm_tile(const P& p, char* smem, const GemmArgs& g, int layer) {
    const int tid = threadIdx.x, lane = tid & 63, wid = tid >> 6, wm = wid >> 1, wn = wid & 1, fr = lane & 15, fq = lane >> 4;
    char* As = smem; char* Bs = smem + 2 * 16384; int* rowid = (int*)(smem + 4 * 16384);
    const int kc = tid & 7, r0 = tid >> 3;
    const bf16_t* ap[4]; const bf16_t* bp[4];
    if (g.gather) { if (tid < 128) rowid[tid] = (tid < g.mvalid) ? g.gather[tid] : -1; __syncthreads(); }
#pragma unroll
    for (int i = 0; i < 4; ++i) {
        const int r = r0 + 32 * i;
        size_t arow;
        if (g.gather) { int id = rowid[r]; if (id < 0) id = rowid[0]; arow = (size_t)(id >> g.gshift); } else arow = (size_t)(g.m0 + r);
        ap[i] = g.A + arow * g.lda + kc * 8;
        bp[i] = g.Bt + (size_t)(g.n0 + r) * g.K + kc * 8;
    }
    f32x4 acc[4][4];
#pragma unroll
    for (int a = 0; a < 4; ++a)
#pragma unroll
        for (int b = 0; b < 4; ++b) acc[a][b] = (f32x4){0.f, 0.f, 0.f, 0.f};
    u32x4 ra[4], rb[4];
    const int nk = g.K / 64;
#pragma unroll
    for (int i = 0; i < 4; ++i) { ra[i] = *(const u32x4*)(ap[i]); rb[i] = *(const u32x4*)(bp[i]); }
#pragma unroll
    for (int i = 0; i < 4; ++i) { const int r = r0 + 32 * i; const int off = r * 128 + ((kc ^ (r & 7)) << 4); *(u32x4*)(As + off) = ra[i]; *(u32x4*)(Bs + off) = rb[i]; }
    __syncthreads();
    for (int kt = 0; kt < nk; ++kt) {
        const int cur = kt & 1;
        if (kt + 1 < nk) {
#pragma unroll
            for (int i = 0; i < 4; ++i) { ra[i] = *(const u32x4*)(ap[i] + (kt + 1) * 64); rb[i] = *(const u32x4*)(bp[i] + (kt + 1) * 64); }
        }
        const char* Ac = As + cur * 16384; const char* Bc = Bs + cur * 16384;
#pragma unroll
        for (int s = 0; s < 2; ++s) {
            bf16x8 af[4], bfv[4];
#pragma unroll
            for (int i = 0; i < 4; ++i) {
                const int ra_ = wm * 64 + i * 16 + fr, rb_ = wn * 64 + i * 16 + fr;
                af[i] = *(const bf16x8*)(Ac + ra_ * 128 + (((s * 4 + fq) ^ (fr & 7)) << 4));
                bfv[i] = *(const bf16x8*)(Bc + rb_ * 128 + (((s * 4 + fq) ^ (fr & 7)) << 4));
            }
#pragma unroll
            for (int mi = 0; mi < 4; ++mi)
#pragma unroll
                for (int ni = 0; ni < 4; ++ni) acc[mi][ni] = __builtin_amdgcn_mfma_f32_16x16x32_bf16(bfv[ni], af[mi], acc[mi][ni], 0, 0, 0);
        }
        if (kt + 1 < nk) {
            char* An = As + (cur ^ 1) * 16384; char* Bn = Bs + (cur ^ 1) * 16384;
#pragma unroll
            for (int i = 0; i < 4; ++i) { const int r = r0 + 32 * i; const int off = r * 128 + ((kc ^ (r & 7)) << 4); *(u32x4*)(An + off) = ra[i]; *(u32x4*)(Bn + off) = rb[i]; }
        }
        __syncthreads();
    }
    const int colw = g.n0 + wn * 64;
    if (EPI == EPI_IN_EVEN) {
        const int region = colw >> 9;
        const float* gn = region == 0 ? p.att_q_norm : p.att_k_norm;
#pragma unroll
        for (int mi = 0; mi < 4; ++mi) {
            const int row = g.m0 + wm * 64 + mi * 16 + fr;
            float sc = 1.f;
            if (region < 2) {
                float ss = 0.f;
#pragma unroll
                for (int ni = 0; ni < 4; ++ni) ss += acc[mi][ni][0] * acc[mi][ni][0] + acc[mi][ni][1] * acc[mi][ni][1] + acc[mi][ni][2] * acc[mi][ni][2] + acc[mi][ni][3] * acc[mi][ni][3];
                ss += __shfl_xor(ss, 16); ss += __shfl_xor(ss, 32);
                sc = rsqrtf(ss * (1.0f / 64.0f) + EPS) * (region == 0 ? 0.125f : 1.0f);
            }
#pragma unroll
            for (int ni = 0; ni < 4; ++ni) {
                f32x4 v = acc[mi][ni];
                if (region < 2) { const f32x4 gg = *(const f32x4*)(gn + ni * 16 + fq * 4); v = v * sc * gg; }
                u32x2 w; w.x = pack2(v[0], v[1]); w.y = pack2(v[2], v[3]);
                *(u32x2*)(p.proj + (size_t)row * EVEN_IN + colw + ni * 16 + fq * 4) = w;
            }
        }
    } else if (EPI == EPI_IN_ODD) {
        const bool act = colw < 1024;
#pragma unroll
        for (int mi = 0; mi < 4; ++mi) {
            const int row = g.m0 + wm * 64 + mi * 16 + fr;
#pragma unroll
            for (int ni = 0; ni < 4; ++ni) {
                f32x4 v = acc[mi][ni];
                if (act) { v[0] = gelu_exact(v[0]); v[1] = gelu_exact(v[1]); v[2] = gelu_exact(v[2]); v[3] = gelu_exact(v[3]); }
                u32x2 w; w.x = pack2(v[0], v[1]); w.y = pack2(v[2], v[3]);
                *(u32x2*)(p.proj + (size_t)row * ODD_IN + colw + ni * 16 + fq * 4) = w;
            }
        }
    } else if (EPI == EPI_OUT) {
        const float* res = layer == 0 ? p.x : p.out;
#pragma unroll
        for (int mi = 0; mi < 4; ++mi) {
            const int row = g.m0 + wm * 64 + mi * 16 + fr;
#pragma unroll
            for (int ni = 0; ni < 4; ++ni) {
                const size_t off = (size_t)row * DM + colw + ni * 16 + fq * 4;
                const f32x4 r = *(const f32x4*)(res + off);
                *(f32x4*)(p.out + off) = r + acc[mi][ni];
            }
        }
    } else if (EPI == EPI_GU) {
        const int f0 = (colw >> 6) * 32;
#pragma unroll
        for (int mi = 0; mi < 4; ++mi) {
            const int id = rowid[wm * 64 + mi * 16 + fr];
            if (id >= 0) {
                const float w = p.pw[id];
#pragma unroll
                for (int ni = 0; ni < 2; ++ni) {
                    f32x4 gt = acc[mi][ni], up = acc[mi][ni + 2], h;
#pragma unroll
                    for (int j = 0; j < 4; ++j) h[j] = gt[j] / (1.0f + __expf(-gt[j])) * up[j] * w;
                    u32x2 ww; ww.x = pack2(h[0], h[1]); ww.y = pack2(h[2], h[3]);
                    *(u32x2*)(p.hid + (size_t)id * FF + f0 + ni * 16 + fq * 4) = ww;
                }
            }
        }
    } else if (EPI == EPI_DOWN) {
#pragma unroll
        for (int mi = 0; mi < 4; ++mi) {
            const int id = rowid[wm * 64 + mi * 16 + fr];
            if (id >= 0) {
#pragma unroll
                for (int ni = 0; ni < 4; ++ni) {
                    const f32x4 v = acc[mi][ni];
                    u32x2 ww; ww.x = pack2(v[0], v[1]); ww.y = pack2(v[2], v[3]);
                    *(u32x2*)(p.y + (size_t)id * DM + colw + ni * 16 + fq * 4) = ww;
                }
            }
        }
    }
    __syncthreads();
}

constexpr int SMEM_BYTES = GEMM_LDS;

DI void transpose_unit(char* smem, const float* __restrict__ s, bf16_t* __restrict__ d, int K, int N, int k0, int n0, int rowblk, int rowoff) {
    float (*tile)[65] = (float (*)[65])smem;
    for (int i = 0; i < 16; ++i) { int idx = threadIdx.x + 256 * i; int k = idx >> 6, n = idx & 63; tile[k][n] = s[(size_t)(k0 + k) * N + n0 + n]; }
    __syncthreads();
    for (int i = 0; i < 16; ++i) { int idx = threadIdx.x + 256 * i; int n = idx >> 6, k = idx & 63; int nn = n0 + n;
        int dr = (nn >> 5) * rowblk + (nn & 31) + rowoff; d[(size_t)dr * K + k0 + k] = f2bf(tile[k][n]); }
    __syncthreads();
}

DI void rmsnorm_row(const float* __restrict__ hr, const float* __restrict__ gain, bf16_t* __restrict__ dst, int lane) {
    f32x4 v[4]; float ss = 0.f;
#pragma unroll
    for (int i = 0; i < 4; ++i) { v[i] = *(const f32x4*)(hr + i * 256 + lane * 4); ss += v[i][0] * v[i][0] + v[i][1] * v[i][1] + v[i][2] * v[i][2] + v[i][3] * v[i][3]; }
    ss = wave_sum(ss);
    const float rstd = rsqrtf(ss * (1.0f / DM) + EPS);
#pragma unroll
    for (int i = 0; i < 4; ++i) { const f32x4 g = *(const f32x4*)(gain + i * 256 + lane * 4);
        u32x2 w; w.x = pack2(v[i][0] * rstd * g[0], v[i][1] * rstd * g[1]); w.y = pack2(v[i][2] * rstd * g[2], v[i][3] * rstd * g[3]);
        *(u32x2*)(dst + i * 256 + lane * 4) = w; }
}

DI void ph_prologue(const P& p, char* smem) {
    if (blockIdx.x == 0 && threadIdx.x < 64) p.cnt[threadIdx.x] = 0;
    constexpr int U0 = 16 * 32;
    constexpr int U1 = U0 + 16 * 16;
    constexpr int U2 = U1 + 16 * 40;
    constexpr int U3 = U2 + 16 * 16;
    constexpr int U4 = U3 + 64 * 16 * 4;
    constexpr int U5 = U4 + 64 * 16 * 4;
    constexpr int U6 = U5 + 64 * 4 * 16;
    for (int u = blockIdx.x; u < U6; u += gridDim.x) {
        if (u < U0) { int t = u; transpose_unit(smem, p.w_in_even, p.wt_in_even, DM, EVEN_IN, (t / 32) * 64, (t % 32) * 64, 32, 0); }
        else if (u < U1) { int t = u - U0; transpose_unit(smem, p.w_out_even, p.wt_out_even, DM, DM, (t / 16) * 64, (t % 16) * 64, 32, 0); }
        else if (u < U2) { int t = u - U1; transpose_unit(smem, p.w_in_odd, p.wt_in_odd, DM, ODD_IN, (t / 40) * 64, (t % 40) * 64, 32, 0); }
        else if (u < U3) { int t = u - U2; transpose_unit(smem, p.w_out_odd, p.wt_out_odd, DM, DM, (t / 16) * 64, (t % 16) * 64, 32, 0); }
        else if (u < U4) { int t = u - U3; int ex = t / 64; t %= 64; transpose_unit(smem, p.w_gate + (size_t)ex * DM * FF, p.wt_gu + (size_t)ex * 512 * DM, DM, FF, (t / 4) * 64, (t % 4) * 64, 64, 0); }
        else if (u < U5) { int t = u - U4; int ex = t / 64; t %= 64; transpose_unit(smem, p.w_up + (size_t)ex * DM * FF, p.wt_gu + (size_t)ex * 512 * DM, DM, FF, (t / 4) * 64, (t % 4) * 64, 64, 32); }
        else { int t = u - U5; int ex = t / 64; t %= 64; transpose_unit(smem, p.w_down + (size_t)ex * FF * DM, p.wt_d + (size_t)ex * DM * FF, FF, DM, (t / 16) * 64, (t % 16) * 64, 32, 0); }
    }
    const int wave = threadIdx.x >> 6, lane = threadIdx.x & 63;
    for (int u = blockIdx.x; u < NTOK / 4; u += gridDim.x) {
        const int tok = u * 4 + wave;
        rmsnorm_row(p.x + (size_t)tok * DM, p.mix_norm_even, p.xn + (size_t)tok * DM, lane);
    }
}

template <int EPI>
DI void ph_gemm_dense(const P& p, char* smem, const bf16_t* A, int lda, const bf16_t* Bt, int K, int N, int layer) {
    const int ntn = N / 128, ntiles = (NTOK / 128) * ntn;
    for (int t = blockIdx.x; t < ntiles; t += gridDim.x) {
        GemmArgs g; g.A = A; g.lda = lda; g.gather = nullptr; g.mvalid = 128; g.gshift = 0; g.Bt = Bt; g.K = K;
        g.m0 = (t / ntn) * 128; g.n0 = (t % ntn) * 128;
        gemm_tile<EPI>(p, smem, g, layer);
    }
}

template <int EPI>
DI void ph_gemm_moe(const P& p, char* smem, int layer) {
    const int ntn = (EPI == EPI_GU) ? 4 : 8;
    const int* cnt = p.cnt + layer * NEXP;
    int total = 0;
    for (int e = 0; e < NEXP; ++e) total += (cnt[e] + 127) >> 7;
    for (int u = blockIdx.x; u < total * ntn; u += gridDim.x) {
        int mt = u / ntn; const int nt = u % ntn;
        int e = 0, c = 0;
        for (; e < NEXP; ++e) { c = cnt[e]; const int t = (c + 127) >> 7; if (mt < t) break; mt -= t; }
        GemmArgs g; g.gather = p.plist + (size_t)e * LISTCAP + mt * 128; g.mvalid = c - mt * 128 < 128 ? c - mt * 128 : 128;
        g.m0 = 0; g.n0 = nt * 128;
        const int ex = layer * NEXP + e;
        if (EPI == EPI_GU) { g.A = p.xn; g.lda = DM; g.gshift = 1; g.Bt = p.wt_gu + (size_t)ex * 512 * DM; g.K = DM; }
        else { g.A = p.hid; g.lda = FF; g.gshift = 0; g.Bt = p.wt_d + (size_t)ex * DM * FF; g.K = FF; }
        gemm_tile<EPI>(p, smem, g, layer);
    }
}

DI void band_attn_unit(const P& p, char* smem, int unit) {
    float (*sq)[64] = (float (*)[64])smem;
    float (*sp)[576] = (float (*)[576])(smem + 1024);
    const int wave = threadIdx.x >> 6, lane = threadIdx.x & 63;
    const int c = unit & 63, h = (unit >> 6) & 7, b = unit >> 9;
    const float* bias = p.att_rel_bias + h * 257;
    for (int i = wave; i < 64; i += 4) {
        const int tq = c * 64 + i; const size_t tok = (size_t)b * NS + tq;
        sq[wave][lane] = bf2f(p.proj[tok * EVEN_IN + h * 64 + lane]);
        float sc[9]; float mx = -3.0e38f;
#pragma unroll
        for (int r = 0; r < 9; ++r) {
            const int j = lane + 64 * r; const int tk = (c - 8) * 64 + j;
            float s = -1e30f;
            if (tk >= 0) {
                const bf16_t* kr = p.proj + ((size_t)b * NS + tk) * EVEN_IN + 512 + h * 64;
                float d = 0.f;
                for (int dd = 0; dd < 64; ++dd) d += sq[wave][dd] * bf2f(kr[dd]);
                int dist = tq - tk; if (dist > 128) dist = 128;
                s = d + bias[dist + 128];
            }
            sc[r] = s; mx = fmaxf(mx, s);
        }
        mx = wave_max(mx);
        float sum = 0.f;
#pragma unroll
        for (int r = 0; r < 9; ++r) { const float e = __expf(sc[r] - mx); sum += e; sp[wave][lane + 64 * r] = e; }
        sum = wave_sum(sum);
        float o = 0.f;
        for (int j = 0; j < 576; ++j) {
            const int tk = (c - 8) * 64 + j;
            if (tk >= 0) o += sp[wave][j] * bf2f(p.proj[((size_t)b * NS + tk) * EVEN_IN + 1024 + h * 64 + lane]);
        }
        p.mixed[tok * DM + h * 64 + lane] = f2bf(o / sum);
    }
}

DI void pool_unit(const P& p, char* smem, int tok) {
    float* sm = (float*)smem;
    const int s = tok & (NS - 1);
    for (int ch = threadIdx.x; ch < 512; ch += 256) {
        const int g = ch >> 7, w = 2 << g;
        int lo = s + 1 - w; if (lo < 0) lo = 0;
        float sum = 0.f;
        for (int t = lo; t <= s; ++t) sum += bf2f(p.proj[(size_t)(tok - s + t) * EVEN_IN + 1536 + ch]);
        sm[ch] = sum / (float)(s + 1 - lo) - bf2f(p.proj[(size_t)tok * EVEN_IN + 1536 + ch]);
    }
    __syncthreads();
    for (int ch = threadIdx.x; ch < 512; ch += 256) {
        const int g = ch >> 7, d = ch & 127;
        float y = 0.f;
        for (int c = 0; c < 128; ++c) y += sm[g * 128 + c] * p.pool_w[(g * 128 + c) * 128 + d];
        p.mixed[(size_t)tok * DM + 512 + ch] = f2bf(y * p.pool_scale[ch]);
    }
    __syncthreads();
}

DI void ph_mix_even(const P& p, char* smem) {
    for (int u = blockIdx.x; u < NB * 8 * 64; u += gridDim.x) band_attn_unit(p, smem, u);
    __syncthreads();
    for (int u = blockIdx.x; u < NTOK; u += gridDim.x) pool_unit(p, smem, u);
}

DI void ph_sgu_norm(const P& p) {
    const int wave = threadIdx.x >> 6, lane = threadIdx.x & 63;
    for (int u = blockIdx.x; u < NTOK / 4; u += gridDim.x) {
        const int tok = u * 4 + wave;
        float v[8]; float ss = 0.f;
#pragma unroll
        for (int i = 0; i < 8; ++i) { v[i] = bf2f(p.proj[(size_t)tok * ODD_IN + 512 + i * 64 + lane]); ss += v[i] * v[i]; }
        ss = wave_sum(ss);
        const float rstd = rsqrtf(ss * (1.0f / 512.0f) + EPS);
#pragma unroll
        for (int i = 0; i < 8; ++i) p.vvn[(size_t)tok * 512 + i * 64 + lane] = f2bf(v[i] * rstd * p.sgu_v_norm[i * 64 + lane]);
    }
}

DI void sgu_mix_unit(const P& p, int tok) {
    const int tt = tok & 127, base = tok - tt;
    for (int ch = threadIdx.x; ch < 512; ch += 256) {
        const int g = ch >> 7;
        const float* wr = p.sgu_w + ((size_t)g * 128 + tt) * 128;
        float a = 0.f;
        for (int ss = 0; ss <= tt; ++ss) a += wr[ss] * bf2f(p.vvn[(size_t)(base + ss) * 512 + ch]);
        a += p.sgu_b[g * 128 + tt];
        p.mixed[(size_t)tok * DM + ch] = f2bf(bf2f(p.proj[(size_t)tok * ODD_IN + ch]) * a);
    }
}

DI void sb_attn_unit(const P& p, char* smem, int unit) {
    float (*sq)[64] = (float (*)[64])smem;
    const int wave = threadIdx.x >> 6, lane = threadIdx.x & 63;
    const int gw = unit * 4 + wave;
    const int h = gw & 7; const int tok = gw >> 3; const int t = tok & (NS - 1); const size_t tb = (size_t)(tok - t);
    sq[wave][lane] = bf2f(p.proj[(size_t)tok * ODD_IN + 1024 + h * 64 + lane]);
    float o = 0.f, carry = 0.f;
    for (int it = 0; it * 64 < t; ++it) {
        const int s = t - 1 - (it * 64 + lane);
        const bool valid = s >= 0;
        float z = 0.f, L = 0.f;
        if (valid) {
            const bf16_t* kr = p.proj + (tb + s) * ODD_IN + 1536 + h * 64;
            float d = 0.f;
            for (int dd = 0; dd < 64; ++dd) d += sq[wave][dd] * bf2f(kr[dd]);
            z = d * 0.125f;
            L = -(fmaxf(z, 0.f) + log1pf(__expf(-fabsf(z))));
        }
        float inc = L;
#pragma unroll
        for (int off = 1; off < 64; off <<= 1) { const float n = __shfl_up(inc, off); if (lane >= off) inc += n; }
        const float a = valid ? __expf(z + carry + inc) : 0.f;
        carry += __shfl(inc, 63);
        for (int jj = 0; jj < 64; ++jj) {
            const int sj = t - 1 - (it * 64 + jj);
            if (sj < 0) break;
            const float aj = __shfl(a, jj);
            o += aj * bf2f(p.proj[(tb + sj) * ODD_IN + 2048 + h * 64 + lane]);
        }
        if (carry < -104.0f) break;
    }
    p.mixed[(size_t)tok * DM + 512 + h * 64 + lane] = f2bf(o);
}

DI void ph_mix_odd(const P& p, char* smem) {
    for (int u = blockIdx.x; u < NTOK; u += gridDim.x) sgu_mix_unit(p, u);
    for (int u = blockIdx.x; u < NTOK * 8 / 4; u += gridDim.x) sb_attn_unit(p, smem, u);
}

DI void router_token(const P& p, int layer, int tok, int lane) {
    const float* hr = p.out + (size_t)tok * DM;
    const float* gn = p.ffn_norm + layer * DM;
    int* cnt = p.cnt + layer * NEXP;
    f32x4 v[4]; float ss = 0.f;
#pragma unroll
    for (int i = 0; i < 4; ++i) { v[i] = *(const f32x4*)(hr + i * 256 + lane * 4); ss += v[i][0] * v[i][0] + v[i][1] * v[i][1] + v[i][2] * v[i][2] + v[i][3] * v[i][3]; }
    ss = wave_sum(ss);
    const float rstd = rsqrtf(ss * (1.0f / DM) + EPS);
#pragma unroll
    for (int i = 0; i < 4; ++i) { const f32x4 g = *(const f32x4*)(gn + i * 256 + lane * 4); v[i] = v[i] * rstd * g;
        u32x2 w; w.x = pack2(v[i][0], v[i][1]); w.y = pack2(v[i][2], v[i][3]);
        *(u32x2*)(p.xn + (size_t)tok * DM + i * 256 + lane * 4) = w; }
    const float* wg = p.w_rg + (size_t)layer * DM * 4;
    const float* we = p.w_re + (size_t)layer * DM * 32;
    float mylogit = 0.f;
    {
        f32x4 a = (f32x4){0.f, 0.f, 0.f, 0.f};
#pragma unroll
        for (int i = 0; i < 4; ++i)
#pragma unroll
            for (int j = 0; j < 4; ++j) { const int k = i * 256 + lane * 4 + j; a += v[i][j] * *(const f32x4*)(wg + k * 4); }
#pragma unroll
        for (int o = 0; o < 4; ++o) { const float s = wave_sum(a[o]); if (lane == o) mylogit = s; }
    }
    for (int ob = 0; ob < 8; ++ob) {
        f32x4 a = (f32x4){0.f, 0.f, 0.f, 0.f};
#pragma unroll
        for (int i = 0; i < 4; ++i)
#pragma unroll
            for (int j = 0; j < 4; ++j) { const int k = i * 256 + lane * 4 + j; a += v[i][j] * *(const f32x4*)(we + k * 32 + ob * 4); }
#pragma unroll
        for (int o = 0; o < 4; ++o) { const float s = wave_sum(a[o]); if (lane == 4 + ob * 4 + o) mylogit = s; }
    }
    const float g0 = __shfl(mylogit, 0), g1 = __shfl(mylogit, 1), g2 = __shfl(mylogit, 2), g3 = __shfl(mylogit, 3);
    int gs = 0; float gm = g0;
    if (g1 > gm) { gm = g1; gs = 1; }
    if (g2 > gm) { gm = g2; gs = 2; }
    if (g3 > gm) { gm = g3; gs = 3; }
    const float gw = 1.0f / (__expf(g0 - gm) + __expf(g1 - gm) + __expf(g2 - gm) + __expf(g3 - gm));
    float ev[8];
#pragma unroll
    for (int j = 0; j < 8; ++j) ev[j] = __shfl(mylogit, 4 + gs * 8 + j);
    int i1 = 0; float v1 = ev[0];
#pragma unroll
    for (int j = 1; j < 8; ++j) if (ev[j] > v1) { v1 = ev[j]; i1 = j; }
    int i2 = -1; float v2 = -3.0e38f;
#pragma unroll
    for (int j = 0; j < 8; ++j) if (j != i1 && ev[j] > v2) { v2 = ev[j]; i2 = j; }
    const float w1 = 1.0f / (1.0f + __expf(v2 - v1));
    const float w2 = 1.0f - w1;
    if (lane == 0) {
        const int e1 = gs * 8 + i1, e2 = gs * 8 + i2;
        int pos = atomicAdd(cnt + e1, 1); p.plist[(size_t)e1 * LISTCAP + pos] = tok * 2;
        pos = atomicAdd(cnt + e2, 1); p.plist[(size_t)e2 * LISTCAP + pos] = tok * 2 + 1;
        p.pw[tok * 2] = w1 * gw; p.pw[tok * 2 + 1] = w2 * gw;
    }
}

DI void ph_router(const P& p, int layer) {
    const int wave = threadIdx.x >> 6, lane = threadIdx.x & 63;
    for (int u = blockIdx.x; u < NTOK / 4; u += gridDim.x) router_token(p, layer, u * 4 + wave, lane);
}

DI void ph_combine(const P& p, int layer) {
    const int wave = threadIdx.x >> 6, lane = threadIdx.x & 63;
    for (int u = blockIdx.x; u < NTOK / 4; u += gridDim.x) {
        const size_t tok = (size_t)u * 4 + wave;
        float* hr = p.out + tok * DM;
        f32x4 v[4]; float ss = 0.f;
#pragma unroll
        for (int i = 0; i < 4; ++i) {
            const int c = i * 256 + lane * 4;
            f32x4 h = *(const f32x4*)(hr + c);
            const u32x2 a = *(const u32x2*)(p.y + (tok * 2) * DM + c), b = *(const u32x2*)(p.y + (tok * 2 + 1) * DM + c);
            h[0] += bf2f((bf16_t)(a.x & 0xffff)) + bf2f((bf16_t)(b.x & 0xffff));
            h[1] += bf2f((bf16_t)(a.x >> 16)) + bf2f((bf16_t)(b.x >> 16));
            h[2] += bf2f((bf16_t)(a.y & 0xffff)) + bf2f((bf16_t)(b.y & 0xffff));
            h[3] += bf2f((bf16_t)(a.y >> 16)) + bf2f((bf16_t)(b.y >> 16));
            *(f32x4*)(hr + c) = h; v[i] = h;
            ss += h[0] * h[0] + h[1] * h[1] + h[2] * h[2] + h[3] * h[3];
        }
        if (layer == 0) {
            ss = wave_sum(ss);
            const float rstd = rsqrtf(ss * (1.0f / DM) + EPS);
#pragma unroll
            for (int i = 0; i < 4; ++i) { const f32x4 g = *(const f32x4*)(p.mix_norm_odd + i * 256 + lane * 4);
                u32x2 w; w.x = pack2(v[i][0] * rstd * g[0], v[i][1] * rstd * g[1]); w.y = pack2(v[i][2] * rstd * g[2], v[i][3] * rstd * g[3]);
                *(u32x2*)(p.xn + tok * DM + i * 256 + lane * 4) = w; }
        }
    }
}

constexpr int NPHASE = 16;
__global__ __launch_bounds__(256, 2) void mega(P p, int ph0, int ph1) {
    __shared__ __attribute__((aligned(16))) char smem[SMEM_BYTES];
    cg::grid_group grid = cg::this_grid();
#define PHASE(i, call) if (ph0 <= (i) && (i) < ph1) { call; if ((i) + 1 < ph1) grid.sync(); }
    PHASE(0, ph_prologue(p, smem))
    PHASE(1, (ph_gemm_dense<EPI_IN_EVEN>(p, smem, p.xn, DM, p.wt_in_even, DM, EVEN_IN, 0)))
    PHASE(2, ph_mix_even(p, smem))
    PHASE(3, (ph_gemm_dense<EPI_OUT>(p, smem, p.mixed, DM, p.wt_out_even, DM, DM, 0)))
    PHASE(4, ph_router(p, 0))
    PHASE(5, (ph_gemm_moe<EPI_GU>(p, smem, 0)))
    PHASE(6, (ph_gemm_moe<EPI_DOWN>(p, smem, 0)))
    PHASE(7, ph_combine(p, 0))
    PHASE(8, (ph_gemm_dense<EPI_IN_ODD>(p, smem, p.xn, DM, p.wt_in_odd, DM, ODD_IN, 1)))
    PHASE(9, ph_sgu_norm(p))
    PHASE(10, ph_mix_odd(p, smem))
    PHASE(11, (ph_gemm_dense<EPI_OUT>(p, smem, p.mixed, DM, p.wt_out_odd, DM, DM, 1)))
    PHASE(12, ph_router(p, 1))
    PHASE(13, (ph_gemm_moe<EPI_GU>(p, smem, 1)))
    PHASE(14, (ph_gemm_moe<EPI_DOWN>(p, smem, 1)))
    PHASE(15, ph_combine(p, 1))
}

extern "C" void kernel_launch(void* const* d_in, const int* in_sizes, int n_in, void* d_out, int out_size, void* d_ws, size_t ws_size, hipStream_t stream) {
    P p{};
    p.x = (const float*)d_in[0]; p.mix_norm_even = (const float*)d_in[1]; p.w_in_even = (const float*)d_in[2]; p.att_q_norm = (const float*)d_in[3];
    p.att_k_norm = (const float*)d_in[4]; p.att_rel_bias = (const float*)d_in[5]; p.pool_w = (const float*)d_in[6]; p.pool_scale = (const float*)d_in[7];
    p.w_out_even = (const float*)d_in[8]; p.mix_norm_odd = (const float*)d_in[9]; p.w_in_odd = (const float*)d_in[10]; p.sgu_v_norm = (const float*)d_in[11];
    p.sgu_w = (const float*)d_in[12]; p.sgu_b = (const float*)d_in[13]; p.w_out_odd = (const float*)d_in[14]; p.ffn_norm = (const float*)d_in[15];
    p.w_rg = (const float*)d_in[16]; p.w_re = (const float*)d_in[17]; p.w_gate = (const float*)d_in[18]; p.w_up = (const float*)d_in[19]; p.w_down = (const float*)d_in[20];
    p.out = (float*)d_out;
    char* ws = (char*)d_ws; size_t off = 0;
    auto take = [&](size_t bytes) { char* r = ws + off; off += (bytes + 255) & ~(size_t)255; return r; };
    p.wt_in_even = (bf16_t*)take((size_t)EVEN_IN * DM * 2);
    p.wt_out_even = (bf16_t*)take((size_t)DM * DM * 2);
    p.wt_in_odd = (bf16_t*)take((size_t)ODD_IN * DM * 2);
    p.wt_out_odd = (bf16_t*)take((size_t)DM * DM * 2);
    p.wt_gu = (bf16_t*)take((size_t)2 * NEXP * 512 * DM * 2);
    p.wt_d = (bf16_t*)take((size_t)2 * NEXP * DM * FF * 2);
    p.xn = (bf16_t*)take((size_t)NTOK * DM * 2);
    p.proj = (bf16_t*)take((size_t)NTOK * ODD_IN * 2);
    p.y = p.proj;
    p.mixed = (bf16_t*)take((size_t)NTOK * DM * 2);
    p.hid = p.mixed;
    p.vvn = p.xn;
    p.pw = (float*)take((size_t)NTOK * 2 * 4);
    p.plist = (int*)take((size_t)NEXP * LISTCAP * 4);
    p.cnt = (int*)take(256);

    static int grid_blocks = 0;
    if (!grid_blocks) {
        int dev = 0, cus = 0, per_cu = 0;
        (void)hipGetDevice(&dev);
        (void)hipDeviceGetAttribute(&cus, hipDeviceAttributeMultiprocessorCount, dev);
        (void)hipOccupancyMaxActiveBlocksPerMultiprocessor(&per_cu, mega, 256, 0);
        if (per_cu > 2) per_cu = 2;
        if (per_cu < 1) per_cu = 1;
        grid_blocks = cus * per_cu;
    }
    int ph0 = 0, ph1 = NPHASE;
    void* args[] = {&p, &ph0, &ph1};
    hipError_t e = hipLaunchCooperativeKernel((void*)mega, dim3(grid_blocks), dim3(256), args, 0, stream);
    if (e != hipSuccess) fprintf(stderr, "cooperative launch failed: %s (grid %d)\n", hipGetErrorString(e), grid_blocks);
}
```

```cpp
#include <hip/hip_runtime.h>
#include <hip/hip_cooperative_groups.h>
#include <stdint.h>
#include <stdio.h>
namespace cg = cooperative_groups;

typedef unsigned short bf16_t;
typedef short bf16x8 __attribute__((ext_vector_type(8)));
typedef float f32x4 __attribute__((ext_vector_type(4)));
typedef unsigned u32x4 __attribute__((ext_vector_type(4)));
typedef unsigned u32x2 __attribute__((ext_vector_type(2)));

#define DI __device__ __forceinline__

constexpr int NB = 4, NS = 4096, NTOK = NB * NS, DM = 1024;
constexpr int EVEN_IN = 2048, ODD_IN = 2560;
constexpr int NEXP = 32, FF = 256;
constexpr int LISTCAP = NTOK;
constexpr float EPS = 1e-6f;
constexpr float LOG2E = 1.4426950408889634f;
constexpr float QSCALE = 0.125f * LOG2E;

DI bf16_t f2bf(float x) { unsigned u = __float_as_uint(x); u += 0x7fffu + ((u >> 16) & 1u); return (bf16_t)(u >> 16); }
DI float bf2f(bf16_t b) { return __uint_as_float(((unsigned)b) << 16); }
typedef float f32x2 __attribute__((ext_vector_type(2)));
typedef __bf16 bf16x2n __attribute__((ext_vector_type(2)));
DI unsigned pack2(float lo, float hi) { f32x2 v = {lo, hi}; bf16x2n r = __builtin_convertvector(v, bf16x2n); return __builtin_bit_cast(unsigned, r); }
DI float wave_sum(float v) { for (int o = 32; o > 0; o >>= 1) v += __shfl_xor(v, o); return v; }
DI float wave_max(float v) { for (int o = 32; o > 0; o >>= 1) v = fmaxf(v, __shfl_xor(v, o)); return v; }
DI float gelu_exact(float x) { return 0.5f * x * (1.0f + erff(x * 0.70710678118654752f)); }

struct P {
    const float *x, *mix_norm_even, *w_in_even, *att_q_norm, *att_k_norm, *att_rel_bias, *pool_w, *pool_scale, *w_out_even;
    const float *mix_norm_odd, *w_in_odd, *sgu_v_norm, *sgu_w, *sgu_b, *w_out_odd, *ffn_norm, *w_rg, *w_re, *w_gate, *w_up, *w_down;
    float* out;
    bf16_t *wt_in_even, *wt_out_even, *wt_in_odd, *wt_out_odd, *wt_gu, *wt_d;
    bf16_t *xn, *proj, *mixed, *hid, *y, *vvn;
    float* pw; int* plist; int* cnt;
};

enum { EPI_IN_EVEN = 0, EPI_IN_ODD = 1, EPI_OUT = 2, EPI_GU = 3, EPI_DOWN = 4 };
constexpr int GEMM_LDS = 2 * 2 * 128 * 128 + 512;

struct GemmArgs {
    const bf16_t* A; int lda; const int* gather; int mvalid;
    int gshift;
    const bf16_t* Bt; int K;
    int m0, n0;
};

template <int EPI>
DI void gemm_tile(const P& p, char* smem, const GemmArgs& g, int layer) {
    const int tid = threadIdx.x, lane = tid & 63, wid = tid >> 6, wm = wid >> 1, wn = wid & 1, fr = lane & 15, fq = lane >> 4;
    char* As = smem; char* Bs = smem + 2 * 16384; int* rowid = (int*)(smem + 4 * 16384);
    const int kc = tid & 7, r0 = tid >> 3;
    const bf16_t* ap[4]; const bf16_t* bp[4];
    if (g.gather) { if (tid < 128) rowid[tid] = (tid < g.mvalid) ? g.gather[tid] : -1; __syncthreads(); }
#pragma unroll
    for (int i = 0; i < 4; ++i) {
        const int r = r0 + 32 * i;
        size_t arow;
        if (g.gather) { int id = rowid[r]; if (id < 0) id = rowid[0]; arow = (size_t)(id >> g.gshift); } else arow = (size_t)(g.m0 + r);
        ap[i] = g.A + arow * g.lda + kc * 8;
        bp[i] = g.Bt + (size_t)(g.n0 + r) * g.K + kc * 8;
    }
    f32x4 acc[4][4];
#pragma unroll
    for (int a = 0; a < 4; ++a)
#pragma unroll
        for (int b = 0; b < 4; ++b) acc[a][b] = (f32x4){0.f, 0.f, 0.f, 0.f};
    u32x4 ra[4], rb[4];
    const int nk = g.K / 64;
#pragma unroll
    for (int i = 0; i < 4; ++i) { ra[i] = *(const u32x4*)(ap[i]); rb[i] = *(const u32x4*)(bp[i]); }
#pragma unroll
    for (int i = 0; i < 4; ++i) { const int r = r0 + 32 * i; const int off = r * 128 + ((kc ^ (r & 7)) << 4); *(u32x4*)(As + off) = ra[i]; *(u32x4*)(Bs + off) = rb[i]; }
    __syncthreads();
    for (int kt = 0; kt < nk; ++kt) {
        const int cur = kt & 1;
        if (kt + 1 < nk) {
#pragma unroll
            for (int i = 0; i < 4; ++i) { ra[i] = *(const u32x4*)(ap[i] + (kt + 1) * 64); rb[i] = *(const u32x4*)(bp[i] + (kt + 1) * 64); }
        }
        const char* Ac = As + cur * 16384; const char* Bc = Bs + cur * 16384;
#pragma unroll
        for (int s = 0; s < 2; ++s) {
            bf16x8 af[4], bfv[4];
#pragma unroll
            for (int i = 0; i < 4; ++i) {
                const int ra_ = wm * 64 + i * 16 + fr, rb_ = wn * 64 + i * 16 + fr;
                af[i] = *(const bf16x8*)(Ac + ra_ * 128 + (((s * 4 + fq) ^ (fr & 7)) << 4));
                bfv[i] = *(const bf16x8*)(Bc + rb_ * 128 + (((s * 4 + fq) ^ (fr & 7)) << 4));
            }
#pragma unroll
            for (int mi = 0; mi < 4; ++mi)
#pragma unroll
                for (int ni = 0; ni < 4; ++ni) acc[mi][ni] = __builtin_amdgcn_mfma_f32_16x16x32_bf16(bfv[ni], af[mi], acc[mi][ni], 0, 0, 0);
        }
        if (kt + 1 < nk) {
            char* An = As + (cur ^ 1) * 16384; char* Bn = Bs + (cur ^ 1) * 16384;
#pragma unroll
            for (int i = 0; i < 4; ++i) { const int r = r0 + 32 * i; const int off = r * 128 + ((kc ^ (r & 7)) << 4); *(u32x4*)(An + off) = ra[i]; *(u32x4*)(Bn + off) = rb[i]; }
        }
        __syncthreads();
    }
    const int colw = g.n0 + wn * 64;
    if (EPI == EPI_IN_EVEN) {
        const int region = colw >> 9;
        const float* gn = region == 0 ? p.att_q_norm : p.att_k_norm;
#pragma unroll
        for (int mi = 0; mi < 4; ++mi) {
            const int row = g.m0 + wm * 64 + mi * 16 + fr;
            float sc = 1.f;
            if (region < 2) {
                float ss = 0.f;
#pragma unroll
                for (int ni = 0; ni < 4; ++ni) ss += acc[mi][ni][0] * acc[mi][ni][0] + acc[mi][ni][1] * acc[mi][ni][1] + acc[mi][ni][2] * acc[mi][ni][2] + acc[mi][ni][3] * acc[mi][ni][3];
                ss += __shfl_xor(ss, 16); ss += __shfl_xor(ss, 32);
                sc = rsqrtf(ss * (1.0f / 64.0f) + EPS) * (region == 0 ? QSCALE : 1.0f);
            }
#pragma unroll
            for (int ni = 0; ni < 4; ++ni) {
                f32x4 v = acc[mi][ni];
                if (region < 2) { const f32x4 gg = *(const f32x4*)(gn + ni * 16 + fq * 4); v = v * sc * gg; }
                u32x2 w; w.x = pack2(v[0], v[1]); w.y = pack2(v[2], v[3]);
                *(u32x2*)(p.proj + (size_t)row * EVEN_IN + colw + ni * 16 + fq * 4) = w;
            }
        }
    } else if (EPI == EPI_IN_ODD) {
        const bool act = colw < 1024;
#pragma unroll
        for (int mi = 0; mi < 4; ++mi) {
            const int row = g.m0 + wm * 64 + mi * 16 + fr;
#pragma unroll
            for (int ni = 0; ni < 4; ++ni) {
                f32x4 v = acc[mi][ni];
                if (act) { v[0] = gelu_exact(v[0]); v[1] = gelu_exact(v[1]); v[2] = gelu_exact(v[2]); v[3] = gelu_exact(v[3]); }
                else if (colw < 1536) v = v * QSCALE;
                u32x2 w; w.x = pack2(v[0], v[1]); w.y = pack2(v[2], v[3]);
                *(u32x2*)(p.proj + (size_t)row * ODD_IN + colw + ni * 16 + fq * 4) = w;
            }
        }
    } else if (EPI == EPI_OUT) {
        const float* res = layer == 0 ? p.x : p.out;
#pragma unroll
        for (int mi = 0; mi < 4; ++mi) {
            const int row = g.m0 + wm * 64 + mi * 16 + fr;
#pragma unroll
            for (int ni = 0; ni < 4; ++ni) {
                const size_t off = (size_t)row * DM + colw + ni * 16 + fq * 4;
                const f32x4 r = *(const f32x4*)(res + off);
                *(f32x4*)(p.out + off) = r + acc[mi][ni];
            }
        }
    } else if (EPI == EPI_GU) {
        const int f0 = (colw >> 6) * 32;
#pragma unroll
        for (int mi = 0; mi < 4; ++mi) {
            const int id = rowid[wm * 64 + mi * 16 + fr];
            if (id >= 0) {
                const float w = p.pw[id];
#pragma unroll
                for (int ni = 0; ni < 2; ++ni) {
                    f32x4 gt = acc[mi][ni], up = acc[mi][ni + 2], h;
#pragma unroll
                    for (int j = 0; j < 4; ++j) h[j] = gt[j] / (1.0f + __expf(-gt[j])) * up[j] * w;
                    u32x2 ww; ww.x = pack2(h[0], h[1]); ww.y = pack2(h[2], h[3]);
                    *(u32x2*)(p.hid + (size_t)id * FF + f0 + ni * 16 + fq * 4) = ww;
                }
            }
        }
    } else if (EPI == EPI_DOWN) {
#pragma unroll
        for (int mi = 0; mi < 4; ++mi) {
            const int id = rowid[wm * 64 + mi * 16 + fr];
            if (id >= 0) {
#pragma unroll
                for (int ni = 0; ni < 4; ++ni) {
                    const f32x4 v = acc[mi][ni];
                    u32x2 ww; ww.x = pack2(v[0], v[1]); ww.y = pack2(v[2], v[3]);
                    *(u32x2*)(p.y + (size_t)id * DM + colw + ni * 16 + fq * 4) = ww;
                }
            }
        }
    }
    __syncthreads();
}

constexpr int SMEM_BYTES = GEMM_LDS;

DI void transpose_unit(char* smem, const float* __restrict__ s, bf16_t* __restrict__ d, int K, int N, int k0, int n0, int rowblk, int rowoff) {
    float (*tile)[65] = (float (*)[65])smem;
    for (int i = 0; i < 16; ++i) { int idx = threadIdx.x + 256 * i; int k = idx >> 6, n = idx & 63; tile[k][n] = s[(size_t)(k0 + k) * N + n0 + n]; }
    __syncthreads();
    for (int i = 0; i < 16; ++i) { int idx = threadIdx.x + 256 * i; int n = idx >> 6, k = idx & 63; int nn = n0 + n;
        int dr = (nn >> 5) * rowblk + (nn & 31) + rowoff; d[(size_t)dr * K + k0 + k] = f2bf(tile[k][n]); }
    __syncthreads();
}

DI void rmsnorm_row(const float* __restrict__ hr, const float* __restrict__ gain, bf16_t* __restrict__ dst, int lane) {
    f32x4 v[4]; float ss = 0.f;
#pragma unroll
    for (int i = 0; i < 4; ++i) { v[i] = *(const f32x4*)(hr + i * 256 + lane * 4); ss += v[i][0] * v[i][0] + v[i][1] * v[i][1] + v[i][2] * v[i][2] + v[i][3] * v[i][3]; }
    ss = wave_sum(ss);
    const float rstd = rsqrtf(ss * (1.0f / DM) + EPS);
#pragma unroll
    for (int i = 0; i < 4; ++i) { const f32x4 g = *(const f32x4*)(gain + i * 256 + lane * 4);
        u32x2 w; w.x = pack2(v[i][0] * rstd * g[0], v[i][1] * rstd * g[1]); w.y = pack2(v[i][2] * rstd * g[2], v[i][3] * rstd * g[3]);
        *(u32x2*)(dst + i * 256 + lane * 4) = w; }
}

DI void ph_prologue(const P& p, char* smem) {
    if (blockIdx.x == 0 && threadIdx.x < 64) p.cnt[threadIdx.x] = 0;
    constexpr int U0 = 16 * 32;
    constexpr int U1 = U0 + 16 * 16;
    constexpr int U2 = U1 + 16 * 40;
    constexpr int U3 = U2 + 16 * 16;
    constexpr int U4 = U3 + 64 * 16 * 4;
    constexpr int U5 = U4 + 64 * 16 * 4;
    constexpr int U6 = U5 + 64 * 4 * 16;
    for (int u = blockIdx.x; u < U6; u += gridDim.x) {
        if (u < U0) { int t = u; transpose_unit(smem, p.w_in_even, p.wt_in_even, DM, EVEN_IN, (t / 32) * 64, (t % 32) * 64, 32, 0); }
        else if (u < U1) { int t = u - U0; transpose_unit(smem, p.w_out_even, p.wt_out_even, DM, DM, (t / 16) * 64, (t % 16) * 64, 32, 0); }
        else if (u < U2) { int t = u - U1; transpose_unit(smem, p.w_in_odd, p.wt_in_odd, DM, ODD_IN, (t / 40) * 64, (t % 40) * 64, 32, 0); }
        else if (u < U3) { int t = u - U2; transpose_unit(smem, p.w_out_odd, p.wt_out_odd, DM, DM, (t / 16) * 64, (t % 16) * 64, 32, 0); }
        else if (u < U4) { int t = u - U3; int ex = t / 64; t %= 64; transpose_unit(smem, p.w_gate + (size_t)ex * DM * FF, p.wt_gu + (size_t)ex * 512 * DM, DM, FF, (t / 4) * 64, (t % 4) * 64, 64, 0); }
        else if (u < U5) { int t = u - U4; int ex = t / 64; t %= 64; transpose_unit(smem, p.w_up + (size_t)ex * DM * FF, p.wt_gu + (size_t)ex * 512 * DM, DM, FF, (t / 4) * 64, (t % 4) * 64, 64, 32); }
        else { int t = u - U5; int ex = t / 64; t %= 64; transpose_unit(smem, p.w_down + (size_t)ex * FF * DM, p.wt_d + (size_t)ex * DM * FF, FF, DM, (t / 16) * 64, (t % 16) * 64, 32, 0); }
    }
    const int wave = threadIdx.x >> 6, lane = threadIdx.x & 63;
    for (int u = blockIdx.x; u < NTOK / 4; u += gridDim.x) {
        const int tok = u * 4 + wave;
        rmsnorm_row(p.x + (size_t)tok * DM, p.mix_norm_even, p.xn + (size_t)tok * DM, lane);
    }
}

template <int EPI>
DI void ph_gemm_dense(const P& p, char* smem, const bf16_t* A, int lda, const bf16_t* Bt, int K, int N, int layer) {
    const int ntn = N / 128, ntiles = (NTOK / 128) * ntn;
    for (int t = blockIdx.x; t < ntiles; t += gridDim.x) {
        GemmArgs g; g.A = A; g.lda = lda; g.gather = nullptr; g.mvalid = 128; g.gshift = 0; g.Bt = Bt; g.K = K;
        g.m0 = (t / ntn) * 128; g.n0 = (t % ntn) * 128;
        gemm_tile<EPI>(p, smem, g, layer);
    }
}

template <int EPI>
DI void ph_gemm_moe(const P& p, char* smem, int layer) {
    const int ntn = (EPI == EPI_GU) ? 4 : 8;
    const int* cnt = p.cnt + layer * NEXP;
    int total = 0;
    for (int e = 0; e < NEXP; ++e) total += (cnt[e] + 127) >> 7;
    for (int u = blockIdx.x; u < total * ntn; u += gridDim.x) {
        int mt = u / ntn; const int nt = u % ntn;
        int e = 0, c = 0;
        for (; e < NEXP; ++e) { c = cnt[e]; const int t = (c + 127) >> 7; if (mt < t) break; mt -= t; }
        GemmArgs g; g.gather = p.plist + (size_t)e * LISTCAP + mt * 128; g.mvalid = c - mt * 128 < 128 ? c - mt * 128 : 128;
        g.m0 = 0; g.n0 = nt * 128;
        const int ex = layer * NEXP + e;
        if (EPI == EPI_GU) { g.A = p.xn; g.lda = DM; g.gshift = 1; g.Bt = p.wt_gu + (size_t)ex * 512 * DM; g.K = DM; }
        else { g.A = p.hid; g.lda = FF; g.gshift = 0; g.Bt = p.wt_d + (size_t)ex * DM * FF; g.K = FF; }
        gemm_tile<EPI>(p, smem, g, layer);
    }
}


typedef float f32x16 __attribute__((ext_vector_type(16)));
typedef short s16x4 __attribute__((ext_vector_type(4)));
#define LDSAS __attribute__((address_space(3)))
#define MFMA32(a, b, c) __builtin_amdgcn_mfma_f32_32x32x16_bf16((a), (b), (c), 0, 0, 0)
DI int crow(int i, int h) { return (i & 3) + 8 * (i >> 2) + 4 * h; }
DI s16x4 tr_read(const char* p) { return __builtin_bit_cast(s16x4, __builtin_amdgcn_ds_read_tr16_b64_v4i16((LDSAS s16x4*)p)); }
DI float swap_max(float v) { auto rr = __builtin_amdgcn_permlane32_swap(__float_as_uint(v), __float_as_uint(v), false, false); return fmaxf(__uint_as_float(rr[0]), __uint_as_float(rr[1])); }
DI float swap_sum(float v) { auto rr = __builtin_amdgcn_permlane32_swap(__float_as_uint(v), __float_as_uint(v), false, false); return __uint_as_float(rr[0]) + __uint_as_float(rr[1]); }
DI float bcast_lo(float v) { auto rr = __builtin_amdgcn_permlane32_swap(__float_as_uint(v), __float_as_uint(v), false, false); return __uint_as_float(rr[0]); }
DI bf16x8 pack8(const f32x16& x, int s) {
    u32x4 w; w.x = pack2(x[8 * s], x[8 * s + 1]); w.y = pack2(x[8 * s + 2], x[8 * s + 3]); w.z = pack2(x[8 * s + 4], x[8 * s + 5]); w.w = pack2(x[8 * s + 6], x[8 * s + 7]);
    return __builtin_bit_cast(bf16x8, w);
}
constexpr int KV_TILE = 8192;
struct KVStage { u32x4 k[2], v[2]; };
DI void kv_load(KVStage& st, const bf16_t* kbase, const bf16_t* vbase, int ld, int key0) {
    const int tid = threadIdx.x, c = tid & 7, r0 = tid >> 3;
#pragma unroll
    for (int i = 0; i < 2; ++i) { const size_t off = (size_t)(key0 + r0 + 32 * i) * ld + c * 8; st.k[i] = *(const u32x4*)(kbase + off); st.v[i] = *(const u32x4*)(vbase + off); }
}
DI void kv_store(const KVStage& st, char* kt, char* vt) {
    const int tid = threadIdx.x, c = tid & 7, r0 = tid >> 3;
#pragma unroll
    for (int i = 0; i < 2; ++i) { const int r = r0 + 32 * i;
        *(u32x4*)(kt + r * 128 + ((c ^ ((r >> 1) & 7)) << 4)) = st.k[i];
        *(u32x4*)(vt + r * 128 + ((((c >> 2) ^ ((r >> 1) & 1))) << 6) + ((c & 3) << 4)) = st.v[i]; }
}
DI bf16x8 k_frag(const char* kt, int sb, int st, int r32, int hh) {
    const int row = sb * 32 + r32;
    return *(const bf16x8*)(kt + row * 128 + (((2 * st + hh) ^ ((row >> 1) & 7)) << 4));
}
DI bf16x8 vt_frag(const char* vt, int sb, int st, int dh, int lane) {
    const int hh = lane >> 5, g1 = (lane >> 4) & 1, pp = lane & 3, q = (lane & 15) >> 2;
    const int key = sb * 32 + 16 * st + 4 * hh + q;
    const char* a = vt + key * 128 + ((dh ^ ((q >> 1) & 1)) << 6) + g1 * 32 + pp * 8;
    const s16x4 lo = tr_read(a), hi = tr_read(a + 8 * 128);
    return (bf16x8){lo[0], lo[1], lo[2], lo[3], hi[0], hi[1], hi[2], hi[3]};
}

DI void band_attn_unit(const P& p, char* smem, int unit) {
    const int tid = threadIdx.x, lane = tid & 63, wid = tid >> 6, r32 = lane & 31, hh = lane >> 5;
    const int cp = unit & 31, h = (unit >> 5) & 7, b = unit >> 8;
    const int c = 2 * cp + (wid >> 1);
    const int tq = c * 64 + (wid & 1) * 32 + r32;
    const size_t rowb = (size_t)b * NS;
    const bf16_t* kbase = p.proj + rowb * EVEN_IN + 512 + h * 64;
    const bf16_t* vbase = p.proj + rowb * EVEN_IN + 1024 + h * 64;
    float* sbias = (float*)(smem + 4 * KV_TILE);
    __syncthreads();
    for (int i = tid; i < 257; i += 256) sbias[i] = p.att_rel_bias[h * 257 + i] * LOG2E;
    bf16x8 qf[4];
#pragma unroll
    for (int st = 0; st < 4; ++st) qf[st] = *(const bf16x8*)(p.proj + (rowb + tq) * EVEN_IN + h * 64 + st * 16 + hh * 8);
    const int ck0 = (2 * cp - 8) > 0 ? (2 * cp - 8) : 0, nt = 2 * cp + 2 - ck0;
    float m = -3.0e38f, lsum = 0.f;
    f32x16 o0, o1;
#pragma unroll
    for (int i = 0; i < 16; ++i) { o0[i] = 0.f; o1[i] = 0.f; }
    KVStage stg;
    kv_load(stg, kbase, vbase, EVEN_IN, ck0 * 64);
    kv_store(stg, smem, smem + 2 * KV_TILE);
    __syncthreads();
    for (int it = 0; it < nt; ++it) {
        const int ck = ck0 + it, cur = it & 1;
        if (it + 1 < nt) kv_load(stg, kbase, vbase, EVEN_IN, (ck + 1) * 64);
        const char* kt = smem + cur * KV_TILE; const char* vt = smem + (2 + cur) * KV_TILE;
        if (ck >= c - 8 && ck <= c) {
            f32x16 s0, s1;
#pragma unroll
            for (int i = 0; i < 16; ++i) { s0[i] = 0.f; s1[i] = 0.f; }
#pragma unroll
            for (int st = 0; st < 4; ++st) { s0 = MFMA32(k_frag(kt, 0, st, r32, hh), qf[st], s0); s1 = MFMA32(k_frag(kt, 1, st, r32, hh), qf[st], s1); }
            if (c - ck >= 3) { const float bb = sbias[256];
#pragma unroll
                for (int i = 0; i < 16; ++i) { s0[i] += bb; s1[i] += bb; }
            } else {
                const int d0 = tq - ck * 64 - 4 * hh;
#pragma unroll
                for (int i = 0; i < 16; ++i) {
                    int da = d0 - ((i & 3) + 8 * (i >> 2)), db = da - 32;
                    da = da > 128 ? 128 : da; db = db > 128 ? 128 : db;
                    s0[i] += sbias[da + 128]; s1[i] += sbias[db + 128];
                }
            }
            float tm = fmaxf(s0[0], s1[0]);
#pragma unroll
            for (int i = 1; i < 16; ++i) tm = fmaxf(tm, fmaxf(s0[i], s1[i]));
            tm = swap_max(tm);
            const float mn = fmaxf(m, tm);
            const float alpha = __builtin_amdgcn_exp2f(m - mn);
            m = mn;
            float ps = 0.f;
#pragma unroll
            for (int i = 0; i < 16; ++i) { s0[i] = __builtin_amdgcn_exp2f(s0[i] - mn); s1[i] = __builtin_amdgcn_exp2f(s1[i] - mn); ps += s0[i] + s1[i]; }
            lsum = lsum * alpha + ps;
#pragma unroll
            for (int i = 0; i < 16; ++i) { o0[i] *= alpha; o1[i] *= alpha; }
#pragma unroll
            for (int st = 0; st < 2; ++st) {
                const bf16x8 pa = pack8(s0, st), pb = pack8(s1, st);
                o0 = MFMA32(vt_frag(vt, 0, st, 0, lane), pa, o0); o1 = MFMA32(vt_frag(vt, 0, st, 1, lane), pa, o1);
                o0 = MFMA32(vt_frag(vt, 1, st, 0, lane), pb, o0); o1 = MFMA32(vt_frag(vt, 1, st, 1, lane), pb, o1);
            }
        }
        if (it + 1 < nt) kv_store(stg, smem + (cur ^ 1) * KV_TILE, smem + (2 + (cur ^ 1)) * KV_TILE);
        __syncthreads();
    }
    const float inv = 1.0f / swap_sum(lsum);
    bf16_t* orow = p.mixed + (rowb + tq) * DM + h * 64 + 4 * hh;
#pragma unroll
    for (int g = 0; g < 4; ++g) {
        u32x2 w0, w1;
        w0.x = pack2(o0[4 * g] * inv, o0[4 * g + 1] * inv); w0.y = pack2(o0[4 * g + 2] * inv, o0[4 * g + 3] * inv);
        w1.x = pack2(o1[4 * g] * inv, o1[4 * g + 1] * inv); w1.y = pack2(o1[4 * g + 2] * inv, o1[4 * g + 3] * inv);
        *(u32x2*)(orow + 8 * g) = w0; *(u32x2*)(orow + 32 + 8 * g) = w1;
    }
}

DI void sb_attn_unit(const P& p, char* smem, int unit) {
    const int tid = threadIdx.x, lane = tid & 63, wid = tid >> 6, r32 = lane & 31, hh = lane >> 5;
    const int qb = unit & 31, h = (unit >> 5) & 7, b = unit >> 8;
    const int tw = qb * 128 + wid * 32, t = tw + r32;
    const size_t rowb = (size_t)b * NS;
    const bf16_t* kbase = p.proj + rowb * ODD_IN + 1536 + h * 64;
    const bf16_t* vbase = p.proj + rowb * ODD_IN + 2048 + h * 64;
    volatile int* wdone = (volatile int*)(smem + 4 * KV_TILE);
    __syncthreads();
    bf16x8 qf[4];
#pragma unroll
    for (int st = 0; st < 4; ++st) qf[st] = *(const bf16x8*)(p.proj + (rowb + t) * ODD_IN + 1024 + h * 64 + st * 16 + hh * 8);
    bf16x8 tf[2];
#pragma unroll
    for (int st = 0; st < 2; ++st)
#pragma unroll
        for (int j = 0; j < 8; ++j) tf[st][j] = (16 * st + 8 * (j >> 2) + 4 * hh + (j & 3)) >= r32 ? (short)0x3F80 : (short)0;
    f32x16 o0, o1;
#pragma unroll
    for (int i = 0; i < 16; ++i) { o0[i] = 0.f; o1[i] = 0.f; }
    float carry = 0.f; bool done = false;
    const int kt0 = 2 * qb + 1;
    KVStage stg;
    kv_load(stg, kbase, vbase, ODD_IN, kt0 * 64);
    kv_store(stg, smem, smem + 2 * KV_TILE);
    __syncthreads();
    for (int it = 0; it <= kt0; ++it) {
        const int kt = kt0 - it, cur = it & 1;
        if (kt > 0) kv_load(stg, kbase, vbase, ODD_IN, (kt - 1) * 64);
        const char* ktile = smem + cur * KV_TILE; const char* vtile = smem + (2 + cur) * KV_TILE;
        if (!done && kt * 64 < tw + 31) {
#pragma unroll
            for (int sbi = 0; sbi < 2; ++sbi) {
                const int sb = 1 - sbi;
                f32x16 x;
#pragma unroll
                for (int i = 0; i < 16; ++i) x[i] = 0.f;
#pragma unroll
                for (int st = 0; st < 4; ++st) x = MFMA32(k_frag(ktile, sb, st, r32, hh), qf[st], x);
                const int kb = kt * 64 + sb * 32 + 4 * hh;
                f32x16 L, Lr;
#pragma unroll
                for (int i = 0; i < 16; ++i) {
                    const bool valid = kb + (i & 3) + 8 * (i >> 2) < t;
                    const float z = x[i];
                    const float sp = fmaxf(z, 0.f) + __builtin_amdgcn_logf(1.0f + __builtin_amdgcn_exp2f(-fabsf(z)));
                    L[i] = valid ? -sp : 0.f;
                    x[i] = valid ? z : -1.0e30f;
                }
                f32x16 cum;
#pragma unroll
                for (int i = 0; i < 16; ++i) cum[i] = carry;
#pragma unroll
                for (int st = 0; st < 2; ++st) {
                    const bf16x8 hi = pack8(L, st);
#pragma unroll
                    for (int j = 0; j < 8; ++j) Lr[8 * st + j] = L[8 * st + j] - __uint_as_float(((unsigned)(unsigned short)hi[j]) << 16);
                    cum = MFMA32(tf[st], hi, cum);
                }
#pragma unroll
                for (int st = 0; st < 2; ++st) cum = MFMA32(tf[st], pack8(Lr, st), cum);
                carry = bcast_lo(cum[0]);
#pragma unroll
                for (int i = 0; i < 16; ++i) x[i] = __builtin_amdgcn_exp2f(x[i] + cum[i]);
#pragma unroll
                for (int st = 0; st < 2; ++st) {
                    const bf16x8 pa = pack8(x, st);
                    o0 = MFMA32(vt_frag(vtile, sb, st, 0, lane), pa, o0); o1 = MFMA32(vt_frag(vtile, sb, st, 1, lane), pa, o1);
                }
            }
            done = __all(carry < -150.0f);
        }
        if (lane == 0) wdone[cur * 4 + wid] = done ? 1 : 0;
        if (kt > 0) kv_store(stg, smem + (cur ^ 1) * KV_TILE, smem + (2 + (cur ^ 1)) * KV_TILE);
        __syncthreads();
        if (wdone[cur * 4] + wdone[cur * 4 + 1] + wdone[cur * 4 + 2] + wdone[cur * 4 + 3] == 4) break;
    }
    bf16_t* orow = p.mixed + (rowb + t) * DM + 512 + h * 64 + 4 * hh;
#pragma unroll
    for (int g = 0; g < 4; ++g) {
        u32x2 w0, w1;
        w0.x = pack2(o0[4 * g], o0[4 * g + 1]); w0.y = pack2(o0[4 * g + 2], o0[4 * g + 3]);
        w1.x = pack2(o1[4 * g], o1[4 * g + 1]); w1.y = pack2(o1[4 * g + 2], o1[4 * g + 3]);
        *(u32x2*)(orow + 8 * g) = w0; *(u32x2*)(orow + 32 + 8 * g) = w1;
    }
}

DI void pool_unit(const P& p, char* smem, int tok) {
    float* sm = (float*)smem;
    const int s = tok & (NS - 1);
    for (int ch = threadIdx.x; ch < 512; ch += 256) {
        const int g = ch >> 7, w = 2 << g;
        int lo = s + 1 - w; if (lo < 0) lo = 0;
        float sum = 0.f;
        for (int t = lo; t <= s; ++t) sum += bf2f(p.proj[(size_t)(tok - s + t) * EVEN_IN + 1536 + ch]);
        sm[ch] = sum / (float)(s + 1 - lo) - bf2f(p.proj[(size_t)tok * EVEN_IN + 1536 + ch]);
    }
    __syncthreads();
    for (int ch = threadIdx.x; ch < 512; ch += 256) {
        const int g = ch >> 7, d = ch & 127;
        float y = 0.f;
        for (int c = 0; c < 128; ++c) y += sm[g * 128 + c] * p.pool_w[(g * 128 + c) * 128 + d];
        p.mixed[(size_t)tok * DM + 512 + ch] = f2bf(y * p.pool_scale[ch]);
    }
    __syncthreads();
}

DI void ph_mix_even(const P& p, char* smem) {
    for (int u = blockIdx.x; u < NB * 8 * 32; u += gridDim.x) band_attn_unit(p, smem, u);
    __syncthreads();
    for (int u = blockIdx.x; u < NTOK; u += gridDim.x) pool_unit(p, smem, u);
}

DI void ph_sgu_norm(const P& p) {
    const int wave = threadIdx.x >> 6, lane = threadIdx.x & 63;
    for (int u = blockIdx.x; u < NTOK / 4; u += gridDim.x) {
        const int tok = u * 4 + wave;
        float v[8]; float ss = 0.f;
#pragma unroll
        for (int i = 0; i < 8; ++i) { v[i] = bf2f(p.proj[(size_t)tok * ODD_IN + 512 + i * 64 + lane]); ss += v[i] * v[i]; }
        ss = wave_sum(ss);
        const float rstd = rsqrtf(ss * (1.0f / 512.0f) + EPS);
#pragma unroll
        for (int i = 0; i < 8; ++i) p.vvn[(size_t)tok * 512 + i * 64 + lane] = f2bf(v[i] * rstd * p.sgu_v_norm[i * 64 + lane]);
    }
}

DI void sgu_mix_unit(const P& p, int tok) {
    const int tt = tok & 127, base = tok - tt;
    for (int ch = threadIdx.x; ch < 512; ch += 256) {
        const int g = ch >> 7;
        const float* wr = p.sgu_w + ((size_t)g * 128 + tt) * 128;
        float a = 0.f;
        for (int ss = 0; ss <= tt; ++ss) a += wr[ss] * bf2f(p.vvn[(size_t)(base + ss) * 512 + ch]);
        a += p.sgu_b[g * 128 + tt];
        p.mixed[(size_t)tok * DM + ch] = f2bf(bf2f(p.proj[(size_t)tok * ODD_IN + ch]) * a);
    }
}

DI void ph_mix_odd(const P& p, char* smem) {
    for (int u = blockIdx.x; u < NTOK; u += gridDim.x) sgu_mix_unit(p, u);
    __syncthreads();
    for (int u = blockIdx.x; u < NB * 8 * 32; u += gridDim.x) sb_attn_unit(p, smem, u);
}

DI void router_token(const P& p, int layer, int tok, int lane) {
    const float* hr = p.out + (size_t)tok * DM;
    const float* gn = p.ffn_norm + layer * DM;
    int* cnt = p.cnt + layer * NEXP;
    f32x4 v[4]; float ss = 0.f;
#pragma unroll
    for (int i = 0; i < 4; ++i) { v[i] = *(const f32x4*)(hr + i * 256 + lane * 4); ss += v[i][0] * v[i][0] + v[i][1] * v[i][1] + v[i][2] * v[i][2] + v[i][3] * v[i][3]; }
    ss = wave_sum(ss);
    const float rstd = rsqrtf(ss * (1.0f / DM) + EPS);
#pragma unroll
    for (int i = 0; i < 4; ++i) { const f32x4 g = *(const f32x4*)(gn + i * 256 + lane * 4); v[i] = v[i] * rstd * g;
        u32x2 w; w.x = pack2(v[i][0], v[i][1]); w.y = pack2(v[i][2], v[i][3]);
        *(u32x2*)(p.xn + (size_t)tok * DM + i * 256 + lane * 4) = w; }
    const float* wg = p.w_rg + (size_t)layer * DM * 4;
    const float* we = p.w_re + (size_t)layer * DM * 32;
    float mylogit = 0.f;
    {
        f32x4 a = (f32x4){0.f, 0.f, 0.f, 0.f};
#pragma unroll
        for (int i = 0; i < 4; ++i)
#pragma unroll
            for (int j = 0; j < 4; ++j) { const int k = i * 256 + lane * 4 + j; a += v[i][j] * *(const f32x4*)(wg + k * 4); }
#pragma unroll
        for (int o = 0; o < 4; ++o) { const float s = wave_sum(a[o]); if (lane == o) mylogit = s; }
    }
    for (int ob = 0; ob < 8; ++ob) {
        f32x4 a = (f32x4){0.f, 0.f, 0.f, 0.f};
#pragma unroll
        for (int i = 0; i < 4; ++i)
#pragma unroll
            for (int j = 0; j < 4; ++j) { const int k = i * 256 + lane * 4 + j; a += v[i][j] * *(const f32x4*)(we + k * 32 + ob * 4); }
#pragma unroll
        for (int o = 0; o < 4; ++o) { const float s = wave_sum(a[o]); if (lane == 4 + ob * 4 + o) mylogit = s; }
    }
    const float g0 = __shfl(mylogit, 0), g1 = __shfl(mylogit, 1), g2 = __shfl(mylogit, 2), g3 = __shfl(mylogit, 3);
    int gs = 0; float gm = g0;
    if (g1 > gm) { gm = g1; gs = 1; }
    if (g2 > gm) { gm = g2; gs = 2; }
    if (g3 > gm) { gm = g3; gs = 3; }
    const float gw = 1.0f / (__expf(g0 - gm) + __expf(g1 - gm) + __expf(g2 - gm) + __expf(g3 - gm));
    float ev[8];
#pragma unroll
    for (int j = 0; j < 8; ++j) ev[j] = __shfl(mylogit, 4 + gs * 8 + j);
    int i1 = 0; float v1 = ev[0];
#pragma unroll
    for (int j = 1; j < 8; ++j) if (ev[j] > v1) { v1 = ev[j]; i1 = j; }
    int i2 = -1; float v2 = -3.0e38f;
#pragma unroll
    for (int j = 0; j < 8; ++j) if (j != i1 && ev[j] > v2) { v2 = ev[j]; i2 = j; }
    const float w1 = 1.0f / (1.0f + __expf(v2 - v1));
    const float w2 = 1.0f - w1;
    if (lane == 0) {
        const int e1 = gs * 8 + i1, e2 = gs * 8 + i2;
        int pos = atomicAdd(cnt + e1, 1); p.plist[(size_t)e1 * LISTCAP + pos] = tok * 2;
        pos = atomicAdd(cnt + e2, 1); p.plist[(size_t)e2 * LISTCAP + pos] = tok * 2 + 1;
        p.pw[tok * 2] = w1 * gw; p.pw[tok * 2 + 1] = w2 * gw;
    }
}

DI void ph_router(const P& p, int layer) {
    const int wave = threadIdx.x >> 6, lane = threadIdx.x & 63;
    for (int u = blockIdx.x; u < NTOK / 4; u += gridDim.x) router_token(p, layer, u * 4 + wave, lane);
}

DI void ph_combine(const P& p, int layer) {
    const int wave = threadIdx.x >> 6, lane = threadIdx.x & 63;
    for (int u = blockIdx.x; u < NTOK / 4; u += gridDim.x) {
        const size_t tok = (size_t)u * 4 + wave;
        float* hr = p.out + tok * DM;
        f32x4 v[4]; float ss = 0.f;
#pragma unroll
        for (int i = 0; i < 4; ++i) {
            const int c = i * 256 + lane * 4;
            f32x4 h = *(const f32x4*)(hr + c);
            const u32x2 a = *(const u32x2*)(p.y + (tok * 2) * DM + c), b = *(const u32x2*)(p.y + (tok * 2 + 1) * DM + c);
            h[0] += bf2f((bf16_t)(a.x & 0xffff)) + bf2f((bf16_t)(b.x & 0xffff));
            h[1] += bf2f((bf16_t)(a.x >> 16)) + bf2f((bf16_t)(b.x >> 16));
            h[2] += bf2f((bf16_t)(a.y & 0xffff)) + bf2f((bf16_t)(b.y & 0xffff));
            h[3] += bf2f((bf16_t)(a.y >> 16)) + bf2f((bf16_t)(b.y >> 16));
            *(f32x4*)(hr + c) = h; v[i] = h;
            ss += h[0] * h[0] + h[1] * h[1] + h[2] * h[2] + h[3] * h[3];
        }
        if (layer == 0) {
            ss = wave_sum(ss);
            const float rstd = rsqrtf(ss * (1.0f / DM) + EPS);
#pragma unroll
            for (int i = 0; i < 4; ++i) { const f32x4 g = *(const f32x4*)(p.mix_norm_odd + i * 256 + lane * 4);
                u32x2 w; w.x = pack2(v[i][0] * rstd * g[0], v[i][1] * rstd * g[1]); w.y = pack2(v[i][2] * rstd * g[2], v[i][3] * rstd * g[3]);
                *(u32x2*)(p.xn + tok * DM + i * 256 + lane * 4) = w; }
        }
    }
}

constexpr int NPHASE = 16;
__global__ __launch_bounds__(256, 2) void mega(P p, int ph0, int ph1) {
    __shared__ __attribute__((aligned(16))) char smem[SMEM_BYTES];
    cg::grid_group grid = cg::this_grid();
#define PHASE(i, call) if (ph0 <= (i) && (i) < ph1) { call; if ((i) + 1 < ph1) grid.sync(); }
    PHASE(0, ph_prologue(p, smem))
    PHASE(1, (ph_gemm_dense<EPI_IN_EVEN>(p, smem, p.xn, DM, p.wt_in_even, DM, EVEN_IN, 0)))
    PHASE(2, ph_mix_even(p, smem))
    PHASE(3, (ph_gemm_dense<EPI_OUT>(p, smem, p.mixed, DM, p.wt_out_even, DM, DM, 0)))
    PHASE(4, ph_router(p, 0))
    PHASE(5, (ph_gemm_moe<EPI_GU>(p, smem, 0)))
    PHASE(6, (ph_gemm_moe<EPI_DOWN>(p, smem, 0)))
    PHASE(7, ph_combine(p, 0))
    PHASE(8, (ph_gemm_dense<EPI_IN_ODD>(p, smem, p.xn, DM, p.wt_in_odd, DM, ODD_IN, 1)))
    PHASE(9, ph_sgu_norm(p))
    PHASE(10, ph_mix_odd(p, smem))
    PHASE(11, (ph_gemm_dense<EPI_OUT>(p, smem, p.mixed, DM, p.wt_out_odd, DM, DM, 1)))
    PHASE(12, ph_router(p, 1))
    PHASE(13, (ph_gemm_moe<EPI_GU>(p, smem, 1)))
    PHASE(14, (ph_gemm_moe<EPI_DOWN>(p, smem, 1)))
    PHASE(15, ph_combine(p, 1))
}

extern "C" void kernel_launch(void* const* d_in, const int* in_sizes, int n_in, void* d_out, int out_size, void* d_ws, size_t ws_size, hipStream_t stream) {
    P p{};
    p.x = (const float*)d_in[0]; p.mix_norm_even = (const float*)d_in[1]; p.w_in_even = (const float*)d_in[2]; p.att_q_norm = (const float*)d_in[3];
    p.att_k_norm = (const float*)d_in[4]; p.att_rel_bias = (const float*)d_in[5]; p.pool_w = (const float*)d_in[6]; p.pool_scale = (const float*)d_in[7];
    p.w_out_even = (const float*)d_in[8]; p.mix_norm_odd = (const float*)d_in[9]; p.w_in_odd = (const float*)d_in[10]; p.sgu_v_norm = (const float*)d_in[11];
    p.sgu_w = (const float*)d_in[12]; p.sgu_b = (const float*)d_in[13]; p.w_out_odd = (const float*)d_in[14]; p.ffn_norm = (const float*)d_in[15];
    p.w_rg = (const float*)d_in[16]; p.w_re = (const float*)d_in[17]; p.w_gate = (const float*)d_in[18]; p.w_up = (const float*)d_in[19]; p.w_down = (const float*)d_in[20];
    p.out = (float*)d_out;
    char* ws = (char*)d_ws; size_t off = 0;
    auto take = [&](size_t bytes) { char* r = ws + off; off += (bytes + 255) & ~(size_t)255; return r; };
    p.wt_in_even = (bf16_t*)take((size_t)EVEN_IN * DM * 2);
    p.wt_out_even = (bf16_t*)take((size_t)DM * DM * 2);
    p.wt_in_odd = (bf16_t*)take((size_t)ODD_IN * DM * 2);
    p.wt_out_odd = (bf16_t*)take((size_t)DM * DM * 2);
    p.wt_gu = (bf16_t*)take((size_t)2 * NEXP * 512 * DM * 2);
    p.wt_d = (bf16_t*)take((size_t)2 * NEXP * DM * FF * 2);
    p.xn = (bf16_t*)take((size_t)NTOK * DM * 2);
    p.proj = (bf16_t*)take((size_t)NTOK * ODD_IN * 2);
    p.y = p.proj;
    p.mixed = (bf16_t*)take((size_t)NTOK * DM * 2);
    p.hid = p.mixed;
    p.vvn = p.xn;
    p.pw = (float*)take((size_t)NTOK * 2 * 4);
    p.plist = (int*)take((size_t)NEXP * LISTCAP * 4);
    p.cnt = (int*)take(256);

    static int grid_blocks = 0;
    if (!grid_blocks) {
        int dev = 0, cus = 0, per_cu = 0;
        (void)hipGetDevice(&dev);
        (void)hipDeviceGetAttribute(&cus, hipDeviceAttributeMultiprocessorCount, dev);
        (void)hipOccupancyMaxActiveBlocksPerMultiprocessor(&per_cu, mega, 256, 0);
        if (per_cu > 2) per_cu = 2;
        if (per_cu < 1) per_cu = 1;
        grid_blocks = cus * per_cu;
    }
    int ph0 = 0, ph1 = NPHASE;
    void* args[] = {&p, &ph0, &ph1};
    hipError_t e = hipLaunchCooperativeKernel((void*)mega, dim3(grid_blocks), dim3(256), args, 0, stream);
    if (e != hipSuccess) fprintf(stderr, "cooperative launch failed: %s (grid %d)\n", hipGetErrorString(e), grid_blocks);
}
```

```cpp
#include <hip/hip_runtime.h>
#include <hip/hip_cooperative_groups.h>
#include <stdint.h>
#include <stdio.h>
namespace cg = cooperative_groups;

typedef unsigned short bf16_t;
typedef short bf16x8 __attribute__((ext_vector_type(8)));
typedef float f32x4 __attribute__((ext_vector_type(4)));
typedef unsigned u32x4 __attribute__((ext_vector_type(4)));
typedef unsigned u32x2 __attribute__((ext_vector_type(2)));

#define DI __device__ __forceinline__

constexpr int NB = 4, NS = 4096, NTOK = NB * NS, DM = 1024;
constexpr int EVEN_IN = 2048, ODD_IN = 2560;
constexpr int NEXP = 32, FF = 256;
constexpr int LISTCAP = NTOK;
constexpr float EPS = 1e-6f;
constexpr float LOG2E = 1.4426950408889634f;
constexpr float QSCALE = 0.125f * LOG2E;

DI bf16_t f2bf(float x) { unsigned u = __float_as_uint(x); u += 0x7fffu + ((u >> 16) & 1u); return (bf16_t)(u >> 16); }
DI float bf2f(bf16_t b) { return __uint_as_float(((unsigned)b) << 16); }
typedef float f32x2 __attribute__((ext_vector_type(2)));
typedef __bf16 bf16x2n __attribute__((ext_vector_type(2)));
DI unsigned pack2(float lo, float hi) { f32x2 v = {lo, hi}; bf16x2n r = __builtin_convertvector(v, bf16x2n); return __builtin_bit_cast(unsigned, r); }
DI float wave_sum(float v) { for (int o = 32; o > 0; o >>= 1) v += __shfl_xor(v, o); return v; }
DI float wave_max(float v) { for (int o = 32; o > 0; o >>= 1) v = fmaxf(v, __shfl_xor(v, o)); return v; }
DI float gelu_exact(float x) { return 0.5f * x * (1.0f + erff(x * 0.70710678118654752f)); }

struct P {
    const float *x, *mix_norm_even, *w_in_even, *att_q_norm, *att_k_norm, *att_rel_bias, *pool_w, *pool_scale, *w_out_even;
    const float *mix_norm_odd, *w_in_odd, *sgu_v_norm, *sgu_w, *sgu_b, *w_out_odd, *ffn_norm, *w_rg, *w_re, *w_gate, *w_up, *w_down;
    float* out;
    bf16_t *wt_in_even, *wt_out_even, *wt_in_odd, *wt_out_odd, *wt_gu, *wt_d;
    bf16_t *xn, *proj, *mixed, *hid, *y;
    float* pw; int* plist; int* cnt; unsigned* bar;
};

enum { EPI_IN_EVEN = 0, EPI_IN_ODD = 1, EPI_OUT = 2, EPI_GU = 3, EPI_DOWN = 4 };
constexpr int GEMM_LDS = 2 * 2 * 128 * 128 + 512;

struct GemmArgs {
    const bf16_t* A; int lda; const int* gather; int mvalid;
    int gshift;
    const bf16_t* Bt; int K;
    int m0, n0;
};

template <int EPI>
DI void gemm_tile(const P& p, char* smem, const GemmArgs& g, int layer) {
    const int tid = threadIdx.x, lane = tid & 63, wid = tid >> 6, wm = wid >> 1, wn = wid & 1, fr = lane & 15, fq = lane >> 4;
    char* As = smem; char* Bs = smem + 2 * 16384; int* rowid = (int*)(smem + 4 * 16384);
    const int kc = tid & 7, r0 = tid >> 3;
    const bf16_t* ap[4]; const bf16_t* bp[4];
    if (g.gather) { if (tid < 128) rowid[tid] = (tid < g.mvalid) ? g.gather[tid] : -1; __syncthreads(); }
#pragma unroll
    for (int i = 0; i < 4; ++i) {
        const int r = r0 + 32 * i;
        size_t arow;
        if (g.gather) { int id = rowid[r]; if (id < 0) id = rowid[0]; arow = (size_t)(id >> g.gshift); } else arow = (size_t)(g.m0 + r);
        ap[i] = g.A + arow * g.lda + kc * 8;
        bp[i] = g.Bt + (size_t)(g.n0 + r) * g.K + kc * 8;
    }
    f32x4 acc[4][4];
#pragma unroll
    for (int a = 0; a < 4; ++a)
#pragma unroll
        for (int b = 0; b < 4; ++b) acc[a][b] = (f32x4){0.f, 0.f, 0.f, 0.f};
    u32x4 ra[4], rb[4];
    const int nk = g.K / 64;
#pragma unroll
    for (int i = 0; i < 4; ++i) { ra[i] = *(const u32x4*)(ap[i]); rb[i] = *(const u32x4*)(bp[i]); }
#pragma unroll
    for (int i = 0; i < 4; ++i) { const int r = r0 + 32 * i; const int off = r * 128 + ((kc ^ (r & 7)) << 4); *(u32x4*)(As + off) = ra[i]; *(u32x4*)(Bs + off) = rb[i]; }
    __syncthreads();
    for (int kt = 0; kt < nk; ++kt) {
        const int cur = kt & 1;
        if (kt + 1 < nk) {
#pragma unroll
            for (int i = 0; i < 4; ++i) { ra[i] = *(const u32x4*)(ap[i] + (kt + 1) * 64); rb[i] = *(const u32x4*)(bp[i] + (kt + 1) * 64); }
        }
        const char* Ac = As + cur * 16384; const char* Bc = Bs + cur * 16384;
#pragma unroll
        for (int s = 0; s < 2; ++s) {
            bf16x8 af[4], bfv[4];
#pragma unroll
            for (int i = 0; i < 4; ++i) {
                const int ra_ = wm * 64 + i * 16 + fr, rb_ = wn * 64 + i * 16 + fr;
                af[i] = *(const bf16x8*)(Ac + ra_ * 128 + (((s * 4 + fq) ^ (fr & 7)) << 4));
                bfv[i] = *(const bf16x8*)(Bc + rb_ * 128 + (((s * 4 + fq) ^ (fr & 7)) << 4));
            }
#pragma unroll
            for (int mi = 0; mi < 4; ++mi)
#pragma unroll
                for (int ni = 0; ni < 4; ++ni) acc[mi][ni] = __builtin_amdgcn_mfma_f32_16x16x32_bf16(bfv[ni], af[mi], acc[mi][ni], 0, 0, 0);
        }
        if (kt + 1 < nk) {
            char* An = As + (cur ^ 1) * 16384; char* Bn = Bs + (cur ^ 1) * 16384;
#pragma unroll
            for (int i = 0; i < 4; ++i) { const int r = r0 + 32 * i; const int off = r * 128 + ((kc ^ (r & 7)) << 4); *(u32x4*)(An + off) = ra[i]; *(u32x4*)(Bn + off) = rb[i]; }
        }
        __syncthreads();
    }
    const int colw = g.n0 + wn * 64;
    if (EPI == EPI_IN_EVEN) {
        const int region = colw >> 9;
        const float* gn = region == 0 ? p.att_q_norm : p.att_k_norm;
#pragma unroll
        for (int mi = 0; mi < 4; ++mi) {
            const int row = g.m0 + wm * 64 + mi * 16 + fr;
            float sc = 1.f;
            if (region < 2) {
                float ss = 0.f;
#pragma unroll
                for (int ni = 0; ni < 4; ++ni) ss += acc[mi][ni][0] * acc[mi][ni][0] + acc[mi][ni][1] * acc[mi][ni][1] + acc[mi][ni][2] * acc[mi][ni][2] + acc[mi][ni][3] * acc[mi][ni][3];
                ss += __shfl_xor(ss, 16); ss += __shfl_xor(ss, 32);
                sc = rsqrtf(ss * (1.0f / 64.0f) + EPS) * (region == 0 ? QSCALE : 1.0f);
            }
#pragma unroll
            for (int ni = 0; ni < 4; ++ni) {
                f32x4 v = acc[mi][ni];
                if (region < 2) { const f32x4 gg = *(const f32x4*)(gn + ni * 16 + fq * 4); v = v * sc * gg; }
                u32x2 w; w.x = pack2(v[0], v[1]); w.y = pack2(v[2], v[3]);
                *(u32x2*)(p.proj + (size_t)row * EVEN_IN + colw + ni * 16 + fq * 4) = w;
            }
        }
    } else if (EPI == EPI_IN_ODD) {
        const bool act = colw < 1024;
#pragma unroll
        for (int mi = 0; mi < 4; ++mi) {
            const int row = g.m0 + wm * 64 + mi * 16 + fr;
#pragma unroll
            for (int ni = 0; ni < 4; ++ni) {
                f32x4 v = acc[mi][ni];
                if (act) { v[0] = gelu_exact(v[0]); v[1] = gelu_exact(v[1]); v[2] = gelu_exact(v[2]); v[3] = gelu_exact(v[3]); }
                else if (colw < 1536) v = v * QSCALE;
                u32x2 w; w.x = pack2(v[0], v[1]); w.y = pack2(v[2], v[3]);
                *(u32x2*)(p.proj + (size_t)row * ODD_IN + colw + ni * 16 + fq * 4) = w;
            }
        }
    } else if (EPI == EPI_OUT) {
        const float* res = layer == 0 ? p.x : p.out;
#pragma unroll
        for (int mi = 0; mi < 4; ++mi) {
            const int row = g.m0 + wm * 64 + mi * 16 + fr;
#pragma unroll
            for (int ni = 0; ni < 4; ++ni) {
                const size_t off = (size_t)row * DM + colw + ni * 16 + fq * 4;
                const f32x4 r = *(const f32x4*)(res + off);
                *(f32x4*)(p.out + off) = r + acc[mi][ni];
            }
        }
    } else if (EPI == EPI_GU) {
        const int f0 = (colw >> 6) * 32;
#pragma unroll
        for (int mi = 0; mi < 4; ++mi) {
            const int id = rowid[wm * 64 + mi * 16 + fr];
            if (id >= 0) {
                const float w = p.pw[id];
#pragma unroll
                for (int ni = 0; ni < 2; ++ni) {
                    f32x4 gt = acc[mi][ni], up = acc[mi][ni + 2], h;
#pragma unroll
                    for (int j = 0; j < 4; ++j) h[j] = gt[j] / (1.0f + __expf(-gt[j])) * up[j] * w;
                    u32x2 ww; ww.x = pack2(h[0], h[1]); ww.y = pack2(h[2], h[3]);
                    *(u32x2*)(p.hid + (size_t)id * FF + f0 + ni * 16 + fq * 4) = ww;
                }
            }
        }
    } else if (EPI == EPI_DOWN) {
#pragma unroll
        for (int mi = 0; mi < 4; ++mi) {
            const int id = rowid[wm * 64 + mi * 16 + fr];
            if (id >= 0) {
#pragma unroll
                for (int ni = 0; ni < 4; ++ni) {
                    const f32x4 v = acc[mi][ni];
                    u32x2 ww; ww.x = pack2(v[0], v[1]); ww.y = pack2(v[2], v[3]);
                    *(u32x2*)(p.y + (size_t)id * DM + colw + ni * 16 + fq * 4) = ww;
                }
            }
        }
    }
    __syncthreads();
}

constexpr int SMEM_BYTES = GEMM_LDS;

DI void transpose_store(char* smem, bf16_t* __restrict__ d, int K, int k0, int n0, int rowblk, int rowoff) {
    float (*tile)[65] = (float (*)[65])smem;
#pragma unroll
    for (int i = 0; i < 2; ++i) { const int idx = threadIdx.x + 256 * i; const int n = idx >> 3, kc = idx & 7; const int nn = n0 + n;
        const int dr = (nn >> 5) * rowblk + (nn & 31) + rowoff;
        u32x4 w; w.x = pack2(tile[kc * 8][n], tile[kc * 8 + 1][n]); w.y = pack2(tile[kc * 8 + 2][n], tile[kc * 8 + 3][n]);
        w.z = pack2(tile[kc * 8 + 4][n], tile[kc * 8 + 5][n]); w.w = pack2(tile[kc * 8 + 6][n], tile[kc * 8 + 7][n]);
        *(u32x4*)(d + (size_t)dr * K + k0 + kc * 8) = w; }
    __syncthreads();
}
DI void transpose_unit(char* smem, const float* __restrict__ s, bf16_t* __restrict__ d, int K, int N, int k0, int n0, int rowblk, int rowoff) {
    float (*tile)[65] = (float (*)[65])smem;
#pragma unroll
    for (int i = 0; i < 4; ++i) { const int idx = threadIdx.x + 256 * i; const int k = idx >> 4, n4 = (idx & 15) * 4;
        const f32x4 v = *(const f32x4*)(s + (size_t)(k0 + k) * N + n0 + n4);
        tile[k][n4] = v[0]; tile[k][n4 + 1] = v[1]; tile[k][n4 + 2] = v[2]; tile[k][n4 + 3] = v[3]; }
    __syncthreads();
    transpose_store(smem, d, K, k0, n0, rowblk, rowoff);
}
DI void poolfold_unit(const P& p, char* smem, int k0, int n0) {
    float (*tile)[65] = (float (*)[65])smem;
    const int g = k0 >> 7, c0 = k0 & 127;
    for (int i = 0; i < 16; ++i) {
        const int idx = threadIdx.x + 256 * i; const int kk = idx >> 6, nn = idx & 63;
        const float* pw = p.pool_w + (size_t)(g * 128 + c0 + kk) * 128;
        const float* wo = p.w_out_even + (size_t)(512 + g * 128) * DM + n0 + nn;
        float a = 0.f;
        for (int d = 0; d < 128; ++d) a += pw[d] * p.pool_scale[g * 128 + d] * wo[(size_t)d * DM];
        tile[kk][nn] = a;
    }
    __syncthreads();
    transpose_store(smem, p.wt_out_even, DM, 512 + k0, n0, 32, 0);
}

DI void rmsnorm_row(const float* __restrict__ hr, const float* __restrict__ gain, bf16_t* __restrict__ dst, int lane) {
    f32x4 v[4]; float ss = 0.f;
#pragma unroll
    for (int i = 0; i < 4; ++i) { v[i] = *(const f32x4*)(hr + i * 256 + lane * 4); ss += v[i][0] * v[i][0] + v[i][1] * v[i][1] + v[i][2] * v[i][2] + v[i][3] * v[i][3]; }
    ss = wave_sum(ss);
    const float rstd = rsqrtf(ss * (1.0f / DM) + EPS);
#pragma unroll
    for (int i = 0; i < 4; ++i) { const f32x4 g = *(const f32x4*)(gain + i * 256 + lane * 4);
        u32x2 w; w.x = pack2(v[i][0] * rstd * g[0], v[i][1] * rstd * g[1]); w.y = pack2(v[i][2] * rstd * g[2], v[i][3] * rstd * g[3]);
        *(u32x2*)(dst + i * 256 + lane * 4) = w; }
}

DI void ph_prologue(const P& p, char* smem) {
    if (blockIdx.x == 0 && threadIdx.x < 64) p.cnt[threadIdx.x] = 0;
    constexpr int UF = 8 * 16;
    constexpr int U0 = UF + 16 * 32;
    constexpr int U1 = U0 + 8 * 16;
    constexpr int U2 = U1 + 16 * 40;
    constexpr int U3 = U2 + 16 * 16;
    constexpr int U4 = U3 + 64 * 16 * 4;
    constexpr int U5 = U4 + 64 * 16 * 4;
    constexpr int U6 = U5 + 64 * 4 * 16;
    for (int u = blockIdx.x; u < U6; u += gridDim.x) {
        if (u < UF) { poolfold_unit(p, smem, (u / 16) * 64, (u % 16) * 64); }
        else if (u < U0) { int t = u - UF; transpose_unit(smem, p.w_in_even, p.wt_in_even, DM, EVEN_IN, (t / 32) * 64, (t % 32) * 64, 32, 0); }
        else if (u < U1) { int t = u - U0; transpose_unit(smem, p.w_out_even, p.wt_out_even, DM, DM, (t / 16) * 64, (t % 16) * 64, 32, 0); }
        else if (u < U2) { int t = u - U1; transpose_unit(smem, p.w_in_odd, p.wt_in_odd, DM, ODD_IN, (t / 40) * 64, (t % 40) * 64, 32, 0); }
        else if (u < U3) { int t = u - U2; transpose_unit(smem, p.w_out_odd, p.wt_out_odd, DM, DM, (t / 16) * 64, (t % 16) * 64, 32, 0); }
        else if (u < U4) { int t = u - U3; int ex = t / 64; t %= 64; transpose_unit(smem, p.w_gate + (size_t)ex * DM * FF, p.wt_gu + (size_t)ex * 512 * DM, DM, FF, (t / 4) * 64, (t % 4) * 64, 64, 0); }
        else if (u < U5) { int t = u - U4; int ex = t / 64; t %= 64; transpose_unit(smem, p.w_up + (size_t)ex * DM * FF, p.wt_gu + (size_t)ex * 512 * DM, DM, FF, (t / 4) * 64, (t % 4) * 64, 64, 32); }
        else { int t = u - U5; int ex = t / 64; t %= 64; transpose_unit(smem, p.w_down + (size_t)ex * FF * DM, p.wt_d + (size_t)ex * DM * FF, FF, DM, (t / 16) * 64, (t % 16) * 64, 32, 0); }
    }
    const int wave = threadIdx.x >> 6, lane = threadIdx.x & 63;
    for (int u = blockIdx.x; u < NTOK / 4; u += gridDim.x) {
        const int tok = u * 4 + wave;
        rmsnorm_row(p.x + (size_t)tok * DM, p.mix_norm_even, p.xn + (size_t)tok * DM, lane);
    }
}

template <int EPI>
DI void ph_gemm_dense(const P& p, char* smem, const bf16_t* A, int lda, const bf16_t* Bt, int K, int N, int layer) {
    const int ntn = N / 128, ntiles = (NTOK / 128) * ntn;
    for (int t = blockIdx.x; t < ntiles; t += gridDim.x) {
        GemmArgs g; g.A = A; g.lda = lda; g.gather = nullptr; g.mvalid = 128; g.gshift = 0; g.Bt = Bt; g.K = K;
        g.m0 = (t / ntn) * 128; g.n0 = (t % ntn) * 128;
        gemm_tile<EPI>(p, smem, g, layer);
    }
}

template <int EPI>
DI void ph_gemm_moe(const P& p, char* smem, int layer) {
    const int ntn = (EPI == EPI_GU) ? 4 : 8;
    const int* cnt = p.cnt + layer * NEXP;
    int total = 0;
    for (int e = 0; e < NEXP; ++e) total += (cnt[e] + 127) >> 7;
    for (int u = blockIdx.x; u < total * ntn; u += gridDim.x) {
        int mt = u / ntn; const int nt = u % ntn;
        int e = 0, c = 0;
        for (; e < NEXP; ++e) { c = cnt[e]; const int t = (c + 127) >> 7; if (mt < t) break; mt -= t; }
        GemmArgs g; g.gather = p.plist + (size_t)e * LISTCAP + mt * 128; g.mvalid = c - mt * 128 < 128 ? c - mt * 128 : 128;
        g.m0 = 0; g.n0 = nt * 128;
        const int ex = layer * NEXP + e;
        if (EPI == EPI_GU) { g.A = p.xn; g.lda = DM; g.gshift = 1; g.Bt = p.wt_gu + (size_t)ex * 512 * DM; g.K = DM; }
        else { g.A = p.hid; g.lda = FF; g.gshift = 0; g.Bt = p.wt_d + (size_t)ex * DM * FF; g.K = FF; }
        gemm_tile<EPI>(p, smem, g, layer);
    }
}


typedef float f32x16 __attribute__((ext_vector_type(16)));
typedef short s16x4 __attribute__((ext_vector_type(4)));
#define LDSAS __attribute__((address_space(3)))
#define MFMA32(a, b, c) __builtin_amdgcn_mfma_f32_32x32x16_bf16((a), (b), (c), 0, 0, 0)
DI int crow(int i, int h) { return (i & 3) + 8 * (i >> 2) + 4 * h; }
DI s16x4 tr_read(const char* p) { return __builtin_bit_cast(s16x4, __builtin_amdgcn_ds_read_tr16_b64_v4i16((LDSAS s16x4*)p)); }
DI float swap_max(float v) { auto rr = __builtin_amdgcn_permlane32_swap(__float_as_uint(v), __float_as_uint(v), false, false); return fmaxf(__uint_as_float(rr[0]), __uint_as_float(rr[1])); }
DI float swap_sum(float v) { auto rr = __builtin_amdgcn_permlane32_swap(__float_as_uint(v), __float_as_uint(v), false, false); return __uint_as_float(rr[0]) + __uint_as_float(rr[1]); }
DI float bcast_lo(float v) { auto rr = __builtin_amdgcn_permlane32_swap(__float_as_uint(v), __float_as_uint(v), false, false); return __uint_as_float(rr[0]); }
DI bf16x8 pack8(const f32x16& x, int s) {
    u32x4 w; w.x = pack2(x[8 * s], x[8 * s + 1]); w.y = pack2(x[8 * s + 2], x[8 * s + 3]); w.z = pack2(x[8 * s + 4], x[8 * s + 5]); w.w = pack2(x[8 * s + 6], x[8 * s + 7]);
    return __builtin_bit_cast(bf16x8, w);
}
constexpr int KV_TILE = 8192;
struct KVStage { u32x4 k[2], v[2]; };
DI void kv_load(KVStage& st, const bf16_t* kbase, const bf16_t* vbase, int ld, int key0) {
    const int tid = threadIdx.x, c = tid & 7, r0 = tid >> 3;
#pragma unroll
    for (int i = 0; i < 2; ++i) { const size_t off = (size_t)(key0 + r0 + 32 * i) * ld + c * 8; st.k[i] = *(const u32x4*)(kbase + off); st.v[i] = *(const u32x4*)(vbase + off); }
}
DI void kv_store(const KVStage& st, char* kt, char* vt) {
    const int tid = threadIdx.x, c = tid & 7, r0 = tid >> 3;
#pragma unroll
    for (int i = 0; i < 2; ++i) { const int r = r0 + 32 * i;
        *(u32x4*)(kt + r * 128 + ((c ^ ((r >> 1) & 7)) << 4)) = st.k[i];
        *(u32x4*)(vt + r * 128 + ((((c >> 2) ^ ((r >> 1) & 1))) << 6) + ((c & 3) << 4)) = st.v[i]; }
}
DI bf16x8 k_frag(const char* kt, int sb, int st, int r32, int hh) {
    const int row = sb * 32 + r32;
    return *(const bf16x8*)(kt + row * 128 + (((2 * st + hh) ^ ((row >> 1) & 7)) << 4));
}
DI bf16x8 vt_frag(const char* vt, int sb, int st, int dh, int lane) {
    const int hh = lane >> 5, g1 = (lane >> 4) & 1, pp = lane & 3, q = (lane & 15) >> 2;
    const int key = sb * 32 + 16 * st + 4 * hh + q;
    const char* a = vt + key * 128 + ((dh ^ ((q >> 1) & 1)) << 6) + g1 * 32 + pp * 8;
    const s16x4 lo = tr_read(a), hi = tr_read(a + 8 * 128);
    return (bf16x8){lo[0], lo[1], lo[2], lo[3], hi[0], hi[1], hi[2], hi[3]};
}


#define XB_TMO      128
#define XB_XCNT(j)  (256  + 64 * (j))
#define XB_XSUB(j)  (1280 + 64 * (j))
#define XB_XGEN(j)  (2304 + 64 * (j))
#define XB_TOP      3328
#define XB_TOPGEN   3392
#define XCD_BAR_WORDS 3456
#define XB_SPIN_CAP (1u << 22)
DI unsigned xb_ld(unsigned* q)              { return __hip_atomic_load(q, __ATOMIC_RELAXED, __HIP_MEMORY_SCOPE_AGENT); }
DI unsigned xb_add(unsigned* q, unsigned v) { return __hip_atomic_fetch_add(q, v, __ATOMIC_RELAXED, __HIP_MEMORY_SCOPE_AGENT); }
DI unsigned xb_xcc_id() { return (unsigned)__builtin_amdgcn_s_getreg((3 << 11) | 20) & 0xFu; }
#define XB_SPIN(cond, bar) do { unsigned _sp = 0; while (cond) { __builtin_amdgcn_s_sleep(1); \
    if ((++_sp & 255u) == 0u) { if (xb_ld(&(bar)[XB_TMO])) break; if (_sp > XB_SPIN_CAP) { atomicAdd(&(bar)[XB_TMO], 1u); break; } } } } while (0)
struct XcdBarrier { unsigned* bar; unsigned x; volatile LDSAS unsigned* st; };
DI XcdBarrier xcd_barrier_post(unsigned* bar, volatile LDSAS unsigned* st) {
    XcdBarrier b; b.bar = bar; b.x = xb_xcc_id(); b.st = st;
    if (threadIdx.x == 0) (void)xb_add(&bar[XB_XCNT(b.x)], 1u);
    return b;
}
DI void xcd_barrier_complete(unsigned* bar, unsigned x, unsigned& nloc, unsigned& nx) {
    const unsigned G = gridDim.x * gridDim.y * gridDim.z;
    unsigned sum, cnt, mine, sp = 0u;
    for (;;) {
        sum = 0u; cnt = 0u; mine = 0u;
#pragma unroll
        for (unsigned j = 0; j < 16; ++j) { const unsigned c = xb_ld(&bar[XB_XCNT(j)]); sum += c; cnt += (c > 0u) ? 1u : 0u; mine = (j == x) ? c : mine; }
        if (sum == G) break;
        __builtin_amdgcn_s_sleep(1);
        if ((++sp & 255u) == 0u) { if (xb_ld(&bar[XB_TMO])) break; if (sp > XB_SPIN_CAP) { atomicAdd(&bar[XB_TMO], 1u); break; } }
    }
    nloc = mine > 0u ? mine : 1u; nx = cnt > 0u ? cnt : 1u;
}
DI void xcd_barrier(const XcdBarrier& b) {
    asm volatile("s_waitcnt vmcnt(0)" ::: "memory");
    __syncthreads();
    if (threadIdx.x == 0) {
        unsigned* bar = b.bar;
        __builtin_amdgcn_s_waitcnt(0);
        unsigned nloc = b.st[0], nx = b.st[1];
        if (nloc == 0u) { xcd_barrier_complete(bar, b.x, nloc, nx); b.st[0] = nloc; b.st[1] = nx; }
        const unsigned old = xb_add(&bar[XB_XSUB(b.x)], 1u);
        const unsigned gen = old / nloc;
        if (old + 1u == (gen + 1u) * nloc) {
            __builtin_amdgcn_fence(__ATOMIC_RELEASE, "agent");
            asm volatile("s_waitcnt vmcnt(0)" ::: "memory");
            const unsigned og = xb_add(&bar[XB_TOP], 1u);
            const unsigned tg = og / nx;
            if (og + 1u == (tg + 1u) * nx) xb_add(&bar[XB_TOPGEN], 1u);
            else XB_SPIN(xb_ld(&bar[XB_TOPGEN]) == tg, bar);
            __builtin_amdgcn_fence(__ATOMIC_ACQUIRE, "agent");
            xb_add(&bar[XB_XGEN(b.x)], 1u);
            asm volatile("s_waitcnt vmcnt(0)" ::: "memory");
        } else {
            XB_SPIN(xb_ld(&bar[XB_XGEN(b.x)]) == gen, bar);
            __builtin_amdgcn_fence(__ATOMIC_ACQUIRE, "agent");
            asm volatile("s_waitcnt vmcnt(0)" ::: "memory");
        }
    }
    __syncthreads();
}

DI void band_attn_unit(const P& p, char* smem, int unit) {
    const int tid = threadIdx.x, lane = tid & 63, wid = tid >> 6, r32 = lane & 31, hh = lane >> 5;
    const int cp = unit & 31, h = (unit >> 5) & 7, b = unit >> 8;
    const int c = 2 * cp + (wid >> 1);
    const int tq = c * 64 + (wid & 1) * 32 + r32;
    const size_t rowb = (size_t)b * NS;
    const bf16_t* kbase = p.proj + rowb * EVEN_IN + 512 + h * 64;
    const bf16_t* vbase = p.proj + rowb * EVEN_IN + 1024 + h * 64;
    float* sbias = (float*)(smem + 4 * KV_TILE);
    __syncthreads();
    for (int i = tid; i < 257; i += 256) sbias[i] = p.att_rel_bias[h * 257 + i] * LOG2E;
    bf16x8 qf[4];
#pragma unroll
    for (int st = 0; st < 4; ++st) qf[st] = *(const bf16x8*)(p.proj + (rowb + tq) * EVEN_IN + h * 64 + st * 16 + hh * 8);
    const int ck0 = (2 * cp - 8) > 0 ? (2 * cp - 8) : 0, nt = 2 * cp + 2 - ck0;
    float m = -3.0e38f, lsum = 0.f;
    f32x16 o0, o1;
#pragma unroll
    for (int i = 0; i < 16; ++i) { o0[i] = 0.f; o1[i] = 0.f; }
    KVStage stg;
    kv_load(stg, kbase, vbase, EVEN_IN, ck0 * 64);
    kv_store(stg, smem, smem + 2 * KV_TILE);
    __syncthreads();
    for (int it = 0; it < nt; ++it) {
        const int ck = ck0 + it, cur = it & 1;
        if (it + 1 < nt) kv_load(stg, kbase, vbase, EVEN_IN, (ck + 1) * 64);
        const char* kt = smem + cur * KV_TILE; const char* vt = smem + (2 + cur) * KV_TILE;
        if (ck >= c - 8 && ck <= c) {
            f32x16 s0, s1;
#pragma unroll
            for (int i = 0; i < 16; ++i) { s0[i] = 0.f; s1[i] = 0.f; }
#pragma unroll
            for (int st = 0; st < 4; ++st) { s0 = MFMA32(k_frag(kt, 0, st, r32, hh), qf[st], s0); s1 = MFMA32(k_frag(kt, 1, st, r32, hh), qf[st], s1); }
            if (c - ck >= 3) { const float bb = sbias[256];
#pragma unroll
                for (int i = 0; i < 16; ++i) { s0[i] += bb; s1[i] += bb; }
            } else {
                const int d0 = tq - ck * 64 - 4 * hh;
#pragma unroll
                for (int i = 0; i < 16; ++i) {
                    int da = d0 - ((i & 3) + 8 * (i >> 2)), db = da - 32;
                    da = da > 128 ? 128 : da; db = db > 128 ? 128 : db;
                    s0[i] += sbias[da + 128]; s1[i] += sbias[db + 128];
                }
            }
            float tm = fmaxf(s0[0], s1[0]);
#pragma unroll
            for (int i = 1; i < 16; ++i) tm = fmaxf(tm, fmaxf(s0[i], s1[i]));
            tm = swap_max(tm);
            const float mn = fmaxf(m, tm);
            const float alpha = __builtin_amdgcn_exp2f(m - mn);
            m = mn;
            float ps = 0.f;
#pragma unroll
            for (int i = 0; i < 16; ++i) { s0[i] = __builtin_amdgcn_exp2f(s0[i] - mn); s1[i] = __builtin_amdgcn_exp2f(s1[i] - mn); ps += s0[i] + s1[i]; }
            lsum = lsum * alpha + ps;
#pragma unroll
            for (int i = 0; i < 16; ++i) { o0[i] *= alpha; o1[i] *= alpha; }
#pragma unroll
            for (int st = 0; st < 2; ++st) {
                const bf16x8 pa = pack8(s0, st), pb = pack8(s1, st);
                o0 = MFMA32(vt_frag(vt, 0, st, 0, lane), pa, o0); o1 = MFMA32(vt_frag(vt, 0, st, 1, lane), pa, o1);
                o0 = MFMA32(vt_frag(vt, 1, st, 0, lane), pb, o0); o1 = MFMA32(vt_frag(vt, 1, st, 1, lane), pb, o1);
            }
        }
        if (it + 1 < nt) kv_store(stg, smem + (cur ^ 1) * KV_TILE, smem + (2 + (cur ^ 1)) * KV_TILE);
        __syncthreads();
    }
    const float inv = 1.0f / swap_sum(lsum);
    bf16_t* orow = p.mixed + (rowb + tq) * DM + h * 64 + 4 * hh;
#pragma unroll
    for (int g = 0; g < 4; ++g) {
        u32x2 w0, w1;
        w0.x = pack2(o0[4 * g] * inv, o0[4 * g + 1] * inv); w0.y = pack2(o0[4 * g + 2] * inv, o0[4 * g + 3] * inv);
        w1.x = pack2(o1[4 * g] * inv, o1[4 * g + 1] * inv); w1.y = pack2(o1[4 * g + 2] * inv, o1[4 * g + 3] * inv);
        *(u32x2*)(orow + 8 * g) = w0; *(u32x2*)(orow + 32 + 8 * g) = w1;
    }
}

DI void sb_attn_unit(const P& p, char* smem, int unit) {
    const int tid = threadIdx.x, lane = tid & 63, wid = tid >> 6, r32 = lane & 31, hh = lane >> 5;
    const int qb = unit & 31, h = (unit >> 5) & 7, b = unit >> 8;
    const int tw = qb * 128 + wid * 32, t = tw + r32;
    const size_t rowb = (size_t)b * NS;
    const bf16_t* kbase = p.proj + rowb * ODD_IN + 1536 + h * 64;
    const bf16_t* vbase = p.proj + rowb * ODD_IN + 2048 + h * 64;
    volatile int* wdone = (volatile int*)(smem + 4 * KV_TILE);
    __syncthreads();
    bf16x8 qf[4];
#pragma unroll
    for (int st = 0; st < 4; ++st) qf[st] = *(const bf16x8*)(p.proj + (rowb + t) * ODD_IN + 1024 + h * 64 + st * 16 + hh * 8);
    bf16x8 tf[2];
#pragma unroll
    for (int st = 0; st < 2; ++st)
#pragma unroll
        for (int j = 0; j < 8; ++j) tf[st][j] = (16 * st + 8 * (j >> 2) + 4 * hh + (j & 3)) >= r32 ? (short)0x3F80 : (short)0;
    f32x16 o0, o1;
#pragma unroll
    for (int i = 0; i < 16; ++i) { o0[i] = 0.f; o1[i] = 0.f; }
    float carry = 0.f; bool done = false;
    const int kt0 = 2 * qb + 1;
    KVStage stg;
    kv_load(stg, kbase, vbase, ODD_IN, kt0 * 64);
    kv_store(stg, smem, smem + 2 * KV_TILE);
    __syncthreads();
    for (int it = 0; it <= kt0; ++it) {
        const int kt = kt0 - it, cur = it & 1;
        if (kt > 0) kv_load(stg, kbase, vbase, ODD_IN, (kt - 1) * 64);
        const char* ktile = smem + cur * KV_TILE; const char* vtile = smem + (2 + cur) * KV_TILE;
        if (!done && kt * 64 < tw + 31) {
#pragma unroll
            for (int sbi = 0; sbi < 2; ++sbi) {
                const int sb = 1 - sbi;
                f32x16 x;
#pragma unroll
                for (int i = 0; i < 16; ++i) x[i] = 0.f;
#pragma unroll
                for (int st = 0; st < 4; ++st) x = MFMA32(k_frag(ktile, sb, st, r32, hh), qf[st], x);
                const int kb = kt * 64 + sb * 32 + 4 * hh;
                f32x16 L, Lr;
#pragma unroll
                for (int i = 0; i < 16; ++i) {
                    const bool valid = kb + (i & 3) + 8 * (i >> 2) < t;
                    const float z = x[i];
                    const float sp = fmaxf(z, 0.f) + __builtin_amdgcn_logf(1.0f + __builtin_amdgcn_exp2f(-fabsf(z)));
                    L[i] = valid ? -sp : 0.f;
                    x[i] = valid ? z : -1.0e30f;
                }
                f32x16 cum;
#pragma unroll
                for (int i = 0; i < 16; ++i) cum[i] = carry;
#pragma unroll
                for (int st = 0; st < 2; ++st) {
                    const bf16x8 hi = pack8(L, st);
#pragma unroll
                    for (int j = 0; j < 8; ++j) Lr[8 * st + j] = L[8 * st + j] - __uint_as_float(((unsigned)(unsigned short)hi[j]) << 16);
                    cum = MFMA32(tf[st], hi, cum);
                }
#pragma unroll
                for (int st = 0; st < 2; ++st) cum = MFMA32(tf[st], pack8(Lr, st), cum);
                carry = bcast_lo(cum[0]);
#pragma unroll
                for (int i = 0; i < 16; ++i) x[i] = __builtin_amdgcn_exp2f(x[i] + cum[i]);
#pragma unroll
                for (int st = 0; st < 2; ++st) {
                    const bf16x8 pa = pack8(x, st);
                    o0 = MFMA32(vt_frag(vtile, sb, st, 0, lane), pa, o0); o1 = MFMA32(vt_frag(vtile, sb, st, 1, lane), pa, o1);
                }
            }
            done = __all(carry < -150.0f);
        }
        if (lane == 0) wdone[cur * 4 + wid] = done ? 1 : 0;
        if (kt > 0) kv_store(stg, smem + (cur ^ 1) * KV_TILE, smem + (2 + (cur ^ 1)) * KV_TILE);
        __syncthreads();
        if (wdone[cur * 4] + wdone[cur * 4 + 1] + wdone[cur * 4 + 2] + wdone[cur * 4 + 3] == 4) break;
    }
    bf16_t* orow = p.mixed + (rowb + t) * DM + 512 + h * 64 + 4 * hh;
#pragma unroll
    for (int g = 0; g < 4; ++g) {
        u32x2 w0, w1;
        w0.x = pack2(o0[4 * g], o0[4 * g + 1]); w0.y = pack2(o0[4 * g + 2], o0[4 * g + 3]);
        w1.x = pack2(o1[4 * g], o1[4 * g + 1]); w1.y = pack2(o1[4 * g + 2], o1[4 * g + 3]);
        *(u32x2*)(orow + 8 * g) = w0; *(u32x2*)(orow + 32 + 8 * g) = w1;
    }
}

DI void unpack8(const u32x4 v, float* f) {
    f[0] = __uint_as_float(v.x << 16); f[1] = __uint_as_float(v.x & 0xffff0000u); f[2] = __uint_as_float(v.y << 16); f[3] = __uint_as_float(v.y & 0xffff0000u);
    f[4] = __uint_as_float(v.z << 16); f[5] = __uint_as_float(v.z & 0xffff0000u); f[6] = __uint_as_float(v.w << 16); f[7] = __uint_as_float(v.w & 0xffff0000u);
}
DI void pool_items(const P& p) {
    for (int it = blockIdx.x * 256 + threadIdx.x; it < NTOK * 64; it += gridDim.x * 256) {
        const int tok = it >> 6, ch8 = it & 63, g = ch8 >> 4, w = 2 << g, s = tok & (NS - 1);
        const int n = (s + 1 < w) ? s + 1 : w;
        float sum[8], own[8];
#pragma unroll
        for (int j = 0; j < 8; ++j) sum[j] = 0.f;
        const bf16_t* src = p.proj + (size_t)tok * EVEN_IN + 1536 + ch8 * 8;
        for (int t = 0; t < n; ++t) {
            unpack8(*(const u32x4*)(src - (size_t)t * EVEN_IN), own);
#pragma unroll
            for (int j = 0; j < 8; ++j) sum[j] += own[j];
        }
        unpack8(*(const u32x4*)src, own);
        const float inv = 1.0f / (float)n;
        u32x4 o; o.x = pack2(sum[0] * inv - own[0], sum[1] * inv - own[1]); o.y = pack2(sum[2] * inv - own[2], sum[3] * inv - own[3]);
        o.z = pack2(sum[4] * inv - own[4], sum[5] * inv - own[5]); o.w = pack2(sum[6] * inv - own[6], sum[7] * inv - own[7]);
        *(u32x4*)(p.mixed + (size_t)tok * DM + 512 + ch8 * 8) = o;
    }
}

DI void ph_mix_even(const P& p, char* smem) {
    for (int u = blockIdx.x; u < NB * 8 * 32; u += gridDim.x) band_attn_unit(p, smem, u);
    pool_items(p);
}

DI int sgu_f(int s) { return (s & 3) | ((s >> 1) & 4); }
DI void sgu_unit(const P& p, char* smem, int unit) {
    const int tid = threadIdx.x, lane = tid & 63, wid = tid >> 6, wm = wid >> 1, wn = wid & 1, fr = lane & 15, fq = lane >> 4;
    const int g = unit & 3; const size_t tok0 = (size_t)(unit >> 2) * 128;
    char* As = smem; char* Gs = smem + 32768; float* srstd = (float*)(smem + 65536);
    __syncthreads();
    {
        const int row = tid >> 1, half = tid & 1;
        const bf16_t* src = p.proj + (tok0 + row) * ODD_IN + 512 + half * 256;
        float ss = 0.f;
        for (int i = 0; i < 32; ++i) { float f[8]; unpack8(*(const u32x4*)(src + i * 8), f);
#pragma unroll
            for (int j = 0; j < 8; ++j) ss += f[j] * f[j]; }
        ss += __shfl_xor(ss, 1);
        if (half == 0) srstd[row] = rsqrtf(ss * (1.0f / 512.0f) + EPS);
    }
#pragma unroll
    for (int i = 0; i < 8; ++i) {
        const int idx = tid + 256 * i, s = idx >> 4, ch = idx & 15;
        const u32x4 v = *(const u32x4*)(p.proj + (tok0 + s) * ODD_IN + 512 + g * 128 + ch * 8);
        *(u32x4*)(Gs + s * 256 + (((ch >> 1) ^ sgu_f(s)) << 5) + ((ch & 1) << 4)) = v;
    }
    __syncthreads();
#pragma unroll
    for (int i = 0; i < 8; ++i) {
        const int idx = tid + 256 * i, t = idx >> 4, c8 = idx & 15, s0 = c8 * 8;
        const float* wr = p.sgu_w + ((size_t)g * 128 + t) * 128 + s0;
        const f32x4 a = *(const f32x4*)wr, b = *(const f32x4*)(wr + 4);
        float f[8] = {a[0], a[1], a[2], a[3], b[0], b[1], b[2], b[3]};
#pragma unroll
        for (int j = 0; j < 8; ++j) f[j] = (s0 + j <= t) ? f[j] * srstd[s0 + j] : 0.f;
        u32x4 w; w.x = pack2(f[0], f[1]); w.y = pack2(f[2], f[3]); w.z = pack2(f[4], f[5]); w.w = pack2(f[6], f[7]);
        *(u32x4*)(As + (c8 >> 3) * 16384 + t * 128 + (((c8 & 7) ^ (t & 7)) << 4)) = w;
    }
    __syncthreads();
    f32x4 acc[4][4];
#pragma unroll
    for (int a = 0; a < 4; ++a)
#pragma unroll
        for (int b = 0; b < 4; ++b) acc[a][b] = (f32x4){0.f, 0.f, 0.f, 0.f};
    const int qq = fr >> 2, pp = fr & 3;
#pragma unroll
    for (int kt = 0; kt < 2; ++kt) {
        if (kt == 1 && wm == 0) continue;
#pragma unroll
        for (int s2 = 0; s2 < 2; ++s2) {
            bf16x8 af[4], bfv[4];
#pragma unroll
            for (int i = 0; i < 4; ++i) {
                const int ra_ = wm * 64 + i * 16 + fr;
                af[i] = *(const bf16x8*)(As + kt * 16384 + ra_ * 128 + (((s2 * 4 + fq) ^ (fr & 7)) << 4));
                const int srow = kt * 64 + s2 * 32 + 8 * fq + qq, blk = wn * 4 + i;
                const s16x4 lo = tr_read(Gs + srow * 256 + ((blk ^ sgu_f(srow)) << 5) + pp * 8);
                const s16x4 hi = tr_read(Gs + (srow + 4) * 256 + ((blk ^ sgu_f(srow + 4)) << 5) + pp * 8);
                bfv[i] = (bf16x8){lo[0], lo[1], lo[2], lo[3], hi[0], hi[1], hi[2], hi[3]};
            }
#pragma unroll
            for (int mi = 0; mi < 4; ++mi)
#pragma unroll
                for (int ni = 0; ni < 4; ++ni) acc[mi][ni] = __builtin_amdgcn_mfma_f32_16x16x32_bf16(bfv[ni], af[mi], acc[mi][ni], 0, 0, 0);
        }
    }
#pragma unroll
    for (int mi = 0; mi < 4; ++mi) {
        const int t = wm * 64 + mi * 16 + fr;
        const float bias = p.sgu_b[g * 128 + t];
#pragma unroll
        for (int ni = 0; ni < 4; ++ni) {
            const int c = g * 128 + wn * 64 + ni * 16 + fq * 4;
            const f32x4 gn = *(const f32x4*)(p.sgu_v_norm + c);
            const u32x2 uu = *(const u32x2*)(p.proj + (tok0 + t) * ODD_IN + c);
            const float u0 = __uint_as_float(uu.x << 16), u1 = __uint_as_float(uu.x & 0xffff0000u), u2 = __uint_as_float(uu.y << 16), u3 = __uint_as_float(uu.y & 0xffff0000u);
            const f32x4 a = acc[mi][ni];
            u32x2 w; w.x = pack2(u0 * (gn[0] * a[0] + bias), u1 * (gn[1] * a[1] + bias)); w.y = pack2(u2 * (gn[2] * a[2] + bias), u3 * (gn[3] * a[3] + bias));
            *(u32x2*)(p.mixed + (tok0 + t) * DM + c) = w;
        }
    }
}

DI void ph_mix_odd(const P& p, char* smem) {
    for (int u = blockIdx.x; u < NB * 8 * 32; u += gridDim.x) sb_attn_unit(p, smem, u);
    for (int u = blockIdx.x; u < (NTOK / 128) * 4; u += gridDim.x) sgu_unit(p, smem, u);
}

DI void router_token(const P& p, int layer, int tok, int lane) {
    const float* hr = p.out + (size_t)tok * DM;
    const float* gn = p.ffn_norm + layer * DM;
    int* cnt = p.cnt + layer * NEXP;
    f32x4 v[4]; float ss = 0.f;
#pragma unroll
    for (int i = 0; i < 4; ++i) { v[i] = *(const f32x4*)(hr + i * 256 + lane * 4); ss += v[i][0] * v[i][0] + v[i][1] * v[i][1] + v[i][2] * v[i][2] + v[i][3] * v[i][3]; }
    ss = wave_sum(ss);
    const float rstd = rsqrtf(ss * (1.0f / DM) + EPS);
#pragma unroll
    for (int i = 0; i < 4; ++i) { const f32x4 g = *(const f32x4*)(gn + i * 256 + lane * 4); v[i] = v[i] * rstd * g;
        u32x2 w; w.x = pack2(v[i][0], v[i][1]); w.y = pack2(v[i][2], v[i][3]);
        *(u32x2*)(p.xn + (size_t)tok * DM + i * 256 + lane * 4) = w; }
    const float* wg = p.w_rg + (size_t)layer * DM * 4;
    const float* we = p.w_re + (size_t)layer * DM * 32;
    float mylogit = 0.f;
    {
        f32x4 a = (f32x4){0.f, 0.f, 0.f, 0.f};
#pragma unroll
        for (int i = 0; i < 4; ++i)
#pragma unroll
            for (int j = 0; j < 4; ++j) { const int k = i * 256 + lane * 4 + j; a += v[i][j] * *(const f32x4*)(wg + k * 4); }
#pragma unroll
        for (int o = 0; o < 4; ++o) { const float s = wave_sum(a[o]); if (lane == o) mylogit = s; }
    }
    for (int ob = 0; ob < 8; ++ob) {
        f32x4 a = (f32x4){0.f, 0.f, 0.f, 0.f};
#pragma unroll
        for (int i = 0; i < 4; ++i)
#pragma unroll
            for (int j = 0; j < 4; ++j) { const int k = i * 256 + lane * 4 + j; a += v[i][j] * *(const f32x4*)(we + k * 32 + ob * 4); }
#pragma unroll
        for (int o = 0; o < 4; ++o) { const float s = wave_sum(a[o]); if (lane == 4 + ob * 4 + o) mylogit = s; }
    }
    const float g0 = __shfl(mylogit, 0), g1 = __shfl(mylogit, 1), g2 = __shfl(mylogit, 2), g3 = __shfl(mylogit, 3);
    int gs = 0; float gm = g0;
    if (g1 > gm) { gm = g1; gs = 1; }
    if (g2 > gm) { gm = g2; gs = 2; }
    if (g3 > gm) { gm = g3; gs = 3; }
    const float gw = 1.0f / (__expf(g0 - gm) + __expf(g1 - gm) + __expf(g2 - gm) + __expf(g3 - gm));
    float ev[8];
#pragma unroll
    for (int j = 0; j < 8; ++j) ev[j] = __shfl(mylogit, 4 + gs * 8 + j);
    int i1 = 0; float v1 = ev[0];
#pragma unroll
    for (int j = 1; j < 8; ++j) if (ev[j] > v1) { v1 = ev[j]; i1 = j; }
    int i2 = -1; float v2 = -3.0e38f;
#pragma unroll
    for (int j = 0; j < 8; ++j) if (j != i1 && ev[j] > v2) { v2 = ev[j]; i2 = j; }
    const float w1 = 1.0f / (1.0f + __expf(v2 - v1));
    const float w2 = 1.0f - w1;
    if (lane == 0) {
        const int e1 = gs * 8 + i1, e2 = gs * 8 + i2;
        int pos = atomicAdd(cnt + e1, 1); p.plist[(size_t)e1 * LISTCAP + pos] = tok * 2;
        pos = atomicAdd(cnt + e2, 1); p.plist[(size_t)e2 * LISTCAP + pos] = tok * 2 + 1;
        p.pw[tok * 2] = w1 * gw; p.pw[tok * 2 + 1] = w2 * gw;
    }
}

DI void ph_router(const P& p, int layer) {
    const int wave = threadIdx.x >> 6, lane = threadIdx.x & 63;
    for (int u = blockIdx.x; u < NTOK / 4; u += gridDim.x) router_token(p, layer, u * 4 + wave, lane);
}

DI void ph_combine(const P& p, int layer) {
    const int wave = threadIdx.x >> 6, lane = threadIdx.x & 63;
    for (int u = blockIdx.x; u < NTOK / 4; u += gridDim.x) {
        const size_t tok = (size_t)u * 4 + wave;
        float* hr = p.out + tok * DM;
        f32x4 v[4]; float ss = 0.f;
#pragma unroll
        for (int i = 0; i < 4; ++i) {
            const int c = i * 256 + lane * 4;
            f32x4 h = *(const f32x4*)(hr + c);
            const u32x2 a = *(const u32x2*)(p.y + (tok * 2) * DM + c), b = *(const u32x2*)(p.y + (tok * 2 + 1) * DM + c);
            h[0] += bf2f((bf16_t)(a.x & 0xffff)) + bf2f((bf16_t)(b.x & 0xffff));
            h[1] += bf2f((bf16_t)(a.x >> 16)) + bf2f((bf16_t)(b.x >> 16));
            h[2] += bf2f((bf16_t)(a.y & 0xffff)) + bf2f((bf16_t)(b.y & 0xffff));
            h[3] += bf2f((bf16_t)(a.y >> 16)) + bf2f((bf16_t)(b.y >> 16));
            *(f32x4*)(hr + c) = h; v[i] = h;
            ss += h[0] * h[0] + h[1] * h[1] + h[2] * h[2] + h[3] * h[3];
        }
        if (layer == 0) {
            ss = wave_sum(ss);
            const float rstd = rsqrtf(ss * (1.0f / DM) + EPS);
#pragma unroll
            for (int i = 0; i < 4; ++i) { const f32x4 g = *(const f32x4*)(p.mix_norm_odd + i * 256 + lane * 4);
                u32x2 w; w.x = pack2(v[i][0] * rstd * g[0], v[i][1] * rstd * g[1]); w.y = pack2(v[i][2] * rstd * g[2], v[i][3] * rstd * g[3]);
                *(u32x2*)(p.xn + tok * DM + i * 256 + lane * 4) = w; }
        }
    }
}

constexpr int NPHASE = 15;
__global__ __launch_bounds__(256, 2) void mega(P p, int ph0, int ph1) {
    __shared__ __attribute__((aligned(16))) char smem[SMEM_BYTES + 16];
    volatile LDSAS unsigned* xst = (volatile LDSAS unsigned*)(smem + SMEM_BYTES);
    if (threadIdx.x < 4) xst[threadIdx.x] = 0u;
    __syncthreads();
    const XcdBarrier xb = xcd_barrier_post(p.bar, xst);
#define PHASE(i, call) if (ph0 <= (i) && (i) < ph1) { call; if ((i) + 1 < ph1) xcd_barrier(xb); }
    PHASE(0, ph_prologue(p, smem))
    PHASE(1, (ph_gemm_dense<EPI_IN_EVEN>(p, smem, p.xn, DM, p.wt_in_even, DM, EVEN_IN, 0)))
    PHASE(2, ph_mix_even(p, smem))
    PHASE(3, (ph_gemm_dense<EPI_OUT>(p, smem, p.mixed, DM, p.wt_out_even, DM, DM, 0)))
    PHASE(4, ph_router(p, 0))
    PHASE(5, (ph_gemm_moe<EPI_GU>(p, smem, 0)))
    PHASE(6, (ph_gemm_moe<EPI_DOWN>(p, smem, 0)))
    PHASE(7, ph_combine(p, 0))
    PHASE(8, (ph_gemm_dense<EPI_IN_ODD>(p, smem, p.xn, DM, p.wt_in_odd, DM, ODD_IN, 1)))
    PHASE(9, ph_mix_odd(p, smem))
    PHASE(10, (ph_gemm_dense<EPI_OUT>(p, smem, p.mixed, DM, p.wt_out_odd, DM, DM, 1)))
    PHASE(11, ph_router(p, 1))
    PHASE(12, (ph_gemm_moe<EPI_GU>(p, smem, 1)))
    PHASE(13, (ph_gemm_moe<EPI_DOWN>(p, smem, 1)))
    PHASE(14, ph_combine(p, 1))
}

extern "C" void kernel_launch(void* const* d_in, const int* in_sizes, int n_in, void* d_out, int out_size, void* d_ws, size_t ws_size, hipStream_t stream) {
    P p{};
    p.x = (const float*)d_in[0]; p.mix_norm_even = (const float*)d_in[1]; p.w_in_even = (const float*)d_in[2]; p.att_q_norm = (const float*)d_in[3];
    p.att_k_norm = (const float*)d_in[4]; p.att_rel_bias = (const float*)d_in[5]; p.pool_w = (const float*)d_in[6]; p.pool_scale = (const float*)d_in[7];
    p.w_out_even = (const float*)d_in[8]; p.mix_norm_odd = (const float*)d_in[9]; p.w_in_odd = (const float*)d_in[10]; p.sgu_v_norm = (const float*)d_in[11];
    p.sgu_w = (const float*)d_in[12]; p.sgu_b = (const float*)d_in[13]; p.w_out_odd = (const float*)d_in[14]; p.ffn_norm = (const float*)d_in[15];
    p.w_rg = (const float*)d_in[16]; p.w_re = (const float*)d_in[17]; p.w_gate = (const float*)d_in[18]; p.w_up = (const float*)d_in[19]; p.w_down = (const float*)d_in[20];
    p.out = (float*)d_out;
    char* ws = (char*)d_ws; size_t off = 0;
    auto take = [&](size_t bytes) { char* r = ws + off; off += (bytes + 255) & ~(size_t)255; return r; };
    p.wt_in_even = (bf16_t*)take((size_t)EVEN_IN * DM * 2);
    p.wt_out_even = (bf16_t*)take((size_t)DM * DM * 2);
    p.wt_in_odd = (bf16_t*)take((size_t)ODD_IN * DM * 2);
    p.wt_out_odd = (bf16_t*)take((size_t)DM * DM * 2);
    p.wt_gu = (bf16_t*)take((size_t)2 * NEXP * 512 * DM * 2);
    p.wt_d = (bf16_t*)take((size_t)2 * NEXP * DM * FF * 2);
    p.xn = (bf16_t*)take((size_t)NTOK * DM * 2);
    p.proj = (bf16_t*)take((size_t)NTOK * ODD_IN * 2);
    p.y = p.proj;
    p.mixed = (bf16_t*)take((size_t)NTOK * DM * 2);
    p.hid = p.mixed;
    p.pw = (float*)take((size_t)NTOK * 2 * 4);
    p.plist = (int*)take((size_t)NEXP * LISTCAP * 4);
    p.cnt = (int*)take(256);
    p.bar = (unsigned*)take(XCD_BAR_WORDS * 4);
    (void)hipMemsetAsync(p.bar, 0, XCD_BAR_WORDS * 4, stream);

    static int grid_blocks = 0;
    if (!grid_blocks) {
        int dev = 0, cus = 0, per_cu = 0;
        (void)hipGetDevice(&dev);
        (void)hipDeviceGetAttribute(&cus, hipDeviceAttributeMultiprocessorCount, dev);
        (void)hipOccupancyMaxActiveBlocksPerMultiprocessor(&per_cu, mega, 256, 0);
        if (per_cu > 2) per_cu = 2;
        if (per_cu < 1) per_cu = 1;
        grid_blocks = cus * per_cu;
    }
    int ph0 = 0, ph1 = NPHASE;
    void* args[] = {&p, &ph0, &ph1};
    hipError_t e = hipLaunchCooperativeKernel((void*)mega, dim3(grid_blocks), dim3(256), args, 0, stream);
    if (e != hipSuccess) fprintf(stderr, "cooperative launch failed: %s (grid %d)\n", hipGetErrorString(e), grid_blocks);
}
```

```cpp
#include <hip/hip_runtime.h>
#include <hip/hip_cooperative_groups.h>
#include <stdint.h>
#include <stdio.h>

typedef unsigned short bf16_t;
typedef short bf16x8 __attribute__((ext_vector_type(8)));
typedef short s16x4 __attribute__((ext_vector_type(4)));
typedef float f32x2 __attribute__((ext_vector_type(2)));
typedef float f32x4 __attribute__((ext_vector_type(4)));
typedef float f32x16 __attribute__((ext_vector_type(16)));
typedef unsigned u32x4 __attribute__((ext_vector_type(4)));
typedef unsigned u32x2 __attribute__((ext_vector_type(2)));
typedef __bf16 bf16x2n __attribute__((ext_vector_type(2)));

#define DI __device__ __forceinline__
#define LDSAS __attribute__((address_space(3)))
#define MFMA32(a, b, c) __builtin_amdgcn_mfma_f32_32x32x16_bf16((a), (b), (c), 0, 0, 0)
#define MFMA16(a, b, c) __builtin_amdgcn_mfma_f32_16x16x32_bf16((a), (b), (c), 0, 0, 0)

constexpr int NB = 4, NS = 4096, NTOK = NB * NS, DM = 1024;
constexpr int EVEN_IN = 2048, ODD_IN = 2560;
constexpr int NEXP = 32, FF = 256;
constexpr int LISTCAP = NTOK;
constexpr float EPS = 1e-6f;
constexpr float LOG2E = 1.4426950408889634f;
constexpr float QSCALE = 0.125f * LOG2E;

DI float bf2f(bf16_t b) { return __uint_as_float(((unsigned)b) << 16); }
DI unsigned pack2(float lo, float hi) { f32x2 v = {lo, hi}; bf16x2n r = __builtin_convertvector(v, bf16x2n); return __builtin_bit_cast(unsigned, r); }
DI float wave_sum(float v) { for (int o = 32; o > 0; o >>= 1) v += __shfl_xor(v, o); return v; }
DI float gelu_exact(float x) { return 0.5f * x * (1.0f + erff(x * 0.70710678118654752f)); }
DI s16x4 tr_read(const char* p) { return __builtin_bit_cast(s16x4, __builtin_amdgcn_ds_read_tr16_b64_v4i16((LDSAS s16x4*)p)); }
DI void unpack8(const u32x4 v, float* f) {
    f[0] = __uint_as_float(v.x << 16); f[1] = __uint_as_float(v.x & 0xffff0000u); f[2] = __uint_as_float(v.y << 16); f[3] = __uint_as_float(v.y & 0xffff0000u);
    f[4] = __uint_as_float(v.z << 16); f[5] = __uint_as_float(v.z & 0xffff0000u); f[6] = __uint_as_float(v.w << 16); f[7] = __uint_as_float(v.w & 0xffff0000u);
}
DI int kswz(int k) { return (k & 3) | ((k >> 1) & 4); }

struct P {
    const float *x, *mix_norm_even, *w_in_even, *att_q_norm, *att_k_norm, *att_rel_bias, *pool_w, *pool_scale, *w_out_even;
    const float *mix_norm_odd, *w_in_odd, *sgu_v_norm, *sgu_w, *sgu_b, *w_out_odd, *ffn_norm, *w_rg, *w_re, *w_gate, *w_up, *w_down;
    float* out;
    bf16_t *wb_in_even, *wb_out_even, *wb_in_odd, *wb_out_odd, *wb_gate, *wb_up, *wb_down, *wr_hi, *wr_lo;
    bf16_t *xn, *proj, *mixed, *hid, *y;
    float *pw, *rs; int* plist; int* cnt; unsigned* bar;
};

enum { EPI_IN_EVEN = 0, EPI_IN_ODD = 1, EPI_OUT = 2, EPI_GU = 3, EPI_DOWN = 4 };
constexpr int GEMM_LDS = 2 * 2 * 16384 + 512;
constexpr int SMEM_BYTES = GEMM_LDS;

struct GemmArgs {
    const bf16_t* A; int lda; const int* gather; int mvalid; int gshift;
    const bf16_t* B0; const bf16_t* B1; int ldb; int gu;
    int K, m0, n0;
};

template <int EPI>
DI void gemm_tile(const P& p, char* smem, const GemmArgs& g, int layer) {
    const int tid = threadIdx.x, lane = tid & 63, wid = tid >> 6, wm = wid >> 1, wn = wid & 1, fr = lane & 15, fq = lane >> 4;
    char* As = smem; char* Bs = smem + 2 * 16384; int* rowid = (int*)(smem + 4 * 16384);
    const int kc = tid & 7, r0 = tid >> 3;
    const int ch = tid & 15, kr0 = tid >> 4;
    const bf16_t* ap[4]; const bf16_t* bp[4];
    if (g.gather) { if (tid < 128) rowid[tid] = (tid < g.mvalid) ? g.gather[tid] : -1; __syncthreads(); }
    const bf16_t* bcol = g.gu ? ((((ch >> 2) & 1) ? g.B1 : g.B0) + (g.n0 >> 1) + (ch >> 3) * 32 + (ch & 3) * 8) : (g.B0 + g.n0 + ch * 8);
#pragma unroll
    for (int i = 0; i < 4; ++i) {
        const int r = r0 + 32 * i;
        size_t arow;
        if (g.gather) { int id = rowid[r]; if (id < 0) id = rowid[0]; arow = (size_t)(id >> g.gshift); } else arow = (size_t)(g.m0 + r);
        ap[i] = g.A + arow * g.lda + kc * 8;
        bp[i] = bcol + (size_t)(kr0 + 16 * i) * g.ldb;
    }
    const size_t bstep = (size_t)64 * g.ldb;
    f32x4 acc[4][4];
#pragma unroll
    for (int a = 0; a < 4; ++a)
#pragma unroll
        for (int b = 0; b < 4; ++b) acc[a][b] = (f32x4){0.f, 0.f, 0.f, 0.f};
    u32x4 ra[4], rb[4];
    const int nk = g.K / 64;
    const int qq = fr >> 2, pp = fr & 3, bsw = qq | ((fq & 1) << 2);
#pragma unroll
    for (int i = 0; i < 4; ++i) { ra[i] = *(const u32x4*)(ap[i]); rb[i] = *(const u32x4*)(bp[i]); }
#pragma unroll
    for (int i = 0; i < 4; ++i) { const int r = r0 + 32 * i; *(u32x4*)(As + r * 128 + ((kc ^ (r & 7)) << 4)) = ra[i];
        const int k = kr0 + 16 * i; *(u32x4*)(Bs + k * 256 + (((ch >> 1) ^ kswz(k)) << 5) + ((ch & 1) << 4)) = rb[i]; }
    __syncthreads();
    for (int kt = 0; kt < nk; ++kt) {
        const int cur = kt & 1;
        if (kt + 1 < nk) {
#pragma unroll
            for (int i = 0; i < 4; ++i) { ra[i] = *(const u32x4*)(ap[i] + (kt + 1) * 64); rb[i] = *(const u32x4*)(bp[i] + (size_t)(kt + 1) * bstep); }
        }
        const char* Ac = As + cur * 16384; const char* Bc = Bs + cur * 16384;
#pragma unroll
        for (int s = 0; s < 2; ++s) {
            bf16x8 af[4], bfv[4];
            const char* brow = Bc + (s * 32 + 8 * fq + qq) * 256 + pp * 8;
#pragma unroll
            for (int i = 0; i < 4; ++i) {
                af[i] = *(const bf16x8*)(Ac + (wm * 64 + i * 16 + fr) * 128 + (((s * 4 + fq) ^ (fr & 7)) << 4));
                const int bo = ((wn * 4 + i) ^ bsw) << 5;
                const s16x4 lo = tr_read(brow + bo), hi = tr_read(brow + 4 * 256 + bo);
                bfv[i] = (bf16x8){lo[0], lo[1], lo[2], lo[3], hi[0], hi[1], hi[2], hi[3]};
            }
#pragma unroll
            for (int mi = 0; mi < 4; ++mi)
#pragma unroll
                for (int ni = 0; ni < 4; ++ni) acc[mi][ni] = MFMA16(bfv[ni], af[mi], acc[mi][ni]);
        }
        if (kt + 1 < nk) {
            char* An = As + (cur ^ 1) * 16384; char* Bn = Bs + (cur ^ 1) * 16384;
#pragma unroll
            for (int i = 0; i < 4; ++i) { const int r = r0 + 32 * i; *(u32x4*)(An + r * 128 + ((kc ^ (r & 7)) << 4)) = ra[i];
                const int k = kr0 + 16 * i; *(u32x4*)(Bn + k * 256 + (((ch >> 1) ^ kswz(k)) << 5) + ((ch & 1) << 4)) = rb[i]; }
        }
        __syncthreads();
    }
    const int colw = g.n0 + wn * 64;
    if (EPI == EPI_IN_EVEN) {
        const int region = colw >> 9;
        const float* gn = region == 0 ? p.att_q_norm : p.att_k_norm;
#pragma unroll
        for (int mi = 0; mi < 4; ++mi) {
            const int row = g.m0 + wm * 64 + mi * 16 + fr;
            float sc = 1.f;
            if (region < 2) {
                float ss = 0.f;
#pragma unroll
                for (int ni = 0; ni < 4; ++ni) ss += acc[mi][ni][0] * acc[mi][ni][0] + acc[mi][ni][1] * acc[mi][ni][1] + acc[mi][ni][2] * acc[mi][ni][2] + acc[mi][ni][3] * acc[mi][ni][3];
                ss += __shfl_xor(ss, 16); ss += __shfl_xor(ss, 32);
                sc = rsqrtf(ss * (1.0f / 64.0f) + EPS) * (region == 0 ? QSCALE : 1.0f);
            }
#pragma unroll
            for (int ni = 0; ni < 4; ++ni) {
                f32x4 v = acc[mi][ni];
                if (region < 2) { const f32x4 gg = *(const f32x4*)(gn + ni * 16 + fq * 4); v = v * sc * gg; }
                u32x2 w; w.x = pack2(v[0], v[1]); w.y = pack2(v[2], v[3]);
                *(u32x2*)(p.proj + (size_t)row * EVEN_IN + colw + ni * 16 + fq * 4) = w;
            }
        }
    } else if (EPI == EPI_IN_ODD) {
        const bool act = colw < 1024;
#pragma unroll
        for (int mi = 0; mi < 4; ++mi) {
            const int row = g.m0 + wm * 64 + mi * 16 + fr;
#pragma unroll
            for (int ni = 0; ni < 4; ++ni) {
                f32x4 v = acc[mi][ni];
                if (act) { v[0] = gelu_exact(v[0]); v[1] = gelu_exact(v[1]); v[2] = gelu_exact(v[2]); v[3] = gelu_exact(v[3]); }
                else if (colw < 1536) v = v * QSCALE;
                u32x2 w; w.x = pack2(v[0], v[1]); w.y = pack2(v[2], v[3]);
                *(u32x2*)(p.proj + (size_t)row * ODD_IN + colw + ni * 16 + fq * 4) = w;
            }
        }
    } else if (EPI == EPI_OUT) {
        const float* res = layer == 0 ? p.x : p.out;
#pragma unroll
        for (int mi = 0; mi < 4; ++mi) {
            const int row = g.m0 + wm * 64 + mi * 16 + fr;
#pragma unroll
            for (int ni = 0; ni < 4; ++ni) {
                const size_t off = (size_t)row * DM + colw + ni * 16 + fq * 4;
                const f32x4 r = *(const f32x4*)(res + off);
                *(f32x4*)(p.out + off) = r + acc[mi][ni];
            }
        }
    } else if (EPI == EPI_GU) {
        const int f0 = (g.n0 >> 1) + wn * 32;
#pragma unroll
        for (int mi = 0; mi < 4; ++mi) {
            const int id = rowid[wm * 64 + mi * 16 + fr];
            if (id >= 0) {
                const float w = p.pw[id], rs = p.rs[id >> 1];
#pragma unroll
                for (int ni = 0; ni < 2; ++ni) {
                    const f32x4 gt = acc[mi][ni] * rs, up = acc[mi][ni + 2] * (rs * w); f32x4 h;
#pragma unroll
                    for (int j = 0; j < 4; ++j) h[j] = gt[j] / (1.0f + __expf(-gt[j])) * up[j];
                    u32x2 ww; ww.x = pack2(h[0], h[1]); ww.y = pack2(h[2], h[3]);
                    *(u32x2*)(p.hid + (size_t)id * FF + f0 + ni * 16 + fq * 4) = ww;
                }
            }
        }
    } else if (EPI == EPI_DOWN) {
#pragma unroll
        for (int mi = 0; mi < 4; ++mi) {
            const int id = rowid[wm * 64 + mi * 16 + fr];
            if (id >= 0) {
#pragma unroll
                for (int ni = 0; ni < 4; ++ni) {
                    const f32x4 v = acc[mi][ni];
                    u32x2 ww; ww.x = pack2(v[0], v[1]); ww.y = pack2(v[2], v[3]);
                    *(u32x2*)(p.y + (size_t)id * DM + colw + ni * 16 + fq * 4) = ww;
                }
            }
        }
    }
    __syncthreads();
}

template <int EPI>
DI void ph_gemm_dense(const P& p, char* smem, const bf16_t* A, int lda, const bf16_t* B, int K, int N, int layer) {
    const int ntn = N / 128, ntiles = (NTOK / 128) * ntn;
    for (int t = blockIdx.x; t < ntiles; t += gridDim.x) {
        GemmArgs g; g.A = A; g.lda = lda; g.gather = nullptr; g.mvalid = 128; g.gshift = 0; g.B0 = B; g.B1 = B; g.ldb = N; g.gu = 0; g.K = K;
        g.m0 = (t / ntn) * 128; g.n0 = (t % ntn) * 128;
        gemm_tile<EPI>(p, smem, g, layer);
    }
}

template <int EPI>
DI void ph_gemm_moe(const P& p, char* smem, int layer) {
    const int ntn = (EPI == EPI_GU) ? 4 : 8;
    const int* cnt = p.cnt + layer * NEXP;
    int total = 0;
    for (int e = 0; e < NEXP; ++e) total += (cnt[e] + 127) >> 7;
    for (int u = blockIdx.x; u < total * ntn; u += gridDim.x) {
        int mt = u / ntn; const int nt = u % ntn;
        int e = 0, c = 0;
        for (; e < NEXP; ++e) { c = cnt[e]; const int t = (c + 127) >> 7; if (mt < t) break; mt -= t; }
        GemmArgs g; g.gather = p.plist + (size_t)e * LISTCAP + mt * 128; g.mvalid = c - mt * 128 < 128 ? c - mt * 128 : 128;
        g.m0 = 0; g.n0 = nt * 128;
        const size_t ex = (size_t)(layer * NEXP + e);
        if (EPI == EPI_GU) { g.A = p.xn; g.lda = DM; g.gshift = 1; g.B0 = p.wb_gate + ex * DM * FF; g.B1 = p.wb_up + ex * DM * FF; g.ldb = FF; g.gu = 1; g.K = DM; }
        else { g.A = p.hid; g.lda = FF; g.gshift = 0; g.B0 = p.wb_down + ex * FF * DM; g.B1 = g.B0; g.ldb = DM; g.gu = 0; g.K = FF; }
        gemm_tile<EPI>(p, smem, g, layer);
    }
}

DI void convert_flat(const float* __restrict__ src, bf16_t* __restrict__ dst, size_t n8) {
    for (size_t i = (size_t)blockIdx.x * 256 + threadIdx.x; i < n8; i += (size_t)gridDim.x * 256) {
        const f32x4 a = *(const f32x4*)(src + i * 8), b = *(const f32x4*)(src + i * 8 + 4);
        u32x4 w; w.x = pack2(a[0], a[1]); w.y = pack2(a[2], a[3]); w.z = pack2(b[0], b[1]); w.w = pack2(b[2], b[3]);
        *(u32x4*)(dst + i * 8) = w;
    }
}
DI void poolfold_unit(const P& p, char* smem, int unit) {
    float (*At)[64] = (float (*)[64])smem;
    float (*Bs)[64] = (float (*)[64])(smem + 32768);
    const int tid = threadIdx.x, g = unit >> 5, c0 = ((unit >> 4) & 1) * 64, n0 = (unit & 15) * 64;
    __syncthreads();
    for (int i = 0; i < 32; ++i) { const int idx = tid + 256 * i, d = idx >> 6, c = idx & 63;
        At[d][c] = p.pool_w[(size_t)(g * 128 + c0 + c) * 128 + d] * p.pool_scale[g * 128 + d]; }
    for (int i = 0; i < 8; ++i) { const int idx = tid + 256 * i, d = idx >> 4, n4 = (idx & 15) * 4;
        *(f32x4*)&Bs[d][n4] = *(const f32x4*)(p.w_out_even + (size_t)(512 + g * 128 + d) * DM + n0 + n4); }
    __syncthreads();
    const int tc = (tid >> 4) * 4, tn = (tid & 15) * 4;
    f32x4 acc[4];
#pragma unroll
    for (int i = 0; i < 4; ++i) acc[i] = (f32x4){0.f, 0.f, 0.f, 0.f};
    for (int d = 0; d < 128; ++d) {
        const f32x4 a = *(const f32x4*)&At[d][tc], b = *(const f32x4*)&Bs[d][tn];
#pragma unroll
        for (int i = 0; i < 4; ++i) acc[i] += a[i] * b;
    }
#pragma unroll
    for (int i = 0; i < 4; ++i) { u32x2 w; w.x = pack2(acc[i][0], acc[i][1]); w.y = pack2(acc[i][2], acc[i][3]);
        *(u32x2*)(p.wb_out_even + (size_t)(512 + g * 128 + c0 + tc + i) * DM + n0 + tn) = w; }
}
DI void rmsnorm_row(const float* __restrict__ hr, const float* __restrict__ gain, bf16_t* __restrict__ dst, int lane) {
    f32x4 v[4]; float ss = 0.f;
#pragma unroll
    for (int i = 0; i < 4; ++i) { v[i] = *(const f32x4*)(hr + i * 256 + lane * 4); ss += v[i][0] * v[i][0] + v[i][1] * v[i][1] + v[i][2] * v[i][2] + v[i][3] * v[i][3]; }
    ss = wave_sum(ss);
    const float rstd = rsqrtf(ss * (1.0f / DM) + EPS);
#pragma unroll
    for (int i = 0; i < 4; ++i) { const f32x4 g = *(const f32x4*)(gain + i * 256 + lane * 4);
        u32x2 w; w.x = pack2(v[i][0] * rstd * g[0], v[i][1] * rstd * g[1]); w.y = pack2(v[i][2] * rstd * g[2], v[i][3] * rstd * g[3]);
        *(u32x2*)(dst + i * 256 + lane * 4) = w; }
}
DI void ph_prologue(const P& p, char* smem) {
    if (blockIdx.x == 0 && threadIdx.x < 64) p.cnt[threadIdx.x] = 0;
    for (int u = blockIdx.x; u < 128; u += gridDim.x) poolfold_unit(p, smem, u);
    for (int i = blockIdx.x * 256 + threadIdx.x; i < 2 * 96 * DM; i += gridDim.x * 256) {
        const int k = i & (DM - 1), R = (i >> 10) % 96, layer = i / (96 * DM);
        const int T = R >> 5, r = R & 31, L = 16 * T + (r & 3) + 4 * (r >> 3);
        float w = 0.f;
        if (L < 32) w = p.w_re[((size_t)layer * DM + k) * 32 + L]; else if (L < 36) w = p.w_rg[((size_t)layer * DM + k) * 4 + (L - 32)];
        w *= p.ffn_norm[layer * DM + k];
        const unsigned hi = pack2(w, 0.f) & 0xffffu;
        p.wr_hi[i] = (bf16_t)hi; p.wr_lo[i] = (bf16_t)(pack2(w - __uint_as_float(hi << 16), 0.f) & 0xffffu);
    }
    const int wave = threadIdx.x >> 6, lane = threadIdx.x & 63;
    for (int u = blockIdx.x; u < NTOK / 4; u += gridDim.x) {
        const int tok = u * 4 + wave;
        rmsnorm_row(p.x + (size_t)tok * DM, p.mix_norm_even, p.xn + (size_t)tok * DM, lane);
    }
    convert_flat(p.w_in_even, p.wb_in_even, (size_t)DM * EVEN_IN / 8);
    convert_flat(p.w_out_even, p.wb_out_even, (size_t)512 * DM / 8);
    convert_flat(p.w_in_odd, p.wb_in_odd, (size_t)DM * ODD_IN / 8);
    convert_flat(p.w_out_odd, p.wb_out_odd, (size_t)DM * DM / 8);
    convert_flat(p.w_gate, p.wb_gate, (size_t)64 * DM * FF / 8);
    convert_flat(p.w_up, p.wb_up, (size_t)64 * DM * FF / 8);
    convert_flat(p.w_down, p.wb_down, (size_t)64 * FF * DM / 8);
}

DI int crow(int i, int h) { return (i & 3) + 8 * (i >> 2) + 4 * h; }
DI float swap_max(float v) { auto rr = __builtin_amdgcn_permlane32_swap(__float_as_uint(v), __float_as_uint(v), false, false); return fmaxf(__uint_as_float(rr[0]), __uint_as_float(rr[1])); }
DI float swap_sum(float v) { auto rr = __builtin_amdgcn_permlane32_swap(__float_as_uint(v), __float_as_uint(v), false, false); return __uint_as_float(rr[0]) + __uint_as_float(rr[1]); }
DI float bcast_lo(float v) { auto rr = __builtin_amdgcn_permlane32_swap(__float_as_uint(v), __float_as_uint(v), false, false); return __uint_as_float(rr[0]); }
DI bf16x8 pack8(const f32x16& x, int s) {
    u32x4 w; w.x = pack2(x[8 * s], x[8 * s + 1]); w.y = pack2(x[8 * s + 2], x[8 * s + 3]); w.z = pack2(x[8 * s + 4], x[8 * s + 5]); w.w = pack2(x[8 * s + 6], x[8 * s + 7]);
    return __builtin_bit_cast(bf16x8, w);
}
constexpr int KV_TILE = 8192;
struct KVStage { u32x4 k[2], v[2]; };
DI void kv_load(KVStage& st, const bf16_t* kbase, const bf16_t* vbase, int ld, int key0) {
    const int tid = threadIdx.x, c = tid & 7, r0 = tid >> 3;
#pragma unroll
    for (int i = 0; i < 2; ++i) { const size_t off = (size_t)(key0 + r0 + 32 * i) * ld + c * 8; st.k[i] = *(const u32x4*)(kbase + off); st.v[i] = *(const u32x4*)(vbase + off); }
}
DI void kv_store(const KVStage& st, char* kt, char* vt) {
    const int tid = threadIdx.x, c = tid & 7, r0 = tid >> 3;
#pragma unroll
    for (int i = 0; i < 2; ++i) { const int r = r0 + 32 * i;
        *(u32x4*)(kt + r * 128 + ((c ^ ((r >> 1) & 7)) << 4)) = st.k[i];
        *(u32x4*)(vt + r * 128 + ((((c >> 2) ^ ((r >> 1) & 1))) << 6) + ((c & 3) << 4)) = st.v[i]; }
}
DI bf16x8 k_frag(const char* kt, int sb, int st, int r32, int hh) {
    const int row = sb * 32 + r32;
    return *(const bf16x8*)(kt + row * 128 + (((2 * st + hh) ^ ((row >> 1) & 7)) << 4));
}
DI bf16x8 vt_frag(const char* vt, int sb, int st, int dh, int lane) {
    const int hh = lane >> 5, g1 = (lane >> 4) & 1, pp = lane & 3, q = (lane & 15) >> 2;
    const int key = sb * 32 + 16 * st + 4 * hh + q;
    const char* a = vt + key * 128 + ((dh ^ ((q >> 1) & 1)) << 6) + g1 * 32 + pp * 8;
    const s16x4 lo = tr_read(a), hi = tr_read(a + 8 * 128);
    return (bf16x8){lo[0], lo[1], lo[2], lo[3], hi[0], hi[1], hi[2], hi[3]};
}


#define XB_TMO      128
#define XB_XCNT(j)  (256  + 64 * (j))
#define XB_XSUB(j)  (1280 + 64 * (j))
#define XB_XGEN(j)  (2304 + 64 * (j))
#define XB_TOP      3328
#define XB_TOPGEN   3392
#define XCD_BAR_WORDS 3456
#define XB_SPIN_CAP (1u << 22)
DI unsigned xb_ld(unsigned* q)              { return __hip_atomic_load(q, __ATOMIC_RELAXED, __HIP_MEMORY_SCOPE_AGENT); }
DI unsigned xb_add(unsigned* q, unsigned v) { return __hip_atomic_fetch_add(q, v, __ATOMIC_RELAXED, __HIP_MEMORY_SCOPE_AGENT); }
DI unsigned xb_xcc_id() { return (unsigned)__builtin_amdgcn_s_getreg((3 << 11) | 20) & 0xFu; }
#define XB_SPIN(cond, bar) do { unsigned _sp = 0; while (cond) { __builtin_amdgcn_s_sleep(1); \
    if ((++_sp & 255u) == 0u) { if (xb_ld(&(bar)[XB_TMO])) break; if (_sp > XB_SPIN_CAP) { atomicAdd(&(bar)[XB_TMO], 1u); break; } } } } while (0)
struct XcdBarrier { unsigned* bar; unsigned x; volatile LDSAS unsigned* st; };
DI XcdBarrier xcd_barrier_post(unsigned* bar, volatile LDSAS unsigned* st) {
    XcdBarrier b; b.bar = bar; b.x = xb_xcc_id(); b.st = st;
    if (threadIdx.x == 0) (void)xb_add(&bar[XB_XCNT(b.x)], 1u);
    return b;
}
DI void xcd_barrier_complete(unsigned* bar, unsigned x, unsigned& nloc, unsigned& nx) {
    const unsigned G = gridDim.x * gridDim.y * gridDim.z;
    unsigned sum, cnt, mine, sp = 0u;
    for (;;) {
        sum = 0u; cnt = 0u; mine = 0u;
#pragma unroll
        for (unsigned j = 0; j < 16; ++j) { const unsigned c = xb_ld(&bar[XB_XCNT(j)]); sum += c; cnt += (c > 0u) ? 1u : 0u; mine = (j == x) ? c : mine; }
        if (sum == G) break;
        __builtin_amdgcn_s_sleep(1);
        if ((++sp & 255u) == 0u) { if (xb_ld(&bar[XB_TMO])) break; if (sp > XB_SPIN_CAP) { atomicAdd(&bar[XB_TMO], 1u); break; } }
    }
    nloc = mine > 0u ? mine : 1u; nx = cnt > 0u ? cnt : 1u;
}
DI void xcd_barrier(const XcdBarrier& b) {
    asm volatile("s_waitcnt vmcnt(0)" ::: "memory");
    __syncthreads();
    if (threadIdx.x == 0) {
        unsigned* bar = b.bar;
        __builtin_amdgcn_s_waitcnt(0);
        unsigned nloc = b.st[0], nx = b.st[1];
        if (nloc == 0u) { xcd_barrier_complete(bar, b.x, nloc, nx); b.st[0] = nloc; b.st[1] = nx; }
        const unsigned old = xb_add(&bar[XB_XSUB(b.x)], 1u);
        const unsigned gen = old / nloc;
        if (old + 1u == (gen + 1u) * nloc) {
            __builtin_amdgcn_fence(__ATOMIC_RELEASE, "agent");
            asm volatile("s_waitcnt vmcnt(0)" ::: "memory");
            const unsigned og = xb_add(&bar[XB_TOP], 1u);
            const unsigned tg = og / nx;
            if (og + 1u == (tg + 1u) * nx) xb_add(&bar[XB_TOPGEN], 1u);
            else XB_SPIN(xb_ld(&bar[XB_TOPGEN]) == tg, bar);
            __builtin_amdgcn_fence(__ATOMIC_ACQUIRE, "agent");
            xb_add(&bar[XB_XGEN(b.x)], 1u);
            asm volatile("s_waitcnt vmcnt(0)" ::: "memory");
        } else {
            XB_SPIN(xb_ld(&bar[XB_XGEN(b.x)]) == gen, bar);
            __builtin_amdgcn_fence(__ATOMIC_ACQUIRE, "agent");
            asm volatile("s_waitcnt vmcnt(0)" ::: "memory");
        }
    }
    __syncthreads();
}

DI void band_attn_unit(const P& p, char* smem, int unit) {
    const int tid = threadIdx.x, lane = tid & 63, wid = tid >> 6, r32 = lane & 31, hh = lane >> 5;
    const int cp = unit & 31, h = (unit >> 5) & 7, b = unit >> 8;
    const int c = 2 * cp + (wid >> 1);
    const int tq = c * 64 + (wid & 1) * 32 + r32;
    const size_t rowb = (size_t)b * NS;
    const bf16_t* kbase = p.proj + rowb * EVEN_IN + 512 + h * 64;
    const bf16_t* vbase = p.proj + rowb * EVEN_IN + 1024 + h * 64;
    float* sbias = (float*)(smem + 4 * KV_TILE);
    __syncthreads();
    for (int i = tid; i < 257; i += 256) sbias[i] = p.att_rel_bias[h * 257 + i] * LOG2E;
    bf16x8 qf[4];
#pragma unroll
    for (int st = 0; st < 4; ++st) qf[st] = *(const bf16x8*)(p.proj + (rowb + tq) * EVEN_IN + h * 64 + st * 16 + hh * 8);
    const int ck0 = (2 * cp - 8) > 0 ? (2 * cp - 8) : 0, nt = 2 * cp + 2 - ck0;
    float m = -3.0e38f, lsum = 0.f;
    f32x16 o0, o1;
#pragma unroll
    for (int i = 0; i < 16; ++i) { o0[i] = 0.f; o1[i] = 0.f; }
    KVStage stg;
    kv_load(stg, kbase, vbase, EVEN_IN, ck0 * 64);
    kv_store(stg, smem, smem + 2 * KV_TILE);
    __syncthreads();
    for (int it = 0; it < nt; ++it) {
        const int ck = ck0 + it, cur = it & 1;
        if (it + 1 < nt) kv_load(stg, kbase, vbase, EVEN_IN, (ck + 1) * 64);
        const char* kt = smem + cur * KV_TILE; const char* vt = smem + (2 + cur) * KV_TILE;
        if (ck >= c - 8 && ck <= c) {
            f32x16 s0, s1;
#pragma unroll
            for (int i = 0; i < 16; ++i) { s0[i] = 0.f; s1[i] = 0.f; }
#pragma unroll
            for (int st = 0; st < 4; ++st) { s0 = MFMA32(k_frag(kt, 0, st, r32, hh), qf[st], s0); s1 = MFMA32(k_frag(kt, 1, st, r32, hh), qf[st], s1); }
            if (c - ck >= 3) { const float bb = sbias[256];
#pragma unroll
                for (int i = 0; i < 16; ++i) { s0[i] += bb; s1[i] += bb; }
            } else {
                const int d0 = tq - ck * 64 - 4 * hh;
#pragma unroll
                for (int i = 0; i < 16; ++i) {
                    int da = d0 - ((i & 3) + 8 * (i >> 2)), db = da - 32;
                    da = da > 128 ? 128 : da; db = db > 128 ? 128 : db;
                    s0[i] += sbias[da + 128]; s1[i] += sbias[db + 128];
                }
            }
            float tm = fmaxf(s0[0], s1[0]);
#pragma unroll
            for (int i = 1; i < 16; ++i) tm = fmaxf(tm, fmaxf(s0[i], s1[i]));
            tm = swap_max(tm);
            const float mn = fmaxf(m, tm);
            const float alpha = __builtin_amdgcn_exp2f(m - mn);
            m = mn;
            float ps = 0.f;
#pragma unroll
            for (int i = 0; i < 16; ++i) { s0[i] = __builtin_amdgcn_exp2f(s0[i] - mn); s1[i] = __builtin_amdgcn_exp2f(s1[i] - mn); ps += s0[i] + s1[i]; }
            lsum = lsum * alpha + ps;
#pragma unroll
            for (int i = 0; i < 16; ++i) { o0[i] *= alpha; o1[i] *= alpha; }
#pragma unroll
            for (int st = 0; st < 2; ++st) {
                const bf16x8 pa = pack8(s0, st), pb = pack8(s1, st);
                o0 = MFMA32(vt_frag(vt, 0, st, 0, lane), pa, o0); o1 = MFMA32(vt_frag(vt, 0, st, 1, lane), pa, o1);
                o0 = MFMA32(vt_frag(vt, 1, st, 0, lane), pb, o0); o1 = MFMA32(vt_frag(vt, 1, st, 1, lane), pb, o1);
            }
        }
        if (it + 1 < nt) kv_store(stg, smem + (cur ^ 1) * KV_TILE, smem + (2 + (cur ^ 1)) * KV_TILE);
        __syncthreads();
    }
    const float inv = 1.0f / swap_sum(lsum);
    bf16_t* orow = p.mixed + (rowb + tq) * DM + h * 64 + 4 * hh;
#pragma unroll
    for (int g = 0; g < 4; ++g) {
        u32x2 w0, w1;
        w0.x = pack2(o0[4 * g] * inv, o0[4 * g + 1] * inv); w0.y = pack2(o0[4 * g + 2] * inv, o0[4 * g + 3] * inv);
        w1.x = pack2(o1[4 * g] * inv, o1[4 * g + 1] * inv); w1.y = pack2(o1[4 * g + 2] * inv, o1[4 * g + 3] * inv);
        *(u32x2*)(orow + 8 * g) = w0; *(u32x2*)(orow + 32 + 8 * g) = w1;
    }
}

DI void sb_attn_unit(const P& p, char* smem, int unit) {
    const int tid = threadIdx.x, lane = tid & 63, wid = tid >> 6, r32 = lane & 31, hh = lane >> 5;
    const int qb = unit & 31, h = (unit >> 5) & 7, b = unit >> 8;
    const int tw = qb * 128 + wid * 32, t = tw + r32;
    const size_t rowb = (size_t)b * NS;
    const bf16_t* kbase = p.proj + rowb * ODD_IN + 1536 + h * 64;
    const bf16_t* vbase = p.proj + rowb * ODD_IN + 2048 + h * 64;
    volatile int* wdone = (volatile int*)(smem + 4 * KV_TILE);
    __syncthreads();
    bf16x8 qf[4];
#pragma unroll
    for (int st = 0; st < 4; ++st) qf[st] = *(const bf16x8*)(p.proj + (rowb + t) * ODD_IN + 1024 + h * 64 + st * 16 + hh * 8);
    bf16x8 tf[2];
#pragma unroll
    for (int st = 0; st < 2; ++st)
#pragma unroll
        for (int j = 0; j < 8; ++j) tf[st][j] = (16 * st + 8 * (j >> 2) + 4 * hh + (j & 3)) >= r32 ? (short)0x3F80 : (short)0;
    f32x16 o0, o1;
#pragma unroll
    for (int i = 0; i < 16; ++i) { o0[i] = 0.f; o1[i] = 0.f; }
    float carry = 0.f; bool done = false;
    const int kt0 = 2 * qb + 1;
    KVStage stg;
    kv_load(stg, kbase, vbase, ODD_IN, kt0 * 64);
    kv_store(stg, smem, smem + 2 * KV_TILE);
    __syncthreads();
    for (int it = 0; it <= kt0; ++it) {
        const int kt = kt0 - it, cur = it & 1;
        if (kt > 0) kv_load(stg, kbase, vbase, ODD_IN, (kt - 1) * 64);
        const char* ktile = smem + cur * KV_TILE; const char* vtile = smem + (2 + cur) * KV_TILE;
        if (!done && kt * 64 < tw + 31) {
#pragma unroll
            for (int sbi = 0; sbi < 2; ++sbi) {
                const int sb = 1 - sbi;
                f32x16 x;
#pragma unroll
                for (int i = 0; i < 16; ++i) x[i] = 0.f;
#pragma unroll
                for (int st = 0; st < 4; ++st) x = MFMA32(k_frag(ktile, sb, st, r32, hh), qf[st], x);
                const int kb = kt * 64 + sb * 32 + 4 * hh;
                f32x16 L, Lr;
#pragma unroll
                for (int i = 0; i < 16; ++i) {
                    const bool valid = kb + (i & 3) + 8 * (i >> 2) < t;
                    const float z = x[i];
                    const float sp = fmaxf(z, 0.f) + __builtin_amdgcn_logf(1.0f + __builtin_amdgcn_exp2f(-fabsf(z)));
                    L[i] = valid ? -sp : 0.f;
                    x[i] = valid ? z : -1.0e30f;
                }
                f32x16 cum;
#pragma unroll
                for (int i = 0; i < 16; ++i) cum[i] = carry;
#pragma unroll
                for (int st = 0; st < 2; ++st) {
                    const bf16x8 hi = pack8(L, st);
#pragma unroll
                    for (int j = 0; j < 8; ++j) Lr[8 * st + j] = L[8 * st + j] - __uint_as_float(((unsigned)(unsigned short)hi[j]) << 16);
                    cum = MFMA32(tf[st], hi, cum);
                }
#pragma unroll
                for (int st = 0; st < 2; ++st) cum = MFMA32(tf[st], pack8(Lr, st), cum);
                carry = bcast_lo(cum[0]);
#pragma unroll
                for (int i = 0; i < 16; ++i) x[i] = __builtin_amdgcn_exp2f(x[i] + cum[i]);
#pragma unroll
                for (int st = 0; st < 2; ++st) {
                    const bf16x8 pa = pack8(x, st);
                    o0 = MFMA32(vt_frag(vtile, sb, st, 0, lane), pa, o0); o1 = MFMA32(vt_frag(vtile, sb, st, 1, lane), pa, o1);
                }
            }
            done = __all(carry < -150.0f);
        }
        if (lane == 0) wdone[cur * 4 + wid] = done ? 1 : 0;
        if (kt > 0) kv_store(stg, smem + (cur ^ 1) * KV_TILE, smem + (2 + (cur ^ 1)) * KV_TILE);
        __syncthreads();
        if (wdone[cur * 4] + wdone[cur * 4 + 1] + wdone[cur * 4 + 2] + wdone[cur * 4 + 3] == 4) break;
    }
    bf16_t* orow = p.mixed + (rowb + t) * DM + 512 + h * 64 + 4 * hh;
#pragma unroll
    for (int g = 0; g < 4; ++g) {
        u32x2 w0, w1;
        w0.x = pack2(o0[4 * g], o0[4 * g + 1]); w0.y = pack2(o0[4 * g + 2], o0[4 * g + 3]);
        w1.x = pack2(o1[4 * g], o1[4 * g + 1]); w1.y = pack2(o1[4 * g + 2], o1[4 * g + 3]);
        *(u32x2*)(orow + 8 * g) = w0; *(u32x2*)(orow + 32 + 8 * g) = w1;
    }
}

DI void pool_items(const P& p) {
    for (int it = blockIdx.x * 256 + threadIdx.x; it < NTOK * 64; it += gridDim.x * 256) {
        const int tok = it >> 6, ch8 = it & 63, g = ch8 >> 4, w = 2 << g, s = tok & (NS - 1);
        const int n = (s + 1 < w) ? s + 1 : w;
        float sum[8], own[8];
#pragma unroll
        for (int j = 0; j < 8; ++j) sum[j] = 0.f;
        const bf16_t* src = p.proj + (size_t)tok * EVEN_IN + 1536 + ch8 * 8;
        for (int t = 0; t < n; ++t) {
            unpack8(*(const u32x4*)(src - (size_t)t * EVEN_IN), own);
#pragma unroll
            for (int j = 0; j < 8; ++j) sum[j] += own[j];
        }
        unpack8(*(const u32x4*)src, own);
        const float inv = 1.0f / (float)n;
        u32x4 o; o.x = pack2(sum[0] * inv - own[0], sum[1] * inv - own[1]); o.y = pack2(sum[2] * inv - own[2], sum[3] * inv - own[3]);
        o.z = pack2(sum[4] * inv - own[4], sum[5] * inv - own[5]); o.w = pack2(sum[6] * inv - own[6], sum[7] * inv - own[7]);
        *(u32x4*)(p.mixed + (size_t)tok * DM + 512 + ch8 * 8) = o;
    }
}

DI void ph_mix_even(const P& p, char* smem) {
    for (int u = blockIdx.x; u < NB * 8 * 32; u += gridDim.x) band_attn_unit(p, smem, u);
    pool_items(p);
}

DI void sgu_unit(const P& p, char* smem, int unit) {
    const int tid = threadIdx.x, lane = tid & 63, wid = tid >> 6, wm = wid >> 1, wn = wid & 1, fr = lane & 15, fq = lane >> 4;
    const int g = unit & 3; const size_t tok0 = (size_t)(unit >> 2) * 128;
    char* As = smem; char* Gs = smem + 32768; float* srstd = (float*)(smem + 65536);
    __syncthreads();
    {
        const int row = tid >> 1, half = tid & 1;
        const bf16_t* src = p.proj + (tok0 + row) * ODD_IN + 512 + half * 256;
        float ss = 0.f;
        for (int i = 0; i < 32; ++i) { float f[8]; unpack8(*(const u32x4*)(src + i * 8), f);
#pragma unroll
            for (int j = 0; j < 8; ++j) ss += f[j] * f[j]; }
        ss += __shfl_xor(ss, 1);
        if (half == 0) srstd[row] = rsqrtf(ss * (1.0f / 512.0f) + EPS);
    }
#pragma unroll
    for (int i = 0; i < 8; ++i) {
        const int idx = tid + 256 * i, s = idx >> 4, ch = idx & 15;
        const u32x4 v = *(const u32x4*)(p.proj + (tok0 + s) * ODD_IN + 512 + g * 128 + ch * 8);
        *(u32x4*)(Gs + s * 256 + (((ch >> 1) ^ kswz(s)) << 5) + ((ch & 1) << 4)) = v;
    }
    __syncthreads();
#pragma unroll
    for (int i = 0; i < 8; ++i) {
        const int idx = tid + 256 * i, t = idx >> 4, c8 = idx & 15, s0 = c8 * 8;
        const float* wr = p.sgu_w + ((size_t)g * 128 + t) * 128 + s0;
        const f32x4 a = *(const f32x4*)wr, b = *(const f32x4*)(wr + 4);
        float f[8] = {a[0], a[1], a[2], a[3], b[0], b[1], b[2], b[3]};
#pragma unroll
        for (int j = 0; j < 8; ++j) f[j] = (s0 + j <= t) ? f[j] * srstd[s0 + j] : 0.f;
        u32x4 w; w.x = pack2(f[0], f[1]); w.y = pack2(f[2], f[3]); w.z = pack2(f[4], f[5]); w.w = pack2(f[6], f[7]);
        *(u32x4*)(As + (c8 >> 3) * 16384 + t * 128 + (((c8 & 7) ^ (t & 7)) << 4)) = w;
    }
    __syncthreads();
    f32x4 acc[4][4];
#pragma unroll
    for (int a = 0; a < 4; ++a)
#pragma unroll
        for (int b = 0; b < 4; ++b) acc[a][b] = (f32x4){0.f, 0.f, 0.f, 0.f};
    const int qq = fr >> 2, pp = fr & 3;
#pragma unroll
    for (int kt = 0; kt < 2; ++kt) {
        if (kt == 1 && wm == 0) continue;
#pragma unroll
        for (int s2 = 0; s2 < 2; ++s2) {
            bf16x8 af[4], bfv[4];
#pragma unroll
            for (int i = 0; i < 4; ++i) {
                const int ra_ = wm * 64 + i * 16 + fr;
                af[i] = *(const bf16x8*)(As + kt * 16384 + ra_ * 128 + (((s2 * 4 + fq) ^ (fr & 7)) << 4));
                const int srow = kt * 64 + s2 * 32 + 8 * fq + qq, blk = wn * 4 + i;
                const s16x4 lo = tr_read(Gs + srow * 256 + ((blk ^ kswz(srow)) << 5) + pp * 8);
                const s16x4 hi = tr_read(Gs + (srow + 4) * 256 + ((blk ^ kswz(srow + 4)) << 5) + pp * 8);
                bfv[i] = (bf16x8){lo[0], lo[1], lo[2], lo[3], hi[0], hi[1], hi[2], hi[3]};
            }
#pragma unroll
            for (int mi = 0; mi < 4; ++mi)
#pragma unroll
                for (int ni = 0; ni < 4; ++ni) acc[mi][ni] = __builtin_amdgcn_mfma_f32_16x16x32_bf16(bfv[ni], af[mi], acc[mi][ni], 0, 0, 0);
        }
    }
#pragma unroll
    for (int mi = 0; mi < 4; ++mi) {
        const int t = wm * 64 + mi * 16 + fr;
        const float bias = p.sgu_b[g * 128 + t];
#pragma unroll
        for (int ni = 0; ni < 4; ++ni) {
            const int c = g * 128 + wn * 64 + ni * 16 + fq * 4;
            const f32x4 gn = *(const f32x4*)(p.sgu_v_norm + c);
            const u32x2 uu = *(const u32x2*)(p.proj + (tok0 + t) * ODD_IN + c);
            const float u0 = __uint_as_float(uu.x << 16), u1 = __uint_as_float(uu.x & 0xffff0000u), u2 = __uint_as_float(uu.y << 16), u3 = __uint_as_float(uu.y & 0xffff0000u);
            const f32x4 a = acc[mi][ni];
            u32x2 w; w.x = pack2(u0 * (gn[0] * a[0] + bias), u1 * (gn[1] * a[1] + bias)); w.y = pack2(u2 * (gn[2] * a[2] + bias), u3 * (gn[3] * a[3] + bias));
            *(u32x2*)(p.mixed + (tok0 + t) * DM + c) = w;
        }
    }
}

DI void ph_mix_odd(const P& p, char* smem) {
    for (int u = blockIdx.x; u < NB * 8 * 32; u += gridDim.x) sb_attn_unit(p, smem, u);
    for (int u = blockIdx.x; u < (NTOK / 128) * 4; u += gridDim.x) sgu_unit(p, smem, u);
}

DI void router_unit(const P& p, char* smem, int layer, int unit) {
    const int tid = threadIdx.x, lane = tid & 63, wid = tid >> 6, r32 = lane & 31, hh = lane >> 5;
    float (*part)[36][32] = (float (*)[36][32])smem;
    float (*wss)[32] = (float (*)[32])(smem + 18432);
    int* lcnt = (int*)(smem + 18432 + 512);
    int* lbase = lcnt + 32;
    int* cnt = p.cnt + layer * NEXP;
    const int tok = unit * 32 + r32, kq = wid * 256 + 8 * hh;
    __syncthreads();
    if (tid < 32) lcnt[tid] = 0;
    const float* hrow = p.out + (size_t)tok * DM + kq;
    const float* gn = p.ffn_norm + layer * DM + kq;
    const bf16_t* whi = p.wr_hi + ((size_t)layer * 96 + r32) * DM + kq;
    const bf16_t* wlo = p.wr_lo + ((size_t)layer * 96 + r32) * DM + kq;
    bf16_t* xo = p.xn + (size_t)tok * DM + kq;
    f32x16 c0, c1, c2;
#pragma unroll
    for (int i = 0; i < 16; ++i) { c0[i] = 0.f; c1[i] = 0.f; c2[i] = 0.f; }
    float ss = 0.f;
#pragma unroll 4
    for (int st = 0; st < 16; ++st) {
        const f32x4 a = *(const f32x4*)(hrow + 16 * st), b = *(const f32x4*)(hrow + 16 * st + 4);
        const f32x4 ga = *(const f32x4*)(gn + 16 * st), gb = *(const f32x4*)(gn + 16 * st + 4);
        ss += a[0] * a[0] + a[1] * a[1] + a[2] * a[2] + a[3] * a[3] + b[0] * b[0] + b[1] * b[1] + b[2] * b[2] + b[3] * b[3];
        u32x4 xw; xw.x = pack2(a[0] * ga[0], a[1] * ga[1]); xw.y = pack2(a[2] * ga[2], a[3] * ga[3]); xw.z = pack2(b[0] * gb[0], b[1] * gb[1]); xw.w = pack2(b[2] * gb[2], b[3] * gb[3]);
        *(u32x4*)(xo + 16 * st) = xw;
        u32x4 hw; hw.x = pack2(a[0], a[1]); hw.y = pack2(a[2], a[3]); hw.z = pack2(b[0], b[1]); hw.w = pack2(b[2], b[3]);
        u32x4 lw;
        lw.x = pack2(a[0] - __uint_as_float(hw.x << 16), a[1] - __uint_as_float(hw.x & 0xffff0000u)); lw.y = pack2(a[2] - __uint_as_float(hw.y << 16), a[3] - __uint_as_float(hw.y & 0xffff0000u));
        lw.z = pack2(b[0] - __uint_as_float(hw.z << 16), b[1] - __uint_as_float(hw.z & 0xffff0000u)); lw.w = pack2(b[2] - __uint_as_float(hw.w << 16), b[3] - __uint_as_float(hw.w & 0xffff0000u));
        const bf16x8 hhi = __builtin_bit_cast(bf16x8, hw), hlo = __builtin_bit_cast(bf16x8, lw);
        bf16x8 wh, wl;
        wh = *(const bf16x8*)(whi + 16 * st); wl = *(const bf16x8*)(wlo + 16 * st);
        c0 = MFMA32(wh, hhi, c0); c0 = MFMA32(wh, hlo, c0); c0 = MFMA32(wl, hhi, c0);
        wh = *(const bf16x8*)(whi + 32 * DM + 16 * st); wl = *(const bf16x8*)(wlo + 32 * DM + 16 * st);
        c1 = MFMA32(wh, hhi, c1); c1 = MFMA32(wh, hlo, c1); c1 = MFMA32(wl, hhi, c1);
        wh = *(const bf16x8*)(whi + 64 * DM + 16 * st); wl = *(const bf16x8*)(wlo + 64 * DM + 16 * st);
        c2 = MFMA32(wh, hhi, c2); c2 = MFMA32(wh, hlo, c2); c2 = MFMA32(wl, hhi, c2);
    }
    {
        auto rr = __builtin_amdgcn_permlane32_swap(__float_as_uint(ss), __float_as_uint(ss), false, false);
        ss = __uint_as_float(rr[0]) + __uint_as_float(rr[1]);
        if (hh == 0) {
#pragma unroll
            for (int i = 0; i < 16; ++i) { part[wid][i][r32] = c0[i]; part[wid][16 + i][r32] = c1[i]; }
#pragma unroll
            for (int i = 0; i < 4; ++i) part[wid][32 + i][r32] = c2[i];
            wss[wid][r32] = ss;
        }
    }
    __syncthreads();
    int e1 = 0, e2 = 0, r1 = 0, r2 = 0; float w1 = 0.f, w2 = 0.f, rstd = 0.f;
    const int mytok = unit * 32 + tid;
    if (tid < 32) {
        rstd = rsqrtf((wss[0][tid] + wss[1][tid] + wss[2][tid] + wss[3][tid]) * (1.0f / DM) + EPS);
        float gl[4], ev[8];
#pragma unroll
        for (int j = 0; j < 4; ++j) gl[j] = (part[0][32 + j][tid] + part[1][32 + j][tid] + part[2][32 + j][tid] + part[3][32 + j][tid]) * rstd;
        int gs = 0; float gm = gl[0];
#pragma unroll
        for (int j = 1; j < 4; ++j) if (gl[j] > gm) { gm = gl[j]; gs = j; }
        const float gw = 1.0f / (__expf(gl[0] - gm) + __expf(gl[1] - gm) + __expf(gl[2] - gm) + __expf(gl[3] - gm));
#pragma unroll
        for (int j = 0; j < 8; ++j) { const int s = gs * 8 + j; ev[j] = (part[0][s][tid] + part[1][s][tid] + part[2][s][tid] + part[3][s][tid]) * rstd; }
        int i1 = 0; float v1 = ev[0];
#pragma unroll
        for (int j = 1; j < 8; ++j) if (ev[j] > v1) { v1 = ev[j]; i1 = j; }
        int i2 = -1; float v2 = -3.0e38f;
#pragma unroll
        for (int j = 0; j < 8; ++j) if (j != i1 && ev[j] > v2) { v2 = ev[j]; i2 = j; }
        w1 = 1.0f / (1.0f + __expf(v2 - v1)); w2 = (1.0f - w1) * gw; w1 *= gw;
        e1 = gs * 8 + i1; e2 = gs * 8 + i2;
        r1 = atomicAdd(lcnt + e1, 1); r2 = atomicAdd(lcnt + e2, 1);
    }
    __syncthreads();
    if (tid < 32) { const int n = lcnt[tid]; lbase[tid] = n ? atomicAdd(cnt + tid, n) : 0; }
    __syncthreads();
    if (tid < 32) {
        p.plist[(size_t)e1 * LISTCAP + lbase[e1] + r1] = mytok * 2; p.plist[(size_t)e2 * LISTCAP + lbase[e2] + r2] = mytok * 2 + 1;
        p.pw[mytok * 2] = w1; p.pw[mytok * 2 + 1] = w2; p.rs[mytok] = rstd;
    }
}
DI void ph_router(const P& p, char* smem, int layer) {
    for (int u = blockIdx.x; u < NTOK / 32; u += gridDim.x) router_unit(p, smem, layer, u);
}

DI void ph_combine(const P& p, int layer) {
    const int wave = threadIdx.x >> 6, lane = threadIdx.x & 63;
    for (int u = blockIdx.x; u < NTOK / 4; u += gridDim.x) {
        const size_t tok = (size_t)u * 4 + wave;
        float* hr = p.out + tok * DM;
        f32x4 v[4]; float ss = 0.f;
#pragma unroll
        for (int i = 0; i < 4; ++i) {
            const int c = i * 256 + lane * 4;
            f32x4 h = *(const f32x4*)(hr + c);
            const u32x2 a = *(const u32x2*)(p.y + (tok * 2) * DM + c), b = *(const u32x2*)(p.y + (tok * 2 + 1) * DM + c);
            h[0] += bf2f((bf16_t)(a.x & 0xffff)) + bf2f((bf16_t)(b.x & 0xffff));
            h[1] += bf2f((bf16_t)(a.x >> 16)) + bf2f((bf16_t)(b.x >> 16));
            h[2] += bf2f((bf16_t)(a.y & 0xffff)) + bf2f((bf16_t)(b.y & 0xffff));
            h[3] += bf2f((bf16_t)(a.y >> 16)) + bf2f((bf16_t)(b.y >> 16));
            *(f32x4*)(hr + c) = h; v[i] = h;
            ss += h[0] * h[0] + h[1] * h[1] + h[2] * h[2] + h[3] * h[3];
        }
        if (layer == 0) {
            ss = wave_sum(ss);
            const float rstd = rsqrtf(ss * (1.0f / DM) + EPS);
#pragma unroll
            for (int i = 0; i < 4; ++i) { const f32x4 g = *(const f32x4*)(p.mix_norm_odd + i * 256 + lane * 4);
                u32x2 w; w.x = pack2(v[i][0] * rstd * g[0], v[i][1] * rstd * g[1]); w.y = pack2(v[i][2] * rstd * g[2], v[i][3] * rstd * g[3]);
                *(u32x2*)(p.xn + tok * DM + i * 256 + lane * 4) = w; }
        }
    }
}

constexpr int NPHASE = 15;
#ifndef REPS
#define REPS {1,1,1,1,1,1,1,1,1,1,1,1,1,1,1}
#endif
__device__ constexpr int REP[15] = REPS;
__global__ __launch_bounds__(256, 2) void mega(P p, int ph0, int ph1) {
    __shared__ __attribute__((aligned(16))) char smem[SMEM_BYTES + 16];
    volatile LDSAS unsigned* xst = (volatile LDSAS unsigned*)(smem + SMEM_BYTES);
    if (threadIdx.x < 4) xst[threadIdx.x] = 0u;
    __syncthreads();
    const XcdBarrier xb = xcd_barrier_post(p.bar, xst);
#define PHASE(i, call) if (ph0 <= (i) && (i) < ph1) { for (int r_ = 0; r_ < REP[i]; ++r_) { call; if (r_ + 1 < REP[i] || (i) + 1 < ph1) xcd_barrier(xb); } }
    PHASE(0, ph_prologue(p, smem))
    PHASE(1, (ph_gemm_dense<EPI_IN_EVEN>(p, smem, p.xn, DM, p.wb_in_even, DM, EVEN_IN, 0)))
    PHASE(2, ph_mix_even(p, smem))
    PHASE(3, (ph_gemm_dense<EPI_OUT>(p, smem, p.mixed, DM, p.wb_out_even, DM, DM, 0)))
    PHASE(4, ph_router(p, smem, 0))
    PHASE(5, (ph_gemm_moe<EPI_GU>(p, smem, 0)))
    PHASE(6, (ph_gemm_moe<EPI_DOWN>(p, smem, 0)))
    PHASE(7, ph_combine(p, 0))
    PHASE(8, (ph_gemm_dense<EPI_IN_ODD>(p, smem, p.xn, DM, p.wb_in_odd, DM, ODD_IN, 1)))
    PHASE(9, ph_mix_odd(p, smem))
    PHASE(10, (ph_gemm_dense<EPI_OUT>(p, smem, p.mixed, DM, p.wb_out_odd, DM, DM, 1)))
    PHASE(11, ph_router(p, smem, 1))
    PHASE(12, (ph_gemm_moe<EPI_GU>(p, smem, 1)))
    PHASE(13, (ph_gemm_moe<EPI_DOWN>(p, smem, 1)))
    PHASE(14, ph_combine(p, 1))
}

extern "C" void kernel_launch(void* const* d_in, const int* in_sizes, int n_in, void* d_out, int out_size, void* d_ws, size_t ws_size, hipStream_t stream) {
    P p{};
    p.x = (const float*)d_in[0]; p.mix_norm_even = (const float*)d_in[1]; p.w_in_even = (const float*)d_in[2]; p.att_q_norm = (const float*)d_in[3];
    p.att_k_norm = (const float*)d_in[4]; p.att_rel_bias = (const float*)d_in[5]; p.pool_w = (const float*)d_in[6]; p.pool_scale = (const float*)d_in[7];
    p.w_out_even = (const float*)d_in[8]; p.mix_norm_odd = (const float*)d_in[9]; p.w_in_odd = (const float*)d_in[10]; p.sgu_v_norm = (const float*)d_in[11];
    p.sgu_w = (const float*)d_in[12]; p.sgu_b = (const float*)d_in[13]; p.w_out_odd = (const float*)d_in[14]; p.ffn_norm = (const float*)d_in[15];
    p.w_rg = (const float*)d_in[16]; p.w_re = (const float*)d_in[17]; p.w_gate = (const float*)d_in[18]; p.w_up = (const float*)d_in[19]; p.w_down = (const float*)d_in[20];
    p.out = (float*)d_out;
    char* ws = (char*)d_ws; size_t off = 0;
    auto take = [&](size_t bytes) { char* r = ws + off; off += (bytes + 255) & ~(size_t)255; return r; };
    p.wb_in_even = (bf16_t*)take((size_t)EVEN_IN * DM * 2);
    p.wb_out_even = (bf16_t*)take((size_t)DM * DM * 2);
    p.wb_in_odd = (bf16_t*)take((size_t)ODD_IN * DM * 2);
    p.wb_out_odd = (bf16_t*)take((size_t)DM * DM * 2);
    p.wb_gate = (bf16_t*)take((size_t)2 * NEXP * DM * FF * 2);
    p.wb_up = (bf16_t*)take((size_t)2 * NEXP * DM * FF * 2);
    p.wb_down = (bf16_t*)take((size_t)2 * NEXP * DM * FF * 2);
    p.wr_hi = (bf16_t*)take((size_t)2 * 96 * DM * 2);
    p.wr_lo = (bf16_t*)take((size_t)2 * 96 * DM * 2);
    p.xn = (bf16_t*)take((size_t)NTOK * DM * 2);
    p.proj = (bf16_t*)take((size_t)NTOK * ODD_IN * 2);
    p.y = p.proj;
    p.mixed = (bf16_t*)take((size_t)NTOK * DM * 2);
    p.hid = p.mixed;
    p.pw = (float*)take((size_t)NTOK * 2 * 4);
    p.rs = (float*)take((size_t)NTOK * 4);
    p.plist = (int*)take((size_t)NEXP * LISTCAP * 4);
    p.cnt = (int*)take(256);
    p.bar = (unsigned*)take(XCD_BAR_WORDS * 4);
    (void)hipMemsetAsync(p.bar, 0, XCD_BAR_WORDS * 4, stream);

    static int grid_blocks = 0;
    if (!grid_blocks) {
        int dev = 0, cus = 0, per_cu = 0;
        (void)hipGetDevice(&dev);
        (void)hipDeviceGetAttribute(&cus, hipDeviceAttributeMultiprocessorCount, dev);
        (void)hipOccupancyMaxActiveBlocksPerMultiprocessor(&per_cu, mega, 256, 0);
        if (per_cu > 2) per_cu = 2;
        if (per_cu < 1) per_cu = 1;
        grid_blocks = cus * per_cu;
    }
    int ph0 = 0, ph1 = NPHASE;
    void* args[] = {&p, &ph0, &ph1};
    hipError_t e = hipLaunchCooperativeKernel((void*)mega, dim3(grid_blocks), dim3(256), args, 0, stream);
    if (e != hipSuccess) fprintf(stderr, "cooperative launch failed: %s (grid %d)\n", hipGetErrorString(e), grid_blocks);
}
```

```cpp
#include <hip/hip_runtime.h>
#include <hip/hip_cooperative_groups.h>
#include <stdint.h>
#include <stdio.h>

typedef unsigned short bf16_t;
typedef short bf16x8 __attribute__((ext_vector_type(8)));
typedef short s16x4 __attribute__((ext_vector_type(4)));
typedef float f32x2 __attribute__((ext_vector_type(2)));
typedef float f32x4 __attribute__((ext_vector_type(4)));
typedef float f32x16 __attribute__((ext_vector_type(16)));
typedef unsigned u32x4 __attribute__((ext_vector_type(4)));
typedef unsigned u32x2 __attribute__((ext_vector_type(2)));
typedef __bf16 bf16x2n __attribute__((ext_vector_type(2)));

#define DI __device__ __forceinline__
#define LDSAS __attribute__((address_space(3)))
#define MFMA32(a, b, c) __builtin_amdgcn_mfma_f32_32x32x16_bf16((a), (b), (c), 0, 0, 0)
#define MFMA16(a, b, c) __builtin_amdgcn_mfma_f32_16x16x32_bf16((a), (b), (c), 0, 0, 0)

constexpr int NB = 4, NS = 4096, NTOK = NB * NS, DM = 1024;
constexpr int EVEN_IN = 2048, ODD_IN = 2560;
constexpr int NEXP = 32, FF = 256;
constexpr int LISTCAP = NTOK;
constexpr float EPS = 1e-6f;
constexpr float LOG2E = 1.4426950408889634f;
constexpr float QSCALE = 0.125f * LOG2E;

DI float bf2f(bf16_t b) { return __uint_as_float(((unsigned)b) << 16); }
DI unsigned pack2(float lo, float hi) { f32x2 v = {lo, hi}; bf16x2n r = __builtin_convertvector(v, bf16x2n); return __builtin_bit_cast(unsigned, r); }
DI float wave_sum(float v) { for (int o = 32; o > 0; o >>= 1) v += __shfl_xor(v, o); return v; }
DI float gelu_exact(float x) { return 0.5f * x * (1.0f + erff(x * 0.70710678118654752f)); }
DI s16x4 tr_read(const char* p) { return __builtin_bit_cast(s16x4, __builtin_amdgcn_ds_read_tr16_b64_v4i16((LDSAS s16x4*)p)); }
DI void unpack8(const u32x4 v, float* f) {
    f[0] = __uint_as_float(v.x << 16); f[1] = __uint_as_float(v.x & 0xffff0000u); f[2] = __uint_as_float(v.y << 16); f[3] = __uint_as_float(v.y & 0xffff0000u);
    f[4] = __uint_as_float(v.z << 16); f[5] = __uint_as_float(v.z & 0xffff0000u); f[6] = __uint_as_float(v.w << 16); f[7] = __uint_as_float(v.w & 0xffff0000u);
}
DI int kswz(int k) { return (k & 3) | ((k >> 1) & 4); }

struct P {
    const float *x, *mix_norm_even, *w_in_even, *att_q_norm, *att_k_norm, *att_rel_bias, *pool_w, *pool_scale, *w_out_even;
    const float *mix_norm_odd, *w_in_odd, *sgu_v_norm, *sgu_w, *sgu_b, *w_out_odd, *ffn_norm, *w_rg, *w_re, *w_gate, *w_up, *w_down;
    float* out;
    bf16_t *wb_in_even, *wb_out_even, *wb_in_odd, *wb_out_odd, *wb_gate, *wb_up, *wb_down, *wr_hi, *wr_lo;
    bf16_t *xn, *proj, *mixed, *hid, *y;
    float *pw, *rs; int* plist; int* cnt; unsigned* bar;
    const float* cs[10]; bf16_t* cd[10];
};

enum { EPI_IN_EVEN = 0, EPI_IN_ODD = 1, EPI_OUT = 2, EPI_GU = 3, EPI_DOWN = 4 };
constexpr int G_A0 = 0, G_B0 = 65536, G_ROWID = 131072;
constexpr int SMEM_BYTES = 131072 + 1024;
constexpr int HALF_LDS = 66048;

struct GemmArgs {
    const bf16_t* A; int lda; const int* gather; int mvalid; int gshift;
    const bf16_t* B0; const bf16_t* B1; int ldb; int gu;
    int K, m0, n0;
};

DI f32x2 gelu_pk(f32x2 v) {
    const f32x2 av = __builtin_elementwise_abs(v), d = av * 0.2316418882f + 1.0f;
    f32x2 t; t.x = __builtin_amdgcn_rcpf(d.x); t.y = __builtin_amdgcn_rcpf(d.y);
    f32x2 q = t * 0.5307027145f + (-0.7265760135f); q = q * t + 0.7107068705f; q = q * t + (-0.142248368f); q = q * t + 0.127414796f; q = q * t;
    const f32x2 s = (v * v) * (-0.72134752044f);
    f32x2 e; e.x = __builtin_amdgcn_exp2f(s.x); e.y = __builtin_amdgcn_exp2f(s.y);
    const f32x2 m = v * (q * e), r = v - m;
    f32x2 o; o.x = v.x < 0.f ? m.x : r.x; o.y = v.y < 0.f ? m.y : r.y; return o;
}

template <int EPI, int MT>
DI void gemm_tile(const P& p, char* smem, const GemmArgs& g, int layer) {
    const int tid = threadIdx.x, lane = tid & 63, wid = tid >> 6, wm = wid >> 2, wn = wid & 3, r32 = lane & 31, hh = lane >> 5;
    int* rowid = (int*)(smem + G_ROWID);
    const int kc = tid & 7, r0 = tid >> 3;
    const int ch = tid & 31, kr0 = tid >> 5;
    const bf16_t* ap[MT]; const bf16_t* bp[4];
    if (g.gather) { if (tid < 64 * MT) rowid[tid] = (tid < g.mvalid) ? g.gather[tid] : -1; __syncthreads(); }
    const bf16_t* bcol = g.gu ? ((((ch >> 2) & 1) ? g.B1 : g.B0) + (g.n0 >> 1) + (ch >> 3) * 32 + (ch & 3) * 8) : (g.B0 + g.n0 + ch * 8);
#pragma unroll
    for (int i = 0; i < MT; ++i) {
        const int r = r0 + 64 * i;
        size_t arow;
        if (g.gather) { int id = rowid[r]; if (id < 0) id = rowid[0]; arow = (size_t)(id >> g.gshift); } else arow = (size_t)(g.m0 + r);
        ap[i] = g.A + arow * g.lda + kc * 8;
    }
#pragma unroll
    for (int i = 0; i < 4; ++i) bp[i] = bcol + (size_t)(kr0 + 16 * i) * g.ldb;
    const size_t bstep = (size_t)64 * g.ldb;
    f32x16 acc[MT][2];
#pragma unroll
    for (int a = 0; a < MT; ++a)
#pragma unroll
        for (int b = 0; b < 2; ++b)
#pragma unroll
            for (int i = 0; i < 16; ++i) acc[a][b][i] = 0.f;
    u32x4 ra[MT], rb[4];
    const int nk = g.K / 64;
    const int arow0 = wm * 32 * MT + r32;
    const int asw = (r32 >> 1) & 7;
    const int g1 = (lane >> 4) & 1, qq = (lane & 15) >> 2, pp = lane & 3;
    const int bk0 = 8 * hh + qq;
#define G_LOAD(KT) do { _Pragma("unroll") for (int i = 0; i < MT; ++i) ra[i] = *(const u32x4*)(ap[i] + (KT) * 64); \
                        _Pragma("unroll") for (int i = 0; i < 4; ++i) rb[i] = *(const u32x4*)(bp[i] + (size_t)(KT) * bstep); } while (0)
#define G_STORE(BUF) do { char* An_ = smem + G_A0 + (BUF) * 32768; char* Bn_ = smem + G_B0 + (BUF) * 32768; \
        _Pragma("unroll") for (int i = 0; i < MT; ++i) { const int r = r0 + 64 * i; *(u32x4*)(An_ + r * 128 + ((kc ^ ((r >> 1) & 7)) << 4)) = ra[i]; } \
        _Pragma("unroll") for (int i = 0; i < 4; ++i) { const int k = kr0 + 16 * i; *(u32x4*)(Bn_ + k * 512 + (((ch >> 2) ^ (k & 7)) << 6) + ((ch & 3) << 4)) = rb[i]; } } while (0)
#define G_COMPUTE(BUF) do { const char* Ac = smem + G_A0 + (BUF) * 32768; const char* Bc = smem + G_B0 + (BUF) * 32768; \
        _Pragma("unroll") for (int st = 0; st < 4; ++st) { bf16x8 af[MT], bfv[2]; \
            _Pragma("unroll") for (int mt = 0; mt < MT; ++mt) af[mt] = *(const bf16x8*)(Ac + (arow0 + mt * 32) * 128 + (((2 * st + hh) ^ asw) << 4)); \
            _Pragma("unroll") for (int nt = 0; nt < 2; ++nt) { const int k = 16 * st + bk0; \
                const char* b0_ = Bc + k * 512 + (((wn * 2 + nt) ^ (k & 7)) << 6) + g1 * 32 + pp * 8; \
                const char* b1_ = Bc + (k + 4) * 512 + (((wn * 2 + nt) ^ ((k + 4) & 7)) << 6) + g1 * 32 + pp * 8; \
                const s16x4 lo = tr_read(b0_), hi = tr_read(b1_); \
                bfv[nt] = (bf16x8){lo[0], lo[1], lo[2], lo[3], hi[0], hi[1], hi[2], hi[3]}; } \
            _Pragma("unroll") for (int mt = 0; mt < MT; ++mt) _Pragma("unroll") for (int nt = 0; nt < 2; ++nt) acc[mt][nt] = MFMA32(bfv[nt], af[mt], acc[mt][nt]); } } while (0)
    G_LOAD(0);
    G_STORE(0);
    __syncthreads();
    for (int kt = 0; kt < nk; ++kt) {
        const int cur = kt & 1;
        if (kt + 1 < nk) G_LOAD(kt + 1);
        __builtin_amdgcn_sched_barrier(0);
        G_COMPUTE(cur);
        __builtin_amdgcn_sched_barrier(0);
        if (kt + 1 < nk) G_STORE(cur ^ 1);
        __syncthreads();
    }
#undef G_LOAD
#undef G_STORE
#undef G_COMPUTE
    const int colw = g.n0 + wn * 64;
    char* wsl = smem + wid * 16384;
    const int rowb = wm * 32 * MT;
    if (EPI == EPI_IN_EVEN || EPI == EPI_IN_ODD || EPI == EPI_DOWN) {
        const int region = colw >> 9;
        const float* gn = region == 0 ? p.att_q_norm : p.att_k_norm;
        const bool act = colw < 1024;
        const float qs = (colw >= 1024 && colw < 1536) ? QSCALE : 1.0f;
#pragma unroll
        for (int mt = 0; mt < MT; ++mt) {
            float sc = 1.f;
            if (EPI == EPI_IN_EVEN && region < 2) {
                float ss = 0.f;
#pragma unroll
                for (int nt = 0; nt < 2; ++nt)
#pragma unroll
                    for (int i = 0; i < 16; ++i) ss += acc[mt][nt][i] * acc[mt][nt][i];
                auto rr = __builtin_amdgcn_permlane32_swap(__float_as_uint(ss), __float_as_uint(ss), false, false);
                ss = __uint_as_float(rr[0]) + __uint_as_float(rr[1]);
                sc = rsqrtf(ss * (1.0f / 64.0f) + EPS) * (region == 0 ? QSCALE : 1.0f);
            }
#pragma unroll
            for (int nt = 0; nt < 2; ++nt)
#pragma unroll
                for (int gq = 0; gq < 4; ++gq) {
                    f32x2 v0 = {acc[mt][nt][4 * gq], acc[mt][nt][4 * gq + 1]}, v1 = {acc[mt][nt][4 * gq + 2], acc[mt][nt][4 * gq + 3]};
                    if (EPI == EPI_IN_EVEN) { if (region < 2) { const f32x4 gg = *(const f32x4*)(gn + nt * 32 + 8 * gq + 4 * hh); v0.x *= sc * gg[0]; v0.y *= sc * gg[1]; v1.x *= sc * gg[2]; v1.y *= sc * gg[3]; } }
                    else if (EPI == EPI_IN_ODD) { if (act) { v0 = gelu_pk(v0); v1 = gelu_pk(v1); } else { v0 = v0 * qs; v1 = v1 * qs; } }
                    u32x2 w; w.x = pack2(v0.x, v0.y); w.y = pack2(v1.x, v1.y);
                    *(u32x2*)(wsl + r32 * 128 + (((nt * 4 + gq) ^ (r32 & 7)) << 4) + hh * 8) = w;
                }
#pragma unroll
            for (int ps = 0; ps < 4; ++ps) {
                const int row = ps * 8 + (lane >> 3), chunk = lane & 7;
                const u32x4 v = *(const u32x4*)(wsl + row * 128 + ((chunk ^ (row & 7)) << 4));
                const int trow = rowb + mt * 32 + row;
                if (EPI == EPI_DOWN) { const int id = rowid[trow]; if (id >= 0) *(u32x4*)(p.y + (size_t)id * DM + colw + chunk * 8) = v; }
                else if (EPI == EPI_IN_EVEN) *(u32x4*)(p.proj + (size_t)(g.m0 + trow) * EVEN_IN + colw + chunk * 8) = v;
                else *(u32x4*)(p.proj + (size_t)(g.m0 + trow) * ODD_IN + colw + chunk * 8) = v;
            }
        }
    } else if (EPI == EPI_OUT) {
        const float* res = layer == 0 ? p.x : p.out;
#pragma unroll
        for (int mt = 0; mt < MT; ++mt) {
#pragma unroll
            for (int nt = 0; nt < 2; ++nt)
#pragma unroll
                for (int gq = 0; gq < 4; ++gq) {
                    const f32x4 v = {acc[mt][nt][4 * gq], acc[mt][nt][4 * gq + 1], acc[mt][nt][4 * gq + 2], acc[mt][nt][4 * gq + 3]};
                    *(f32x4*)(wsl + r32 * 256 + (((nt * 8 + 2 * gq + hh) ^ (r32 & 15)) << 4)) = v;
                }
#pragma unroll
            for (int ps = 0; ps < 8; ++ps) {
                const int row = ps * 4 + (lane >> 4), chunk = lane & 15;
                const f32x4 v = *(const f32x4*)(wsl + row * 256 + ((chunk ^ (row & 15)) << 4));
                const size_t off = (size_t)(g.m0 + rowb + mt * 32 + row) * DM + colw + chunk * 4;
                const f32x4 r = *(const f32x4*)(res + off);
                *(f32x4*)(p.out + off) = r + v;
            }
        }
    } else if (EPI == EPI_GU) {
        const int f0 = (g.n0 >> 1) + wn * 32;
#pragma unroll
        for (int mt = 0; mt < MT; ++mt) {
            const int id = rowid[rowb + mt * 32 + r32];
            const float w = id >= 0 ? p.pw[id] : 0.f, rs = id >= 0 ? p.rs[id >> 1] : 0.f;
#pragma unroll
            for (int gq = 0; gq < 4; ++gq) {
                float h[4];
#pragma unroll
                for (int j = 0; j < 4; ++j) { const float gt = acc[mt][0][4 * gq + j] * rs, up = acc[mt][1][4 * gq + j] * (rs * w); h[j] = gt / (1.0f + __expf(-gt)) * up; }
                u32x2 ww; ww.x = pack2(h[0], h[1]); ww.y = pack2(h[2], h[3]);
                *(u32x2*)(wsl + r32 * 64 + ((gq ^ (r32 & 3)) << 4) + hh * 8) = ww;
            }
#pragma unroll
            for (int ps = 0; ps < 2; ++ps) {
                const int row = ps * 16 + (lane >> 2), chunk = lane & 3;
                const u32x4 v = *(const u32x4*)(wsl + row * 64 + ((chunk ^ (row & 3)) << 4));
                const int id2 = rowid[rowb + mt * 32 + row];
                if (id2 >= 0) *(u32x4*)(p.hid + (size_t)id2 * FF + f0 + chunk * 8) = v;
            }
        }
    }
    __syncthreads();
}

template <int EPI>
DI void ph_gemm_dense(const P& p, char* smem, const bf16_t* A, int lda, const bf16_t* B, int K, int N, int layer) {
    const int ntn = N / 256, ntm = NTOK / 256, per_xcd = (ntm / 8) * ntn;
    const bool xcd = (gridDim.x & 7) == 0;
    const int x = blockIdx.x & 7, gx = gridDim.x >> 3;
    const int jend = xcd ? per_xcd : ntm * ntn, jstep = xcd ? gx : (int)gridDim.x;
    for (int j = xcd ? (int)(blockIdx.x >> 3) : (int)blockIdx.x; j < jend; j += jstep) {
        GemmArgs g; g.A = A; g.lda = lda; g.gather = nullptr; g.mvalid = 256; g.gshift = 0; g.B0 = B; g.B1 = B; g.ldb = N; g.gu = 0; g.K = K;
        g.m0 = ((xcd ? x * (ntm / 8) : 0) + j / ntn) * 256; g.n0 = (j % ntn) * 256;
        gemm_tile<EPI, 4>(p, smem, g, layer);
    }
}

template <int EPI>
DI void ph_gemm_moe(const P& p, char* smem, int layer) {
    const int ntn = (EPI == EPI_GU) ? 2 : 4;
    const int* cnt = p.cnt + layer * NEXP;
    int total = 0;
    for (int e = 0; e < NEXP; ++e) total += (cnt[e] + 127) >> 7;
    for (int u = blockIdx.x; u < total * ntn; u += gridDim.x) {
        int mt = u / ntn; const int nt = u % ntn;
        int e = 0, c = 0;
        for (; e < NEXP; ++e) { c = cnt[e]; const int t = (c + 127) >> 7; if (mt < t) break; mt -= t; }
        GemmArgs g; g.gather = p.plist + (size_t)e * LISTCAP + mt * 128; g.mvalid = c - mt * 128 < 128 ? c - mt * 128 : 128;
        g.m0 = 0; g.n0 = nt * 256;
        const size_t ex = (size_t)(layer * NEXP + e);
        if (EPI == EPI_GU) { g.A = p.xn; g.lda = DM; g.gshift = 1; g.B0 = p.wb_gate + ex * DM * FF; g.B1 = p.wb_up + ex * DM * FF; g.ldb = FF; g.gu = 1; g.K = DM; }
        else { g.A = p.hid; g.lda = FF; g.gshift = 0; g.B0 = p.wb_down + ex * FF * DM; g.B1 = g.B0; g.ldb = DM; g.gu = 0; g.K = FF; }
        gemm_tile<EPI, 2>(p, smem, g, layer);
    }
}

DI void convert_flat(const float* __restrict__ src, bf16_t* __restrict__ dst, size_t n8) {
    for (size_t i = (size_t)blockIdx.x * 512 + threadIdx.x; i < n8; i += (size_t)gridDim.x * 512) {
        const f32x4 a = *(const f32x4*)(src + i * 8), b = *(const f32x4*)(src + i * 8 + 4);
        u32x4 w; w.x = pack2(a[0], a[1]); w.y = pack2(a[2], a[3]); w.z = pack2(b[0], b[1]); w.w = pack2(b[2], b[3]);
        *(u32x4*)(dst + i * 8) = w;
    }
}
DI void poolfold_unit(const P& p, char* smem, int unit) {
    float (*At)[64] = (float (*)[64])smem;
    float (*Bs)[64] = (float (*)[64])(smem + 32768);
    const int tid = threadIdx.x & 255, g = unit >> 5, c0 = ((unit >> 4) & 1) * 64, n0 = (unit & 15) * 64;
    __syncthreads();
    for (int i = 0; i < 32; ++i) { const int idx = tid + 256 * i, d = idx >> 6, c = idx & 63;
        At[d][c] = p.pool_w[(size_t)(g * 128 + c0 + c) * 128 + d] * p.pool_scale[g * 128 + d]; }
    for (int i = 0; i < 8; ++i) { const int idx = tid + 256 * i, d = idx >> 4, n4 = (idx & 15) * 4;
        *(f32x4*)&Bs[d][n4] = *(const f32x4*)(p.w_out_even + (size_t)(512 + g * 128 + d) * DM + n0 + n4); }
    __syncthreads();
    const int tc = (tid >> 4) * 4, tn = (tid & 15) * 4;
    f32x4 acc[4];
#pragma unroll
    for (int i = 0; i < 4; ++i) acc[i] = (f32x4){0.f, 0.f, 0.f, 0.f};
    for (int d = 0; d < 128; ++d) {
        const f32x4 a = *(const f32x4*)&At[d][tc], b = *(const f32x4*)&Bs[d][tn];
#pragma unroll
        for (int i = 0; i < 4; ++i) acc[i] += a[i] * b;
    }
#pragma unroll
    for (int i = 0; i < 4; ++i) { u32x2 w; w.x = pack2(acc[i][0], acc[i][1]); w.y = pack2(acc[i][2], acc[i][3]);
        *(u32x2*)(p.wb_out_even + (size_t)(512 + g * 128 + c0 + tc + i) * DM + n0 + tn) = w; }
}
DI void rmsnorm_row(const float* __restrict__ hr, const float* __restrict__ gain, bf16_t* __restrict__ dst, int lane) {
    f32x4 v[4]; float ss = 0.f;
#pragma unroll
    for (int i = 0; i < 4; ++i) { v[i] = *(const f32x4*)(hr + i * 256 + lane * 4); ss += v[i][0] * v[i][0] + v[i][1] * v[i][1] + v[i][2] * v[i][2] + v[i][3] * v[i][3]; }
    ss = wave_sum(ss);
    const float rstd = rsqrtf(ss * (1.0f / DM) + EPS);
#pragma unroll
    for (int i = 0; i < 4; ++i) { const f32x4 g = *(const f32x4*)(gain + i * 256 + lane * 4);
        u32x2 w; w.x = pack2(v[i][0] * rstd * g[0], v[i][1] * rstd * g[1]); w.y = pack2(v[i][2] * rstd * g[2], v[i][3] * rstd * g[3]);
        *(u32x2*)(dst + i * 256 + lane * 4) = w; }
}
DI void ph_prologue(const P& p, char* smem) {
    if (blockIdx.x == 0 && threadIdx.x < 64) p.cnt[threadIdx.x] = 0;
    for (int u = blockIdx.x; u < 64; u += gridDim.x) poolfold_unit(p, smem + (threadIdx.x >> 8) * HALF_LDS, u * 2 + (threadIdx.x >> 8));
    for (int i = blockIdx.x * 512 + threadIdx.x; i < 2 * 96 * DM; i += gridDim.x * 512) {
        const int k = i & (DM - 1), R = (i >> 10) % 96, layer = i / (96 * DM);
        const int T = R >> 5, r = R & 31, L = 16 * T + (r & 3) + 4 * (r >> 3);
        float w = 0.f;
        if (L < 32) w = p.w_re[((size_t)layer * DM + k) * 32 + L]; else if (L < 36) w = p.w_rg[((size_t)layer * DM + k) * 4 + (L - 32)];
        w *= p.ffn_norm[layer * DM + k];
        const unsigned hi = pack2(w, 0.f) & 0xffffu;
        p.wr_hi[i] = (bf16_t)hi; p.wr_lo[i] = (bf16_t)(pack2(w - __uint_as_float(hi << 16), 0.f) & 0xffffu);
    }
    const int wave = threadIdx.x >> 6, lane = threadIdx.x & 63;
    for (int u = blockIdx.x; u < NTOK / 8; u += gridDim.x) {
        const int tok = u * 8 + wave;
        rmsnorm_row(p.x + (size_t)tok * DM, p.mix_norm_even, p.xn + (size_t)tok * DM, lane);
    }
    convert_flat(p.w_in_even, p.wb_in_even, (size_t)DM * EVEN_IN / 8);
    convert_flat(p.w_out_even, p.wb_out_even, (size_t)512 * DM / 8);
}
DI void convert_experts(const P& p, int layer) {
    const size_t o = (size_t)layer * NEXP * DM * FF;
    convert_flat(p.w_gate + o, p.wb_gate + o, (size_t)NEXP * DM * FF / 8);
    convert_flat(p.w_up + o, p.wb_up + o, (size_t)NEXP * DM * FF / 8);
    convert_flat(p.w_down + o, p.wb_down + o, (size_t)NEXP * DM * FF / 8);
}

DI int crow(int i, int h) { return (i & 3) + 8 * (i >> 2) + 4 * h; }
DI float swap_max(float v) { auto rr = __builtin_amdgcn_permlane32_swap(__float_as_uint(v), __float_as_uint(v), false, false); return fmaxf(__uint_as_float(rr[0]), __uint_as_float(rr[1])); }
DI float swap_sum(float v) { auto rr = __builtin_amdgcn_permlane32_swap(__float_as_uint(v), __float_as_uint(v), false, false); return __uint_as_float(rr[0]) + __uint_as_float(rr[1]); }
DI float bcast_lo(float v) { auto rr = __builtin_amdgcn_permlane32_swap(__float_as_uint(v), __float_as_uint(v), false, false); return __uint_as_float(rr[0]); }
DI bf16x8 pack8(const f32x16& x, int s) {
    u32x4 w; w.x = pack2(x[8 * s], x[8 * s + 1]); w.y = pack2(x[8 * s + 2], x[8 * s + 3]); w.z = pack2(x[8 * s + 4], x[8 * s + 5]); w.w = pack2(x[8 * s + 6], x[8 * s + 7]);
    return __builtin_bit_cast(bf16x8, w);
}
constexpr int KV_TILE = 8192;
struct KVStage { u32x4 k[2], v[2]; };
DI void kv_load(KVStage& st, const bf16_t* kbase, const bf16_t* vbase, int ld, int key0) {
    const int tid = threadIdx.x & 255, c = tid & 7, r0 = tid >> 3;
#pragma unroll
    for (int i = 0; i < 2; ++i) { const size_t off = (size_t)(key0 + r0 + 32 * i) * ld + c * 8; st.k[i] = *(const u32x4*)(kbase + off); st.v[i] = *(const u32x4*)(vbase + off); }
}
DI void kv_store(const KVStage& st, char* kt, char* vt) {
    const int tid = threadIdx.x & 255, c = tid & 7, r0 = tid >> 3;
#pragma unroll
    for (int i = 0; i < 2; ++i) { const int r = r0 + 32 * i;
        *(u32x4*)(kt + r * 128 + ((c ^ ((r >> 1) & 7)) << 4)) = st.k[i];
        *(u32x4*)(vt + r * 128 + ((((c >> 2) ^ ((r >> 1) & 1))) << 6) + ((c & 3) << 4)) = st.v[i]; }
}
DI bf16x8 k_frag(const char* kt, int sb, int st, int r32, int hh) {
    const int row = sb * 32 + r32;
    return *(const bf16x8*)(kt + row * 128 + (((2 * st + hh) ^ ((row >> 1) & 7)) << 4));
}
DI bf16x8 vt_frag(const char* vt, int sb, int st, int dh, int lane) {
    const int hh = lane >> 5, g1 = (lane >> 4) & 1, pp = lane & 3, q = (lane & 15) >> 2;
    const int key = sb * 32 + 16 * st + 4 * hh + q;
    const char* a = vt + key * 128 + ((dh ^ ((q >> 1) & 1)) << 6) + g1 * 32 + pp * 8;
    const s16x4 lo = tr_read(a), hi = tr_read(a + 8 * 128);
    return (bf16x8){lo[0], lo[1], lo[2], lo[3], hi[0], hi[1], hi[2], hi[3]};
}


#define XB_TMO      128
#define XB_XCNT(j)  (256  + 64 * (j))
#define XB_XSUB(j)  (1280 + 64 * (j))
#define XB_XGEN(j)  (2304 + 64 * (j))
#define XB_TOP      3328
#define XB_TOPGEN   3392
#define XCD_BAR_WORDS 3456
#define XB_SPIN_CAP (1u << 22)
DI unsigned xb_ld(unsigned* q)              { return __hip_atomic_load(q, __ATOMIC_RELAXED, __HIP_MEMORY_SCOPE_AGENT); }
DI unsigned xb_add(unsigned* q, unsigned v) { return __hip_atomic_fetch_add(q, v, __ATOMIC_RELAXED, __HIP_MEMORY_SCOPE_AGENT); }
DI unsigned xb_xcc_id() { return (unsigned)__builtin_amdgcn_s_getreg((3 << 11) | 20) & 0xFu; }
#define XB_SPIN(cond, bar) do { unsigned _sp = 0; while (cond) { __builtin_amdgcn_s_sleep(1); \
    if ((++_sp & 255u) == 0u) { if (xb_ld(&(bar)[XB_TMO])) break; if (_sp > XB_SPIN_CAP) { atomicAdd(&(bar)[XB_TMO], 1u); break; } } } } while (0)
struct XcdBarrier { unsigned* bar; unsigned x; volatile LDSAS unsigned* st; };
DI XcdBarrier xcd_barrier_post(unsigned* bar, volatile LDSAS unsigned* st) {
    XcdBarrier b; b.bar = bar; b.x = xb_xcc_id(); b.st = st;
    if (threadIdx.x == 0) (void)xb_add(&bar[XB_XCNT(b.x)], 1u);
    return b;
}
DI void xcd_barrier_complete(unsigned* bar, unsigned x, unsigned& nloc, unsigned& nx) {
    const unsigned G = gridDim.x * gridDim.y * gridDim.z;
    unsigned sum, cnt, mine, sp = 0u;
    for (;;) {
        sum = 0u; cnt = 0u; mine = 0u;
#pragma unroll
        for (unsigned j = 0; j < 16; ++j) { const unsigned c = xb_ld(&bar[XB_XCNT(j)]); sum += c; cnt += (c > 0u) ? 1u : 0u; mine = (j == x) ? c : mine; }
        if (sum == G) break;
        __builtin_amdgcn_s_sleep(1);
        if ((++sp & 255u) == 0u) { if (xb_ld(&bar[XB_TMO])) break; if (sp > XB_SPIN_CAP) { atomicAdd(&bar[XB_TMO], 1u); break; } }
    }
    nloc = mine > 0u ? mine : 1u; nx = cnt > 0u ? cnt : 1u;
}
DI void xcd_barrier(const XcdBarrier& b) {
    asm volatile("s_waitcnt vmcnt(0)" ::: "memory");
    __syncthreads();
    if (threadIdx.x == 0) {
        unsigned* bar = b.bar;
        __builtin_amdgcn_s_waitcnt(0);
        unsigned nloc = b.st[0], nx = b.st[1];
        if (nloc == 0u) { xcd_barrier_complete(bar, b.x, nloc, nx); b.st[0] = nloc; b.st[1] = nx; }
        const unsigned old = xb_add(&bar[XB_XSUB(b.x)], 1u);
        const unsigned gen = old / nloc;
        if (old + 1u == (gen + 1u) * nloc) {
            __builtin_amdgcn_fence(__ATOMIC_RELEASE, "agent");
            asm volatile("s_waitcnt vmcnt(0)" ::: "memory");
            const unsigned og = xb_add(&bar[XB_TOP], 1u);
            const unsigned tg = og / nx;
            if (og + 1u == (tg + 1u) * nx) xb_add(&bar[XB_TOPGEN], 1u);
            else XB_SPIN(xb_ld(&bar[XB_TOPGEN]) == tg, bar);
            __builtin_amdgcn_fence(__ATOMIC_ACQUIRE, "agent");
            xb_add(&bar[XB_XGEN(b.x)], 1u);
            asm volatile("s_waitcnt vmcnt(0)" ::: "memory");
        } else {
            XB_SPIN(xb_ld(&bar[XB_XGEN(b.x)]) == gen, bar);
            __builtin_amdgcn_fence(__ATOMIC_ACQUIRE, "agent");
            asm volatile("s_waitcnt vmcnt(0)" ::: "memory");
        }
    }
    __syncthreads();
}


struct ConvRegs { f32x4 v[4]; bf16_t* dst; };
struct ConvPlan { int layer; int sl_e, sl_in, sl_out, nslots; };
DI ConvPlan conv_plan(const P& p, int layer) {
    ConvPlan c; c.layer = layer;
    const unsigned per = gridDim.x * 512u;
    c.sl_e = (int)((NEXP * DM * FF / 16 + per - 1) / per);
    c.sl_in = layer == 0 ? (int)((DM * ODD_IN / 16 + per - 1) / per) : 0;
    c.sl_out = layer == 0 ? (int)((DM * DM / 16 + per - 1) / per) : 0;
    c.nslots = 3 * c.sl_e + c.sl_in + c.sl_out;
    return c;
}
DI void conv_load(const P& p, const ConvPlan& c, int slot, ConvRegs& r) {
    r.dst = nullptr;
    if (slot >= c.nslots) return;
    int seg, ls = slot;
    if (ls < 3 * c.sl_e) { seg = ls / c.sl_e; ls -= seg * c.sl_e; }
    else if ((ls -= 3 * c.sl_e) < c.sl_in) seg = 3;
    else { ls -= c.sl_in; seg = 4; }
    const unsigned ng = seg < 3 ? NEXP * DM * FF / 16 : (seg == 3 ? DM * ODD_IN / 16 : DM * DM / 16);
    const float* s = p.cs[c.layer * 5 + seg]; bf16_t* d = p.cd[c.layer * 5 + seg];
    const unsigned gi = ((unsigned)ls * gridDim.x + blockIdx.x) * 512u + threadIdx.x;
    if (gi < ng) {
        const size_t e = (size_t)gi * 16;
        r.dst = d + e;
#pragma unroll
        for (int i = 0; i < 4; ++i) r.v[i] = *(const f32x4*)(s + e + 4 * i);
    }
}
DI void conv_store(ConvRegs& r) {
    if (r.dst) {
        u32x4 a, b;
        a.x = pack2(r.v[0][0], r.v[0][1]); a.y = pack2(r.v[0][2], r.v[0][3]); a.z = pack2(r.v[1][0], r.v[1][1]); a.w = pack2(r.v[1][2], r.v[1][3]);
        b.x = pack2(r.v[2][0], r.v[2][1]); b.y = pack2(r.v[2][2], r.v[2][3]); b.z = pack2(r.v[3][0], r.v[3][1]); b.w = pack2(r.v[3][2], r.v[3][3]);
        *(u32x4*)r.dst = a; *(u32x4*)(r.dst + 8) = b;
    }
}
DI void conv_rest(const P& p, const ConvPlan& c, int slot) {
    for (; slot < c.nslots; ++slot) { ConvRegs r; conv_load(p, c, slot, r); conv_store(r); }
}

DI void band_attn_unit(const P& p, char* smem, int unit, const ConvPlan& cv, int& cslot, ConvRegs& cr) {
    const int tid = threadIdx.x & 255, lane = tid & 63, wid = tid >> 6, r32 = lane & 31, hh = lane >> 5;
    const int cp = unit & 31, h = (unit >> 5) & 7, b = unit >> 8;
    const int c = 2 * cp + (wid >> 1);
    const int tq = c * 64 + (wid & 1) * 32 + r32;
    const size_t rowb = (size_t)b * NS;
    const bf16_t* kbase = p.proj + rowb * EVEN_IN + 512 + h * 64;
    const bf16_t* vbase = p.proj + rowb * EVEN_IN + 1024 + h * 64;
    float* sbias = (float*)(smem + 4 * KV_TILE);
    __syncthreads();
    for (int i = tid; i < 257; i += 256) sbias[i] = p.att_rel_bias[h * 257 + i] * LOG2E;
    bf16x8 qf[4];
#pragma unroll
    for (int st = 0; st < 4; ++st) qf[st] = *(const bf16x8*)(p.proj + (rowb + tq) * EVEN_IN + h * 64 + st * 16 + hh * 8);
    const int ck0 = (2 * cp - 8) > 0 ? (2 * cp - 8) : 0, nt = 2 * cp + 2 - ck0;
    float m = -3.0e38f, lsum = 0.f;
    f32x16 o0, o1;
#pragma unroll
    for (int i = 0; i < 16; ++i) { o0[i] = 0.f; o1[i] = 0.f; }
    KVStage stg;
    kv_load(stg, kbase, vbase, EVEN_IN, ck0 * 64);
    kv_store(stg, smem, smem + 2 * KV_TILE);
    __syncthreads();
    for (int it = 0; it < nt; ++it) {
        const int ck = ck0 + it, cur = it & 1;
        if (it + 1 < nt) kv_load(stg, kbase, vbase, EVEN_IN, (ck + 1) * 64);
        conv_store(cr); conv_load(p, cv, cslot++, cr);
        __builtin_amdgcn_sched_barrier(0);
        const char* kt = smem + cur * KV_TILE; const char* vt = smem + (2 + cur) * KV_TILE;
        if (ck >= c - 8 && ck <= c) {
            f32x16 s0, s1;
#pragma unroll
            for (int i = 0; i < 16; ++i) { s0[i] = 0.f; s1[i] = 0.f; }
#pragma unroll
            for (int st = 0; st < 4; ++st) { s0 = MFMA32(k_frag(kt, 0, st, r32, hh), qf[st], s0); s1 = MFMA32(k_frag(kt, 1, st, r32, hh), qf[st], s1); }
            if (c - ck >= 3) { const float bb = sbias[256];
#pragma unroll
                for (int i = 0; i < 16; ++i) { s0[i] += bb; s1[i] += bb; }
            } else {
                const int d0 = tq - ck * 64 - 4 * hh;
#pragma unroll
                for (int i = 0; i < 16; ++i) {
                    int da = d0 - ((i & 3) + 8 * (i >> 2)), db = da - 32;
                    da = da > 128 ? 128 : da; db = db > 128 ? 128 : db;
                    s0[i] += sbias[da + 128]; s1[i] += sbias[db + 128];
                }
            }
            float tm = fmaxf(s0[0], s1[0]);
#pragma unroll
            for (int i = 1; i < 16; ++i) tm = fmaxf(tm, fmaxf(s0[i], s1[i]));
            tm = swap_max(tm);
            const float mn = fmaxf(m, tm);
            const float alpha = __builtin_amdgcn_exp2f(m - mn);
            m = mn;
            float ps = 0.f;
#pragma unroll
            for (int i = 0; i < 16; ++i) { s0[i] = __builtin_amdgcn_exp2f(s0[i] - mn); s1[i] = __builtin_amdgcn_exp2f(s1[i] - mn); ps += s0[i] + s1[i]; }
            lsum = lsum * alpha + ps;
#pragma unroll
            for (int i = 0; i < 16; ++i) { o0[i] *= alpha; o1[i] *= alpha; }
#pragma unroll
            for (int st = 0; st < 2; ++st) {
                const bf16x8 pa = pack8(s0, st), pb = pack8(s1, st);
                o0 = MFMA32(vt_frag(vt, 0, st, 0, lane), pa, o0); o1 = MFMA32(vt_frag(vt, 0, st, 1, lane), pa, o1);
                o0 = MFMA32(vt_frag(vt, 1, st, 0, lane), pb, o0); o1 = MFMA32(vt_frag(vt, 1, st, 1, lane), pb, o1);
            }
        }
        __builtin_amdgcn_sched_barrier(0);
        if (it + 1 < nt) kv_store(stg, smem + (cur ^ 1) * KV_TILE, smem + (2 + (cur ^ 1)) * KV_TILE);
        __syncthreads();
    }
    const float inv = 1.0f / swap_sum(lsum);
    bf16_t* orow = p.mixed + (rowb + tq) * DM + h * 64 + 4 * hh;
#pragma unroll
    for (int g = 0; g < 4; ++g) {
        u32x2 w0, w1;
        w0.x = pack2(o0[4 * g] * inv, o0[4 * g + 1] * inv); w0.y = pack2(o0[4 * g + 2] * inv, o0[4 * g + 3] * inv);
        w1.x = pack2(o1[4 * g] * inv, o1[4 * g + 1] * inv); w1.y = pack2(o1[4 * g + 2] * inv, o1[4 * g + 3] * inv);
        *(u32x2*)(orow + 8 * g) = w0; *(u32x2*)(orow + 32 + 8 * g) = w1;
    }
}

DI void sb_attn_unit(const P& p, char* smem, volatile int* wdone, int unit, const ConvPlan& cv, int& cslot, ConvRegs& cr0) {
    const int tid = threadIdx.x & 255, lane = tid & 63, wid = tid >> 6, r32 = lane & 31, hh = lane >> 5, wid8 = threadIdx.x >> 6;
    const int qb = unit & 31, h = (unit >> 5) & 7, b = unit >> 8;
    const int tw = qb * 128 + wid * 32, t = tw + r32;
    const size_t rowb = (size_t)b * NS;
    const bf16_t* kbase = p.proj + rowb * ODD_IN + 1536 + h * 64;
    const bf16_t* vbase = p.proj + rowb * ODD_IN + 2048 + h * 64;
    __syncthreads();
    bf16x8 qf[4];
#pragma unroll
    for (int st = 0; st < 4; ++st) qf[st] = *(const bf16x8*)(p.proj + (rowb + t) * ODD_IN + 1024 + h * 64 + st * 16 + hh * 8);
    bf16x8 tf[2];
#pragma unroll
    for (int st = 0; st < 2; ++st)
#pragma unroll
        for (int j = 0; j < 8; ++j) tf[st][j] = (16 * st + 8 * (j >> 2) + 4 * hh + (j & 3)) >= r32 ? (short)0x3F80 : (short)0;
    f32x16 o0, o1;
#pragma unroll
    for (int i = 0; i < 16; ++i) { o0[i] = 0.f; o1[i] = 0.f; }
    float carry = 0.f; bool done = false;
    const int kt0 = 2 * qb + 1;
    KVStage stg;
    kv_load(stg, kbase, vbase, ODD_IN, kt0 * 64);
    kv_store(stg, smem, smem + 2 * KV_TILE);
    __syncthreads();
    for (int it = 0; it <= kt0; ++it) {
        const int kt = kt0 - it, cur = it & 1;
        if (kt > 0) kv_load(stg, kbase, vbase, ODD_IN, (kt - 1) * 64);
        conv_store(cr0); conv_load(p, cv, cslot++, cr0);
        __builtin_amdgcn_sched_barrier(0);
        const char* ktile = smem + cur * KV_TILE; const char* vtile = smem + (2 + cur) * KV_TILE;
        if (!done && kt * 64 < tw + 31) {
#pragma unroll
            for (int sbi = 0; sbi < 2; ++sbi) {
                const int sb = 1 - sbi;
                f32x16 x;
#pragma unroll
                for (int i = 0; i < 16; ++i) x[i] = 0.f;
#pragma unroll
                for (int st = 0; st < 4; ++st) x = MFMA32(k_frag(ktile, sb, st, r32, hh), qf[st], x);
                const int kb = kt * 64 + sb * 32 + 4 * hh;
                f32x16 L, Lr;
#pragma unroll
                for (int i = 0; i < 16; ++i) {
                    const bool valid = kb + (i & 3) + 8 * (i >> 2) < t;
                    const float z = x[i];
                    const float sp = fmaxf(z, 0.f) + __builtin_amdgcn_logf(1.0f + __builtin_amdgcn_exp2f(-fabsf(z)));
                    L[i] = valid ? -sp : 0.f;
                    x[i] = valid ? z : -1.0e30f;
                }
                f32x16 cum;
#pragma unroll
                for (int i = 0; i < 16; ++i) cum[i] = carry;
#pragma unroll
                for (int st = 0; st < 2; ++st) {
                    const bf16x8 hi = pack8(L, st);
#pragma unroll
                    for (int j = 0; j < 8; ++j) Lr[8 * st + j] = L[8 * st + j] - __uint_as_float(((unsigned)(unsigned short)hi[j]) << 16);
                    cum = MFMA32(tf[st], hi, cum);
                }
#pragma unroll
                for (int st = 0; st < 2; ++st) cum = MFMA32(tf[st], pack8(Lr, st), cum);
                carry = bcast_lo(cum[0]);
#pragma unroll
                for (int i = 0; i < 16; ++i) x[i] = __builtin_amdgcn_exp2f(x[i] + cum[i]);
#pragma unroll
                for (int st = 0; st < 2; ++st) {
                    const bf16x8 pa = pack8(x, st);
                    o0 = MFMA32(vt_frag(vtile, sb, st, 0, lane), pa, o0); o1 = MFMA32(vt_frag(vtile, sb, st, 1, lane), pa, o1);
                }
            }
            done = __all(carry < -150.0f);
        }
        __builtin_amdgcn_sched_barrier(0);
        if (lane == 0) wdone[cur * 8 + wid8] = done ? 1 : 0;
        if (kt > 0) kv_store(stg, smem + (cur ^ 1) * KV_TILE, smem + (2 + (cur ^ 1)) * KV_TILE);
        __syncthreads();
        if (wdone[cur * 8] + wdone[cur * 8 + 1] + wdone[cur * 8 + 2] + wdone[cur * 8 + 3] + wdone[cur * 8 + 4] + wdone[cur * 8 + 5] + wdone[cur * 8 + 6] + wdone[cur * 8 + 7] == 8) break;
    }
    bf16_t* orow = p.mixed + (rowb + t) * DM + 512 + h * 64 + 4 * hh;
#pragma unroll
    for (int g = 0; g < 4; ++g) {
        u32x2 w0, w1;
        w0.x = pack2(o0[4 * g], o0[4 * g + 1]); w0.y = pack2(o0[4 * g + 2], o0[4 * g + 3]);
        w1.x = pack2(o1[4 * g], o1[4 * g + 1]); w1.y = pack2(o1[4 * g + 2], o1[4 * g + 3]);
        *(u32x2*)(orow + 8 * g) = w0; *(u32x2*)(orow + 32 + 8 * g) = w1;
    }
}

DI void pool_items(const P& p) {
    for (int it = blockIdx.x * 512 + threadIdx.x; it < NTOK * 64; it += gridDim.x * 512) {
        const int tok = it >> 6, ch8 = it & 63, g = ch8 >> 4, w = 2 << g, s = tok & (NS - 1);
        const int n = (s + 1 < w) ? s + 1 : w;
        float sum[8], own[8];
#pragma unroll
        for (int j = 0; j < 8; ++j) sum[j] = 0.f;
        const bf16_t* src = p.proj + (size_t)tok * EVEN_IN + 1536 + ch8 * 8;
        u32x4 wv[16];
#pragma unroll
        for (int t = 0; t < 16; ++t) wv[t] = (t < n) ? *(const u32x4*)(src - (size_t)t * EVEN_IN) : (u32x4){0u, 0u, 0u, 0u};
#pragma unroll
        for (int t = 0; t < 16; ++t) { unpack8(wv[t], own);
#pragma unroll
            for (int j = 0; j < 8; ++j) sum[j] += own[j]; }
        unpack8(wv[0], own);
        const float inv = 1.0f / (float)n;
        u32x4 o; o.x = pack2(sum[0] * inv - own[0], sum[1] * inv - own[1]); o.y = pack2(sum[2] * inv - own[2], sum[3] * inv - own[3]);
        o.z = pack2(sum[4] * inv - own[4], sum[5] * inv - own[5]); o.w = pack2(sum[6] * inv - own[6], sum[7] * inv - own[7]);
        *(u32x4*)(p.mixed + (size_t)tok * DM + 512 + ch8 * 8) = o;
    }
}

DI void sgu_unit(const P& p, char* smem, int unit) {
    const int tid = threadIdx.x & 255, lane = tid & 63, wid = tid >> 6, wm = wid >> 1, wn = wid & 1, fr = lane & 15, fq = lane >> 4;
    const int g = unit & 3; const size_t tok0 = (size_t)(unit >> 2) * 128;
    char* As = smem; char* Gs = smem + 32768; float* srstd = (float*)(smem + 65536);
    __syncthreads();
    {
        const int row = tid >> 1, half = tid & 1;
        const bf16_t* src = p.proj + (tok0 + row) * ODD_IN + 512 + half * 256;
        float ss = 0.f;
        for (int i = 0; i < 32; ++i) { float f[8]; unpack8(*(const u32x4*)(src + i * 8), f);
#pragma unroll
            for (int j = 0; j < 8; ++j) ss += f[j] * f[j]; }
        ss += __shfl_xor(ss, 1);
        if (half == 0) srstd[row] = rsqrtf(ss * (1.0f / 512.0f) + EPS);
    }
#pragma unroll
    for (int i = 0; i < 8; ++i) {
        const int idx = tid + 256 * i, s = idx >> 4, ch = idx & 15;
        const u32x4 v = *(const u32x4*)(p.proj + (tok0 + s) * ODD_IN + 512 + g * 128 + ch * 8);
        *(u32x4*)(Gs + s * 256 + (((ch >> 1) ^ kswz(s)) << 5) + ((ch & 1) << 4)) = v;
    }
    __syncthreads();
#pragma unroll
    for (int i = 0; i < 8; ++i) {
        const int idx = tid + 256 * i, t = idx >> 4, c8 = idx & 15, s0 = c8 * 8;
        const float* wr = p.sgu_w + ((size_t)g * 128 + t) * 128 + s0;
        const f32x4 a = *(const f32x4*)wr, b = *(const f32x4*)(wr + 4);
        float f[8] = {a[0], a[1], a[2], a[3], b[0], b[1], b[2], b[3]};
#pragma unroll
        for (int j = 0; j < 8; ++j) f[j] = (s0 + j <= t) ? f[j] * srstd[s0 + j] : 0.f;
        u32x4 w; w.x = pack2(f[0], f[1]); w.y = pack2(f[2], f[3]); w.z = pack2(f[4], f[5]); w.w = pack2(f[6], f[7]);
        *(u32x4*)(As + (c8 >> 3) * 16384 + t * 128 + (((c8 & 7) ^ (t & 7)) << 4)) = w;
    }
    __syncthreads();
    f32x4 acc[4][4];
#pragma unroll
    for (int a = 0; a < 4; ++a)
#pragma unroll
        for (int b = 0; b < 4; ++b) acc[a][b] = (f32x4){0.f, 0.f, 0.f, 0.f};
    const int qq = fr >> 2, pp = fr & 3;
#pragma unroll
    for (int kt = 0; kt < 2; ++kt) {
        if (kt == 1 && wm == 0) continue;
#pragma unroll
        for (int s2 = 0; s2 < 2; ++s2) {
            bf16x8 af[4], bfv[4];
#pragma unroll
            for (int i = 0; i < 4; ++i) {
                const int ra_ = wm * 64 + i * 16 + fr;
                af[i] = *(const bf16x8*)(As + kt * 16384 + ra_ * 128 + (((s2 * 4 + fq) ^ (fr & 7)) << 4));
                const int srow = kt * 64 + s2 * 32 + 8 * fq + qq, blk = wn * 4 + i;
                const s16x4 lo = tr_read(Gs + srow * 256 + ((blk ^ kswz(srow)) << 5) + pp * 8);
                const s16x4 hi = tr_read(Gs + (srow + 4) * 256 + ((blk ^ kswz(srow + 4)) << 5) + pp * 8);
                bfv[i] = (bf16x8){lo[0], lo[1], lo[2], lo[3], hi[0], hi[1], hi[2], hi[3]};
            }
#pragma unroll
            for (int mi = 0; mi < 4; ++mi)
#pragma unroll
                for (int ni = 0; ni < 4; ++ni) acc[mi][ni] = MFMA16(bfv[ni], af[mi], acc[mi][ni]);
        }
    }
#pragma unroll
    for (int mi = 0; mi < 4; ++mi) {
        const int t = wm * 64 + mi * 16 + fr;
        const float bias = p.sgu_b[g * 128 + t];
#pragma unroll
        for (int ni = 0; ni < 4; ++ni) {
            const int c = g * 128 + wn * 64 + ni * 16 + fq * 4;
            const f32x4 gn = *(const f32x4*)(p.sgu_v_norm + c);
            const u32x2 uu = *(const u32x2*)(p.proj + (tok0 + t) * ODD_IN + c);
            const float u0 = __uint_as_float(uu.x << 16), u1 = __uint_as_float(uu.x & 0xffff0000u), u2 = __uint_as_float(uu.y << 16), u3 = __uint_as_float(uu.y & 0xffff0000u);
            const f32x4 a = acc[mi][ni];
            u32x2 w; w.x = pack2(u0 * (gn[0] * a[0] + bias), u1 * (gn[1] * a[1] + bias)); w.y = pack2(u2 * (gn[2] * a[2] + bias), u3 * (gn[3] * a[3] + bias));
            *(u32x2*)(p.mixed + (tok0 + t) * DM + c) = w;
        }
    }
}

DI void router_unit(const P& p, char* smem, int layer, int unit) {
    const int tid = threadIdx.x & 255, lane = tid & 63, wid = tid >> 6, r32 = lane & 31, hh = lane >> 5;
    float (*part)[36][32] = (float (*)[36][32])smem;
    float (*wss)[32] = (float (*)[32])(smem + 18432);
    int* lcnt = (int*)(smem + 18432 + 512);
    int* lbase = lcnt + 32;
    int* cnt = p.cnt + layer * NEXP;
    const int tok = unit * 32 + r32, kq = wid * 256 + 8 * hh;
    __syncthreads();
    if (tid < 32) lcnt[tid] = 0;
    const float* hrow = p.out + (size_t)tok * DM + kq;
    const float* gn = p.ffn_norm + layer * DM + kq;
    const bf16_t* whi = p.wr_hi + ((size_t)layer * 96 + r32) * DM + kq;
    const bf16_t* wlo = p.wr_lo + ((size_t)layer * 96 + r32) * DM + kq;
    bf16_t* xo = p.xn + (size_t)tok * DM + kq;
    f32x16 c0, c1, c2;
#pragma unroll
    for (int i = 0; i < 16; ++i) { c0[i] = 0.f; c1[i] = 0.f; c2[i] = 0.f; }
    float ss = 0.f;
#pragma unroll 4
    for (int st = 0; st < 16; ++st) {
        const f32x4 a = *(const f32x4*)(hrow + 16 * st), b = *(const f32x4*)(hrow + 16 * st + 4);
        const f32x4 ga = *(const f32x4*)(gn + 16 * st), gb = *(const f32x4*)(gn + 16 * st + 4);
        ss += a[0] * a[0] + a[1] * a[1] + a[2] * a[2] + a[3] * a[3] + b[0] * b[0] + b[1] * b[1] + b[2] * b[2] + b[3] * b[3];
        u32x4 xw; xw.x = pack2(a[0] * ga[0], a[1] * ga[1]); xw.y = pack2(a[2] * ga[2], a[3] * ga[3]); xw.z = pack2(b[0] * gb[0], b[1] * gb[1]); xw.w = pack2(b[2] * gb[2], b[3] * gb[3]);
        *(u32x4*)(xo + 16 * st) = xw;
        u32x4 hw; hw.x = pack2(a[0], a[1]); hw.y = pack2(a[2], a[3]); hw.z = pack2(b[0], b[1]); hw.w = pack2(b[2], b[3]);
        u32x4 lw;
        lw.x = pack2(a[0] - __uint_as_float(hw.x << 16), a[1] - __uint_as_float(hw.x & 0xffff0000u)); lw.y = pack2(a[2] - __uint_as_float(hw.y << 16), a[3] - __uint_as_float(hw.y & 0xffff0000u));
        lw.z = pack2(b[0] - __uint_as_float(hw.z << 16), b[1] - __uint_as_float(hw.z & 0xffff0000u)); lw.w = pack2(b[2] - __uint_as_float(hw.w << 16), b[3] - __uint_as_float(hw.w & 0xffff0000u));
        const bf16x8 hhi = __builtin_bit_cast(bf16x8, hw), hlo = __builtin_bit_cast(bf16x8, lw);
        bf16x8 wh, wl;
        wh = *(const bf16x8*)(whi + 16 * st); wl = *(const bf16x8*)(wlo + 16 * st);
        c0 = MFMA32(wh, hhi, c0); c0 = MFMA32(wh, hlo, c0); c0 = MFMA32(wl, hhi, c0);
        wh = *(const bf16x8*)(whi + 32 * DM + 16 * st); wl = *(const bf16x8*)(wlo + 32 * DM + 16 * st);
        c1 = MFMA32(wh, hhi, c1); c1 = MFMA32(wh, hlo, c1); c1 = MFMA32(wl, hhi, c1);
        wh = *(const bf16x8*)(whi + 64 * DM + 16 * st); wl = *(const bf16x8*)(wlo + 64 * DM + 16 * st);
        c2 = MFMA32(wh, hhi, c2); c2 = MFMA32(wh, hlo, c2); c2 = MFMA32(wl, hhi, c2);
    }
    {
        auto rr = __builtin_amdgcn_permlane32_swap(__float_as_uint(ss), __float_as_uint(ss), false, false);
        ss = __uint_as_float(rr[0]) + __uint_as_float(rr[1]);
        if (hh == 0) {
#pragma unroll
            for (int i = 0; i < 16; ++i) { part[wid][i][r32] = c0[i]; part[wid][16 + i][r32] = c1[i]; }
#pragma unroll
            for (int i = 0; i < 4; ++i) part[wid][32 + i][r32] = c2[i];
            wss[wid][r32] = ss;
        }
    }
    __syncthreads();
    int e1 = 0, e2 = 0, r1 = 0, r2 = 0; float w1 = 0.f, w2 = 0.f, rstd = 0.f;
    const int mytok = unit * 32 + tid;
    if (tid < 32) {
        rstd = rsqrtf((wss[0][tid] + wss[1][tid] + wss[2][tid] + wss[3][tid]) * (1.0f / DM) + EPS);
        float gl[4], ev[8];
#pragma unroll
        for (int j = 0; j < 4; ++j) gl[j] = (part[0][32 + j][tid] + part[1][32 + j][tid] + part[2][32 + j][tid] + part[3][32 + j][tid]) * rstd;
        int gs = 0; float gm = gl[0];
#pragma unroll
        for (int j = 1; j < 4; ++j) if (gl[j] > gm) { gm = gl[j]; gs = j; }
        const float gw = 1.0f / (__expf(gl[0] - gm) + __expf(gl[1] - gm) + __expf(gl[2] - gm) + __expf(gl[3] - gm));
#pragma unroll
        for (int j = 0; j < 8; ++j) { const int s = gs * 8 + j; ev[j] = (part[0][s][tid] + part[1][s][tid] + part[2][s][tid] + part[3][s][tid]) * rstd; }
        int i1 = 0; float v1 = ev[0];
#pragma unroll
        for (int j = 1; j < 8; ++j) if (ev[j] > v1) { v1 = ev[j]; i1 = j; }
        int i2 = -1; float v2 = -3.0e38f;
#pragma unroll
        for (int j = 0; j < 8; ++j) if (j != i1 && ev[j] > v2) { v2 = ev[j]; i2 = j; }
        w1 = 1.0f / (1.0f + __expf(v2 - v1)); w2 = (1.0f - w1) * gw; w1 *= gw;
        e1 = gs * 8 + i1; e2 = gs * 8 + i2;
        r1 = atomicAdd(lcnt + e1, 1); r2 = atomicAdd(lcnt + e2, 1);
    }
    __syncthreads();
    if (tid < 32) { const int n = lcnt[tid]; lbase[tid] = n ? atomicAdd(cnt + tid, n) : 0; }
    __syncthreads();
    if (tid < 32) {
        p.plist[(size_t)e1 * LISTCAP + lbase[e1] + r1] = mytok * 2; p.plist[(size_t)e2 * LISTCAP + lbase[e2] + r2] = mytok * 2 + 1;
        p.pw[mytok * 2] = w1; p.pw[mytok * 2 + 1] = w2; p.rs[mytok] = rstd;
    }
}
DI void ph_combine(const P& p, int layer) {
    const int wave = threadIdx.x >> 6, lane = threadIdx.x & 63;
    for (int u = blockIdx.x; u < NTOK / 8; u += gridDim.x) {
        const size_t tok = (size_t)u * 8 + wave;
        float* hr = p.out + tok * DM;
        f32x4 v[4]; float ss = 0.f;
#pragma unroll
        for (int i = 0; i < 4; ++i) {
            const int c = i * 256 + lane * 4;
            f32x4 h = *(const f32x4*)(hr + c);
            const u32x2 a = *(const u32x2*)(p.y + (tok * 2) * DM + c), b = *(const u32x2*)(p.y + (tok * 2 + 1) * DM + c);
            h[0] += bf2f((bf16_t)(a.x & 0xffff)) + bf2f((bf16_t)(b.x & 0xffff));
            h[1] += bf2f((bf16_t)(a.x >> 16)) + bf2f((bf16_t)(b.x >> 16));
            h[2] += bf2f((bf16_t)(a.y & 0xffff)) + bf2f((bf16_t)(b.y & 0xffff));
            h[3] += bf2f((bf16_t)(a.y >> 16)) + bf2f((bf16_t)(b.y >> 16));
            *(f32x4*)(hr + c) = h; v[i] = h;
            ss += h[0] * h[0] + h[1] * h[1] + h[2] * h[2] + h[3] * h[3];
        }
        if (layer == 0) {
            ss = wave_sum(ss);
            const float rstd = rsqrtf(ss * (1.0f / DM) + EPS);
#pragma unroll
            for (int i = 0; i < 4; ++i) { const f32x4 g = *(const f32x4*)(p.mix_norm_odd + i * 256 + lane * 4);
                u32x2 w; w.x = pack2(v[i][0] * rstd * g[0], v[i][1] * rstd * g[1]); w.y = pack2(v[i][2] * rstd * g[2], v[i][3] * rstd * g[3]);
                *(u32x2*)(p.xn + tok * DM + i * 256 + lane * 4) = w; }
        }
    }
}

DI void ph_mix_even(const P& p, char* smem) {
    const int half = threadIdx.x >> 8;
    const ConvPlan cv = conv_plan(p, 0); int cslot = 0; ConvRegs cr; cr.dst = nullptr;
    for (int u = blockIdx.x; u < NB * 4 * 32; u += gridDim.x) {
        const int cp = u & 31, hp = (u >> 5) & 3, b = u >> 7;
        band_attn_unit(p, smem + half * HALF_LDS, (b << 8) | ((hp * 2 + half) << 5) | cp, cv, cslot, cr);
    }
    conv_store(cr); conv_rest(p, cv, cslot);
    pool_items(p);
}
DI void ph_mix_odd(const P& p, char* smem) {
    const int half = threadIdx.x >> 8;
    volatile int* wdone = (volatile int*)(smem + 2 * HALF_LDS);
    const ConvPlan cv = conv_plan(p, 1); int cslot = 0; ConvRegs cr; cr.dst = nullptr;
    for (int u = blockIdx.x; u < NB * 4 * 32; u += gridDim.x) {
        const int qb = 31 - (u >> 4), hp = (u >> 2) & 3, b = u & 3;
        sb_attn_unit(p, smem + half * HALF_LDS, wdone, (b << 8) | ((hp * 2 + half) << 5) | qb, cv, cslot, cr);
    }
    conv_store(cr); conv_rest(p, cv, cslot);
    for (int u = blockIdx.x; u < (NTOK / 128) * 2; u += gridDim.x) sgu_unit(p, smem + half * HALF_LDS, u * 2 + half);
}
DI void ph_router(const P& p, char* smem, int layer) {
    const int half = threadIdx.x >> 8;
    for (int u = blockIdx.x; u < NTOK / 64; u += gridDim.x) router_unit(p, smem + half * HALF_LDS, layer, u * 2 + half);
}

constexpr int NPHASE = 15;
#ifndef REPS
#define REPS {1,1,1,1,1,1,1,1,1,1,1,1,1,1,1}
#endif
__device__ constexpr int REP[15] = REPS;
__global__ __launch_bounds__(512, 2) void mega(P p, int ph0, int ph1) {
    __shared__ __attribute__((aligned(16))) char smem[SMEM_BYTES + 64 + 16];
    volatile LDSAS unsigned* xst = (volatile LDSAS unsigned*)(smem + SMEM_BYTES + 64);
    if (threadIdx.x < 4) xst[threadIdx.x] = 0u;
    __syncthreads();
    const XcdBarrier xb = xcd_barrier_post(p.bar, xst);
#define PHASE(i, call) if (ph0 <= (i) && (i) < ph1) { for (int r_ = 0; r_ < REP[i]; ++r_) { call; if (r_ + 1 < REP[i] || (i) + 1 < ph1) xcd_barrier(xb); } }
    PHASE(0, ph_prologue(p, smem))
    PHASE(1, (ph_gemm_dense<EPI_IN_EVEN>(p, smem, p.xn, DM, p.wb_in_even, DM, EVEN_IN, 0)))
    PHASE(2, ph_mix_even(p, smem))
    PHASE(3, (ph_gemm_dense<EPI_OUT>(p, smem, p.mixed, DM, p.wb_out_even, DM, DM, 0)))
    PHASE(4, ph_router(p, smem, 0))
    PHASE(5, (ph_gemm_moe<EPI_GU>(p, smem, 0)))
    PHASE(6, (ph_gemm_moe<EPI_DOWN>(p, smem, 0)))
    PHASE(7, ph_combine(p, 0))
    PHASE(8, (ph_gemm_dense<EPI_IN_ODD>(p, smem, p.xn, DM, p.wb_in_odd, DM, ODD_IN, 1)))
    PHASE(9, ph_mix_odd(p, smem))
    PHASE(10, (ph_gemm_dense<EPI_OUT>(p, smem, p.mixed, DM, p.wb_out_odd, DM, DM, 1)))
    PHASE(11, ph_router(p, smem, 1))
    PHASE(12, (ph_gemm_moe<EPI_GU>(p, smem, 1)))
    PHASE(13, (ph_gemm_moe<EPI_DOWN>(p, smem, 1)))
    PHASE(14, ph_combine(p, 1))
}

extern "C" void kernel_launch(void* const* d_in, const int* in_sizes, int n_in, void* d_out, int out_size, void* d_ws, size_t ws_size, hipStream_t stream) {
    P p{};
    p.x = (const float*)d_in[0]; p.mix_norm_even = (const float*)d_in[1]; p.w_in_even = (const float*)d_in[2]; p.att_q_norm = (const float*)d_in[3];
    p.att_k_norm = (const float*)d_in[4]; p.att_rel_bias = (const float*)d_in[5]; p.pool_w = (const float*)d_in[6]; p.pool_scale = (const float*)d_in[7];
    p.w_out_even = (const float*)d_in[8]; p.mix_norm_odd = (const float*)d_in[9]; p.w_in_odd = (const float*)d_in[10]; p.sgu_v_norm = (const float*)d_in[11];
    p.sgu_w = (const float*)d_in[12]; p.sgu_b = (const float*)d_in[13]; p.w_out_odd = (const float*)d_in[14]; p.ffn_norm = (const float*)d_in[15];
    p.w_rg = (const float*)d_in[16]; p.w_re = (const float*)d_in[17]; p.w_gate = (const float*)d_in[18]; p.w_up = (const float*)d_in[19]; p.w_down = (const float*)d_in[20];
    p.out = (float*)d_out;
    char* ws = (char*)d_ws; size_t off = 0;
    auto take = [&](size_t bytes) { char* r = ws + off; off += (bytes + 255) & ~(size_t)255; return r; };
    p.wb_in_even = (bf16_t*)take((size_t)EVEN_IN * DM * 2);
    p.wb_out_even = (bf16_t*)take((size_t)DM * DM * 2);
    p.wb_in_odd = (bf16_t*)take((size_t)ODD_IN * DM * 2);
    p.wb_out_odd = (bf16_t*)take((size_t)DM * DM * 2);
    p.wb_gate = (bf16_t*)take((size_t)2 * NEXP * DM * FF * 2);
    p.wb_up = (bf16_t*)take((size_t)2 * NEXP * DM * FF * 2);
    p.wb_down = (bf16_t*)take((size_t)2 * NEXP * DM * FF * 2);
    p.wr_hi = (bf16_t*)take((size_t)2 * 96 * DM * 2);
    p.wr_lo = (bf16_t*)take((size_t)2 * 96 * DM * 2);
    p.xn = (bf16_t*)take((size_t)NTOK * DM * 2);
    p.proj = (bf16_t*)take((size_t)NTOK * ODD_IN * 2);
    p.y = p.proj;
    p.mixed = (bf16_t*)take((size_t)NTOK * DM * 2);
    p.hid = p.mixed;
    p.pw = (float*)take((size_t)NTOK * 2 * 4);
    p.rs = (float*)take((size_t)NTOK * 4);
    p.plist = (int*)take((size_t)NEXP * LISTCAP * 4);
    p.cnt = (int*)take(256);
    p.bar = (unsigned*)take(XCD_BAR_WORDS * 4);
    (void)hipMemsetAsync(p.bar, 0, XCD_BAR_WORDS * 4, stream);
    for (int l = 0; l < 2; ++l) {
        const size_t o = (size_t)l * NEXP * DM * FF;
        p.cs[l * 5 + 0] = p.w_gate + o; p.cd[l * 5 + 0] = p.wb_gate + o;
        p.cs[l * 5 + 1] = p.w_up + o;   p.cd[l * 5 + 1] = p.wb_up + o;
        p.cs[l * 5 + 2] = p.w_down + o; p.cd[l * 5 + 2] = p.wb_down + o;
        p.cs[l * 5 + 3] = p.w_in_odd;   p.cd[l * 5 + 3] = p.wb_in_odd;
        p.cs[l * 5 + 4] = p.w_out_odd;  p.cd[l * 5 + 4] = p.wb_out_odd;
    }

    static int grid_blocks = 0;
    if (!grid_blocks) {
        int dev = 0, cus = 0, per_cu = 0;
        (void)hipGetDevice(&dev);
        (void)hipDeviceGetAttribute(&cus, hipDeviceAttributeMultiprocessorCount, dev);
        (void)hipOccupancyMaxActiveBlocksPerMultiprocessor(&per_cu, mega, 512, 0);
        if (per_cu < 1) per_cu = 1;
        grid_blocks = cus;
    }
    int ph0 = 0, ph1 = NPHASE;
    void* args[] = {&p, &ph0, &ph1};
    hipError_t e = hipLaunchCooperativeKernel((void*)mega, dim3(grid_blocks), dim3(512), args, 0, stream);
    if (e != hipSuccess) fprintf(stderr, "cooperative launch failed: %s (grid %d)\n", hipGetErrorString(e), grid_blocks);
}
```

```cpp
#include <hip/hip_runtime.h>
#include <hip/hip_cooperative_groups.h>
#include <stdint.h>
#include <stdio.h>

typedef unsigned short bf16_t;
typedef short bf16x8 __attribute__((ext_vector_type(8)));
typedef short s16x4 __attribute__((ext_vector_type(4)));
typedef float f32x2 __attribute__((ext_vector_type(2)));
typedef float f32x4 __attribute__((ext_vector_type(4)));
typedef float f32x16 __attribute__((ext_vector_type(16)));
typedef unsigned u32x4 __attribute__((ext_vector_type(4)));
typedef unsigned u32x2 __attribute__((ext_vector_type(2)));
typedef __bf16 bf16x2n __attribute__((ext_vector_type(2)));

#define DI __device__ __forceinline__
#define LDSAS __attribute__((address_space(3)))
#define MFMA32(a, b, c) __builtin_amdgcn_mfma_f32_32x32x16_bf16((a), (b), (c), 0, 0, 0)
#define MFMA16(a, b, c) __builtin_amdgcn_mfma_f32_16x16x32_bf16((a), (b), (c), 0, 0, 0)

constexpr int NB = 4, NS = 4096, NTOK = NB * NS, DM = 1024;
constexpr int EVEN_IN = 2048, ODD_IN = 2560;
constexpr int NEXP = 32, FF = 256;
constexpr int LISTCAP = NTOK;
constexpr float EPS = 1e-6f;
constexpr float LOG2E = 1.4426950408889634f;
constexpr float QSCALE = 0.125f * LOG2E;

DI int opaque_tid() { int t = threadIdx.x; asm volatile("" : "+v"(t)); return t; }
DI float bf2f(bf16_t b) { return __uint_as_float(((unsigned)b) << 16); }
DI unsigned pack2(float lo, float hi) { f32x2 v = {lo, hi}; bf16x2n r = __builtin_convertvector(v, bf16x2n); return __builtin_bit_cast(unsigned, r); }
DI float wave_sum(float v) { for (int o = 32; o > 0; o >>= 1) v += __shfl_xor(v, o); return v; }
DI float gelu_exact(float x) { return 0.5f * x * (1.0f + erff(x * 0.70710678118654752f)); }
DI s16x4 tr_read(const char* p) { return __builtin_bit_cast(s16x4, __builtin_amdgcn_ds_read_tr16_b64_v4i16((LDSAS s16x4*)p)); }
DI void unpack8(const u32x4 v, float* f) {
    f[0] = __uint_as_float(v.x << 16); f[1] = __uint_as_float(v.x & 0xffff0000u); f[2] = __uint_as_float(v.y << 16); f[3] = __uint_as_float(v.y & 0xffff0000u);
    f[4] = __uint_as_float(v.z << 16); f[5] = __uint_as_float(v.z & 0xffff0000u); f[6] = __uint_as_float(v.w << 16); f[7] = __uint_as_float(v.w & 0xffff0000u);
}
DI int kswz(int k) { return (k & 3) | ((k >> 1) & 4); }

struct P {
    const float *x, *mix_norm_even, *w_in_even, *att_q_norm, *att_k_norm, *att_rel_bias, *pool_w, *pool_scale, *w_out_even;
    const float *mix_norm_odd, *w_in_odd, *sgu_v_norm, *sgu_w, *sgu_b, *w_out_odd, *ffn_norm, *w_rg, *w_re, *w_gate, *w_up, *w_down;
    float* out;
    bf16_t *wb_in_even, *wb_out_even, *wb_in_odd, *wb_out_odd, *wb_gate, *wb_up, *wb_down, *wr_hi, *wr_lo;
    bf16_t *xn, *proj, *mixed, *hid, *y;
    float *pw, *rs; int* plist; int* cnt; unsigned* bar;
    const float* cs[10]; bf16_t* cd[10];
};

enum { EPI_IN_EVEN = 0, EPI_IN_ODD = 1, EPI_OUT = 2, EPI_GU = 3, EPI_DOWN = 4 };
constexpr int G_ROWID = 131072;
constexpr int SMEM_BYTES = 131072 + 1024;
constexpr int HALF_LDS = 66048;

struct GemmArgs {
    const bf16_t* A; int lda; const int* gather; int mvalid; int gshift;
    const bf16_t* B0; const bf16_t* B1; int ldb; int gu;
    int K, m0, n0;
};

DI f32x2 gelu_pk(f32x2 v) {
    const f32x2 av = __builtin_elementwise_abs(v), d = av * 0.2316418882f + 1.0f;
    f32x2 t; t.x = __builtin_amdgcn_rcpf(d.x); t.y = __builtin_amdgcn_rcpf(d.y);
    f32x2 q = t * 0.5307027145f + (-0.7265760135f); q = q * t + 0.7107068705f; q = q * t + (-0.142248368f); q = q * t + 0.127414796f; q = q * t;
    const f32x2 s = (v * v) * (-0.72134752044f);
    f32x2 e; e.x = __builtin_amdgcn_exp2f(s.x); e.y = __builtin_amdgcn_exp2f(s.y);
    const f32x2 m = v * (q * e), r = v - m;
    f32x2 o; o.x = v.x < 0.f ? m.x : r.x; o.y = v.y < 0.f ? m.y : r.y; return o;
}

DI void glds16(const void* gsrc, unsigned lds_dst) {
    unsigned keep;
    asm volatile("s_mov_b32 %0, m0\n\ts_mov_b32 m0, %2\n\ts_nop 0\n\tglobal_load_lds_dwordx4 %1, off\n\ts_mov_b32 m0, %0" : "=&s"(keep) : "v"(gsrc), "s"(lds_dst) : "memory");
}
template <int EPI, int MT>
DI void gemm_tile(const P& p, char* smem, const GemmArgs& g, int layer) {
    const int tid = opaque_tid(), lane = tid & 63, wid = tid >> 6, wm = wid >> 2, wn = wid & 3, r32 = lane & 31, hh = lane >> 5;
    int* rowid = (int*)(smem + G_ROWID);
    constexpr int NA = MT / 2;
    constexpr int IPT = NA + 2;
    const bf16_t* ap[NA]; const bf16_t* bp[2];
    if (g.gather) { if (tid < 64 * MT) rowid[tid] = (tid < g.mvalid) ? g.gather[tid] : -1; __syncthreads(); }
#pragma unroll
    for (int i = 0; i < NA; ++i) {
        const int r = (wid * NA + i) * 16 + (lane >> 2), kc = (lane & 3) ^ ((r >> 2) & 3);
        size_t arow;
        if (g.gather) { int id = rowid[r]; if (id < 0) id = rowid[0]; arow = (size_t)(id >> g.gshift); } else arow = (size_t)(g.m0 + r);
        ap[i] = g.A + arow * g.lda + kc * 8;
    }
#pragma unroll
    for (int i = 0; i < 2; ++i) {
        const int k = (wid * 2 + i) * 2 + (lane >> 5), sl = lane & 31, ch = (((sl >> 2) ^ (k & 7)) << 2) | (sl & 3);
        const bf16_t* bcol = g.gu ? ((((ch >> 2) & 1) ? g.B1 : g.B0) + (g.n0 >> 1) + (ch >> 3) * 32 + (ch & 3) * 8) : (g.B0 + g.n0 + ch * 8);
        bp[i] = bcol + (size_t)k * g.ldb;
    }
    const size_t bstep = (size_t)32 * g.ldb;
    f32x16 acc[MT][2];
#pragma unroll
    for (int a = 0; a < MT; ++a)
#pragma unroll
        for (int b = 0; b < 2; ++b)
#pragma unroll
            for (int i = 0; i < 16; ++i) acc[a][b][i] = 0.f;
    const int nk = g.K / 32;
    const int arow0 = wm * 32 * MT + r32;
    const int asw = (r32 >> 2) & 3;
    const int g1 = (lane >> 4) & 1, qq = (lane & 15) >> 2, pp = lane & 3;
    const int bk0 = 8 * hh + qq;
    const unsigned ldsb = (unsigned)(size_t)(LDSAS char*)smem;
    const unsigned adst = ldsb + (wid * NA) * 1024, bdst = ldsb + 16384 + (wid * 2) * 1024;
#define G_LOAD(KT) do { const unsigned so_ = (unsigned)((KT) & 3) * 32768u; \
        _Pragma("unroll") for (int i = 0; i < NA; ++i) glds16(ap[i] + (KT) * 32, (unsigned)__builtin_amdgcn_readfirstlane(adst + so_ + i * 1024)); \
        _Pragma("unroll") for (int i = 0; i < 2; ++i) glds16(bp[i] + (size_t)(KT) * bstep, (unsigned)__builtin_amdgcn_readfirstlane(bdst + so_ + i * 1024)); } while (0)
#define G_COMPUTE(KT) do { const char* Ac = smem + ((KT) & 3) * 32768; const char* Bc = Ac + 16384; \
        _Pragma("unroll") for (int st = 0; st < 2; ++st) { bf16x8 af[MT], bfv[2]; \
            _Pragma("unroll") for (int mt = 0; mt < MT; ++mt) af[mt] = *(const bf16x8*)(Ac + (arow0 + mt * 32) * 64 + (((2 * st + hh) ^ asw) << 4)); \
            _Pragma("unroll") for (int nt = 0; nt < 2; ++nt) { const int k = 16 * st + bk0; \
                const char* b0_ = Bc + k * 512 + (((wn * 2 + nt) ^ (k & 7)) << 6) + g1 * 32 + pp * 8; \
                const char* b1_ = Bc + (k + 4) * 512 + (((wn * 2 + nt) ^ ((k + 4) & 7)) << 6) + g1 * 32 + pp * 8; \
                const s16x4 lo = tr_read(b0_), hi = tr_read(b1_); \
                bfv[nt] = (bf16x8){lo[0], lo[1], lo[2], lo[3], hi[0], hi[1], hi[2], hi[3]}; } \
            _Pragma("unroll") for (int mt = 0; mt < MT; ++mt) _Pragma("unroll") for (int nt = 0; nt < 2; ++nt) acc[mt][nt] = MFMA32(bfv[nt], af[mt], acc[mt][nt]); } } while (0)
#define G_WAIT(N) do { if ((N) == 2) { if (IPT == 4) asm volatile("s_waitcnt vmcnt(8)" ::: "memory"); else asm volatile("s_waitcnt vmcnt(6)" ::: "memory"); } \
                       else if ((N) == 1) { if (IPT == 4) asm volatile("s_waitcnt vmcnt(4)" ::: "memory"); else asm volatile("s_waitcnt vmcnt(3)" ::: "memory"); } \
                       else asm volatile("s_waitcnt vmcnt(0)" ::: "memory"); } while (0)
    G_LOAD(0); G_LOAD(1); G_LOAD(2);
    G_WAIT(2); __syncthreads();
#pragma nounroll
    for (int kt = 0; kt < nk; ++kt) {
        if (kt + 3 < nk) G_LOAD(kt + 3);
        G_COMPUTE(kt);
        if (kt + 3 < nk) G_WAIT(2); else if (kt + 2 < nk) G_WAIT(1); else G_WAIT(0);
        __syncthreads();
    }
#undef G_LOAD
#undef G_COMPUTE
#undef G_WAIT
    const int colw = g.n0 + wn * 64;
    char* wsl = smem + wid * 16384;
    const int rowb = wm * 32 * MT;
    if (EPI == EPI_IN_EVEN || EPI == EPI_IN_ODD || EPI == EPI_DOWN) {
        const int region = colw >> 9;
        const float* gn = region == 0 ? p.att_q_norm : p.att_k_norm;
        const bool act = colw < 1024;
        const float qs = (colw >= 1024 && colw < 1536) ? QSCALE : 1.0f;
#pragma unroll
        for (int mt = 0; mt < MT; ++mt) {
            float sc = 1.f;
            if (EPI == EPI_IN_EVEN && region < 2) {
                float ss = 0.f;
#pragma unroll
                for (int nt = 0; nt < 2; ++nt)
#pragma unroll
                    for (int i = 0; i < 16; ++i) ss += acc[mt][nt][i] * acc[mt][nt][i];
                auto rr = __builtin_amdgcn_permlane32_swap(__float_as_uint(ss), __float_as_uint(ss), false, false);
                ss = __uint_as_float(rr[0]) + __uint_as_float(rr[1]);
                sc = rsqrtf(ss * (1.0f / 64.0f) + EPS) * (region == 0 ? QSCALE : 1.0f);
            }
#pragma unroll
            for (int nt = 0; nt < 2; ++nt)
#pragma unroll
                for (int gq = 0; gq < 4; ++gq) {
                    f32x2 v0 = {acc[mt][nt][4 * gq], acc[mt][nt][4 * gq + 1]}, v1 = {acc[mt][nt][4 * gq + 2], acc[mt][nt][4 * gq + 3]};
                    if (EPI == EPI_IN_EVEN) { if (region < 2) { const f32x4 gg = *(const f32x4*)(gn + nt * 32 + 8 * gq + 4 * hh); v0.x *= sc * gg[0]; v0.y *= sc * gg[1]; v1.x *= sc * gg[2]; v1.y *= sc * gg[3]; } }
                    else if (EPI == EPI_IN_ODD) { if (act) { v0 = gelu_pk(v0); v1 = gelu_pk(v1); } else { v0 = v0 * qs; v1 = v1 * qs; } }
                    u32x2 w; w.x = pack2(v0.x, v0.y); w.y = pack2(v1.x, v1.y);
                    *(u32x2*)(wsl + r32 * 128 + (((nt * 4 + gq) ^ (r32 & 7)) << 4) + hh * 8) = w;
                }
#pragma unroll
            for (int ps = 0; ps < 4; ++ps) {
                const int row = ps * 8 + (lane >> 3), chunk = lane & 7;
                const u32x4 v = *(const u32x4*)(wsl + row * 128 + ((chunk ^ (row & 7)) << 4));
                const int trow = rowb + mt * 32 + row;
                if (EPI == EPI_DOWN) { const int id = rowid[trow]; if (id >= 0) *(u32x4*)(p.y + (size_t)id * DM + colw + chunk * 8) = v; }
                else if (EPI == EPI_IN_EVEN) *(u32x4*)(p.proj + (size_t)(g.m0 + trow) * EVEN_IN + colw + chunk * 8) = v;
                else *(u32x4*)(p.proj + (size_t)(g.m0 + trow) * ODD_IN + colw + chunk * 8) = v;
            }
        }
    } else if (EPI == EPI_OUT) {
        const float* res = layer == 0 ? p.x : p.out;
#pragma unroll
        for (int mt = 0; mt < MT; ++mt) {
#pragma unroll
            for (int nt = 0; nt < 2; ++nt)
#pragma unroll
                for (int gq = 0; gq < 4; ++gq) {
                    const f32x4 v = {acc[mt][nt][4 * gq], acc[mt][nt][4 * gq + 1], acc[mt][nt][4 * gq + 2], acc[mt][nt][4 * gq + 3]};
                    *(f32x4*)(wsl + r32 * 256 + (((nt * 8 + 2 * gq + hh) ^ (r32 & 15)) << 4)) = v;
                }
#pragma unroll
            for (int ps = 0; ps < 8; ++ps) {
                const int row = ps * 4 + (lane >> 4), chunk = lane & 15;
                const f32x4 v = *(const f32x4*)(wsl + row * 256 + ((chunk ^ (row & 15)) << 4));
                const size_t off = (size_t)(g.m0 + rowb + mt * 32 + row) * DM + colw + chunk * 4;
                const f32x4 r = *(const f32x4*)(res + off);
                *(f32x4*)(p.out + off) = r + v;
            }
        }
    } else if (EPI == EPI_GU) {
        const int f0 = (g.n0 >> 1) + wn * 32;
#pragma unroll
        for (int mt = 0; mt < MT; ++mt) {
            const int id = rowid[rowb + mt * 32 + r32];
            const float w = id >= 0 ? p.pw[id] : 0.f, rs = id >= 0 ? p.rs[id >> 1] : 0.f;
#pragma unroll
            for (int gq = 0; gq < 4; ++gq) {
                float h[4];
#pragma unroll
                for (int j = 0; j < 4; ++j) { const float gt = acc[mt][0][4 * gq + j] * rs, up = acc[mt][1][4 * gq + j] * (rs * w); h[j] = gt / (1.0f + __expf(-gt)) * up; }
                u32x2 ww; ww.x = pack2(h[0], h[1]); ww.y = pack2(h[2], h[3]);
                *(u32x2*)(wsl + r32 * 64 + ((gq ^ (r32 & 3)) << 4) + hh * 8) = ww;
            }
#pragma unroll
            for (int ps = 0; ps < 2; ++ps) {
                const int row = ps * 16 + (lane >> 2), chunk = lane & 3;
                const u32x4 v = *(const u32x4*)(wsl + row * 64 + ((chunk ^ (row & 3)) << 4));
                const int id2 = rowid[rowb + mt * 32 + row];
                if (id2 >= 0) *(u32x4*)(p.hid + (size_t)id2 * FF + f0 + chunk * 8) = v;
            }
        }
    }
    __syncthreads();
}

template <int EPI, int MT>
DI void ph_gemm_dense(const P& p, char* smem, const bf16_t* A, int lda, const bf16_t* B, int K, int N, int layer, int nt0, int ntc) {
    const int ntm = NTOK / (64 * MT), per_xcd = (ntm / 8) * ntc;
    const bool xcd = (gridDim.x & 7) == 0;
    const int x = blockIdx.x & 7, gx = gridDim.x >> 3;
    const int jend = xcd ? per_xcd : ntm * ntc, jstep = xcd ? gx : (int)gridDim.x;
    for (int j = xcd ? (int)(blockIdx.x >> 3) : (int)blockIdx.x; j < jend; j += jstep) {
        GemmArgs g; g.A = A; g.lda = lda; g.gather = nullptr; g.mvalid = 64 * MT; g.gshift = 0; g.B0 = B; g.B1 = B; g.ldb = N; g.gu = 0; g.K = K;
        g.m0 = ((xcd ? x * (ntm / 8) : 0) + j / ntc) * (64 * MT); g.n0 = (nt0 + j % ntc) * 256;
        gemm_tile<EPI, MT>(p, smem, g, layer);
    }
}

template <int EPI>
DI void ph_gemm_moe(const P& p, char* smem, int layer) {
    const int ntn = (EPI == EPI_GU) ? 2 : 4;
    const int* cnt = p.cnt + layer * NEXP;
    int total = 0;
    for (int e = 0; e < NEXP; ++e) total += (cnt[e] + 127) >> 7;
    for (int u = blockIdx.x; u < total * ntn; u += gridDim.x) {
        int mt = u / ntn; const int nt = u % ntn;
        int e = 0, c = 0;
        for (; e < NEXP; ++e) { c = cnt[e]; const int t = (c + 127) >> 7; if (mt < t) break; mt -= t; }
        GemmArgs g; g.gather = p.plist + (size_t)e * LISTCAP + mt * 128; g.mvalid = c - mt * 128 < 128 ? c - mt * 128 : 128;
        g.m0 = 0; g.n0 = nt * 256;
        const size_t ex = (size_t)(layer * NEXP + e);
        if (EPI == EPI_GU) { g.A = p.xn; g.lda = DM; g.gshift = 1; g.B0 = p.wb_gate + ex * DM * FF; g.B1 = p.wb_up + ex * DM * FF; g.ldb = FF; g.gu = 1; g.K = DM; }
        else { g.A = p.hid; g.lda = FF; g.gshift = 0; g.B0 = p.wb_down + ex * FF * DM; g.B1 = g.B0; g.ldb = DM; g.gu = 0; g.K = FF; }
        gemm_tile<EPI, 2>(p, smem, g, layer);
    }
}

DI void convert_flat(const float* __restrict__ src, bf16_t* __restrict__ dst, size_t n8) {
    for (size_t i = (size_t)blockIdx.x * 512 + threadIdx.x; i < n8; i += (size_t)gridDim.x * 512) {
        const f32x4 a = *(const f32x4*)(src + i * 8), b = *(const f32x4*)(src + i * 8 + 4);
        u32x4 w; w.x = pack2(a[0], a[1]); w.y = pack2(a[2], a[3]); w.z = pack2(b[0], b[1]); w.w = pack2(b[2], b[3]);
        *(u32x4*)(dst + i * 8) = w;
    }
}
DI void poolfold_unit(const P& p, char* smem, int unit) {
    float (*At)[32] = (float (*)[32])smem;
    float (*Bs)[64] = (float (*)[64])(smem + 16384);
    const int tid = opaque_tid() & 255, g = unit >> 6, c0 = ((unit >> 4) & 3) * 32, n0 = (unit & 15) * 64;
    __syncthreads();
    for (int i = 0; i < 16; ++i) { const int idx = tid + 256 * i, d = idx >> 5, c = idx & 31;
        At[d][c] = p.pool_w[(size_t)(g * 128 + c0 + c) * 128 + d] * p.pool_scale[g * 128 + d]; }
    for (int i = 0; i < 8; ++i) { const int idx = tid + 256 * i, d = idx >> 4, n4 = (idx & 15) * 4;
        *(f32x4*)&Bs[d][n4] = *(const f32x4*)(p.w_out_even + (size_t)(512 + g * 128 + d) * DM + n0 + n4); }
    __syncthreads();
    const int tc = (tid >> 4) * 2, tn = (tid & 15) * 4;
    f32x4 acc[2] = {(f32x4){0.f, 0.f, 0.f, 0.f}, (f32x4){0.f, 0.f, 0.f, 0.f}};
#pragma unroll 8
    for (int d = 0; d < 128; ++d) {
        const f32x2 a = *(const f32x2*)&At[d][tc]; const f32x4 b = *(const f32x4*)&Bs[d][tn];
        acc[0] += a.x * b; acc[1] += a.y * b;
    }
#pragma unroll
    for (int i = 0; i < 2; ++i) { u32x2 w; w.x = pack2(acc[i][0], acc[i][1]); w.y = pack2(acc[i][2], acc[i][3]);
        *(u32x2*)(p.wb_out_even + (size_t)(512 + g * 128 + c0 + tc + i) * DM + n0 + tn) = w; }
}
DI void rmsnorm_rows2(const float* __restrict__ h0, const float* __restrict__ gain, bf16_t* __restrict__ d0, int lane) {
    f32x4 v[2][4]; float ss[2] = {0.f, 0.f};
#pragma unroll
    for (int r = 0; r < 2; ++r)
#pragma unroll
        for (int i = 0; i < 4; ++i) v[r][i] = *(const f32x4*)(h0 + r * DM + i * 256 + lane * 4);
#pragma unroll
    for (int r = 0; r < 2; ++r) {
#pragma unroll
        for (int i = 0; i < 4; ++i) ss[r] += v[r][i][0] * v[r][i][0] + v[r][i][1] * v[r][i][1] + v[r][i][2] * v[r][i][2] + v[r][i][3] * v[r][i][3];
        ss[r] = wave_sum(ss[r]);
    }
#pragma unroll
    for (int r = 0; r < 2; ++r) {
        const float rstd = rsqrtf(ss[r] * (1.0f / DM) + EPS);
#pragma unroll
        for (int i = 0; i < 4; ++i) { const f32x4 g = *(const f32x4*)(gain + i * 256 + lane * 4);
            u32x2 w; w.x = pack2(v[r][i][0] * rstd * g[0], v[r][i][1] * rstd * g[1]); w.y = pack2(v[r][i][2] * rstd * g[2], v[r][i][3] * rstd * g[3]);
            *(u32x2*)(d0 + r * DM + i * 256 + lane * 4) = w; }
    }
}
DI void ph_prologue(const P& p, char* smem) {
    if (blockIdx.x == 0 && threadIdx.x < 64) p.cnt[threadIdx.x] = 0;
    for (int u = blockIdx.x; u < 128; u += gridDim.x) poolfold_unit(p, smem + (threadIdx.x >> 8) * HALF_LDS, u * 2 + (threadIdx.x >> 8));
    for (int i = blockIdx.x * 512 + threadIdx.x; i < 2 * 96 * DM; i += gridDim.x * 512) {
        const int k = i & (DM - 1), R = (i >> 10) % 96, layer = i / (96 * DM);
        const int T = R >> 5, r = R & 31, L = 16 * T + (r & 3) + 4 * (r >> 3);
        float w = 0.f;
        if (L < 32) w = p.w_re[((size_t)layer * DM + k) * 32 + L]; else if (L < 36) w = p.w_rg[((size_t)layer * DM + k) * 4 + (L - 32)];
        w *= p.ffn_norm[layer * DM + k];
        const unsigned hi = pack2(w, 0.f) & 0xffffu;
        p.wr_hi[i] = (bf16_t)hi; p.wr_lo[i] = (bf16_t)(pack2(w - __uint_as_float(hi << 16), 0.f) & 0xffffu);
    }
    const int wave = threadIdx.x >> 6, lane = threadIdx.x & 63;
    for (int u = blockIdx.x; u < NTOK / 16; u += gridDim.x) {
        const int tok = u * 16 + wave * 2;
        rmsnorm_rows2(p.x + (size_t)tok * DM, p.mix_norm_even, p.xn + (size_t)tok * DM, lane);
    }
    convert_flat(p.w_in_even, p.wb_in_even, (size_t)DM * EVEN_IN / 8);
    convert_flat(p.w_out_even, p.wb_out_even, (size_t)512 * DM / 8);
}
DI void convert_experts(const P& p, int layer) {
    const size_t o = (size_t)layer * NEXP * DM * FF;
    convert_flat(p.w_gate + o, p.wb_gate + o, (size_t)NEXP * DM * FF / 8);
    convert_flat(p.w_up + o, p.wb_up + o, (size_t)NEXP * DM * FF / 8);
    convert_flat(p.w_down + o, p.wb_down + o, (size_t)NEXP * DM * FF / 8);
}

DI int crow(int i, int h) { return (i & 3) + 8 * (i >> 2) + 4 * h; }
DI float swap_max(float v) { auto rr = __builtin_amdgcn_permlane32_swap(__float_as_uint(v), __float_as_uint(v), false, false); return fmaxf(__uint_as_float(rr[0]), __uint_as_float(rr[1])); }
DI float swap_sum(float v) { auto rr = __builtin_amdgcn_permlane32_swap(__float_as_uint(v), __float_as_uint(v), false, false); return __uint_as_float(rr[0]) + __uint_as_float(rr[1]); }
DI float bcast_lo(float v) { auto rr = __builtin_amdgcn_permlane32_swap(__float_as_uint(v), __float_as_uint(v), false, false); return __uint_as_float(rr[0]); }
DI bf16x8 pack8(const f32x16& x, int s) {
    u32x4 w; w.x = pack2(x[8 * s], x[8 * s + 1]); w.y = pack2(x[8 * s + 2], x[8 * s + 3]); w.z = pack2(x[8 * s + 4], x[8 * s + 5]); w.w = pack2(x[8 * s + 6], x[8 * s + 7]);
    return __builtin_bit_cast(bf16x8, w);
}
constexpr int KV_TILE = 8192;
struct KVStage { u32x4 k[2], v[2]; };
DI void kv_load(KVStage& st, const bf16_t* kbase, const bf16_t* vbase, int ld, int key0) {
    const int tid = opaque_tid() & 255, c = tid & 7, r0 = tid >> 3;
#pragma unroll
    for (int i = 0; i < 2; ++i) { const size_t off = (size_t)(key0 + r0 + 32 * i) * ld + c * 8; st.k[i] = *(const u32x4*)(kbase + off); st.v[i] = *(const u32x4*)(vbase + off); }
}
DI void kv_store(const KVStage& st, char* kt, char* vt) {
    const int tid = opaque_tid() & 255, c = tid & 7, r0 = tid >> 3;
#pragma unroll
    for (int i = 0; i < 2; ++i) { const int r = r0 + 32 * i;
        *(u32x4*)(kt + r * 128 + ((c ^ ((r >> 1) & 7)) << 4)) = st.k[i];
        *(u32x4*)(vt + r * 128 + ((((c >> 2) ^ ((r >> 1) & 1))) << 6) + ((c & 3) << 4)) = st.v[i]; }
}
DI bf16x8 k_frag(const char* kt, int sb, int st, int r32, int hh) {
    const int row = sb * 32 + r32;
    return *(const bf16x8*)(kt + row * 128 + (((2 * st + hh) ^ ((row >> 1) & 7)) << 4));
}
DI bf16x8 vt_frag(const char* vt, int sb, int st, int dh, int lane) {
    const int hh = lane >> 5, g1 = (lane >> 4) & 1, pp = lane & 3, q = (lane & 15) >> 2;
    const int key = sb * 32 + 16 * st + 4 * hh + q;
    const char* a = vt + key * 128 + ((dh ^ ((q >> 1) & 1)) << 6) + g1 * 32 + pp * 8;
    const s16x4 lo = tr_read(a), hi = tr_read(a + 8 * 128);
    return (bf16x8){lo[0], lo[1], lo[2], lo[3], hi[0], hi[1], hi[2], hi[3]};
}


#define XB_TMO      128
#define XB_XCNT(j)  (256  + 64 * (j))
#define XB_XSUB(j)  (1280 + 64 * (j))
#define XB_XGEN(j)  (2304 + 64 * (j))
#define XB_TOP      3328
#define XB_TOPGEN   3392
#define XCD_BAR_WORDS 3456
#define XB_SPIN_CAP (1u << 22)
DI unsigned xb_ld(unsigned* q)              { return __hip_atomic_load(q, __ATOMIC_RELAXED, __HIP_MEMORY_SCOPE_AGENT); }
DI unsigned xb_add(unsigned* q, unsigned v) { return __hip_atomic_fetch_add(q, v, __ATOMIC_RELAXED, __HIP_MEMORY_SCOPE_AGENT); }
DI unsigned xb_xcc_id() { return (unsigned)__builtin_amdgcn_s_getreg((3 << 11) | 20) & 0xFu; }
#define XB_SPIN(cond, bar) do { unsigned _sp = 0; while (cond) { __builtin_amdgcn_s_sleep(1); \
    if ((++_sp & 255u) == 0u) { if (xb_ld(&(bar)[XB_TMO])) break; if (_sp > XB_SPIN_CAP) { atomicAdd(&(bar)[XB_TMO], 1u); break; } } } } while (0)
struct XcdBarrier { unsigned* bar; unsigned x; volatile LDSAS unsigned* st; };
DI XcdBarrier xcd_barrier_post(unsigned* bar, volatile LDSAS unsigned* st) {
    XcdBarrier b; b.bar = bar; b.x = xb_xcc_id(); b.st = st;
    if (threadIdx.x == 0) (void)xb_add(&bar[XB_XCNT(b.x)], 1u);
    return b;
}
DI void xcd_barrier_complete(unsigned* bar, unsigned x, unsigned& nloc, unsigned& nx) {
    const unsigned G = gridDim.x * gridDim.y * gridDim.z;
    unsigned sum, cnt, mine, sp = 0u;
    for (;;) {
        sum = 0u; cnt = 0u; mine = 0u;
#pragma unroll
        for (unsigned j = 0; j < 16; ++j) { const unsigned c = xb_ld(&bar[XB_XCNT(j)]); sum += c; cnt += (c > 0u) ? 1u : 0u; mine = (j == x) ? c : mine; }
        if (sum == G) break;
        __builtin_amdgcn_s_sleep(1);
        if ((++sp & 255u) == 0u) { if (xb_ld(&bar[XB_TMO])) break; if (sp > XB_SPIN_CAP) { atomicAdd(&bar[XB_TMO], 1u); break; } }
    }
    nloc = mine > 0u ? mine : 1u; nx = cnt > 0u ? cnt : 1u;
}
DI void xcd_barrier(const XcdBarrier& b) {
    asm volatile("s_waitcnt vmcnt(0)" ::: "memory");
    __syncthreads();
    if (threadIdx.x == 0) {
        unsigned* bar = b.bar;
        __builtin_amdgcn_s_waitcnt(0);
        unsigned nloc = b.st[0], nx = b.st[1];
        if (nloc == 0u) { xcd_barrier_complete(bar, b.x, nloc, nx); b.st[0] = nloc; b.st[1] = nx; }
        const unsigned old = xb_add(&bar[XB_XSUB(b.x)], 1u);
        const unsigned gen = old / nloc;
        if (old + 1u == (gen + 1u) * nloc) {
            __builtin_amdgcn_fence(__ATOMIC_RELEASE, "agent");
            asm volatile("s_waitcnt vmcnt(0)" ::: "memory");
            const unsigned og = xb_add(&bar[XB_TOP], 1u);
            const unsigned tg = og / nx;
            if (og + 1u == (tg + 1u) * nx) xb_add(&bar[XB_TOPGEN], 1u);
            else XB_SPIN(xb_ld(&bar[XB_TOPGEN]) == tg, bar);
            __builtin_amdgcn_fence(__ATOMIC_ACQUIRE, "agent");
            xb_add(&bar[XB_XGEN(b.x)], 1u);
            asm volatile("s_waitcnt vmcnt(0)" ::: "memory");
        } else {
            XB_SPIN(xb_ld(&bar[XB_XGEN(b.x)]) == gen, bar);
            __builtin_amdgcn_fence(__ATOMIC_ACQUIRE, "agent");
            asm volatile("s_waitcnt vmcnt(0)" ::: "memory");
        }
    }
    __syncthreads();
}


struct ConvRegs { f32x4 v[4]; bf16_t* dst; };
struct ConvPlan { int layer; int sl_e, sl_in, sl_out, nslots; };
DI ConvPlan conv_plan(const P& p, int layer) {
    ConvPlan c; c.layer = layer;
    const unsigned per = gridDim.x * 512u;
    c.sl_e = (int)((NEXP * DM * FF / 16 + per - 1) / per);
    c.sl_in = layer == 0 ? (int)((DM * ODD_IN / 16 + per - 1) / per) : 0;
    c.sl_out = layer == 0 ? (int)((DM * DM / 16 + per - 1) / per) : 0;
    c.nslots = 3 * c.sl_e + c.sl_in + c.sl_out;
    return c;
}
DI void conv_load(const P& p, const ConvPlan& c, int slot, ConvRegs& r) {
    r.dst = nullptr;
    if (slot >= c.nslots) return;
    int seg, ls = slot;
    if (ls < 3 * c.sl_e) { seg = ls / c.sl_e; ls -= seg * c.sl_e; }
    else if ((ls -= 3 * c.sl_e) < c.sl_in) seg = 3;
    else { ls -= c.sl_in; seg = 4; }
    const unsigned ng = seg < 3 ? NEXP * DM * FF / 16 : (seg == 3 ? DM * ODD_IN / 16 : DM * DM / 16);
    const float* s = p.cs[c.layer * 5 + seg]; bf16_t* d = p.cd[c.layer * 5 + seg];
    const unsigned gi = ((unsigned)ls * gridDim.x + blockIdx.x) * 512u + threadIdx.x;
    if (gi < ng) {
        const size_t e = (size_t)gi * 16;
        r.dst = d + e;
#pragma unroll
        for (int i = 0; i < 4; ++i) r.v[i] = *(const f32x4*)(s + e + 4 * i);
    }
}
DI void conv_store(ConvRegs& r) {
    if (r.dst) {
        u32x4 a, b;
        a.x = pack2(r.v[0][0], r.v[0][1]); a.y = pack2(r.v[0][2], r.v[0][3]); a.z = pack2(r.v[1][0], r.v[1][1]); a.w = pack2(r.v[1][2], r.v[1][3]);
        b.x = pack2(r.v[2][0], r.v[2][1]); b.y = pack2(r.v[2][2], r.v[2][3]); b.z = pack2(r.v[3][0], r.v[3][1]); b.w = pack2(r.v[3][2], r.v[3][3]);
        *(u32x4*)r.dst = a; *(u32x4*)(r.dst + 8) = b;
    }
}
DI void conv_rest(const P& p, const ConvPlan& c, int slot) {
    for (; slot < c.nslots; ++slot) { ConvRegs r; conv_load(p, c, slot, r); conv_store(r); }
}

DI void band_attn_unit(const P& p, char* smem, int unit, const ConvPlan& cv, int& cslot, ConvRegs& cr) {
    const int tid = opaque_tid() & 255, lane = tid & 63, wid = tid >> 6, r32 = lane & 31, hh = lane >> 5;
    const int cp = unit & 31, h = (unit >> 5) & 7, b = unit >> 8;
    const int c = 2 * cp + (wid >> 1);
    const int tq = c * 64 + (wid & 1) * 32 + r32;
    const size_t rowb = (size_t)b * NS;
    const bf16_t* kbase = p.proj + rowb * EVEN_IN + 512 + h * 64;
    const bf16_t* vbase = p.proj + rowb * EVEN_IN + 1024 + h * 64;
    float* sbias = (float*)(smem + 4 * KV_TILE);
    __syncthreads();
    for (int i = tid; i < 257; i += 256) sbias[i] = p.att_rel_bias[h * 257 + i] * LOG2E;
    bf16x8 qf[4];
#pragma unroll
    for (int st = 0; st < 4; ++st) qf[st] = *(const bf16x8*)(p.proj + (rowb + tq) * EVEN_IN + h * 64 + st * 16 + hh * 8);
    const int ck0 = (2 * cp - 8) > 0 ? (2 * cp - 8) : 0, nt = 2 * cp + 2 - ck0;
    float m = -3.0e38f, lsum = 0.f;
    f32x16 o0, o1;
#pragma unroll
    for (int i = 0; i < 16; ++i) { o0[i] = 0.f; o1[i] = 0.f; }
    KVStage stg;
    kv_load(stg, kbase, vbase, EVEN_IN, ck0 * 64);
    kv_store(stg, smem, smem + 2 * KV_TILE);
    __syncthreads();
    for (int it = 0; it < nt; ++it) {
        const int ck = ck0 + it, cur = it & 1;
        if (it + 1 < nt) kv_load(stg, kbase, vbase, EVEN_IN, (ck + 1) * 64);
        conv_store(cr); conv_load(p, cv, cslot++, cr);
        __builtin_amdgcn_sched_barrier(0);
        const char* kt = smem + cur * KV_TILE; const char* vt = smem + (2 + cur) * KV_TILE;
        if (ck >= c - 8 && ck <= c) {
            f32x16 s0, s1;
#pragma unroll
            for (int i = 0; i < 16; ++i) { s0[i] = 0.f; s1[i] = 0.f; }
#pragma unroll
            for (int st = 0; st < 4; ++st) { s0 = MFMA32(k_frag(kt, 0, st, r32, hh), qf[st], s0); s1 = MFMA32(k_frag(kt, 1, st, r32, hh), qf[st], s1); }
            if (c - ck >= 3) { const float bb = sbias[256];
#pragma unroll
                for (int i = 0; i < 16; ++i) { s0[i] += bb; s1[i] += bb; }
            } else {
                const int d0 = tq - ck * 64 - 4 * hh;
#pragma unroll
                for (int i = 0; i < 16; ++i) {
                    int da = d0 - ((i & 3) + 8 * (i >> 2)), db = da - 32;
                    da = da > 128 ? 128 : da; db = db > 128 ? 128 : db;
                    s0[i] += sbias[da + 128]; s1[i] += sbias[db + 128];
                }
            }
            float tm = fmaxf(s0[0], s1[0]);
#pragma unroll
            for (int i = 1; i < 16; ++i) tm = fmaxf(tm, fmaxf(s0[i], s1[i]));
            tm = swap_max(tm);
            const float mn = fmaxf(m, tm);
            const float alpha = __builtin_amdgcn_exp2f(m - mn);
            m = mn;
            float ps = 0.f;
#pragma unroll
            for (int i = 0; i < 16; ++i) { s0[i] = __builtin_amdgcn_exp2f(s0[i] - mn); s1[i] = __builtin_amdgcn_exp2f(s1[i] - mn); ps += s0[i] + s1[i]; }
            lsum = lsum * alpha + ps;
#pragma unroll
            for (int i = 0; i < 16; ++i) { o0[i] *= alpha; o1[i] *= alpha; }
#pragma unroll
            for (int st = 0; st < 2; ++st) {
                const bf16x8 pa = pack8(s0, st), pb = pack8(s1, st);
                o0 = MFMA32(vt_frag(vt, 0, st, 0, lane), pa, o0); o1 = MFMA32(vt_frag(vt, 0, st, 1, lane), pa, o1);
                o0 = MFMA32(vt_frag(vt, 1, st, 0, lane), pb, o0); o1 = MFMA32(vt_frag(vt, 1, st, 1, lane), pb, o1);
            }
        }
        __builtin_amdgcn_sched_barrier(0);
        if (it + 1 < nt) kv_store(stg, smem + (cur ^ 1) * KV_TILE, smem + (2 + (cur ^ 1)) * KV_TILE);
        __syncthreads();
    }
    const float inv = 1.0f / swap_sum(lsum);
    bf16_t* orow = p.mixed + (rowb + tq) * DM + h * 64 + 4 * hh;
#pragma unroll
    for (int g = 0; g < 4; ++g) {
        u32x2 w0, w1;
        w0.x = pack2(o0[4 * g] * inv, o0[4 * g + 1] * inv); w0.y = pack2(o0[4 * g + 2] * inv, o0[4 * g + 3] * inv);
        w1.x = pack2(o1[4 * g] * inv, o1[4 * g + 1] * inv); w1.y = pack2(o1[4 * g + 2] * inv, o1[4 * g + 3] * inv);
        *(u32x2*)(orow + 8 * g) = w0; *(u32x2*)(orow + 32 + 8 * g) = w1;
    }
}

DI void sb_attn_unit(const P& p, char* smem, volatile int* wdone, int unit, const ConvPlan& cv, int& cslot, ConvRegs& cr0) {
    const int tid8 = opaque_tid(), tid = tid8 & 255, lane = tid & 63, wid = tid >> 6, r32 = lane & 31, hh = lane >> 5, wid8 = tid8 >> 6;
    const int qb = unit & 31, h = (unit >> 5) & 7, b = unit >> 8;
    const int tw = qb * 128 + wid * 32, t = tw + r32;
    const size_t rowb = (size_t)b * NS;
    const bf16_t* kbase = p.proj + rowb * ODD_IN + 1536 + h * 64;
    const bf16_t* vbase = p.proj + rowb * ODD_IN + 2048 + h * 64;
    __syncthreads();
    bf16x8 qf[4];
#pragma unroll
    for (int st = 0; st < 4; ++st) qf[st] = *(const bf16x8*)(p.proj + (rowb + t) * ODD_IN + 1024 + h * 64 + st * 16 + hh * 8);
    bf16x8 tf[2];
#pragma unroll
    for (int st = 0; st < 2; ++st)
#pragma unroll
        for (int j = 0; j < 8; ++j) tf[st][j] = (16 * st + 8 * (j >> 2) + 4 * hh + (j & 3)) >= r32 ? (short)0x3F80 : (short)0;
    f32x16 o0, o1;
#pragma unroll
    for (int i = 0; i < 16; ++i) { o0[i] = 0.f; o1[i] = 0.f; }
    float carry = 0.f; bool done = false;
    const int kt0 = 2 * qb + 1;
    KVStage stg;
    kv_load(stg, kbase, vbase, ODD_IN, kt0 * 64);
    kv_store(stg, smem, smem + 2 * KV_TILE);
    __syncthreads();
    for (int it = 0; it <= kt0; ++it) {
        const int kt = kt0 - it, cur = it & 1;
        if (kt > 0) kv_load(stg, kbase, vbase, ODD_IN, (kt - 1) * 64);
        conv_store(cr0); conv_load(p, cv, cslot++, cr0);
        __builtin_amdgcn_sched_barrier(0);
        const char* ktile = smem + cur * KV_TILE; const char* vtile = smem + (2 + cur) * KV_TILE;
        if (!done && kt * 64 < tw + 31) {
#pragma unroll
            for (int sbi = 0; sbi < 2; ++sbi) {
                const int sb = 1 - sbi;
                f32x16 x;
#pragma unroll
                for (int i = 0; i < 16; ++i) x[i] = 0.f;
#pragma unroll
                for (int st = 0; st < 4; ++st) x = MFMA32(k_frag(ktile, sb, st, r32, hh), qf[st], x);
                const int kb = kt * 64 + sb * 32 + 4 * hh;
                f32x16 L, Lr;
#pragma unroll
                for (int i = 0; i < 16; ++i) {
                    const bool valid = kb + (i & 3) + 8 * (i >> 2) < t;
                    const float z = x[i];
                    const float sp = fmaxf(z, 0.f) + __builtin_amdgcn_logf(1.0f + __builtin_amdgcn_exp2f(-fabsf(z)));
                    L[i] = valid ? -sp : 0.f;
                    x[i] = valid ? z : -1.0e30f;
                }
                f32x16 cum;
#pragma unroll
                for (int i = 0; i < 16; ++i) cum[i] = carry;
#pragma unroll
                for (int st = 0; st < 2; ++st) {
                    const bf16x8 hi = pack8(L, st);
#pragma unroll
                    for (int j = 0; j < 8; ++j) Lr[8 * st + j] = L[8 * st + j] - __uint_as_float(((unsigned)(unsigned short)hi[j]) << 16);
                    cum = MFMA32(tf[st], hi, cum);
                }
#pragma unroll
                for (int st = 0; st < 2; ++st) cum = MFMA32(tf[st], pack8(Lr, st), cum);
                carry = bcast_lo(cum[0]);
#pragma unroll
                for (int i = 0; i < 16; ++i) x[i] = __builtin_amdgcn_exp2f(x[i] + cum[i]);
#pragma unroll
                for (int st = 0; st < 2; ++st) {
                    const bf16x8 pa = pack8(x, st);
                    o0 = MFMA32(vt_frag(vtile, sb, st, 0, lane), pa, o0); o1 = MFMA32(vt_frag(vtile, sb, st, 1, lane), pa, o1);
                }
            }
            done = __all(carry < -150.0f);
        }
        __builtin_amdgcn_sched_barrier(0);
        if (lane == 0) wdone[cur * 8 + wid8] = done ? 1 : 0;
        if (kt > 0) kv_store(stg, smem + (cur ^ 1) * KV_TILE, smem + (2 + (cur ^ 1)) * KV_TILE);
        __syncthreads();
        if (wdone[cur * 8] + wdone[cur * 8 + 1] + wdone[cur * 8 + 2] + wdone[cur * 8 + 3] + wdone[cur * 8 + 4] + wdone[cur * 8 + 5] + wdone[cur * 8 + 6] + wdone[cur * 8 + 7] == 8) break;
    }
    bf16_t* orow = p.mixed + (rowb + t) * DM + 512 + h * 64 + 4 * hh;
#pragma unroll
    for (int g = 0; g < 4; ++g) {
        u32x2 w0, w1;
        w0.x = pack2(o0[4 * g], o0[4 * g + 1]); w0.y = pack2(o0[4 * g + 2], o0[4 * g + 3]);
        w1.x = pack2(o1[4 * g], o1[4 * g + 1]); w1.y = pack2(o1[4 * g + 2], o1[4 * g + 3]);
        *(u32x2*)(orow + 8 * g) = w0; *(u32x2*)(orow + 32 + 8 * g) = w1;
    }
}

DI void pool_items(const P& p) {
    for (int it = blockIdx.x * 512 + threadIdx.x; it < NTOK * 64; it += gridDim.x * 512) {
        const int tok = it >> 6, ch8 = it & 63, g = ch8 >> 4, w = 2 << g, s = tok & (NS - 1);
        const int n = (s + 1 < w) ? s + 1 : w;
        float sum[8], own[8];
#pragma unroll
        for (int j = 0; j < 8; ++j) sum[j] = 0.f;
        const bf16_t* src = p.proj + (size_t)tok * EVEN_IN + 1536 + ch8 * 8;
        u32x4 wv[16];
#pragma unroll
        for (int t = 0; t < 16; ++t) wv[t] = (t < n) ? *(const u32x4*)(src - (size_t)t * EVEN_IN) : (u32x4){0u, 0u, 0u, 0u};
#pragma unroll
        for (int t = 0; t < 16; ++t) { unpack8(wv[t], own);
#pragma unroll
            for (int j = 0; j < 8; ++j) sum[j] += own[j]; }
        unpack8(wv[0], own);
        const float inv = 1.0f / (float)n;
        u32x4 o; o.x = pack2(sum[0] * inv - own[0], sum[1] * inv - own[1]); o.y = pack2(sum[2] * inv - own[2], sum[3] * inv - own[3]);
        o.z = pack2(sum[4] * inv - own[4], sum[5] * inv - own[5]); o.w = pack2(sum[6] * inv - own[6], sum[7] * inv - own[7]);
        *(u32x4*)(p.mixed + (size_t)tok * DM + 512 + ch8 * 8) = o;
    }
}

DI void sgu_unit(const P& p, char* smem, int unit) {
    const int tid = opaque_tid() & 255, lane = tid & 63, wid = tid >> 6, wm = wid >> 1, wn = wid & 1, fr = lane & 15, fq = lane >> 4;
    const int g = unit & 3; const size_t tok0 = (size_t)(unit >> 2) * 128;
    char* As = smem; char* Gs = smem + 32768; float* srstd = (float*)(smem + 65536);
    __syncthreads();
    {
        const int row = tid >> 1, half = tid & 1;
        const bf16_t* src = p.proj + (tok0 + row) * ODD_IN + 512 + half * 256;
        float ss = 0.f;
        for (int i = 0; i < 32; ++i) { float f[8]; unpack8(*(const u32x4*)(src + i * 8), f);
#pragma unroll
            for (int j = 0; j < 8; ++j) ss += f[j] * f[j]; }
        ss += __shfl_xor(ss, 1);
        if (half == 0) srstd[row] = rsqrtf(ss * (1.0f / 512.0f) + EPS);
    }
#pragma unroll
    for (int i = 0; i < 8; ++i) {
        const int idx = tid + 256 * i, s = idx >> 4, ch = idx & 15;
        const u32x4 v = *(const u32x4*)(p.proj + (tok0 + s) * ODD_IN + 512 + g * 128 + ch * 8);
        *(u32x4*)(Gs + s * 256 + (((ch >> 1) ^ kswz(s)) << 5) + ((ch & 1) << 4)) = v;
    }
    __syncthreads();
#pragma unroll
    for (int i = 0; i < 8; ++i) {
        const int idx = tid + 256 * i, t = idx >> 4, c8 = idx & 15, s0 = c8 * 8;
        const float* wr = p.sgu_w + ((size_t)g * 128 + t) * 128 + s0;
        const f32x4 a = *(const f32x4*)wr, b = *(const f32x4*)(wr + 4);
        float f[8] = {a[0], a[1], a[2], a[3], b[0], b[1], b[2], b[3]};
#pragma unroll
        for (int j = 0; j < 8; ++j) f[j] = (s0 + j <= t) ? f[j] * srstd[s0 + j] : 0.f;
        u32x4 w; w.x = pack2(f[0], f[1]); w.y = pack2(f[2], f[3]); w.z = pack2(f[4], f[5]); w.w = pack2(f[6], f[7]);
        *(u32x4*)(As + (c8 >> 3) * 16384 + t * 128 + (((c8 & 7) ^ (t & 7)) << 4)) = w;
    }
    __syncthreads();
    f32x4 acc[4][4];
#pragma unroll
    for (int a = 0; a < 4; ++a)
#pragma unroll
        for (int b = 0; b < 4; ++b) acc[a][b] = (f32x4){0.f, 0.f, 0.f, 0.f};
    const int qq = fr >> 2, pp = fr & 3;
#pragma unroll
    for (int kt = 0; kt < 2; ++kt) {
        if (kt == 1 && wm == 0) continue;
#pragma unroll
        for (int s2 = 0; s2 < 2; ++s2) {
            bf16x8 af[4], bfv[4];
#pragma unroll
            for (int i = 0; i < 4; ++i) {
                const int ra_ = wm * 64 + i * 16 + fr;
                af[i] = *(const bf16x8*)(As + kt * 16384 + ra_ * 128 + (((s2 * 4 + fq) ^ (fr & 7)) << 4));
                const int srow = kt * 64 + s2 * 32 + 8 * fq + qq, blk = wn * 4 + i;
                const s16x4 lo = tr_read(Gs + srow * 256 + ((blk ^ kswz(srow)) << 5) + pp * 8);
                const s16x4 hi = tr_read(Gs + (srow + 4) * 256 + ((blk ^ kswz(srow + 4)) << 5) + pp * 8);
                bfv[i] = (bf16x8){lo[0], lo[1], lo[2], lo[3], hi[0], hi[1], hi[2], hi[3]};
            }
#pragma unroll
            for (int mi = 0; mi < 4; ++mi)
#pragma unroll
                for (int ni = 0; ni < 4; ++ni) acc[mi][ni] = MFMA16(bfv[ni], af[mi], acc[mi][ni]);
        }
    }
#pragma unroll
    for (int mi = 0; mi < 4; ++mi) {
        const int t = wm * 64 + mi * 16 + fr;
        const float bias = p.sgu_b[g * 128 + t];
#pragma unroll
        for (int ni = 0; ni < 4; ++ni) {
            const int c = g * 128 + wn * 64 + ni * 16 + fq * 4;
            const f32x4 gn = *(const f32x4*)(p.sgu_v_norm + c);
            const u32x2 uu = *(const u32x2*)(p.proj + (tok0 + t) * ODD_IN + c);
            const float u0 = __uint_as_float(uu.x << 16), u1 = __uint_as_float(uu.x & 0xffff0000u), u2 = __uint_as_float(uu.y << 16), u3 = __uint_as_float(uu.y & 0xffff0000u);
            const f32x4 a = acc[mi][ni];
            u32x2 w; w.x = pack2(u0 * (gn[0] * a[0] + bias), u1 * (gn[1] * a[1] + bias)); w.y = pack2(u2 * (gn[2] * a[2] + bias), u3 * (gn[3] * a[3] + bias));
            *(u32x2*)(p.mixed + (tok0 + t) * DM + c) = w;
        }
    }
}

DI void router_unit(const P& p, char* smem, int layer, int unit) {
    const int tid = opaque_tid() & 255, lane = tid & 63, wid = tid >> 6, r32 = lane & 31, hh = lane >> 5;
    float (*part)[36][32] = (float (*)[36][32])smem;
    float (*wss)[32] = (float (*)[32])(smem + 18432);
    int* lcnt = (int*)(smem + 18432 + 512);
    int* lbase = lcnt + 32;
    int* cnt = p.cnt + layer * NEXP;
    const int tok = unit * 32 + r32, kq = wid * 256 + 8 * hh;
    __syncthreads();
    if (tid < 32) lcnt[tid] = 0;
    const float* hrow = p.out + (size_t)tok * DM + kq;
    const float* gn = p.ffn_norm + layer * DM + kq;
    const bf16_t* whi = p.wr_hi + ((size_t)layer * 96 + r32) * DM + kq;
    const bf16_t* wlo = p.wr_lo + ((size_t)layer * 96 + r32) * DM + kq;
    bf16_t* xo = p.xn + (size_t)tok * DM + kq;
    f32x16 c0, c1, c2;
#pragma unroll
    for (int i = 0; i < 16; ++i) { c0[i] = 0.f; c1[i] = 0.f; c2[i] = 0.f; }
    float ss = 0.f;
#pragma unroll 4
    for (int st = 0; st < 16; ++st) {
        const f32x4 a = *(const f32x4*)(hrow + 16 * st), b = *(const f32x4*)(hrow + 16 * st + 4);
        const f32x4 ga = *(const f32x4*)(gn + 16 * st), gb = *(const f32x4*)(gn + 16 * st + 4);
        ss += a[0] * a[0] + a[1] * a[1] + a[2] * a[2] + a[3] * a[3] + b[0] * b[0] + b[1] * b[1] + b[2] * b[2] + b[3] * b[3];
        u32x4 xw; xw.x = pack2(a[0] * ga[0], a[1] * ga[1]); xw.y = pack2(a[2] * ga[2], a[3] * ga[3]); xw.z = pack2(b[0] * gb[0], b[1] * gb[1]); xw.w = pack2(b[2] * gb[2], b[3] * gb[3]);
        *(u32x4*)(xo + 16 * st) = xw;
        u32x4 hw; hw.x = pack2(a[0], a[1]); hw.y = pack2(a[2], a[3]); hw.z = pack2(b[0], b[1]); hw.w = pack2(b[2], b[3]);
        u32x4 lw;
        lw.x = pack2(a[0] - __uint_as_float(hw.x << 16), a[1] - __uint_as_float(hw.x & 0xffff0000u)); lw.y = pack2(a[2] - __uint_as_float(hw.y << 16), a[3] - __uint_as_float(hw.y & 0xffff0000u));
        lw.z = pack2(b[0] - __uint_as_float(hw.z << 16), b[1] - __uint_as_float(hw.z & 0xffff0000u)); lw.w = pack2(b[2] - __uint_as_float(hw.w << 16), b[3] - __uint_as_float(hw.w & 0xffff0000u));
        const bf16x8 hhi = __builtin_bit_cast(bf16x8, hw), hlo = __builtin_bit_cast(bf16x8, lw);
        bf16x8 wh, wl;
        wh = *(const bf16x8*)(whi + 16 * st); wl = *(const bf16x8*)(wlo + 16 * st);
        c0 = MFMA32(wh, hhi, c0); c0 = MFMA32(wh, hlo, c0); c0 = MFMA32(wl, hhi, c0);
        wh = *(const bf16x8*)(whi + 32 * DM + 16 * st); wl = *(const bf16x8*)(wlo + 32 * DM + 16 * st);
        c1 = MFMA32(wh, hhi, c1); c1 = MFMA32(wh, hlo, c1); c1 = MFMA32(wl, hhi, c1);
        wh = *(const bf16x8*)(whi + 64 * DM + 16 * st); wl = *(const bf16x8*)(wlo + 64 * DM + 16 * st);
        c2 = MFMA32(wh, hhi, c2); c2 = MFMA32(wh, hlo, c2); c2 = MFMA32(wl, hhi, c2);
    }
    {
        auto rr = __builtin_amdgcn_permlane32_swap(__float_as_uint(ss), __float_as_uint(ss), false, false);
        ss = __uint_as_float(rr[0]) + __uint_as_float(rr[1]);
        if (hh == 0) {
#pragma unroll
            for (int i = 0; i < 16; ++i) { part[wid][i][r32] = c0[i]; part[wid][16 + i][r32] = c1[i]; }
#pragma unroll
            for (int i = 0; i < 4; ++i) part[wid][32 + i][r32] = c2[i];
            wss[wid][r32] = ss;
        }
    }
    __syncthreads();
    int e1 = 0, e2 = 0, r1 = 0, r2 = 0; float w1 = 0.f, w2 = 0.f, rstd = 0.f;
    const int mytok = unit * 32 + tid;
    if (tid < 32) {
        rstd = rsqrtf((wss[0][tid] + wss[1][tid] + wss[2][tid] + wss[3][tid]) * (1.0f / DM) + EPS);
        float gl[4], ev[8];
#pragma unroll
        for (int j = 0; j < 4; ++j) gl[j] = (part[0][32 + j][tid] + part[1][32 + j][tid] + part[2][32 + j][tid] + part[3][32 + j][tid]) * rstd;
        int gs = 0; float gm = gl[0];
#pragma unroll
        for (int j = 1; j < 4; ++j) if (gl[j] > gm) { gm = gl[j]; gs = j; }
        const float gw = 1.0f / (__expf(gl[0] - gm) + __expf(gl[1] - gm) + __expf(gl[2] - gm) + __expf(gl[3] - gm));
#pragma unroll
        for (int j = 0; j < 8; ++j) { const int s = gs * 8 + j; ev[j] = (part[0][s][tid] + part[1][s][tid] + part[2][s][tid] + part[3][s][tid]) * rstd; }
        int i1 = 0; float v1 = ev[0];
#pragma unroll
        for (int j = 1; j < 8; ++j) if (ev[j] > v1) { v1 = ev[j]; i1 = j; }
        int i2 = -1; float v2 = -3.0e38f;
#pragma unroll
        for (int j = 0; j < 8; ++j) if (j != i1 && ev[j] > v2) { v2 = ev[j]; i2 = j; }
        w1 = 1.0f / (1.0f + __expf(v2 - v1)); w2 = (1.0f - w1) * gw; w1 *= gw;
        e1 = gs * 8 + i1; e2 = gs * 8 + i2;
        r1 = atomicAdd(lcnt + e1, 1); r2 = atomicAdd(lcnt + e2, 1);
    }
    __syncthreads();
    if (tid < 32) { const int n = lcnt[tid]; lbase[tid] = n ? atomicAdd(cnt + tid, n) : 0; }
    __syncthreads();
    if (tid < 32) {
        p.plist[(size_t)e1 * LISTCAP + lbase[e1] + r1] = mytok * 2; p.plist[(size_t)e2 * LISTCAP + lbase[e2] + r2] = mytok * 2 + 1;
        p.pw[mytok * 2] = w1; p.pw[mytok * 2 + 1] = w2; p.rs[mytok] = rstd;
    }
}
DI void ph_combine(const P& p, int layer) {
    const int wave = threadIdx.x >> 6, lane = threadIdx.x & 63;
    for (int u = blockIdx.x; u < NTOK / 16; u += gridDim.x) {
        const size_t tok0 = (size_t)u * 16 + wave * 2;
        f32x4 h[2][4]; u32x2 ya[2][4], yb[2][4];
#pragma unroll
        for (int r = 0; r < 2; ++r)
#pragma unroll
            for (int i = 0; i < 4; ++i) {
                const int c = i * 256 + lane * 4;
                h[r][i] = *(const f32x4*)(p.out + (tok0 + r) * DM + c);
                ya[r][i] = *(const u32x2*)(p.y + ((tok0 + r) * 2) * DM + c); yb[r][i] = *(const u32x2*)(p.y + ((tok0 + r) * 2 + 1) * DM + c);
            }
#pragma unroll
        for (int r = 0; r < 2; ++r) {
            float ss = 0.f;
#pragma unroll
            for (int i = 0; i < 4; ++i) {
                const u32x2 a = ya[r][i], b = yb[r][i];
                h[r][i][0] += __uint_as_float(a.x << 16) + __uint_as_float(b.x << 16);
                h[r][i][1] += __uint_as_float(a.x & 0xffff0000u) + __uint_as_float(b.x & 0xffff0000u);
                h[r][i][2] += __uint_as_float(a.y << 16) + __uint_as_float(b.y << 16);
                h[r][i][3] += __uint_as_float(a.y & 0xffff0000u) + __uint_as_float(b.y & 0xffff0000u);
                *(f32x4*)(p.out + (tok0 + r) * DM + i * 256 + lane * 4) = h[r][i];
                ss += h[r][i][0] * h[r][i][0] + h[r][i][1] * h[r][i][1] + h[r][i][2] * h[r][i][2] + h[r][i][3] * h[r][i][3];
            }
            if (layer == 0) {
                ss = wave_sum(ss);
                const float rstd = rsqrtf(ss * (1.0f / DM) + EPS);
#pragma unroll
                for (int i = 0; i < 4; ++i) { const f32x4 g = *(const f32x4*)(p.mix_norm_odd + i * 256 + lane * 4);
                    u32x2 w; w.x = pack2(h[r][i][0] * rstd * g[0], h[r][i][1] * rstd * g[1]); w.y = pack2(h[r][i][2] * rstd * g[2], h[r][i][3] * rstd * g[3]);
                    *(u32x2*)(p.xn + (tok0 + r) * DM + i * 256 + lane * 4) = w; }
            }
        }
    }
}

DI void ph_mix_even(const P& p, char* smem) {
    const int half = threadIdx.x >> 8;
    const ConvPlan cv = conv_plan(p, 0); int cslot = 0; ConvRegs cr; cr.dst = nullptr;
    for (int u = blockIdx.x; u < NB * 4 * 32; u += gridDim.x) {
        const int cp = u & 31, hp = (u >> 5) & 3, b = u >> 7;
        band_attn_unit(p, smem + half * HALF_LDS, (b << 8) | ((hp * 2 + half) << 5) | cp, cv, cslot, cr);
    }
    conv_store(cr); conv_rest(p, cv, cslot);
    pool_items(p);
}
DI void ph_mix_odd(const P& p, char* smem) {
    const int half = threadIdx.x >> 8;
    volatile int* wdone = (volatile int*)(smem + 2 * HALF_LDS);
    const ConvPlan cv = conv_plan(p, 1); int cslot = 0; ConvRegs cr; cr.dst = nullptr;
    for (int u = blockIdx.x; u < NB * 4 * 32; u += gridDim.x) {
        const int qb = 31 - (u >> 4), hp = (u >> 2) & 3, b = u & 3;
        sb_attn_unit(p, smem + half * HALF_LDS, wdone, (b << 8) | ((hp * 2 + half) << 5) | qb, cv, cslot, cr);
    }
    conv_store(cr); conv_rest(p, cv, cslot);
    for (int u = blockIdx.x; u < (NTOK / 128) * 2; u += gridDim.x) sgu_unit(p, smem + half * HALF_LDS, u * 2 + half);
}
DI void ph_router(const P& p, char* smem, int layer) {
    const int half = threadIdx.x >> 8;
    for (int u = blockIdx.x; u < NTOK / 64; u += gridDim.x) router_unit(p, smem + half * HALF_LDS, layer, u * 2 + half);
}

constexpr int NPHASE = 15;
#ifndef REPS
#define REPS {1,1,1,1,1,1,1,1,1,1,1,1,1,1,1}
#endif
__device__ constexpr int REP[15] = REPS;
__global__ __launch_bounds__(512, 2) void mega(P p, int ph0, int ph1) {
    __shared__ __attribute__((aligned(16))) char smem[SMEM_BYTES + 64 + 16];
    volatile LDSAS unsigned* xst = (volatile LDSAS unsigned*)(smem + SMEM_BYTES + 64);
    if (threadIdx.x < 4) xst[threadIdx.x] = 0u;
    __syncthreads();
    const XcdBarrier xb = xcd_barrier_post(p.bar, xst);
#define PHASE(i, call) if (ph0 <= (i) && (i) < ph1) { for (int r_ = 0; r_ < REP[i]; ++r_) { call; if (r_ + 1 < REP[i] || (i) + 1 < ph1) xcd_barrier(xb); } }
    PHASE(0, ph_prologue(p, smem))
    PHASE(1, (ph_gemm_dense<EPI_IN_EVEN, 4>(p, smem, p.xn, DM, p.wb_in_even, DM, EVEN_IN, 0, 0, 8)))
    PHASE(2, ph_mix_even(p, smem))
    PHASE(3, (ph_gemm_dense<EPI_OUT, 4>(p, smem, p.mixed, DM, p.wb_out_even, DM, DM, 0, 0, 4)))
    PHASE(4, ph_router(p, smem, 0))
    PHASE(5, (ph_gemm_moe<EPI_GU>(p, smem, 0)))
    PHASE(6, (ph_gemm_moe<EPI_DOWN>(p, smem, 0)))
    PHASE(7, ph_combine(p, 0))
    PHASE(8, (ph_gemm_dense<EPI_IN_ODD, 4>(p, smem, p.xn, DM, p.wb_in_odd, DM, ODD_IN, 1, 0, 8), ph_gemm_dense<EPI_IN_ODD, 2>(p, smem, p.xn, DM, p.wb_in_odd, DM, ODD_IN, 1, 8, 2)))
    PHASE(9, ph_mix_odd(p, smem))
    PHASE(10, (ph_gemm_dense<EPI_OUT, 4>(p, smem, p.mixed, DM, p.wb_out_odd, DM, DM, 1, 0, 4)))
    PHASE(11, ph_router(p, smem, 1))
    PHASE(12, (ph_gemm_moe<EPI_GU>(p, smem, 1)))
    PHASE(13, (ph_gemm_moe<EPI_DOWN>(p, smem, 1)))
    PHASE(14, ph_combine(p, 1))
}

extern "C" void kernel_launch(void* const* d_in, const int* in_sizes, int n_in, void* d_out, int out_size, void* d_ws, size_t ws_size, hipStream_t stream) {
    P p{};
    p.x = (const float*)d_in[0]; p.mix_norm_even = (const float*)d_in[1]; p.w_in_even = (const float*)d_in[2]; p.att_q_norm = (const float*)d_in[3];
    p.att_k_norm = (const float*)d_in[4]; p.att_rel_bias = (const float*)d_in[5]; p.pool_w = (const float*)d_in[6]; p.pool_scale = (const float*)d_in[7];
    p.w_out_even = (const float*)d_in[8]; p.mix_norm_odd = (const float*)d_in[9]; p.w_in_odd = (const float*)d_in[10]; p.sgu_v_norm = (const float*)d_in[11];
    p.sgu_w = (const float*)d_in[12]; p.sgu_b = (const float*)d_in[13]; p.w_out_odd = (const float*)d_in[14]; p.ffn_norm = (const float*)d_in[15];
    p.w_rg = (const float*)d_in[16]; p.w_re = (const float*)d_in[17]; p.w_gate = (const float*)d_in[18]; p.w_up = (const float*)d_in[19]; p.w_down = (const float*)d_in[20];
    p.out = (float*)d_out;
    char* ws = (char*)d_ws; size_t off = 0;
    auto take = [&](size_t bytes) { char* r = ws + off; off += (bytes + 255) & ~(size_t)255; return r; };
    p.wb_in_even = (bf16_t*)take((size_t)EVEN_IN * DM * 2);
    p.wb_out_even = (bf16_t*)take((size_t)DM * DM * 2);
    p.wb_in_odd = (bf16_t*)take((size_t)ODD_IN * DM * 2);
    p.wb_out_odd = (bf16_t*)take((size_t)DM * DM * 2);
    p.wb_gate = (bf16_t*)take((size_t)2 * NEXP * DM * FF * 2);
    p.wb_up = (bf16_t*)take((size_t)2 * NEXP * DM * FF * 2);
    p.wb_down = (bf16_t*)take((size_t)2 * NEXP * DM * FF * 2);
    p.wr_hi = (bf16_t*)take((size_t)2 * 96 * DM * 2);
    p.wr_lo = (bf16_t*)take((size_t)2 * 96 * DM * 2);
    p.xn = (bf16_t*)take((size_t)NTOK * DM * 2);
    p.proj = (bf16_t*)take((size_t)NTOK * ODD_IN * 2);
    p.y = p.proj;
    p.mixed = (bf16_t*)take((size_t)NTOK * DM * 2);
    p.hid = p.mixed;
    p.pw = (float*)take((size_t)NTOK * 2 * 4);
    p.rs = (float*)take((size_t)NTOK * 4);
    p.plist = (int*)take((size_t)NEXP * LISTCAP * 4);
    p.cnt = (int*)take(256);
    p.bar = (unsigned*)take(XCD_BAR_WORDS * 4);
    (void)hipMemsetAsync(p.bar, 0, XCD_BAR_WORDS * 4, stream);
    for (int l = 0; l < 2; ++l) {
        const size_t o = (size_t)l * NEXP * DM * FF;
        p.cs[l * 5 + 0] = p.w_gate + o; p.cd[l * 5 + 0] = p.wb_gate + o;
        p.cs[l * 5 + 1] = p.w_up + o;   p.cd[l * 5 + 1] = p.wb_up + o;
        p.cs[l * 5 + 2] = p.w_down + o; p.cd[l * 5 + 2] = p.wb_down + o;
        p.cs[l * 5 + 3] = p.w_in_odd;   p.cd[l * 5 + 3] = p.wb_in_odd;
        p.cs[l * 5 + 4] = p.w_out_odd;  p.cd[l * 5 + 4] = p.wb_out_odd;
    }

    static int grid_blocks = 0;
    if (!grid_blocks) {
        int dev = 0, cus = 0, per_cu = 0;
        (void)hipGetDevice(&dev);
        (void)hipDeviceGetAttribute(&cus, hipDeviceAttributeMultiprocessorCount, dev);
        (void)hipOccupancyMaxActiveBlocksPerMultiprocessor(&per_cu, mega, 512, 0);
        if (per_cu < 1) per_cu = 1;
        grid_blocks = cus;
    }
    int ph0 = 0, ph1 = NPHASE;
    void* args[] = {&p, &ph0, &ph1};
    hipError_t e = hipLaunchCooperativeKernel((void*)mega, dim3(grid_blocks), dim3(512), args, 0, stream);
    if (e != hipSuccess) fprintf(stderr, "cooperative launch failed: %s (grid %d)\n", hipGetErrorString(e), grid_blocks);
}
```

```cpp
#include <hip/hip_runtime.h>
#include <hip/hip_cooperative_groups.h>
#include <stdint.h>
#include <stdio.h>

typedef unsigned short bf16_t;
typedef short bf16x8 __attribute__((ext_vector_type(8)));
typedef short s16x4 __attribute__((ext_vector_type(4)));
typedef float f32x2 __attribute__((ext_vector_type(2)));
typedef float f32x4 __attribute__((ext_vector_type(4)));
typedef float f32x16 __attribute__((ext_vector_type(16)));
typedef unsigned u32x4 __attribute__((ext_vector_type(4)));
typedef unsigned u32x2 __attribute__((ext_vector_type(2)));
typedef __bf16 bf16x2n __attribute__((ext_vector_type(2)));

#define DI __device__ __forceinline__
#define LDSAS __attribute__((address_space(3)))
#define MFMA32(a, b, c) __builtin_amdgcn_mfma_f32_32x32x16_bf16((a), (b), (c), 0, 0, 0)
#define MFMA16(a, b, c) __builtin_amdgcn_mfma_f32_16x16x32_bf16((a), (b), (c), 0, 0, 0)

constexpr int NB = 4, NS = 4096, NTOK = NB * NS, DM = 1024;
constexpr int EVEN_IN = 2048, ODD_IN = 2560;
constexpr int NEXP = 32, FF = 256;
constexpr int LISTCAP = NTOK;
constexpr float EPS = 1e-6f;
constexpr float LOG2E = 1.4426950408889634f;
constexpr float QSCALE = 0.125f * LOG2E;

DI int opaque_tid() { int t = threadIdx.x; asm volatile("" : "+v"(t)); return t; }
DI float bf2f(bf16_t b) { return __uint_as_float(((unsigned)b) << 16); }
DI unsigned pack2(float lo, float hi) { f32x2 v = {lo, hi}; bf16x2n r = __builtin_convertvector(v, bf16x2n); return __builtin_bit_cast(unsigned, r); }
DI float wave_sum(float v) { for (int o = 32; o > 0; o >>= 1) v += __shfl_xor(v, o); return v; }
DI float gelu_exact(float x) { return 0.5f * x * (1.0f + erff(x * 0.70710678118654752f)); }
DI s16x4 tr_read(const char* p) { return __builtin_bit_cast(s16x4, __builtin_amdgcn_ds_read_tr16_b64_v4i16((LDSAS s16x4*)p)); }
DI void unpack8(const u32x4 v, float* f) {
    f[0] = __uint_as_float(v.x << 16); f[1] = __uint_as_float(v.x & 0xffff0000u); f[2] = __uint_as_float(v.y << 16); f[3] = __uint_as_float(v.y & 0xffff0000u);
    f[4] = __uint_as_float(v.z << 16); f[5] = __uint_as_float(v.z & 0xffff0000u); f[6] = __uint_as_float(v.w << 16); f[7] = __uint_as_float(v.w & 0xffff0000u);
}
DI int kswz(int k) { return (k & 3) | ((k >> 1) & 4); }

struct P {
    const float *x, *mix_norm_even, *w_in_even, *att_q_norm, *att_k_norm, *att_rel_bias, *pool_w, *pool_scale, *w_out_even;
    const float *mix_norm_odd, *w_in_odd, *sgu_v_norm, *sgu_w, *sgu_b, *w_out_odd, *ffn_norm, *w_rg, *w_re, *w_gate, *w_up, *w_down;
    float* out;
    bf16_t *wb_in_even, *wb_out_even, *wb_in_odd, *wb_out_odd, *wb_gate, *wb_up, *wb_down, *wr_hi, *wr_lo;
    bf16_t *hb, *proj, *mixed, *hid, *y;
    float *pw, *rs, *rsm; int* plist; int* cnt; unsigned* bar; int* gdone;
    const float* cs[10]; bf16_t* cd[10];
};

enum { EPI_IN_EVEN = 0, EPI_IN_ODD = 1, EPI_OUT = 2, EPI_GU = 3, EPI_DOWN = 4 };
constexpr int G_ROWID = 131072;
constexpr int SMEM_BYTES = 131072 + 1024;
constexpr int HALF_LDS = 66048;

struct GemmArgs {
    const bf16_t* A; int lda; const int* gather; int mvalid; int gshift;
    const bf16_t* B0; const bf16_t* B1; int ldb; int gu;
    int K, m0, n0;
};

DI f32x2 gelu_pk(f32x2 v) {
    const f32x2 av = __builtin_elementwise_abs(v), d = av * 0.2316418882f + 1.0f;
    f32x2 t; t.x = __builtin_amdgcn_rcpf(d.x); t.y = __builtin_amdgcn_rcpf(d.y);
    f32x2 q = t * 0.5307027145f + (-0.7265760135f); q = q * t + 0.7107068705f; q = q * t + (-0.142248368f); q = q * t + 0.127414796f; q = q * t;
    const f32x2 s = (v * v) * (-0.72134752044f);
    f32x2 e; e.x = __builtin_amdgcn_exp2f(s.x); e.y = __builtin_amdgcn_exp2f(s.y);
    const f32x2 m = v * (q * e), r = v - m;
    f32x2 o; o.x = v.x < 0.f ? m.x : r.x; o.y = v.y < 0.f ? m.y : r.y; return o;
}

DI void glds16(const void* gsrc, unsigned lds_dst) {
    unsigned keep;
    asm volatile("s_mov_b32 %0, m0\n\ts_mov_b32 m0, %2\n\ts_nop 0\n\tglobal_load_lds_dwordx4 %1, off\n\ts_mov_b32 m0, %0" : "=&s"(keep) : "v"(gsrc), "s"(lds_dst) : "memory");
}
DI void glds16_sc1(const void* gsrc, unsigned lds_dst) {
    unsigned keep;
    asm volatile("s_mov_b32 %0, m0\n\ts_mov_b32 m0, %2\n\ts_nop 0\n\tglobal_load_lds_dwordx4 %1, off sc1\n\ts_mov_b32 m0, %0" : "=&s"(keep) : "v"(gsrc), "s"(lds_dst) : "memory");
}
DI void st16_sc1(void* q, u32x4 v) { asm volatile("global_store_dwordx4 %0, %1, off sc1\n\ts_nop 1" :: "v"(q), "v"(v) : "memory"); }
template <int EPI, int MT>
DI void gemm_tile(const P& p, char* smem, const GemmArgs& g, int layer) {
    const int tid = opaque_tid(), lane = tid & 63, wid = tid >> 6, wm = wid >> 2, wn = wid & 3, r32 = lane & 31, hh = lane >> 5;
    int* rowid = (int*)(smem + G_ROWID);
    constexpr int NA = MT / 2;
    constexpr int IPT = NA + 2;
    const bf16_t* ap[NA]; const bf16_t* bp[2];
    if (g.gather) { if (tid < 64 * MT) rowid[tid] = (tid < g.mvalid) ? g.gather[tid] : -1; __syncthreads(); }
#pragma unroll
    for (int i = 0; i < NA; ++i) {
        const int r = (wid * NA + i) * 16 + (lane >> 2), kc = (lane & 3) ^ ((r >> 2) & 3);
        size_t arow;
        if (g.gather) { int id = rowid[r]; if (id < 0) id = rowid[0]; arow = (size_t)(id >> g.gshift); } else arow = (size_t)(g.m0 + r);
        ap[i] = g.A + arow * g.lda + kc * 8;
    }
#pragma unroll
    for (int i = 0; i < 2; ++i) {
        const int k = (wid * 2 + i) * 2 + (lane >> 5), sl = lane & 31, ch = (((sl >> 2) ^ (k & 7)) << 2) | (sl & 3);
        const bf16_t* bcol = g.gu ? ((((ch >> 2) & 1) ? g.B1 : g.B0) + (g.n0 >> 1) + (ch >> 3) * 32 + (ch & 3) * 8) : (g.B0 + g.n0 + ch * 8);
        bp[i] = bcol + (size_t)k * g.ldb;
    }
    const size_t bstep = (size_t)32 * g.ldb;
    f32x16 acc[MT][2];
#pragma unroll
    for (int a = 0; a < MT; ++a)
#pragma unroll
        for (int b = 0; b < 2; ++b)
#pragma unroll
            for (int i = 0; i < 16; ++i) acc[a][b][i] = 0.f;
    const int nk = g.K / 32;
    const int arow0 = wm * 32 * MT + r32;
    const int asw = (r32 >> 2) & 3;
    const int g1 = (lane >> 4) & 1, qq = (lane & 15) >> 2, pp = lane & 3;
    const int bk0 = 8 * hh + qq;
    const unsigned ldsb = (unsigned)(size_t)(LDSAS char*)smem;
    const unsigned adst = ldsb + (wid * NA) * 1024, bdst = ldsb + 16384 + (wid * 2) * 1024;
#define G_LOAD(KT) do { const unsigned so_ = (unsigned)((KT) & 3) * 32768u; \
        _Pragma("unroll") for (int i = 0; i < NA; ++i) { if (EPI == EPI_DOWN) glds16_sc1(ap[i] + (KT) * 32, (unsigned)__builtin_amdgcn_readfirstlane(adst + so_ + i * 1024)); \
                                                        else glds16(ap[i] + (KT) * 32, (unsigned)__builtin_amdgcn_readfirstlane(adst + so_ + i * 1024)); } \
        _Pragma("unroll") for (int i = 0; i < 2; ++i) glds16(bp[i] + (size_t)(KT) * bstep, (unsigned)__builtin_amdgcn_readfirstlane(bdst + so_ + i * 1024)); } while (0)
#define G_COMPUTE(KT) do { const char* Ac = smem + ((KT) & 3) * 32768; const char* Bc = Ac + 16384; \
        _Pragma("unroll") for (int st = 0; st < 2; ++st) { bf16x8 af[MT], bfv[2]; \
            _Pragma("unroll") for (int mt = 0; mt < MT; ++mt) af[mt] = *(const bf16x8*)(Ac + (arow0 + mt * 32) * 64 + (((2 * st + hh) ^ asw) << 4)); \
            _Pragma("unroll") for (int nt = 0; nt < 2; ++nt) { const int k = 16 * st + bk0; \
                const char* b0_ = Bc + k * 512 + (((wn * 2 + nt) ^ (k & 7)) << 6) + g1 * 32 + pp * 8; \
                const char* b1_ = Bc + (k + 4) * 512 + (((wn * 2 + nt) ^ ((k + 4) & 7)) << 6) + g1 * 32 + pp * 8; \
                const s16x4 lo = tr_read(b0_), hi = tr_read(b1_); \
                bfv[nt] = (bf16x8){lo[0], lo[1], lo[2], lo[3], hi[0], hi[1], hi[2], hi[3]}; } \
            _Pragma("unroll") for (int mt = 0; mt < MT; ++mt) _Pragma("unroll") for (int nt = 0; nt < 2; ++nt) acc[mt][nt] = MFMA32(bfv[nt], af[mt], acc[mt][nt]); } } while (0)
#define G_WAIT(N) do { if ((N) == 2) { if (IPT == 4) asm volatile("s_waitcnt vmcnt(8)" ::: "memory"); else asm volatile("s_waitcnt vmcnt(6)" ::: "memory"); } \
                       else if ((N) == 1) { if (IPT == 4) asm volatile("s_waitcnt vmcnt(4)" ::: "memory"); else asm volatile("s_waitcnt vmcnt(3)" ::: "memory"); } \
                       else asm volatile("s_waitcnt vmcnt(0)" ::: "memory"); } while (0)
    G_LOAD(0); G_LOAD(1); G_LOAD(2);
    G_WAIT(2); __syncthreads();
#pragma nounroll
    for (int kt = 0; kt < nk; ++kt) {
        if (kt + 3 < nk) G_LOAD(kt + 3);
        G_COMPUTE(kt);
        if (kt + 3 < nk) G_WAIT(2); else if (kt + 2 < nk) G_WAIT(1); else G_WAIT(0);
        __syncthreads();
    }
#undef G_LOAD
#undef G_COMPUTE
#undef G_WAIT
    const int colw = g.n0 + wn * 64;
    char* wsl = smem + wid * 16384;
    const int rowb = wm * 32 * MT;
    if (EPI == EPI_IN_EVEN || EPI == EPI_IN_ODD || EPI == EPI_DOWN) {
        const int region = colw >> 9;
        const float* gn = region == 0 ? p.att_q_norm : p.att_k_norm;
        const bool act = colw < 1024;
        const float qs = (colw >= 1024 && colw < 1536) ? QSCALE : 1.0f;
#pragma unroll
        for (int mt = 0; mt < MT; ++mt) {
            float sc = 1.f;
            if (EPI == EPI_IN_EVEN || EPI == EPI_IN_ODD) {
                const float rr_ = p.rsm[g.m0 + rowb + mt * 32 + r32];
#pragma unroll
                for (int nt = 0; nt < 2; ++nt) acc[mt][nt] = acc[mt][nt] * rr_;
            }
            if (EPI == EPI_IN_EVEN && region < 2) {
                float ss = 0.f;
#pragma unroll
                for (int nt = 0; nt < 2; ++nt)
#pragma unroll
                    for (int i = 0; i < 16; ++i) ss += acc[mt][nt][i] * acc[mt][nt][i];
                auto rr = __builtin_amdgcn_permlane32_swap(__float_as_uint(ss), __float_as_uint(ss), false, false);
                ss = __uint_as_float(rr[0]) + __uint_as_float(rr[1]);
                sc = rsqrtf(ss * (1.0f / 64.0f) + EPS) * (region == 0 ? QSCALE : 1.0f);
            }
#pragma unroll
            for (int nt = 0; nt < 2; ++nt)
#pragma unroll
                for (int gq = 0; gq < 4; ++gq) {
                    f32x2 v0 = {acc[mt][nt][4 * gq], acc[mt][nt][4 * gq + 1]}, v1 = {acc[mt][nt][4 * gq + 2], acc[mt][nt][4 * gq + 3]};
                    if (EPI == EPI_IN_EVEN) { if (region < 2) { const f32x4 gg = *(const f32x4*)(gn + nt * 32 + 8 * gq + 4 * hh); v0.x *= sc * gg[0]; v0.y *= sc * gg[1]; v1.x *= sc * gg[2]; v1.y *= sc * gg[3]; } }
                    else if (EPI == EPI_IN_ODD) { if (act) { v0 = gelu_pk(v0); v1 = gelu_pk(v1); } else { v0 = v0 * qs; v1 = v1 * qs; } }
                    u32x2 w; w.x = pack2(v0.x, v0.y); w.y = pack2(v1.x, v1.y);
                    *(u32x2*)(wsl + r32 * 128 + (((nt * 4 + gq) ^ (r32 & 7)) << 4) + hh * 8) = w;
                }
#pragma unroll
            for (int ps = 0; ps < 4; ++ps) {
                const int row = ps * 8 + (lane >> 3), chunk = lane & 7;
                const u32x4 v = *(const u32x4*)(wsl + row * 128 + ((chunk ^ (row & 7)) << 4));
                const int trow = rowb + mt * 32 + row;
                if (EPI == EPI_DOWN) { const int id = rowid[trow]; if (id >= 0) *(u32x4*)(p.y + (size_t)id * DM + colw + chunk * 8) = v; }
                else if (EPI == EPI_IN_EVEN) *(u32x4*)(p.proj + (size_t)(g.m0 + trow) * EVEN_IN + colw + chunk * 8) = v;
                else *(u32x4*)(p.proj + (size_t)(g.m0 + trow) * ODD_IN + colw + chunk * 8) = v;
            }
        }
    } else if (EPI == EPI_OUT) {
#pragma unroll
        for (int mt = 0; mt < MT; ++mt) {
#pragma unroll
            for (int nt = 0; nt < 2; ++nt)
#pragma unroll
                for (int gq = 0; gq < 4; ++gq) {
                    const f32x4 v = {acc[mt][nt][4 * gq], acc[mt][nt][4 * gq + 1], acc[mt][nt][4 * gq + 2], acc[mt][nt][4 * gq + 3]};
                    *(f32x4*)(wsl + r32 * 256 + (((nt * 8 + 2 * gq + hh) ^ (r32 & 15)) << 4)) = v;
                }
#pragma unroll
            for (int ps = 0; ps < 8; ++ps) {
                const int row = ps * 4 + (lane >> 4), chunk = lane & 15;
                const f32x4 v = *(const f32x4*)(wsl + row * 256 + ((chunk ^ (row & 15)) << 4));
                const size_t off = (size_t)(g.m0 + rowb + mt * 32 + row) * DM + colw + chunk * 4;
                f32x4 r;
                if (layer == 0) r = *(const f32x4*)(p.x + off);
                else { const u32x2 hb = *(const u32x2*)(p.hb + off); r = (f32x4){__uint_as_float(hb.x << 16), __uint_as_float(hb.x & 0xffff0000u), __uint_as_float(hb.y << 16), __uint_as_float(hb.y & 0xffff0000u)}; }
                r = r + v;
                u32x2 w; w.x = pack2(r[0], r[1]); w.y = pack2(r[2], r[3]);
                *(u32x2*)(p.hb + off) = w;
            }
        }
    } else if (EPI == EPI_GU) {
        const int f0 = (g.n0 >> 1) + wn * 32;
#pragma unroll
        for (int mt = 0; mt < MT; ++mt) {
            const int id = rowid[rowb + mt * 32 + r32];
            const float w = id >= 0 ? p.pw[id] : 0.f, rs = id >= 0 ? p.rs[id >> 1] : 0.f;
#pragma unroll
            for (int gq = 0; gq < 4; ++gq) {
                float h[4];
#pragma unroll
                for (int j = 0; j < 4; ++j) { const float gt = acc[mt][0][4 * gq + j] * rs, up = acc[mt][1][4 * gq + j] * (rs * w); h[j] = gt / (1.0f + __expf(-gt)) * up; }
                u32x2 ww; ww.x = pack2(h[0], h[1]); ww.y = pack2(h[2], h[3]);
                *(u32x2*)(wsl + r32 * 64 + ((gq ^ (r32 & 3)) << 4) + hh * 8) = ww;
            }
#pragma unroll
            for (int ps = 0; ps < 2; ++ps) {
                const int row = ps * 16 + (lane >> 2), chunk = lane & 3;
                const u32x4 v = *(const u32x4*)(wsl + row * 64 + ((chunk ^ (row & 3)) << 4));
                const int id2 = rowid[rowb + mt * 32 + row];
                if (id2 >= 0) st16_sc1(p.hid + (size_t)id2 * FF + f0 + chunk * 8, v);
            }
        }
        asm volatile("s_waitcnt vmcnt(0)" ::: "memory");
    }
    __syncthreads();
}

template <int EPI, int MT>
DI void ph_gemm_dense(const P& p, char* smem, const bf16_t* A, int lda, const bf16_t* B, int K, int N, int layer, int nt0, int ntc) {
    const int ntm = NTOK / (64 * MT), per_xcd = (ntm / 8) * ntc;
    const bool xcd = (gridDim.x & 7) == 0;
    const int x = blockIdx.x & 7, gx = gridDim.x >> 3;
    const int jend = xcd ? per_xcd : ntm * ntc, jstep = xcd ? gx : (int)gridDim.x;
    for (int j = xcd ? (int)(blockIdx.x >> 3) : (int)blockIdx.x; j < jend; j += jstep) {
        GemmArgs g; g.A = A; g.lda = lda; g.gather = nullptr; g.mvalid = 64 * MT; g.gshift = 0; g.B0 = B; g.B1 = B; g.ldb = N; g.gu = 0; g.K = K;
        g.m0 = ((xcd ? x * (ntm / 8) : 0) + j / ntc) * (64 * MT); g.n0 = (nt0 + j % ntc) * 256;
        gemm_tile<EPI, MT>(p, smem, g, layer);
    }
}

DI void moe_locate(const int* cnt, int mt, int& e, int& c, int& mtl) {
    e = 0; c = 0;
    for (; e < NEXP; ++e) { c = cnt[e]; const int t = (c + 127) >> 7; if (mt < t) break; mt -= t; }
    mtl = mt;
}
DI void ph_moe(const P& p, char* smem, int layer) {
    const int* cnt = p.cnt + layer * NEXP;
    int* gdone = p.gdone + layer * 320;
    int* queue = p.gdone + 600 + layer;
    volatile int* s_next = (volatile int*)(smem + SMEM_BYTES + 80);
    int total = 0;
    for (int e = 0; e < NEXP; ++e) total += (cnt[e] + 127) >> 7;
    const int ngu = total * 2, nall = total * 6;
    int mine = 0;
    if (threadIdx.x == 0) mine = __hip_atomic_fetch_add(queue, 1, __ATOMIC_RELAXED, __HIP_MEMORY_SCOPE_AGENT);
    for (;;) {
        if (threadIdx.x == 0) s_next[0] = mine;
        __syncthreads();
        const int u = s_next[0];
        if (u >= nall) break;
        if (threadIdx.x == 0) mine = __hip_atomic_fetch_add(queue, 1, __ATOMIC_RELAXED, __HIP_MEMORY_SCOPE_AGENT);
        if (u < ngu) {
            int e, c, mt; moe_locate(cnt, u >> 1, e, c, mt);
            GemmArgs g; g.gather = p.plist + (size_t)e * LISTCAP + mt * 128; g.mvalid = c - mt * 128 < 128 ? c - mt * 128 : 128;
            g.m0 = 0; g.n0 = (u & 1) * 256;
            const size_t ex = (size_t)(layer * NEXP + e);
            g.A = p.hb; g.lda = DM; g.gshift = 1; g.B0 = p.wb_gate + ex * DM * FF; g.B1 = p.wb_up + ex * DM * FF; g.ldb = FF; g.gu = 1; g.K = DM;
            gemm_tile<EPI_GU, 2>(p, smem, g, layer);
            if (threadIdx.x == 0) __hip_atomic_fetch_add(gdone + (u >> 1), 1, __ATOMIC_RELAXED, __HIP_MEMORY_SCOPE_AGENT);
        } else {
            const int v = u - ngu;
            if (threadIdx.x == 0) { unsigned sp = 0;
                while (__hip_atomic_load(gdone + (v >> 2), __ATOMIC_RELAXED, __HIP_MEMORY_SCOPE_AGENT) < 2) { __builtin_amdgcn_s_sleep(2); if (++sp > (1u << 22)) break; } }
            __syncthreads();
            int e, c, mt; moe_locate(cnt, v >> 2, e, c, mt);
            GemmArgs g; g.gather = p.plist + (size_t)e * LISTCAP + mt * 128; g.mvalid = c - mt * 128 < 128 ? c - mt * 128 : 128;
            g.m0 = 0; g.n0 = (v & 3) * 256;
            const size_t ex = (size_t)(layer * NEXP + e);
            g.A = p.hid; g.lda = FF; g.gshift = 0; g.B0 = p.wb_down + ex * FF * DM; g.B1 = g.B0; g.ldb = DM; g.gu = 0; g.K = FF;
            gemm_tile<EPI_DOWN, 2>(p, smem, g, layer);
        }
    }
}

DI void convert_flat(const float* __restrict__ src, bf16_t* __restrict__ dst, size_t n8, const float* __restrict__ gain = nullptr, int rowlen = 1) {
    for (size_t i = (size_t)blockIdx.x * 512 + threadIdx.x; i < n8; i += (size_t)gridDim.x * 512) {
        f32x4 a = *(const f32x4*)(src + i * 8), b = *(const f32x4*)(src + i * 8 + 4);
        if (gain) { const float gk = gain[(i * 8) / (size_t)rowlen]; a = a * gk; b = b * gk; }
        u32x4 w; w.x = pack2(a[0], a[1]); w.y = pack2(a[2], a[3]); w.z = pack2(b[0], b[1]); w.w = pack2(b[2], b[3]);
        *(u32x4*)(dst + i * 8) = w;
    }
}
DI void poolfold_unit(const P& p, char* smem, int unit) {
    float (*At)[32] = (float (*)[32])smem;
    float (*Bs)[64] = (float (*)[64])(smem + 16384);
    const int tid = opaque_tid() & 255, g = unit >> 6, c0 = ((unit >> 4) & 3) * 32, n0 = (unit & 15) * 64;
    __syncthreads();
    for (int i = 0; i < 16; ++i) { const int idx = tid + 256 * i, d = idx >> 5, c = idx & 31;
        At[d][c] = p.pool_w[(size_t)(g * 128 + c0 + c) * 128 + d] * p.pool_scale[g * 128 + d]; }
    for (int i = 0; i < 8; ++i) { const int idx = tid + 256 * i, d = idx >> 4, n4 = (idx & 15) * 4;
        *(f32x4*)&Bs[d][n4] = *(const f32x4*)(p.w_out_even + (size_t)(512 + g * 128 + d) * DM + n0 + n4); }
    __syncthreads();
    const int tc = (tid >> 4) * 2, tn = (tid & 15) * 4;
    f32x4 acc[2] = {(f32x4){0.f, 0.f, 0.f, 0.f}, (f32x4){0.f, 0.f, 0.f, 0.f}};
#pragma unroll 8
    for (int d = 0; d < 128; ++d) {
        const f32x2 a = *(const f32x2*)&At[d][tc]; const f32x4 b = *(const f32x4*)&Bs[d][tn];
        acc[0] += a.x * b; acc[1] += a.y * b;
    }
#pragma unroll
    for (int i = 0; i < 2; ++i) { u32x2 w; w.x = pack2(acc[i][0], acc[i][1]); w.y = pack2(acc[i][2], acc[i][3]);
        *(u32x2*)(p.wb_out_even + (size_t)(512 + g * 128 + c0 + tc + i) * DM + n0 + tn) = w; }
}
DI void cast_rows2(const P& p, int tok, int lane) {
    f32x4 v[2][4];
#pragma unroll
    for (int r = 0; r < 2; ++r)
#pragma unroll
        for (int i = 0; i < 4; ++i) v[r][i] = *(const f32x4*)(p.x + (size_t)(tok + r) * DM + i * 256 + lane * 4);
#pragma unroll
    for (int r = 0; r < 2; ++r) {
        float ss = 0.f;
#pragma unroll
        for (int i = 0; i < 4; ++i) { ss += v[r][i][0] * v[r][i][0] + v[r][i][1] * v[r][i][1] + v[r][i][2] * v[r][i][2] + v[r][i][3] * v[r][i][3];
            u32x2 w; w.x = pack2(v[r][i][0], v[r][i][1]); w.y = pack2(v[r][i][2], v[r][i][3]);
            *(u32x2*)(p.hb + (size_t)(tok + r) * DM + i * 256 + lane * 4) = w; }
        ss = wave_sum(ss);
        if (lane == 0) p.rsm[tok + r] = rsqrtf(ss * (1.0f / DM) + EPS);
    }
}
DI void ph_prologue(const P& p, char* smem) {
    if (blockIdx.x == 0 && threadIdx.x < 64) p.cnt[threadIdx.x] = 0;
    if (blockIdx.x == 1) for (int i = threadIdx.x; i < 640; i += 512) p.gdone[i] = 0;
    for (int u = blockIdx.x; u < 128; u += gridDim.x) poolfold_unit(p, smem + (threadIdx.x >> 8) * HALF_LDS, u * 2 + (threadIdx.x >> 8));
    for (int i = blockIdx.x * 512 + threadIdx.x; i < 2 * 96 * DM; i += gridDim.x * 512) {
        const int k = i & (DM - 1), R = (i >> 10) % 96, layer = i / (96 * DM);
        const int T = R >> 5, r = R & 31, L = 16 * T + (r & 3) + 4 * (r >> 3);
        float w = 0.f;
        if (L < 32) w = p.w_re[((size_t)layer * DM + k) * 32 + L]; else if (L < 36) w = p.w_rg[((size_t)layer * DM + k) * 4 + (L - 32)];
        w *= p.ffn_norm[layer * DM + k];
        const unsigned hi = pack2(w, 0.f) & 0xffffu;
        p.wr_hi[i] = (bf16_t)hi; p.wr_lo[i] = (bf16_t)(pack2(w - __uint_as_float(hi << 16), 0.f) & 0xffffu);
    }
    const int wave = threadIdx.x >> 6, lane = threadIdx.x & 63;
    for (int u = blockIdx.x; u < NTOK / 16; u += gridDim.x) {
        const int tok = u * 16 + wave * 2;
        cast_rows2(p, tok, lane);
    }
    convert_flat(p.w_in_even, p.wb_in_even, (size_t)DM * EVEN_IN / 8, p.mix_norm_even, EVEN_IN);
    convert_flat(p.w_out_even, p.wb_out_even, (size_t)512 * DM / 8);
}
DI void convert_experts(const P& p, int layer) {
    const size_t o = (size_t)layer * NEXP * DM * FF;
    convert_flat(p.w_gate + o, p.wb_gate + o, (size_t)NEXP * DM * FF / 8);
    convert_flat(p.w_up + o, p.wb_up + o, (size_t)NEXP * DM * FF / 8);
    convert_flat(p.w_down + o, p.wb_down + o, (size_t)NEXP * DM * FF / 8);
}

DI int crow(int i, int h) { return (i & 3) + 8 * (i >> 2) + 4 * h; }
DI float swap_max(float v) { auto rr = __builtin_amdgcn_permlane32_swap(__float_as_uint(v), __float_as_uint(v), false, false); return fmaxf(__uint_as_float(rr[0]), __uint_as_float(rr[1])); }
DI float swap_sum(float v) { auto rr = __builtin_amdgcn_permlane32_swap(__float_as_uint(v), __float_as_uint(v), false, false); return __uint_as_float(rr[0]) + __uint_as_float(rr[1]); }
DI float bcast_lo(float v) { auto rr = __builtin_amdgcn_permlane32_swap(__float_as_uint(v), __float_as_uint(v), false, false); return __uint_as_float(rr[0]); }
DI bf16x8 pack8(const f32x16& x, int s) {
    u32x4 w; w.x = pack2(x[8 * s], x[8 * s + 1]); w.y = pack2(x[8 * s + 2], x[8 * s + 3]); w.z = pack2(x[8 * s + 4], x[8 * s + 5]); w.w = pack2(x[8 * s + 6], x[8 * s + 7]);
    return __builtin_bit_cast(bf16x8, w);
}
constexpr int KV_TILE = 8192;
struct KVStage { u32x4 k[2], v[2]; };
DI void kv_load(KVStage& st, const bf16_t* kbase, const bf16_t* vbase, int ld, int key0) {
    const int tid = opaque_tid() & 255, c = tid & 7, r0 = tid >> 3;
#pragma unroll
    for (int i = 0; i < 2; ++i) { const size_t off = (size_t)(key0 + r0 + 32 * i) * ld + c * 8; st.k[i] = *(const u32x4*)(kbase + off); st.v[i] = *(const u32x4*)(vbase + off); }
}
DI void kv_store(const KVStage& st, char* kt, char* vt) {
    const int tid = opaque_tid() & 255, c = tid & 7, r0 = tid >> 3;
#pragma unroll
    for (int i = 0; i < 2; ++i) { const int r = r0 + 32 * i;
        *(u32x4*)(kt + r * 128 + ((c ^ ((r >> 1) & 7)) << 4)) = st.k[i];
        *(u32x4*)(vt + r * 128 + ((((c >> 2) ^ ((r >> 1) & 1))) << 6) + ((c & 3) << 4)) = st.v[i]; }
}
DI bf16x8 k_frag(const char* kt, int sb, int st, int r32, int hh) {
    const int row = sb * 32 + r32;
    return *(const bf16x8*)(kt + row * 128 + (((2 * st + hh) ^ ((row >> 1) & 7)) << 4));
}
DI bf16x8 vt_frag(const char* vt, int sb, int st, int dh, int lane) {
    const int hh = lane >> 5, g1 = (lane >> 4) & 1, pp = lane & 3, q = (lane & 15) >> 2;
    const int key = sb * 32 + 16 * st + 4 * hh + q;
    const char* a = vt + key * 128 + ((dh ^ ((q >> 1) & 1)) << 6) + g1 * 32 + pp * 8;
    const s16x4 lo = tr_read(a), hi = tr_read(a + 8 * 128);
    return (bf16x8){lo[0], lo[1], lo[2], lo[3], hi[0], hi[1], hi[2], hi[3]};
}


#define XB_TMO      128
#define XB_XCNT(j)  (256  + 64 * (j))
#define XB_XSUB(j)  (1280 + 64 * (j))
#define XB_XGEN(j)  (2304 + 64 * (j))
#define XB_TOP      3328
#define XB_TOPGEN   3392
#define XCD_BAR_WORDS 3456
#define XB_SPIN_CAP (1u << 22)
DI unsigned xb_ld(unsigned* q)              { return __hip_atomic_load(q, __ATOMIC_RELAXED, __HIP_MEMORY_SCOPE_AGENT); }
DI unsigned xb_add(unsigned* q, unsigned v) { return __hip_atomic_fetch_add(q, v, __ATOMIC_RELAXED, __HIP_MEMORY_SCOPE_AGENT); }
DI unsigned xb_xcc_id() { return (unsigned)__builtin_amdgcn_s_getreg((3 << 11) | 20) & 0xFu; }
#define XB_SPIN(cond, bar) do { unsigned _sp = 0; while (cond) { __builtin_amdgcn_s_sleep(1); \
    if ((++_sp & 255u) == 0u) { if (xb_ld(&(bar)[XB_TMO])) break; if (_sp > XB_SPIN_CAP) { atomicAdd(&(bar)[XB_TMO], 1u); break; } } } } while (0)
struct XcdBarrier { unsigned* bar; unsigned x; volatile LDSAS unsigned* st; };
DI XcdBarrier xcd_barrier_post(unsigned* bar, volatile LDSAS unsigned* st) {
    XcdBarrier b; b.bar = bar; b.x = xb_xcc_id(); b.st = st;
    if (threadIdx.x == 0) (void)xb_add(&bar[XB_XCNT(b.x)], 1u);
    return b;
}
DI void xcd_barrier_complete(unsigned* bar, unsigned x, unsigned& nloc, unsigned& nx) {
    const unsigned G = gridDim.x * gridDim.y * gridDim.z;
    unsigned sum, cnt, mine, sp = 0u;
    for (;;) {
        sum = 0u; cnt = 0u; mine = 0u;
#pragma unroll
        for (unsigned j = 0; j < 16; ++j) { const unsigned c = xb_ld(&bar[XB_XCNT(j)]); sum += c; cnt += (c > 0u) ? 1u : 0u; mine = (j == x) ? c : mine; }
        if (sum == G) break;
        __builtin_amdgcn_s_sleep(1);
        if ((++sp & 255u) == 0u) { if (xb_ld(&bar[XB_TMO])) break; if (sp > XB_SPIN_CAP) { atomicAdd(&bar[XB_TMO], 1u); break; } }
    }
    nloc = mine > 0u ? mine : 1u; nx = cnt > 0u ? cnt : 1u;
}
DI void xcd_barrier(const XcdBarrier& b) {
    asm volatile("s_waitcnt vmcnt(0)" ::: "memory");
    __syncthreads();
    if (threadIdx.x == 0) {
        unsigned* bar = b.bar;
        __builtin_amdgcn_s_waitcnt(0);
        unsigned nloc = b.st[0], nx = b.st[1];
        if (nloc == 0u) { xcd_barrier_complete(bar, b.x, nloc, nx); b.st[0] = nloc; b.st[1] = nx; }
        const unsigned old = xb_add(&bar[XB_XSUB(b.x)], 1u);
        const unsigned gen = old / nloc;
        if (old + 1u == (gen + 1u) * nloc) {
            __builtin_amdgcn_fence(__ATOMIC_RELEASE, "agent");
            asm volatile("s_waitcnt vmcnt(0)" ::: "memory");
            const unsigned og = xb_add(&bar[XB_TOP], 1u);
            const unsigned tg = og / nx;
            if (og + 1u == (tg + 1u) * nx) xb_add(&bar[XB_TOPGEN], 1u);
            else XB_SPIN(xb_ld(&bar[XB_TOPGEN]) == tg, bar);
            __builtin_amdgcn_fence(__ATOMIC_ACQUIRE, "agent");
            xb_add(&bar[XB_XGEN(b.x)], 1u);
            asm volatile("s_waitcnt vmcnt(0)" ::: "memory");
        } else {
            XB_SPIN(xb_ld(&bar[XB_XGEN(b.x)]) == gen, bar);
            __builtin_amdgcn_fence(__ATOMIC_ACQUIRE, "agent");
            asm volatile("s_waitcnt vmcnt(0)" ::: "memory");
        }
    }
    __syncthreads();
}


struct ConvRegs { f32x4 v[4]; bf16_t* dst; };
struct ConvPlan { int layer; int sl_e, sl_in, sl_out, nslots; };
DI ConvPlan conv_plan(const P& p, int layer) {
    ConvPlan c; c.layer = layer;
    const unsigned per = gridDim.x * 512u;
    c.sl_e = (int)((NEXP * DM * FF / 16 + per - 1) / per);
    c.sl_in = layer == 0 ? (int)((DM * ODD_IN / 16 + per - 1) / per) : 0;
    c.sl_out = layer == 0 ? (int)((DM * DM / 16 + per - 1) / per) : 0;
    c.nslots = 3 * c.sl_e + c.sl_in + c.sl_out;
    return c;
}
DI void conv_load(const P& p, const ConvPlan& c, int slot, ConvRegs& r) {
    r.dst = nullptr;
    if (slot >= c.nslots) return;
    int seg, ls = slot;
    if (ls < 3 * c.sl_e) { seg = ls / c.sl_e; ls -= seg * c.sl_e; }
    else if ((ls -= 3 * c.sl_e) < c.sl_in) seg = 3;
    else { ls -= c.sl_in; seg = 4; }
    const unsigned ng = seg < 3 ? NEXP * DM * FF / 16 : (seg == 3 ? DM * ODD_IN / 16 : DM * DM / 16);
    const float* s = p.cs[c.layer * 5 + seg]; bf16_t* d = p.cd[c.layer * 5 + seg];
    const unsigned gi = ((unsigned)ls * gridDim.x + blockIdx.x) * 512u + threadIdx.x;
    if (gi < ng) {
        const size_t e = (size_t)gi * 16;
        r.dst = d + e;
        float gk = 1.0f;
        if (seg < 2) gk = p.ffn_norm[c.layer * DM + ((e >> 8) & (DM - 1))];
        else if (seg == 3) gk = p.mix_norm_odd[e / ODD_IN];
#pragma unroll
        for (int i = 0; i < 4; ++i) r.v[i] = *(const f32x4*)(s + e + 4 * i) * gk;
    }
}
DI void conv_store(ConvRegs& r) {
    if (r.dst) {
        u32x4 a, b;
        a.x = pack2(r.v[0][0], r.v[0][1]); a.y = pack2(r.v[0][2], r.v[0][3]); a.z = pack2(r.v[1][0], r.v[1][1]); a.w = pack2(r.v[1][2], r.v[1][3]);
        b.x = pack2(r.v[2][0], r.v[2][1]); b.y = pack2(r.v[2][2], r.v[2][3]); b.z = pack2(r.v[3][0], r.v[3][1]); b.w = pack2(r.v[3][2], r.v[3][3]);
        *(u32x4*)r.dst = a; *(u32x4*)(r.dst + 8) = b;
    }
}
DI void conv_rest(const P& p, const ConvPlan& c, int slot) {
    for (; slot < c.nslots; ++slot) { ConvRegs r; conv_load(p, c, slot, r); conv_store(r); }
}

DI void band_attn_unit(const P& p, char* smem, int unit, const ConvPlan& cv, int& cslot, ConvRegs& cr) {
    const int tid = opaque_tid() & 255, lane = tid & 63, wid = tid >> 6, r32 = lane & 31, hh = lane >> 5;
    const int cp = unit & 31, h = (unit >> 5) & 7, b = unit >> 8;
    const int c = 2 * cp + (wid >> 1);
    const int tq = c * 64 + (wid & 1) * 32 + r32;
    const size_t rowb = (size_t)b * NS;
    const bf16_t* kbase = p.proj + rowb * EVEN_IN + 512 + h * 64;
    const bf16_t* vbase = p.proj + rowb * EVEN_IN + 1024 + h * 64;
    float* sbias = (float*)(smem + 4 * KV_TILE);
    __syncthreads();
    for (int i = tid; i < 257; i += 256) sbias[i] = p.att_rel_bias[h * 257 + i] * LOG2E;
    bf16x8 qf[4];
#pragma unroll
    for (int st = 0; st < 4; ++st) qf[st] = *(const bf16x8*)(p.proj + (rowb + tq) * EVEN_IN + h * 64 + st * 16 + hh * 8);
    const int ck0 = (2 * cp - 8) > 0 ? (2 * cp - 8) : 0, nt = 2 * cp + 2 - ck0;
    float m = -3.0e38f, lsum = 0.f;
    f32x16 o0, o1;
#pragma unroll
    for (int i = 0; i < 16; ++i) { o0[i] = 0.f; o1[i] = 0.f; }
    KVStage stg;
    kv_load(stg, kbase, vbase, EVEN_IN, ck0 * 64);
    kv_store(stg, smem, smem + 2 * KV_TILE);
    __syncthreads();
    for (int it = 0; it < nt; ++it) {
        const int ck = ck0 + it, cur = it & 1;
        if (it + 1 < nt) kv_load(stg, kbase, vbase, EVEN_IN, (ck + 1) * 64);
        conv_store(cr); conv_load(p, cv, cslot++, cr);
        __builtin_amdgcn_sched_barrier(0);
        const char* kt = smem + cur * KV_TILE; const char* vt = smem + (2 + cur) * KV_TILE;
        if (ck >= c - 8 && ck <= c) {
            f32x16 s0, s1;
#pragma unroll
            for (int i = 0; i < 16; ++i) { s0[i] = 0.f; s1[i] = 0.f; }
#pragma unroll
            for (int st = 0; st < 4; ++st) { s0 = MFMA32(k_frag(kt, 0, st, r32, hh), qf[st], s0); s1 = MFMA32(k_frag(kt, 1, st, r32, hh), qf[st], s1); }
            if (c - ck >= 3) { const float bb = sbias[256];
#pragma unroll
                for (int i = 0; i < 16; ++i) { s0[i] += bb; s1[i] += bb; }
            } else {
                const int d0 = tq - ck * 64 - 4 * hh;
#pragma unroll
                for (int i = 0; i < 16; ++i) {
                    int da = d0 - ((i & 3) + 8 * (i >> 2)), db = da - 32;
                    da = da > 128 ? 128 : da; db = db > 128 ? 128 : db;
                    s0[i] += sbias[da + 128]; s1[i] += sbias[db + 128];
                }
            }
            float tm = fmaxf(s0[0], s1[0]);
#pragma unroll
            for (int i = 1; i < 16; ++i) tm = fmaxf(tm, fmaxf(s0[i], s1[i]));
            tm = swap_max(tm);
            const float mn = fmaxf(m, tm);
            const float alpha = __builtin_amdgcn_exp2f(m - mn);
            m = mn;
            float ps = 0.f;
#pragma unroll
            for (int i = 0; i < 16; ++i) { s0[i] = __builtin_amdgcn_exp2f(s0[i] - mn); s1[i] = __builtin_amdgcn_exp2f(s1[i] - mn); ps += s0[i] + s1[i]; }
            lsum = lsum * alpha + ps;
#pragma unroll
            for (int i = 0; i < 16; ++i) { o0[i] *= alpha; o1[i] *= alpha; }
#pragma unroll
            for (int st = 0; st < 2; ++st) {
                const bf16x8 pa = pack8(s0, st), pb = pack8(s1, st);
                o0 = MFMA32(vt_frag(vt, 0, st, 0, lane), pa, o0); o1 = MFMA32(vt_frag(vt, 0, st, 1, lane), pa, o1);
                o0 = MFMA32(vt_frag(vt, 1, st, 0, lane), pb, o0); o1 = MFMA32(vt_frag(vt, 1, st, 1, lane), pb, o1);
            }
        }
        __builtin_amdgcn_sched_barrier(0);
        if (it + 1 < nt) kv_store(stg, smem + (cur ^ 1) * KV_TILE, smem + (2 + (cur ^ 1)) * KV_TILE);
        __syncthreads();
    }
    const float inv = 1.0f / swap_sum(lsum);
    bf16_t* orow = p.mixed + (rowb + tq) * DM + h * 64 + 4 * hh;
#pragma unroll
    for (int g = 0; g < 4; ++g) {
        u32x2 w0, w1;
        w0.x = pack2(o0[4 * g] * inv, o0[4 * g + 1] * inv); w0.y = pack2(o0[4 * g + 2] * inv, o0[4 * g + 3] * inv);
        w1.x = pack2(o1[4 * g] * inv, o1[4 * g + 1] * inv); w1.y = pack2(o1[4 * g + 2] * inv, o1[4 * g + 3] * inv);
        *(u32x2*)(orow + 8 * g) = w0; *(u32x2*)(orow + 32 + 8 * g) = w1;
    }
}

DI void sb_attn_unit(const P& p, char* smem, volatile int* wdone, int unit, const ConvPlan& cv, int& cslot, ConvRegs& cr0) {
    const int tid8 = opaque_tid(), tid = tid8 & 255, lane = tid & 63, wid = tid >> 6, r32 = lane & 31, hh = lane >> 5, wid8 = tid8 >> 6;
    const int qb = unit & 31, h = (unit >> 5) & 7, b = unit >> 8;
    const int tw = qb * 128 + wid * 32, t = tw + r32;
    const size_t rowb = (size_t)b * NS;
    const bf16_t* kbase = p.proj + rowb * ODD_IN + 1536 + h * 64;
    const bf16_t* vbase = p.proj + rowb * ODD_IN + 2048 + h * 64;
    __syncthreads();
    bf16x8 qf[4];
#pragma unroll
    for (int st = 0; st < 4; ++st) qf[st] = *(const bf16x8*)(p.proj + (rowb + t) * ODD_IN + 1024 + h * 64 + st * 16 + hh * 8);
    bf16x8 tf[2];
#pragma unroll
    for (int st = 0; st < 2; ++st)
#pragma unroll
        for (int j = 0; j < 8; ++j) tf[st][j] = (16 * st + 8 * (j >> 2) + 4 * hh + (j & 3)) >= r32 ? (short)0x3F80 : (short)0;
    f32x16 o0, o1;
#pragma unroll
    for (int i = 0; i < 16; ++i) { o0[i] = 0.f; o1[i] = 0.f; }
    float carry = 0.f; bool done = false;
    const int kt0 = 2 * qb + 1;
    KVStage stg;
    kv_load(stg, kbase, vbase, ODD_IN, kt0 * 64);
    kv_store(stg, smem, smem + 2 * KV_TILE);
    __syncthreads();
    for (int it = 0; it <= kt0; ++it) {
        const int kt = kt0 - it, cur = it & 1;
        if (kt > 0) kv_load(stg, kbase, vbase, ODD_IN, (kt - 1) * 64);
        conv_store(cr0); conv_load(p, cv, cslot++, cr0);
        __builtin_amdgcn_sched_barrier(0);
        const char* ktile = smem + cur * KV_TILE; const char* vtile = smem + (2 + cur) * KV_TILE;
        if (!done && kt * 64 < tw + 31) {
#pragma unroll
            for (int sbi = 0; sbi < 2; ++sbi) {
                const int sb = 1 - sbi;
                f32x16 x;
#pragma unroll
                for (int i = 0; i < 16; ++i) x[i] = 0.f;
#pragma unroll
                for (int st = 0; st < 4; ++st) x = MFMA32(k_frag(ktile, sb, st, r32, hh), qf[st], x);
                const int kb = kt * 64 + sb * 32 + 4 * hh;
                f32x16 L, Lr;
#pragma unroll
                for (int i = 0; i < 16; ++i) {
                    const bool valid = kb + (i & 3) + 8 * (i >> 2) < t;
                    const float z = x[i];
                    const float sp = fmaxf(z, 0.f) + __builtin_amdgcn_logf(1.0f + __builtin_amdgcn_exp2f(-fabsf(z)));
                    L[i] = valid ? -sp : 0.f;
                    x[i] = valid ? z : -1.0e30f;
                }
                f32x16 cum;
#pragma unroll
                for (int i = 0; i < 16; ++i) cum[i] = carry;
#pragma unroll
                for (int st = 0; st < 2; ++st) {
                    const bf16x8 hi = pack8(L, st);
#pragma unroll
                    for (int j = 0; j < 8; ++j) Lr[8 * st + j] = L[8 * st + j] - __uint_as_float(((unsigned)(unsigned short)hi[j]) << 16);
                    cum = MFMA32(tf[st], hi, cum);
                }
#pragma unroll
                for (int st = 0; st < 2; ++st) cum = MFMA32(tf[st], pack8(Lr, st), cum);
                carry = bcast_lo(cum[0]);
#pragma unroll
                for (int i = 0; i < 16; ++i) x[i] = __builtin_amdgcn_exp2f(x[i] + cum[i]);
#pragma unroll
                for (int st = 0; st < 2; ++st) {
                    const bf16x8 pa = pack8(x, st);
                    o0 = MFMA32(vt_frag(vtile, sb, st, 0, lane), pa, o0); o1 = MFMA32(vt_frag(vtile, sb, st, 1, lane), pa, o1);
                }
            }
            done = __all(carry < -150.0f);
        }
        __builtin_amdgcn_sched_barrier(0);
        if (lane == 0) wdone[cur * 8 + wid8] = done ? 1 : 0;
        if (kt > 0) kv_store(stg, smem + (cur ^ 1) * KV_TILE, smem + (2 + (cur ^ 1)) * KV_TILE);
        __syncthreads();
        if (wdone[cur * 8] + wdone[cur * 8 + 1] + wdone[cur * 8 + 2] + wdone[cur * 8 + 3] + wdone[cur * 8 + 4] + wdone[cur * 8 + 5] + wdone[cur * 8 + 6] + wdone[cur * 8 + 7] == 8) break;
    }
    bf16_t* orow = p.mixed + (rowb + t) * DM + 512 + h * 64 + 4 * hh;
#pragma unroll
    for (int g = 0; g < 4; ++g) {
        u32x2 w0, w1;
        w0.x = pack2(o0[4 * g], o0[4 * g + 1]); w0.y = pack2(o0[4 * g + 2], o0[4 * g + 3]);
        w1.x = pack2(o1[4 * g], o1[4 * g + 1]); w1.y = pack2(o1[4 * g + 2], o1[4 * g + 3]);
        *(u32x2*)(orow + 8 * g) = w0; *(u32x2*)(orow + 32 + 8 * g) = w1;
    }
}

DI void pool_items(const P& p) {
    for (int it = blockIdx.x * 512 + threadIdx.x; it < NTOK * 64; it += gridDim.x * 512) {
        const int tok = it >> 6, ch8 = it & 63, g = ch8 >> 4, w = 2 << g, s = tok & (NS - 1);
        const int n = (s + 1 < w) ? s + 1 : w;
        float sum[8], own[8];
#pragma unroll
        for (int j = 0; j < 8; ++j) sum[j] = 0.f;
        const bf16_t* src = p.proj + (size_t)tok * EVEN_IN + 1536 + ch8 * 8;
        u32x4 wv[16];
#pragma unroll
        for (int t = 0; t < 16; ++t) wv[t] = (t < n) ? *(const u32x4*)(src - (size_t)t * EVEN_IN) : (u32x4){0u, 0u, 0u, 0u};
#pragma unroll
        for (int t = 0; t < 16; ++t) { unpack8(wv[t], own);
#pragma unroll
            for (int j = 0; j < 8; ++j) sum[j] += own[j]; }
        unpack8(wv[0], own);
        const float inv = 1.0f / (float)n;
        u32x4 o; o.x = pack2(sum[0] * inv - own[0], sum[1] * inv - own[1]); o.y = pack2(sum[2] * inv - own[2], sum[3] * inv - own[3]);
        o.z = pack2(sum[4] * inv - own[4], sum[5] * inv - own[5]); o.w = pack2(sum[6] * inv - own[6], sum[7] * inv - own[7]);
        *(u32x4*)(p.mixed + (size_t)tok * DM + 512 + ch8 * 8) = o;
    }
}

DI void sgu_unit(const P& p, char* smem, int unit) {
    const int tid = opaque_tid() & 255, lane = tid & 63, wid = tid >> 6, wm = wid >> 1, wn = wid & 1, fr = lane & 15, fq = lane >> 4;
    const int g = unit & 3; const size_t tok0 = (size_t)(unit >> 2) * 128;
    char* As = smem; char* Gs = smem + 32768; float* srstd = (float*)(smem + 65536);
    __syncthreads();
    {
        const int row = tid >> 1, half = tid & 1;
        const bf16_t* src = p.proj + (tok0 + row) * ODD_IN + 512 + half * 256;
        float ss = 0.f;
        for (int i = 0; i < 32; ++i) { float f[8]; unpack8(*(const u32x4*)(src + i * 8), f);
#pragma unroll
            for (int j = 0; j < 8; ++j) ss += f[j] * f[j]; }
        ss += __shfl_xor(ss, 1);
        if (half == 0) srstd[row] = rsqrtf(ss * (1.0f / 512.0f) + EPS);
    }
#pragma unroll
    for (int i = 0; i < 8; ++i) {
        const int idx = tid + 256 * i, s = idx >> 4, ch = idx & 15;
        const u32x4 v = *(const u32x4*)(p.proj + (tok0 + s) * ODD_IN + 512 + g * 128 + ch * 8);
        *(u32x4*)(Gs + s * 256 + (((ch >> 1) ^ kswz(s)) << 5) + ((ch & 1) << 4)) = v;
    }
    __syncthreads();
#pragma unroll
    for (int i = 0; i < 8; ++i) {
        const int idx = tid + 256 * i, t = idx >> 4, c8 = idx & 15, s0 = c8 * 8;
        const float* wr = p.sgu_w + ((size_t)g * 128 + t) * 128 + s0;
        const f32x4 a = *(const f32x4*)wr, b = *(const f32x4*)(wr + 4);
        float f[8] = {a[0], a[1], a[2], a[3], b[0], b[1], b[2], b[3]};
#pragma unroll
        for (int j = 0; j < 8; ++j) f[j] = (s0 + j <= t) ? f[j] * srstd[s0 + j] : 0.f;
        u32x4 w; w.x = pack2(f[0], f[1]); w.y = pack2(f[2], f[3]); w.z = pack2(f[4], f[5]); w.w = pack2(f[6], f[7]);
        *(u32x4*)(As + (c8 >> 3) * 16384 + t * 128 + (((c8 & 7) ^ (t & 7)) << 4)) = w;
    }
    __syncthreads();
    f32x4 acc[4][4];
#pragma unroll
    for (int a = 0; a < 4; ++a)
#pragma unroll
        for (int b = 0; b < 4; ++b) acc[a][b] = (f32x4){0.f, 0.f, 0.f, 0.f};
    const int qq = fr >> 2, pp = fr & 3;
#pragma unroll
    for (int kt = 0; kt < 2; ++kt) {
        if (kt == 1 && wm == 0) continue;
#pragma unroll
        for (int s2 = 0; s2 < 2; ++s2) {
            bf16x8 af[4], bfv[4];
#pragma unroll
            for (int i = 0; i < 4; ++i) {
                const int ra_ = wm * 64 + i * 16 + fr;
                af[i] = *(const bf16x8*)(As + kt * 16384 + ra_ * 128 + (((s2 * 4 + fq) ^ (fr & 7)) << 4));
                const int srow = kt * 64 + s2 * 32 + 8 * fq + qq, blk = wn * 4 + i;
                const s16x4 lo = tr_read(Gs + srow * 256 + ((blk ^ kswz(srow)) << 5) + pp * 8);
                const s16x4 hi = tr_read(Gs + (srow + 4) * 256 + ((blk ^ kswz(srow + 4)) << 5) + pp * 8);
                bfv[i] = (bf16x8){lo[0], lo[1], lo[2], lo[3], hi[0], hi[1], hi[2], hi[3]};
            }
#pragma unroll
            for (int mi = 0; mi < 4; ++mi)
#pragma unroll
                for (int ni = 0; ni < 4; ++ni) acc[mi][ni] = MFMA16(bfv[ni], af[mi], acc[mi][ni]);
        }
    }
#pragma unroll
    for (int mi = 0; mi < 4; ++mi) {
        const int t = wm * 64 + mi * 16 + fr;
        const float bias = p.sgu_b[g * 128 + t];
#pragma unroll
        for (int ni = 0; ni < 4; ++ni) {
            const int c = g * 128 + wn * 64 + ni * 16 + fq * 4;
            const f32x4 gn = *(const f32x4*)(p.sgu_v_norm + c);
            const u32x2 uu = *(const u32x2*)(p.proj + (tok0 + t) * ODD_IN + c);
            const float u0 = __uint_as_float(uu.x << 16), u1 = __uint_as_float(uu.x & 0xffff0000u), u2 = __uint_as_float(uu.y << 16), u3 = __uint_as_float(uu.y & 0xffff0000u);
            const f32x4 a = acc[mi][ni];
            u32x2 w; w.x = pack2(u0 * (gn[0] * a[0] + bias), u1 * (gn[1] * a[1] + bias)); w.y = pack2(u2 * (gn[2] * a[2] + bias), u3 * (gn[3] * a[3] + bias));
            *(u32x2*)(p.mixed + (tok0 + t) * DM + c) = w;
        }
    }
}

DI void router_unit(const P& p, char* smem, int layer, int unit) {
    const int tid = opaque_tid() & 255, lane = tid & 63, wid = tid >> 6, r32 = lane & 31, hh = lane >> 5;
    float (*part)[36][32] = (float (*)[36][32])smem;
    float (*wss)[32] = (float (*)[32])(smem + 18432);
    int* lcnt = (int*)(smem + 18432 + 512);
    int* lbase = lcnt + 32;
    int* cnt = p.cnt + layer * NEXP;
    const int tok = unit * 32 + r32, kq = wid * 256 + 8 * hh;
    __syncthreads();
    if (tid < 32) lcnt[tid] = 0;
    const bf16_t* hrow = p.hb + (size_t)tok * DM + kq;
    const bf16_t* whi = p.wr_hi + ((size_t)layer * 96 + r32) * DM + kq;
    const bf16_t* wlo = p.wr_lo + ((size_t)layer * 96 + r32) * DM + kq;
    f32x16 c0, c1, c2;
#pragma unroll
    for (int i = 0; i < 16; ++i) { c0[i] = 0.f; c1[i] = 0.f; c2[i] = 0.f; }
    float ss = 0.f;
#pragma unroll 4
    for (int st = 0; st < 16; ++st) {
        const u32x4 hw = *(const u32x4*)(hrow + 16 * st);
        float f[8]; unpack8(hw, f);
#pragma unroll
        for (int j = 0; j < 8; ++j) ss += f[j] * f[j];
        const bf16x8 hhi = __builtin_bit_cast(bf16x8, hw);
        bf16x8 wh, wl;
        wh = *(const bf16x8*)(whi + 16 * st); wl = *(const bf16x8*)(wlo + 16 * st);
        c0 = MFMA32(wh, hhi, c0); c0 = MFMA32(wl, hhi, c0);
        wh = *(const bf16x8*)(whi + 32 * DM + 16 * st); wl = *(const bf16x8*)(wlo + 32 * DM + 16 * st);
        c1 = MFMA32(wh, hhi, c1); c1 = MFMA32(wl, hhi, c1);
        wh = *(const bf16x8*)(whi + 64 * DM + 16 * st); wl = *(const bf16x8*)(wlo + 64 * DM + 16 * st);
        c2 = MFMA32(wh, hhi, c2); c2 = MFMA32(wl, hhi, c2);
    }
    {
        auto rr = __builtin_amdgcn_permlane32_swap(__float_as_uint(ss), __float_as_uint(ss), false, false);
        ss = __uint_as_float(rr[0]) + __uint_as_float(rr[1]);
        if (hh == 0) {
#pragma unroll
            for (int i = 0; i < 16; ++i) { part[wid][i][r32] = c0[i]; part[wid][16 + i][r32] = c1[i]; }
#pragma unroll
            for (int i = 0; i < 4; ++i) part[wid][32 + i][r32] = c2[i];
            wss[wid][r32] = ss;
        }
    }
    __syncthreads();
    int e1 = 0, e2 = 0, r1 = 0, r2 = 0; float w1 = 0.f, w2 = 0.f, rstd = 0.f;
    const int mytok = unit * 32 + tid;
    if (tid < 32) {
        rstd = rsqrtf((wss[0][tid] + wss[1][tid] + wss[2][tid] + wss[3][tid]) * (1.0f / DM) + EPS);
        float gl[4], ev[8];
#pragma unroll
        for (int j = 0; j < 4; ++j) gl[j] = (part[0][32 + j][tid] + part[1][32 + j][tid] + part[2][32 + j][tid] + part[3][32 + j][tid]) * rstd;
        int gs = 0; float gm = gl[0];
#pragma unroll
        for (int j = 1; j < 4; ++j) if (gl[j] > gm) { gm = gl[j]; gs = j; }
        const float gw = 1.0f / (__expf(gl[0] - gm) + __expf(gl[1] - gm) + __expf(gl[2] - gm) + __expf(gl[3] - gm));
#pragma unroll
        for (int j = 0; j < 8; ++j) { const int s = gs * 8 + j; ev[j] = (part[0][s][tid] + part[1][s][tid] + part[2][s][tid] + part[3][s][tid]) * rstd; }
        int i1 = 0; float v1 = ev[0];
#pragma unroll
        for (int j = 1; j < 8; ++j) if (ev[j] > v1) { v1 = ev[j]; i1 = j; }
        int i2 = -1; float v2 = -3.0e38f;
#pragma unroll
        for (int j = 0; j < 8; ++j) if (j != i1 && ev[j] > v2) { v2 = ev[j]; i2 = j; }
        w1 = 1.0f / (1.0f + __expf(v2 - v1)); w2 = (1.0f - w1) * gw; w1 *= gw;
        e1 = gs * 8 + i1; e2 = gs * 8 + i2;
        r1 = atomicAdd(lcnt + e1, 1); r2 = atomicAdd(lcnt + e2, 1);
    }
    __syncthreads();
    if (tid < 32) { const int n = lcnt[tid]; lbase[tid] = n ? atomicAdd(cnt + tid, n) : 0; }
    __syncthreads();
    if (tid < 32) {
        p.plist[(size_t)e1 * LISTCAP + lbase[e1] + r1] = mytok * 2; p.plist[(size_t)e2 * LISTCAP + lbase[e2] + r2] = mytok * 2 + 1;
        p.pw[mytok * 2] = w1; p.pw[mytok * 2 + 1] = w2; p.rs[mytok] = rstd;
    }
}
DI void ph_combine(const P& p, int layer) {
    const int wave = threadIdx.x >> 6, lane = threadIdx.x & 63;
    for (int u = blockIdx.x; u < NTOK / 16; u += gridDim.x) {
        const size_t tok0 = (size_t)u * 16 + wave * 2;
        u32x2 hv[2][4], ya[2][4], yb[2][4];
#pragma unroll
        for (int r = 0; r < 2; ++r)
#pragma unroll
            for (int i = 0; i < 4; ++i) {
                const int c = i * 256 + lane * 4;
                hv[r][i] = *(const u32x2*)(p.hb + (tok0 + r) * DM + c);
                ya[r][i] = *(const u32x2*)(p.y + ((tok0 + r) * 2) * DM + c); yb[r][i] = *(const u32x2*)(p.y + ((tok0 + r) * 2 + 1) * DM + c);
            }
#pragma unroll
        for (int r = 0; r < 2; ++r) {
            float ss = 0.f;
#pragma unroll
            for (int i = 0; i < 4; ++i) {
                const u32x2 h0 = hv[r][i], a = ya[r][i], b = yb[r][i];
                f32x4 h;
                h[0] = __uint_as_float(h0.x << 16) + __uint_as_float(a.x << 16) + __uint_as_float(b.x << 16);
                h[1] = __uint_as_float(h0.x & 0xffff0000u) + __uint_as_float(a.x & 0xffff0000u) + __uint_as_float(b.x & 0xffff0000u);
                h[2] = __uint_as_float(h0.y << 16) + __uint_as_float(a.y << 16) + __uint_as_float(b.y << 16);
                h[3] = __uint_as_float(h0.y & 0xffff0000u) + __uint_as_float(a.y & 0xffff0000u) + __uint_as_float(b.y & 0xffff0000u);
                ss += h[0] * h[0] + h[1] * h[1] + h[2] * h[2] + h[3] * h[3];
                if (layer == 0) { u32x2 w; w.x = pack2(h[0], h[1]); w.y = pack2(h[2], h[3]); *(u32x2*)(p.hb + (tok0 + r) * DM + i * 256 + lane * 4) = w; }
                else *(f32x4*)(p.out + (tok0 + r) * DM + i * 256 + lane * 4) = h;
            }
            if (layer == 0) { ss = wave_sum(ss); if (lane == 0) p.rsm[tok0 + r] = rsqrtf(ss * (1.0f / DM) + EPS); }
        }
    }
}

DI void ph_mix_even(const P& p, char* smem) {
    const int half = threadIdx.x >> 8;
    const ConvPlan cv = conv_plan(p, 0); int cslot = 0; ConvRegs cr; cr.dst = nullptr;
    for (int u = blockIdx.x; u < NB * 4 * 32; u += gridDim.x) {
        const int cp = u & 31, hp = (u >> 5) & 3, b = u >> 7;
        band_attn_unit(p, smem + half * HALF_LDS, (b << 8) | ((hp * 2 + half) << 5) | cp, cv, cslot, cr);
    }
    conv_store(cr); conv_rest(p, cv, cslot);
    pool_items(p);
}
DI void ph_mix_odd(const P& p, char* smem) {
    const int half = threadIdx.x >> 8;
    volatile int* wdone = (volatile int*)(smem + 2 * HALF_LDS);
    const ConvPlan cv = conv_plan(p, 1); int cslot = 0; ConvRegs cr; cr.dst = nullptr;
    for (int u = blockIdx.x; u < NB * 4 * 32; u += gridDim.x) {
        const int qb = 31 - (u >> 4), hp = (u >> 2) & 3, b = u & 3;
        sb_attn_unit(p, smem + half * HALF_LDS, wdone, (b << 8) | ((hp * 2 + half) << 5) | qb, cv, cslot, cr);
    }
    conv_store(cr); conv_rest(p, cv, cslot);
    for (int u = blockIdx.x; u < (NTOK / 128) * 2; u += gridDim.x) sgu_unit(p, smem + half * HALF_LDS, u * 2 + half);
}
DI void ph_router(const P& p, char* smem, int layer) {
    const int half = threadIdx.x >> 8;
    for (int u = blockIdx.x; u < NTOK / 64; u += gridDim.x) router_unit(p, smem + half * HALF_LDS, layer, u * 2 + half);
}

constexpr int NPHASE = 13;
#ifndef REPS
#define REPS {1,1,1,1,1,1,1,1,1,1,1,1,1}
#endif
__device__ constexpr int REP[13] = REPS;
__global__ __launch_bounds__(512, 2) void mega(P p, int ph0, int ph1) {
    __shared__ __attribute__((aligned(16))) char smem[SMEM_BYTES + 64 + 16 + 16];
    volatile LDSAS unsigned* xst = (volatile LDSAS unsigned*)(smem + SMEM_BYTES + 64);
    if (threadIdx.x < 4) xst[threadIdx.x] = 0u;
    __syncthreads();
    const XcdBarrier xb = xcd_barrier_post(p.bar, xst);
#define PHASE(i, call) if (ph0 <= (i) && (i) < ph1) { for (int r_ = 0; r_ < REP[i]; ++r_) { call; if (r_ + 1 < REP[i] || (i) + 1 < ph1) xcd_barrier(xb); } }
    PHASE(0, ph_prologue(p, smem))
    PHASE(1, (ph_gemm_dense<EPI_IN_EVEN, 4>(p, smem, p.hb, DM, p.wb_in_even, DM, EVEN_IN, 0, 0, 8)))
    PHASE(2, ph_mix_even(p, smem))
    PHASE(3, (ph_gemm_dense<EPI_OUT, 4>(p, smem, p.mixed, DM, p.wb_out_even, DM, DM, 0, 0, 4)))
    PHASE(4, ph_router(p, smem, 0))
    PHASE(5, ph_moe(p, smem, 0))
    PHASE(6, ph_combine(p, 0))
    PHASE(7, (ph_gemm_dense<EPI_IN_ODD, 4>(p, smem, p.hb, DM, p.wb_in_odd, DM, ODD_IN, 1, 0, 8), ph_gemm_dense<EPI_IN_ODD, 2>(p, smem, p.hb, DM, p.wb_in_odd, DM, ODD_IN, 1, 8, 2)))
    PHASE(8, ph_mix_odd(p, smem))
    PHASE(9, (ph_gemm_dense<EPI_OUT, 4>(p, smem, p.mixed, DM, p.wb_out_odd, DM, DM, 1, 0, 4)))
    PHASE(10, ph_router(p, smem, 1))
    PHASE(11, ph_moe(p, smem, 1))
    PHASE(12, ph_combine(p, 1))
}

extern "C" void kernel_launch(void* const* d_in, const int* in_sizes, int n_in, void* d_out, int out_size, void* d_ws, size_t ws_size, hipStream_t stream) {
    P p{};
    p.x = (const float*)d_in[0]; p.mix_norm_even = (const float*)d_in[1]; p.w_in_even = (const float*)d_in[2]; p.att_q_norm = (const float*)d_in[3];
    p.att_k_norm = (const float*)d_in[4]; p.att_rel_bias = (const float*)d_in[5]; p.pool_w = (const float*)d_in[6]; p.pool_scale = (const float*)d_in[7];
    p.w_out_even = (const float*)d_in[8]; p.mix_norm_odd = (const float*)d_in[9]; p.w_in_odd = (const float*)d_in[10]; p.sgu_v_norm = (const float*)d_in[11];
    p.sgu_w = (const float*)d_in[12]; p.sgu_b = (const float*)d_in[13]; p.w_out_odd = (const float*)d_in[14]; p.ffn_norm = (const float*)d_in[15];
    p.w_rg = (const float*)d_in[16]; p.w_re = (const float*)d_in[17]; p.w_gate = (const float*)d_in[18]; p.w_up = (const float*)d_in[19]; p.w_down = (const float*)d_in[20];
    p.out = (float*)d_out;
    char* ws = (char*)d_ws; size_t off = 0;
    auto take = [&](size_t bytes) { char* r = ws + off; off += (bytes + 255) & ~(size_t)255; return r; };
    p.wb_in_even = (bf16_t*)take((size_t)EVEN_IN * DM * 2);
    p.wb_out_even = (bf16_t*)take((size_t)DM * DM * 2);
    p.wb_in_odd = (bf16_t*)take((size_t)ODD_IN * DM * 2);
    p.wb_out_odd = (bf16_t*)take((size_t)DM * DM * 2);
    p.wb_gate = (bf16_t*)take((size_t)2 * NEXP * DM * FF * 2);
    p.wb_up = (bf16_t*)take((size_t)2 * NEXP * DM * FF * 2);
    p.wb_down = (bf16_t*)take((size_t)2 * NEXP * DM * FF * 2);
    p.wr_hi = (bf16_t*)take((size_t)2 * 96 * DM * 2);
    p.wr_lo = (bf16_t*)take((size_t)2 * 96 * DM * 2);
    p.hb = (bf16_t*)take((size_t)NTOK * DM * 2);
    p.proj = (bf16_t*)take((size_t)NTOK * ODD_IN * 2);
    p.y = p.proj;
    p.mixed = (bf16_t*)take((size_t)NTOK * DM * 2);
    p.hid = p.mixed;
    p.pw = (float*)take((size_t)NTOK * 2 * 4);
    p.rs = (float*)take((size_t)NTOK * 4);
    p.rsm = (float*)take((size_t)NTOK * 4);
    p.plist = (int*)take((size_t)NEXP * LISTCAP * 4);
    p.cnt = (int*)take(256);
    p.gdone = (int*)take(640 * 4);
    p.bar = (unsigned*)take(XCD_BAR_WORDS * 4);
    (void)hipMemsetAsync(p.bar, 0, XCD_BAR_WORDS * 4, stream);
    for (int l = 0; l < 2; ++l) {
        const size_t o = (size_t)l * NEXP * DM * FF;
        p.cs[l * 5 + 0] = p.w_gate + o; p.cd[l * 5 + 0] = p.wb_gate + o;
        p.cs[l * 5 + 1] = p.w_up + o;   p.cd[l * 5 + 1] = p.wb_up + o;
        p.cs[l * 5 + 2] = p.w_down + o; p.cd[l * 5 + 2] = p.wb_down + o;
        p.cs[l * 5 + 3] = p.w_in_odd;   p.cd[l * 5 + 3] = p.wb_in_odd;
        p.cs[l * 5 + 4] = p.w_out_odd;  p.cd[l * 5 + 4] = p.wb_out_odd;
    }

    static int grid_blocks = 0;
    if (!grid_blocks) {
        int dev = 0, cus = 0, per_cu = 0;
        (void)hipGetDevice(&dev);
        (void)hipDeviceGetAttribute(&cus, hipDeviceAttributeMultiprocessorCount, dev);
        (void)hipOccupancyMaxActiveBlocksPerMultiprocessor(&per_cu, mega, 512, 0);
        if (per_cu < 1) per_cu = 1;
        grid_blocks = cus;
    }
    int ph0 = 0, ph1 = NPHASE;
    void* args[] = {&p, &ph0, &ph1};
    hipError_t e = hipLaunchCooperativeKernel((void*)mega, dim3(grid_blocks), dim3(512), args, 0, stream);
    if (e != hipSuccess) fprintf(stderr, "cooperative launch failed: %s (grid %d)\n", hipGetErrorString(e), grid_blocks);
}
```

```cpp
#include <hip/hip_runtime.h>
#include <hip/hip_cooperative_groups.h>
#include <stdint.h>
#include <stdio.h>

typedef unsigned short bf16_t;
typedef short bf16x8 __attribute__((ext_vector_type(8)));
typedef short s16x4 __attribute__((ext_vector_type(4)));
typedef float f32x2 __attribute__((ext_vector_type(2)));
typedef float f32x4 __attribute__((ext_vector_type(4)));
typedef float f32x16 __attribute__((ext_vector_type(16)));
typedef unsigned u32x4 __attribute__((ext_vector_type(4)));
typedef unsigned u32x2 __attribute__((ext_vector_type(2)));
typedef __bf16 bf16x2n __attribute__((ext_vector_type(2)));

#define DI __device__ __forceinline__
#define LDSAS __attribute__((address_space(3)))
#define MFMA32(a, b, c) __builtin_amdgcn_mfma_f32_32x32x16_bf16((a), (b), (c), 0, 0, 0)
#define MFMA16(a, b, c) __builtin_amdgcn_mfma_f32_16x16x32_bf16((a), (b), (c), 0, 0, 0)

constexpr int NB = 4, NS = 4096, NTOK = NB * NS, DM = 1024;
constexpr int EVEN_IN = 2048, ODD_IN = 2560;
constexpr int NEXP = 32, FF = 256;
constexpr int LISTCAP = NTOK;
constexpr float EPS = 1e-6f;
constexpr float LOG2E = 1.4426950408889634f;
constexpr float QSCALE = 0.125f * LOG2E;

DI int opaque_tid() { int t = threadIdx.x; asm volatile("" : "+v"(t)); return t; }
DI float bf2f(bf16_t b) { return __uint_as_float(((unsigned)b) << 16); }
DI unsigned pack2(float lo, float hi) { f32x2 v = {lo, hi}; bf16x2n r = __builtin_convertvector(v, bf16x2n); return __builtin_bit_cast(unsigned, r); }
DI float wave_sum(float v) { for (int o = 32; o > 0; o >>= 1) v += __shfl_xor(v, o); return v; }
DI float gelu_exact(float x) { return 0.5f * x * (1.0f + erff(x * 0.70710678118654752f)); }
DI s16x4 tr_read(const char* p) { return __builtin_bit_cast(s16x4, __builtin_amdgcn_ds_read_tr16_b64_v4i16((LDSAS s16x4*)p)); }
DI void unpack8(const u32x4 v, float* f) {
    f[0] = __uint_as_float(v.x << 16); f[1] = __uint_as_float(v.x & 0xffff0000u); f[2] = __uint_as_float(v.y << 16); f[3] = __uint_as_float(v.y & 0xffff0000u);
    f[4] = __uint_as_float(v.z << 16); f[5] = __uint_as_float(v.z & 0xffff0000u); f[6] = __uint_as_float(v.w << 16); f[7] = __uint_as_float(v.w & 0xffff0000u);
}
DI int kswz(int k) { return (k & 3) | ((k >> 1) & 4); }

struct P {
    const float *x, *mix_norm_even, *w_in_even, *att_q_norm, *att_k_norm, *att_rel_bias, *pool_w, *pool_scale, *w_out_even;
    const float *mix_norm_odd, *w_in_odd, *sgu_v_norm, *sgu_w, *sgu_b, *w_out_odd, *ffn_norm, *w_rg, *w_re, *w_gate, *w_up, *w_down;
    float* out;
    bf16_t *wb_in_even, *wb_out_even, *wb_in_odd, *wb_out_odd, *wb_gate, *wb_up, *wb_down, *wr_hi, *wr_lo;
    bf16_t *hb, *proj, *mixed, *hid, *y;
    float *pw, *rs, *rsm; int* plist; int* cnt; unsigned* bar; int* gdone;
    const float* cs[10]; bf16_t* cd[10]; const float* ones; bf16_t* dump;
};

enum { EPI_IN_EVEN = 0, EPI_IN_ODD = 1, EPI_OUT = 2, EPI_GU = 3, EPI_DOWN = 4 };
constexpr int G_ROWID = 131072;
constexpr int SMEM_BYTES = 131072 + 1024;
constexpr int HALF_LDS = 66048;

struct GemmArgs {
    const bf16_t* A; int lda; const int* gather; int mvalid; int gshift;
    const bf16_t* B0; const bf16_t* B1; int ldb; int gu;
    int K, m0, n0;
};

DI f32x2 gelu_pk(f32x2 v) {
    const f32x2 av = __builtin_elementwise_abs(v), d = av * 0.2316418882f + 1.0f;
    f32x2 t; t.x = __builtin_amdgcn_rcpf(d.x); t.y = __builtin_amdgcn_rcpf(d.y);
    f32x2 q = t * 0.5307027145f + (-0.7265760135f); q = q * t + 0.7107068705f; q = q * t + (-0.142248368f); q = q * t + 0.127414796f; q = q * t;
    const f32x2 s = (v * v) * (-0.72134752044f);
    f32x2 e; e.x = __builtin_amdgcn_exp2f(s.x); e.y = __builtin_amdgcn_exp2f(s.y);
    const f32x2 m = v * (q * e), r = v - m;
    f32x2 o; o.x = v.x < 0.f ? m.x : r.x; o.y = v.y < 0.f ? m.y : r.y; return o;
}

DI void glds16(const void* gsrc, unsigned lds_dst) {
    unsigned keep;
    asm volatile("s_mov_b32 %0, m0\n\ts_mov_b32 m0, %2\n\ts_nop 0\n\tglobal_load_lds_dwordx4 %1, off\n\ts_mov_b32 m0, %0" : "=&s"(keep) : "v"(gsrc), "s"(lds_dst) : "memory");
}
DI void glds16_sc1(const void* gsrc, unsigned lds_dst) {
    unsigned keep;
    asm volatile("s_mov_b32 %0, m0\n\ts_mov_b32 m0, %2\n\ts_nop 0\n\tglobal_load_lds_dwordx4 %1, off sc1\n\ts_mov_b32 m0, %0" : "=&s"(keep) : "v"(gsrc), "s"(lds_dst) : "memory");
}
DI void st16_sc1(void* q, u32x4 v) { asm volatile("global_store_dwordx4 %0, %1, off sc1\n\ts_nop 1" :: "v"(q), "v"(v) : "memory"); }
template <int EPI, int MT>
DI void gemm_tile(const P& p, char* smem, const GemmArgs& g, int layer) {
    const int tid = opaque_tid(), lane = tid & 63, wid = tid >> 6, wm = wid >> 2, wn = wid & 3, r32 = lane & 31, hh = lane >> 5;
    int* rowid = (int*)(smem + G_ROWID);
    constexpr int NA = MT / 2;
    constexpr int IPT = NA + 2;
    const bf16_t* ap[NA]; const bf16_t* bp[2];
    if (g.gather) { if (tid < 64 * MT) rowid[tid] = (tid < g.mvalid) ? g.gather[tid] : -1; __syncthreads(); }
#pragma unroll
    for (int i = 0; i < NA; ++i) {
        const int r = (wid * NA + i) * 16 + (lane >> 2), kc = (lane & 3) ^ ((r >> 2) & 3);
        size_t arow;
        if (g.gather) { int id = rowid[r]; if (id < 0) id = rowid[0]; arow = (size_t)(id >> g.gshift); } else arow = (size_t)(g.m0 + r);
        ap[i] = g.A + arow * g.lda + kc * 8;
    }
#pragma unroll
    for (int i = 0; i < 2; ++i) {
        const int k = (wid * 2 + i) * 2 + (lane >> 5), sl = lane & 31, ch = (((sl >> 2) ^ (k & 7)) << 2) | (sl & 3);
        const bf16_t* bcol = g.gu ? ((((ch >> 2) & 1) ? g.B1 : g.B0) + (g.n0 >> 1) + (ch >> 3) * 32 + (ch & 3) * 8) : (g.B0 + g.n0 + ch * 8);
        bp[i] = bcol + (size_t)k * g.ldb;
    }
    const size_t bstep = (size_t)32 * g.ldb;
    f32x16 acc[MT][2];
#pragma unroll
    for (int a = 0; a < MT; ++a)
#pragma unroll
        for (int b = 0; b < 2; ++b)
#pragma unroll
            for (int i = 0; i < 16; ++i) acc[a][b][i] = 0.f;
    const int nk = g.K / 32;
    const int arow0 = wm * 32 * MT + r32;
    const int asw = (r32 >> 2) & 3;
    const int g1 = (lane >> 4) & 1, qq = (lane & 15) >> 2, pp = lane & 3;
    const int bk0 = 8 * hh + qq;
    const unsigned ldsb = (unsigned)(size_t)(LDSAS char*)smem;
    const unsigned adst = ldsb + (wid * NA) * 1024, bdst = ldsb + 16384 + (wid * 2) * 1024;
#define G_LOAD(KT) do { const unsigned so_ = (unsigned)((KT) & 3) * 32768u; \
        _Pragma("unroll") for (int i = 0; i < NA; ++i) { if (EPI == EPI_DOWN) glds16_sc1(ap[i] + (KT) * 32, (unsigned)__builtin_amdgcn_readfirstlane(adst + so_ + i * 1024)); \
                                                        else glds16(ap[i] + (KT) * 32, (unsigned)__builtin_amdgcn_readfirstlane(adst + so_ + i * 1024)); } \
        _Pragma("unroll") for (int i = 0; i < 2; ++i) glds16(bp[i] + (size_t)(KT) * bstep, (unsigned)__builtin_amdgcn_readfirstlane(bdst + so_ + i * 1024)); } while (0)
#define G_COMPUTE(KT) do { const char* Ac = smem + ((KT) & 3) * 32768; const char* Bc = Ac + 16384; \
        _Pragma("unroll") for (int st = 0; st < 2; ++st) { bf16x8 af[MT], bfv[2]; \
            _Pragma("unroll") for (int mt = 0; mt < MT; ++mt) af[mt] = *(const bf16x8*)(Ac + (arow0 + mt * 32) * 64 + (((2 * st + hh) ^ asw) << 4)); \
            _Pragma("unroll") for (int nt = 0; nt < 2; ++nt) { const int k = 16 * st + bk0; \
                const char* b0_ = Bc + k * 512 + (((wn * 2 + nt) ^ (k & 7)) << 6) + g1 * 32 + pp * 8; \
                const char* b1_ = Bc + (k + 4) * 512 + (((wn * 2 + nt) ^ ((k + 4) & 7)) << 6) + g1 * 32 + pp * 8; \
                const s16x4 lo = tr_read(b0_), hi = tr_read(b1_); \
                bfv[nt] = (bf16x8){lo[0], lo[1], lo[2], lo[3], hi[0], hi[1], hi[2], hi[3]}; } \
            _Pragma("unroll") for (int mt = 0; mt < MT; ++mt) _Pragma("unroll") for (int nt = 0; nt < 2; ++nt) acc[mt][nt] = MFMA32(bfv[nt], af[mt], acc[mt][nt]); } } while (0)
#define G_WAIT(N) do { if ((N) == 2) { if (IPT == 4) asm volatile("s_waitcnt vmcnt(8)" ::: "memory"); else asm volatile("s_waitcnt vmcnt(6)" ::: "memory"); } \
                       else if ((N) == 1) { if (IPT == 4) asm volatile("s_waitcnt vmcnt(4)" ::: "memory"); else asm volatile("s_waitcnt vmcnt(3)" ::: "memory"); } \
                       else asm volatile("s_waitcnt vmcnt(0)" ::: "memory"); } while (0)
    G_LOAD(0); G_LOAD(1); G_LOAD(2);
    G_WAIT(2); __syncthreads();
#pragma nounroll
    for (int kt = 0; kt < nk; ++kt) {
        if (kt + 3 < nk) G_LOAD(kt + 3);
        G_COMPUTE(kt);
        if (kt + 3 < nk) G_WAIT(2); else if (kt + 2 < nk) G_WAIT(1); else G_WAIT(0);
        __syncthreads();
    }
#undef G_LOAD
#undef G_COMPUTE
#undef G_WAIT
    const int colw = g.n0 + wn * 64;
    char* wsl = smem + wid * 16384;
    const int rowb = wm * 32 * MT;
    if (EPI == EPI_IN_EVEN || EPI == EPI_IN_ODD || EPI == EPI_DOWN) {
        const int region = colw >> 9;
        const float* gn = region == 0 ? p.att_q_norm : p.att_k_norm;
        const bool act = colw < 1024;
        const float qs = (colw >= 1024 && colw < 1536) ? QSCALE : 1.0f;
#pragma unroll
        for (int mt = 0; mt < MT; ++mt) {
            float sc = 1.f;
            if (EPI == EPI_IN_EVEN || EPI == EPI_IN_ODD) {
                const float rr_ = p.rsm[g.m0 + rowb + mt * 32 + r32];
#pragma unroll
                for (int nt = 0; nt < 2; ++nt) acc[mt][nt] = acc[mt][nt] * rr_;
            }
            if (EPI == EPI_IN_EVEN && region < 2) {
                float ss = 0.f;
#pragma unroll
                for (int nt = 0; nt < 2; ++nt)
#pragma unroll
                    for (int i = 0; i < 16; ++i) ss += acc[mt][nt][i] * acc[mt][nt][i];
                auto rr = __builtin_amdgcn_permlane32_swap(__float_as_uint(ss), __float_as_uint(ss), false, false);
                ss = __uint_as_float(rr[0]) + __uint_as_float(rr[1]);
                sc = rsqrtf(ss * (1.0f / 64.0f) + EPS) * (region == 0 ? QSCALE : 1.0f);
            }
#pragma unroll
            for (int nt = 0; nt < 2; ++nt)
#pragma unroll
                for (int gq = 0; gq < 4; ++gq) {
                    f32x2 v0 = {acc[mt][nt][4 * gq], acc[mt][nt][4 * gq + 1]}, v1 = {acc[mt][nt][4 * gq + 2], acc[mt][nt][4 * gq + 3]};
                    if (EPI == EPI_IN_EVEN) { if (region < 2) { const f32x4 gg = *(const f32x4*)(gn + nt * 32 + 8 * gq + 4 * hh); v0.x *= sc * gg[0]; v0.y *= sc * gg[1]; v1.x *= sc * gg[2]; v1.y *= sc * gg[3]; } }
                    else if (EPI == EPI_IN_ODD) { if (act) { v0 = gelu_pk(v0); v1 = gelu_pk(v1); } else { v0 = v0 * qs; v1 = v1 * qs; } }
                    u32x2 w; w.x = pack2(v0.x, v0.y); w.y = pack2(v1.x, v1.y);
                    *(u32x2*)(wsl + r32 * 128 + (((nt * 4 + gq) ^ (r32 & 7)) << 4) + hh * 8) = w;
                }
#pragma unroll
            for (int ps = 0; ps < 4; ++ps) {
                const int row = ps * 8 + (lane >> 3), chunk = lane & 7;
                const u32x4 v = *(const u32x4*)(wsl + row * 128 + ((chunk ^ (row & 7)) << 4));
                const int trow = rowb + mt * 32 + row;
                if (EPI == EPI_DOWN) { const int id = rowid[trow]; if (id >= 0) *(u32x4*)(p.y + (size_t)id * DM + colw + chunk * 8) = v; }
                else if (EPI == EPI_IN_EVEN) *(u32x4*)(p.proj + (size_t)(g.m0 + trow) * EVEN_IN + colw + chunk * 8) = v;
                else *(u32x4*)(p.proj + (size_t)(g.m0 + trow) * ODD_IN + colw + chunk * 8) = v;
            }
        }
    } else if (EPI == EPI_OUT) {
#pragma unroll
        for (int mt = 0; mt < MT; ++mt) {
#pragma unroll
            for (int nt = 0; nt < 2; ++nt)
#pragma unroll
                for (int gq = 0; gq < 4; ++gq) {
                    const f32x4 v = {acc[mt][nt][4 * gq], acc[mt][nt][4 * gq + 1], acc[mt][nt][4 * gq + 2], acc[mt][nt][4 * gq + 3]};
                    *(f32x4*)(wsl + r32 * 256 + (((nt * 8 + 2 * gq + hh) ^ (r32 & 15)) << 4)) = v;
                }
#pragma unroll
            for (int ps = 0; ps < 8; ++ps) {
                const int row = ps * 4 + (lane >> 4), chunk = lane & 15;
                const f32x4 v = *(const f32x4*)(wsl + row * 256 + ((chunk ^ (row & 15)) << 4));
                const size_t off = (size_t)(g.m0 + rowb + mt * 32 + row) * DM + colw + chunk * 4;
                f32x4 r;
                if (layer == 0) r = *(const f32x4*)(p.x + off);
                else { const u32x2 hb = *(const u32x2*)(p.hb + off); r = (f32x4){__uint_as_float(hb.x << 16), __uint_as_float(hb.x & 0xffff0000u), __uint_as_float(hb.y << 16), __uint_as_float(hb.y & 0xffff0000u)}; }
                r = r + v;
                u32x2 w; w.x = pack2(r[0], r[1]); w.y = pack2(r[2], r[3]);
                *(u32x2*)(p.hb + off) = w;
            }
        }
    } else if (EPI == EPI_GU) {
        const int f0 = (g.n0 >> 1) + wn * 32;
#pragma unroll
        for (int mt = 0; mt < MT; ++mt) {
            const int id = rowid[rowb + mt * 32 + r32];
            const float w = id >= 0 ? p.pw[id] : 0.f, rs = id >= 0 ? p.rs[id >> 1] : 0.f;
#pragma unroll
            for (int gq = 0; gq < 4; ++gq) {
                float h[4];
#pragma unroll
                for (int j = 0; j < 4; ++j) { const float gt = acc[mt][0][4 * gq + j] * rs, up = acc[mt][1][4 * gq + j] * (rs * w); h[j] = gt / (1.0f + __expf(-gt)) * up; }
                u32x2 ww; ww.x = pack2(h[0], h[1]); ww.y = pack2(h[2], h[3]);
                *(u32x2*)(wsl + r32 * 64 + ((gq ^ (r32 & 3)) << 4) + hh * 8) = ww;
            }
#pragma unroll
            for (int ps = 0; ps < 2; ++ps) {
                const int row = ps * 16 + (lane >> 2), chunk = lane & 3;
                const u32x4 v = *(const u32x4*)(wsl + row * 64 + ((chunk ^ (row & 3)) << 4));
                const int id2 = rowid[rowb + mt * 32 + row];
                if (id2 >= 0) st16_sc1(p.hid + (size_t)id2 * FF + f0 + chunk * 8, v);
            }
        }
        asm volatile("s_waitcnt vmcnt(0)" ::: "memory");
    }
    __syncthreads();
}

template <int EPI, int MT>
DI void ph_gemm_dense(const P& p, char* smem, const bf16_t* A, int lda, const bf16_t* B, int K, int N, int layer, int nt0, int ntc) {
    const int ntm = NTOK / (64 * MT), per_xcd = (ntm / 8) * ntc;
    const bool xcd = (gridDim.x & 7) == 0;
    const int x = blockIdx.x & 7, gx = gridDim.x >> 3;
    const int jend = xcd ? per_xcd : ntm * ntc, jstep = xcd ? gx : (int)gridDim.x;
    for (int j = xcd ? (int)(blockIdx.x >> 3) : (int)blockIdx.x; j < jend; j += jstep) {
        GemmArgs g; g.A = A; g.lda = lda; g.gather = nullptr; g.mvalid = 64 * MT; g.gshift = 0; g.B0 = B; g.B1 = B; g.ldb = N; g.gu = 0; g.K = K;
        g.m0 = ((xcd ? x * (ntm / 8) : 0) + j / ntc) * (64 * MT); g.n0 = (nt0 + j % ntc) * 256;
        gemm_tile<EPI, MT>(p, smem, g, layer);
    }
}

DI void moe_locate(const int* cnt, int mt, int& e, int& c, int& mtl) {
    e = 0; c = 0;
    for (; e < NEXP; ++e) { c = cnt[e]; const int t = (c + 127) >> 7; if (mt < t) break; mt -= t; }
    mtl = mt;
}
DI void ph_moe(const P& p, char* smem, int layer) {
    const int* cnt = p.cnt + layer * NEXP;
    int* gdone = p.gdone + layer * 320;
    int* queue = p.gdone + 600 + layer;
    volatile int* s_next = (volatile int*)(smem + SMEM_BYTES + 80);
    int total = 0;
    for (int e = 0; e < NEXP; ++e) total += (cnt[e] + 127) >> 7;
    const int ngu = total * 2, nall = total * 6;
    int mine = 0;
    if (threadIdx.x == 0) mine = __hip_atomic_fetch_add(queue, 1, __ATOMIC_RELAXED, __HIP_MEMORY_SCOPE_AGENT);
    for (;;) {
        if (threadIdx.x == 0) s_next[0] = mine;
        __syncthreads();
        const int u = s_next[0];
        if (u >= nall) break;
        if (threadIdx.x == 0) mine = __hip_atomic_fetch_add(queue, 1, __ATOMIC_RELAXED, __HIP_MEMORY_SCOPE_AGENT);
        if (u < ngu) {
            int e, c, mt; moe_locate(cnt, u >> 1, e, c, mt);
            GemmArgs g; g.gather = p.plist + (size_t)e * LISTCAP + mt * 128; g.mvalid = c - mt * 128 < 128 ? c - mt * 128 : 128;
            g.m0 = 0; g.n0 = (u & 1) * 256;
            const size_t ex = (size_t)(layer * NEXP + e);
            g.A = p.hb; g.lda = DM; g.gshift = 1; g.B0 = p.wb_gate + ex * DM * FF; g.B1 = p.wb_up + ex * DM * FF; g.ldb = FF; g.gu = 1; g.K = DM;
            gemm_tile<EPI_GU, 2>(p, smem, g, layer);
            if (threadIdx.x == 0) __hip_atomic_fetch_add(gdone + (u >> 1), 1, __ATOMIC_RELAXED, __HIP_MEMORY_SCOPE_AGENT);
        } else {
            const int v = u - ngu;
            if (threadIdx.x == 0) { unsigned sp = 0;
                while (__hip_atomic_load(gdone + (v >> 2), __ATOMIC_RELAXED, __HIP_MEMORY_SCOPE_AGENT) < 2) { __builtin_amdgcn_s_sleep(2); if (++sp > (1u << 22)) break; } }
            __syncthreads();
            int e, c, mt; moe_locate(cnt, v >> 2, e, c, mt);
            GemmArgs g; g.gather = p.plist + (size_t)e * LISTCAP + mt * 128; g.mvalid = c - mt * 128 < 128 ? c - mt * 128 : 128;
            g.m0 = 0; g.n0 = (v & 3) * 256;
            const size_t ex = (size_t)(layer * NEXP + e);
            g.A = p.hid; g.lda = FF; g.gshift = 0; g.B0 = p.wb_down + ex * FF * DM; g.B1 = g.B0; g.ldb = DM; g.gu = 0; g.K = FF;
            gemm_tile<EPI_DOWN, 2>(p, smem, g, layer);
        }
    }
}

DI void convert_flat(const float* __restrict__ src, bf16_t* __restrict__ dst, size_t n8, const float* __restrict__ gain = nullptr, int rowlen = 1) {
    for (size_t i = (size_t)blockIdx.x * 512 + threadIdx.x; i < n8; i += (size_t)gridDim.x * 512) {
        f32x4 a = *(const f32x4*)(src + i * 8), b = *(const f32x4*)(src + i * 8 + 4);
        if (gain) { const float gk = gain[(i * 8) / (size_t)rowlen]; a = a * gk; b = b * gk; }
        u32x4 w; w.x = pack2(a[0], a[1]); w.y = pack2(a[2], a[3]); w.z = pack2(b[0], b[1]); w.w = pack2(b[2], b[3]);
        *(u32x4*)(dst + i * 8) = w;
    }
}
DI void poolfold_unit(const P& p, char* smem, int unit) {
    float (*At)[32] = (float (*)[32])smem;
    float (*Bs)[64] = (float (*)[64])(smem + 16384);
    const int tid = opaque_tid() & 255, g = unit >> 6, c0 = ((unit >> 4) & 3) * 32, n0 = (unit & 15) * 64;
    __syncthreads();
    for (int i = 0; i < 16; ++i) { const int idx = tid + 256 * i, d = idx >> 5, c = idx & 31;
        At[d][c] = p.pool_w[(size_t)(g * 128 + c0 + c) * 128 + d] * p.pool_scale[g * 128 + d]; }
    for (int i = 0; i < 8; ++i) { const int idx = tid + 256 * i, d = idx >> 4, n4 = (idx & 15) * 4;
        *(f32x4*)&Bs[d][n4] = *(const f32x4*)(p.w_out_even + (size_t)(512 + g * 128 + d) * DM + n0 + n4); }
    __syncthreads();
    const int tc = (tid >> 4) * 2, tn = (tid & 15) * 4;
    f32x4 acc[2] = {(f32x4){0.f, 0.f, 0.f, 0.f}, (f32x4){0.f, 0.f, 0.f, 0.f}};
#pragma unroll 8
    for (int d = 0; d < 128; ++d) {
        const f32x2 a = *(const f32x2*)&At[d][tc]; const f32x4 b = *(const f32x4*)&Bs[d][tn];
        acc[0] += a.x * b; acc[1] += a.y * b;
    }
#pragma unroll
    for (int i = 0; i < 2; ++i) { u32x2 w; w.x = pack2(acc[i][0], acc[i][1]); w.y = pack2(acc[i][2], acc[i][3]);
        *(u32x2*)(p.wb_out_even + (size_t)(512 + g * 128 + c0 + tc + i) * DM + n0 + tn) = w; }
}
DI void cast_rows2(const P& p, int tok, int lane) {
    f32x4 v[2][4];
#pragma unroll
    for (int r = 0; r < 2; ++r)
#pragma unroll
        for (int i = 0; i < 4; ++i) v[r][i] = *(const f32x4*)(p.x + (size_t)(tok + r) * DM + i * 256 + lane * 4);
#pragma unroll
    for (int r = 0; r < 2; ++r) {
        float ss = 0.f;
#pragma unroll
        for (int i = 0; i < 4; ++i) { ss += v[r][i][0] * v[r][i][0] + v[r][i][1] * v[r][i][1] + v[r][i][2] * v[r][i][2] + v[r][i][3] * v[r][i][3];
            u32x2 w; w.x = pack2(v[r][i][0], v[r][i][1]); w.y = pack2(v[r][i][2], v[r][i][3]);
            *(u32x2*)(p.hb + (size_t)(tok + r) * DM + i * 256 + lane * 4) = w; }
        ss = wave_sum(ss);
        if (lane == 0) p.rsm[tok + r] = rsqrtf(ss * (1.0f / DM) + EPS);
    }
}
DI void ph_prologue(const P& p, char* smem) {
    if (blockIdx.x == 0 && threadIdx.x < 64) p.cnt[threadIdx.x] = 0;
    if (blockIdx.x == 2 && threadIdx.x == 0) ((float*)p.ones)[0] = 1.0f;
    if (blockIdx.x == 1) for (int i = threadIdx.x; i < 640; i += 512) p.gdone[i] = 0;
    for (int u = blockIdx.x; u < 128; u += gridDim.x) poolfold_unit(p, smem + (threadIdx.x >> 8) * HALF_LDS, u * 2 + (threadIdx.x >> 8));
    for (int i = blockIdx.x * 512 + threadIdx.x; i < 2 * 96 * DM; i += gridDim.x * 512) {
        const int k = i & (DM - 1), R = (i >> 10) % 96, layer = i / (96 * DM);
        const int T = R >> 5, r = R & 31, L = 16 * T + (r & 3) + 4 * (r >> 3);
        float w = 0.f;
        if (L < 32) w = p.w_re[((size_t)layer * DM + k) * 32 + L]; else if (L < 36) w = p.w_rg[((size_t)layer * DM + k) * 4 + (L - 32)];
        w *= p.ffn_norm[layer * DM + k];
        const unsigned hi = pack2(w, 0.f) & 0xffffu;
        p.wr_hi[i] = (bf16_t)hi; p.wr_lo[i] = (bf16_t)(pack2(w - __uint_as_float(hi << 16), 0.f) & 0xffffu);
    }
    const int wave = threadIdx.x >> 6, lane = threadIdx.x & 63;
    for (int u = blockIdx.x; u < NTOK / 16; u += gridDim.x) {
        const int tok = u * 16 + wave * 2;
        cast_rows2(p, tok, lane);
    }
    convert_flat(p.w_in_even, p.wb_in_even, (size_t)DM * EVEN_IN / 8, p.mix_norm_even, EVEN_IN);
    convert_flat(p.w_out_even, p.wb_out_even, (size_t)512 * DM / 8);
}
DI void convert_experts(const P& p, int layer) {
    const size_t o = (size_t)layer * NEXP * DM * FF;
    convert_flat(p.w_gate + o, p.wb_gate + o, (size_t)NEXP * DM * FF / 8);
    convert_flat(p.w_up + o, p.wb_up + o, (size_t)NEXP * DM * FF / 8);
    convert_flat(p.w_down + o, p.wb_down + o, (size_t)NEXP * DM * FF / 8);
}

DI int crow(int i, int h) { return (i & 3) + 8 * (i >> 2) + 4 * h; }
DI float swap_max(float v) { auto rr = __builtin_amdgcn_permlane32_swap(__float_as_uint(v), __float_as_uint(v), false, false); return fmaxf(__uint_as_float(rr[0]), __uint_as_float(rr[1])); }
DI float swap_sum(float v) { auto rr = __builtin_amdgcn_permlane32_swap(__float_as_uint(v), __float_as_uint(v), false, false); return __uint_as_float(rr[0]) + __uint_as_float(rr[1]); }
DI float bcast_lo(float v) { auto rr = __builtin_amdgcn_permlane32_swap(__float_as_uint(v), __float_as_uint(v), false, false); return __uint_as_float(rr[0]); }
DI bf16x8 pack8(const f32x16& x, int s) {
    u32x4 w; w.x = pack2(x[8 * s], x[8 * s + 1]); w.y = pack2(x[8 * s + 2], x[8 * s + 3]); w.z = pack2(x[8 * s + 4], x[8 * s + 5]); w.w = pack2(x[8 * s + 6], x[8 * s + 7]);
    return __builtin_bit_cast(bf16x8, w);
}
constexpr int KV_TILE = 8192;
struct KVStage { u32x4 k[2], v[2]; };
DI void kv_load(KVStage& st, const bf16_t* kbase, const bf16_t* vbase, int ld, int key0) {
    const int tid = opaque_tid() & 255, c = tid & 7, r0 = tid >> 3;
#pragma unroll
    for (int i = 0; i < 2; ++i) { const size_t off = (size_t)(key0 + r0 + 32 * i) * ld + c * 8; st.k[i] = *(const u32x4*)(kbase + off); st.v[i] = *(const u32x4*)(vbase + off); }
}
DI void kv_store(const KVStage& st, char* kt, char* vt) {
    const int tid = opaque_tid() & 255, c = tid & 7, r0 = tid >> 3;
#pragma unroll
    for (int i = 0; i < 2; ++i) { const int r = r0 + 32 * i;
        *(u32x4*)(kt + r * 128 + ((c ^ ((r >> 1) & 7)) << 4)) = st.k[i];
        *(u32x4*)(vt + r * 128 + ((((c >> 2) ^ ((r >> 1) & 1))) << 6) + ((c & 3) << 4)) = st.v[i]; }
}
DI bf16x8 k_frag(const char* kt, int sb, int st, int r32, int hh) {
    const int row = sb * 32 + r32;
    return *(const bf16x8*)(kt + row * 128 + (((2 * st + hh) ^ ((row >> 1) & 7)) << 4));
}
DI bf16x8 vt_frag(const char* vt, int sb, int st, int dh, int lane) {
    const int hh = lane >> 5, g1 = (lane >> 4) & 1, pp = lane & 3, q = (lane & 15) >> 2;
    const int key = sb * 32 + 16 * st + 4 * hh + q;
    const char* a = vt + key * 128 + ((dh ^ ((q >> 1) & 1)) << 6) + g1 * 32 + pp * 8;
    const s16x4 lo = tr_read(a), hi = tr_read(a + 8 * 128);
    return (bf16x8){lo[0], lo[1], lo[2], lo[3], hi[0], hi[1], hi[2], hi[3]};
}


#define XB_TMO      128
#define XB_XCNT(j)  (256  + 64 * (j))
#define XB_XSUB(j)  (1280 + 64 * (j))
#define XB_XGEN(j)  (2304 + 64 * (j))
#define XB_TOP      3328
#define XB_TOPGEN   3392
#define XCD_BAR_WORDS 3456
#define XB_SPIN_CAP (1u << 22)
DI unsigned xb_ld(unsigned* q)              { return __hip_atomic_load(q, __ATOMIC_RELAXED, __HIP_MEMORY_SCOPE_AGENT); }
DI unsigned xb_add(unsigned* q, unsigned v) { return __hip_atomic_fetch_add(q, v, __ATOMIC_RELAXED, __HIP_MEMORY_SCOPE_AGENT); }
DI unsigned xb_xcc_id() { return (unsigned)__builtin_amdgcn_s_getreg((3 << 11) | 20) & 0xFu; }
#define XB_SPIN(cond, bar) do { unsigned _sp = 0; while (cond) { __builtin_amdgcn_s_sleep(1); \
    if ((++_sp & 255u) == 0u) { if (xb_ld(&(bar)[XB_TMO])) break; if (_sp > XB_SPIN_CAP) { atomicAdd(&(bar)[XB_TMO], 1u); break; } } } } while (0)
struct XcdBarrier { unsigned* bar; unsigned x; volatile LDSAS unsigned* st; };
DI XcdBarrier xcd_barrier_post(unsigned* bar, volatile LDSAS unsigned* st) {
    XcdBarrier b; b.bar = bar; b.x = xb_xcc_id(); b.st = st;
    if (threadIdx.x == 0) (void)xb_add(&bar[XB_XCNT(b.x)], 1u);
    return b;
}
DI void xcd_barrier_complete(unsigned* bar, unsigned x, unsigned& nloc, unsigned& nx) {
    const unsigned G = gridDim.x * gridDim.y * gridDim.z;
    unsigned sum, cnt, mine, sp = 0u;
    for (;;) {
        sum = 0u; cnt = 0u; mine = 0u;
#pragma unroll
        for (unsigned j = 0; j < 16; ++j) { const unsigned c = xb_ld(&bar[XB_XCNT(j)]); sum += c; cnt += (c > 0u) ? 1u : 0u; mine = (j == x) ? c : mine; }
        if (sum == G) break;
        __builtin_amdgcn_s_sleep(1);
        if ((++sp & 255u) == 0u) { if (xb_ld(&bar[XB_TMO])) break; if (sp > XB_SPIN_CAP) { atomicAdd(&bar[XB_TMO], 1u); break; } }
    }
    nloc = mine > 0u ? mine : 1u; nx = cnt > 0u ? cnt : 1u;
}
DI void xcd_barrier(const XcdBarrier& b) {
    asm volatile("s_waitcnt vmcnt(0)" ::: "memory");
    __syncthreads();
    if (threadIdx.x == 0) {
        unsigned* bar = b.bar;
        __builtin_amdgcn_s_waitcnt(0);
        unsigned nloc = b.st[0], nx = b.st[1];
        if (nloc == 0u) { xcd_barrier_complete(bar, b.x, nloc, nx); b.st[0] = nloc; b.st[1] = nx; }
        const unsigned old = xb_add(&bar[XB_XSUB(b.x)], 1u);
        const unsigned gen = old / nloc;
        if (old + 1u == (gen + 1u) * nloc) {
            __builtin_amdgcn_fence(__ATOMIC_RELEASE, "agent");
            asm volatile("s_waitcnt vmcnt(0)" ::: "memory");
            const unsigned og = xb_add(&bar[XB_TOP], 1u);
            const unsigned tg = og / nx;
            if (og + 1u == (tg + 1u) * nx) xb_add(&bar[XB_TOPGEN], 1u);
            else XB_SPIN(xb_ld(&bar[XB_TOPGEN]) == tg, bar);
            __builtin_amdgcn_fence(__ATOMIC_ACQUIRE, "agent");
            xb_add(&bar[XB_XGEN(b.x)], 1u);
            asm volatile("s_waitcnt vmcnt(0)" ::: "memory");
        } else {
            XB_SPIN(xb_ld(&bar[XB_XGEN(b.x)]) == gen, bar);
            __builtin_amdgcn_fence(__ATOMIC_ACQUIRE, "agent");
            asm volatile("s_waitcnt vmcnt(0)" ::: "memory");
        }
    }
    __syncthreads();
}


struct ConvPlan { int layer; int sl_e, sl_in, sl_out, nslots; };
template <int NV> DI ConvPlan conv_plan(const P& p, int layer) {
    ConvPlan c; c.layer = layer;
    const unsigned per = gridDim.x * 512u, gsz = 4 * NV;
    c.sl_e = (int)((NEXP * DM * FF / gsz + per - 1) / per);
    c.sl_in = layer == 0 ? (int)((DM * ODD_IN / gsz + per - 1) / per) : 0;
    c.sl_out = layer == 0 ? (int)((DM * DM / gsz + per - 1) / per) : 0;
    c.nslots = 3 * c.sl_e + c.sl_in + c.sl_out;
    return c;
}
template <int NV> DI void conv_locate(const P& p, const ConvPlan& c, int slot, const float*& s, bf16_t*& d, const float*& gp) {
    constexpr unsigned gsz = 4 * NV;
    int seg = 0, ls = slot;
    if (ls < 3 * c.sl_e) { seg = ls / c.sl_e; ls -= seg * c.sl_e; }
    else if ((ls -= 3 * c.sl_e) < c.sl_in) seg = 3;
    else { ls -= c.sl_in; seg = 4; }
    const unsigned ng = seg < 3 ? NEXP * DM * FF / gsz : (seg == 3 ? DM * ODD_IN / gsz : DM * DM / gsz);
    const unsigned gi = ((unsigned)ls * gridDim.x + blockIdx.x) * 512u + threadIdx.x;
    const bool live = slot < c.nslots && gi < ng;
    const size_t e = live ? (size_t)gi * gsz : 0;
    const int tix = c.layer * 5 + __builtin_amdgcn_readfirstlane(seg);
    s = p.cs[tix] + e;
    d = live ? p.cd[tix] + e : p.dump + ((size_t)blockIdx.x * 512 + threadIdx.x) * 16;
    gp = p.ones;
    if (live && seg < 2) gp = p.ffn_norm + c.layer * DM + ((e >> 8) & (DM - 1));
    else if (live && seg == 3) gp = p.mix_norm_odd + e / ODD_IN;
}
#define CONV_DECL4(N) f32x4 N##0, N##1, N##2, N##3; float N##g; bf16_t* N##d
#define CONV_DECL2(N) f32x4 N##0, N##1; float N##g; bf16_t* N##d
#define CONV_LOAD4(N, SLOT) do { const float* s_; const float* g_; conv_locate<4>(p, cv, (SLOT), s_, N##d, g_); \
        N##g = *g_; N##0 = *(const f32x4*)s_; N##1 = *(const f32x4*)(s_ + 4); N##2 = *(const f32x4*)(s_ + 8); N##3 = *(const f32x4*)(s_ + 12); } while (0)
#define CONV_LOAD2(N, SLOT) do { const float* s_; const float* g_; conv_locate<2>(p, cv, (SLOT), s_, N##d, g_); \
        N##g = *g_; N##0 = *(const f32x4*)s_; N##1 = *(const f32x4*)(s_ + 4); } while (0)
#define CONV_STORE4(N) do { const f32x4 a_ = N##0 * N##g, b_ = N##1 * N##g, c_ = N##2 * N##g, e_ = N##3 * N##g; u32x4 w_; \
        w_.x = pack2(a_[0], a_[1]); w_.y = pack2(a_[2], a_[3]); w_.z = pack2(b_[0], b_[1]); w_.w = pack2(b_[2], b_[3]); *(u32x4*)N##d = w_; \
        w_.x = pack2(c_[0], c_[1]); w_.y = pack2(c_[2], c_[3]); w_.z = pack2(e_[0], e_[1]); w_.w = pack2(e_[2], e_[3]); *(u32x4*)(N##d + 8) = w_; } while (0)
#define CONV_STORE2(N) do { const f32x4 a_ = N##0 * N##g, b_ = N##1 * N##g; u32x4 w_; \
        w_.x = pack2(a_[0], a_[1]); w_.y = pack2(a_[2], a_[3]); w_.z = pack2(b_[0], b_[1]); w_.w = pack2(b_[2], b_[3]); *(u32x4*)N##d = w_; } while (0)

DI void band_attn_unit(const P& p, char* smem, int unit, const ConvPlan& cv, int& cslot) {
    const int tid = opaque_tid() & 255, lane = tid & 63, wid = tid >> 6, r32 = lane & 31, hh = lane >> 5;
    const int cp = unit & 31, h = (unit >> 5) & 7, b = unit >> 8;
    const int c = 2 * cp + (wid >> 1);
    const int tq = c * 64 + (wid & 1) * 32 + r32;
    const size_t rowb = (size_t)b * NS;
    const bf16_t* kbase = p.proj + rowb * EVEN_IN + 512 + h * 64;
    const bf16_t* vbase = p.proj + rowb * EVEN_IN + 1024 + h * 64;
    float* sbias = (float*)(smem + 4 * KV_TILE);
    __syncthreads();
    for (int i = tid; i < 257; i += 256) sbias[i] = p.att_rel_bias[h * 257 + i] * LOG2E;
    bf16x8 qf[4];
#pragma unroll
    for (int st = 0; st < 4; ++st) qf[st] = *(const bf16x8*)(p.proj + (rowb + tq) * EVEN_IN + h * 64 + st * 16 + hh * 8);
    const int ck0 = (2 * cp - 8) > 0 ? (2 * cp - 8) : 0, nt = 2 * cp + 2 - ck0;
    float m = -3.0e38f, lsum = 0.f;
    f32x16 o0, o1;
#pragma unroll
    for (int i = 0; i < 16; ++i) { o0[i] = 0.f; o1[i] = 0.f; }
    KVStage stg;
    kv_load(stg, kbase, vbase, EVEN_IN, ck0 * 64);
    kv_store(stg, smem, smem + 2 * KV_TILE);
    __syncthreads();
    CONV_DECL4(cA); CONV_DECL4(cB);
    CONV_LOAD4(cA, cslot++); CONV_LOAD4(cB, cslot++);
#define BAND_ITER(it, CRX) do { \
        const int ck = ck0 + it, cur = it & 1; \
        kv_load(stg, kbase, vbase, EVEN_IN, ((it + 1 < nt) ? ck + 1 : ck) * 64); \
        CONV_STORE4(CRX); CONV_LOAD4(CRX, cslot++); \
        __builtin_amdgcn_sched_barrier(0); \
        const char* kt = smem + cur * KV_TILE; const char* vt = smem + (2 + cur) * KV_TILE; \
        if (ck >= c - 8 && ck <= c) { \
            f32x16 s0, s1; \
_Pragma("unroll") \
            for (int i = 0; i < 16; ++i) { s0[i] = 0.f; s1[i] = 0.f; } \
_Pragma("unroll") \
            for (int st = 0; st < 4; ++st) { s0 = MFMA32(k_frag(kt, 0, st, r32, hh), qf[st], s0); s1 = MFMA32(k_frag(kt, 1, st, r32, hh), qf[st], s1); } \
            if (c - ck >= 3) { const float bb = sbias[256]; \
_Pragma("unroll") \
                for (int i = 0; i < 16; ++i) { s0[i] += bb; s1[i] += bb; } \
            } else { \
                const int d0 = tq - ck * 64 - 4 * hh; \
_Pragma("unroll") \
                for (int i = 0; i < 16; ++i) { \
                    int da = d0 - ((i & 3) + 8 * (i >> 2)), db = da - 32; \
                    da = da > 128 ? 128 : da; db = db > 128 ? 128 : db; \
                    s0[i] += sbias[da + 128]; s1[i] += sbias[db + 128]; \
                } \
            } \
            float tm = fmaxf(s0[0], s1[0]); \
_Pragma("unroll") \
            for (int i = 1; i < 16; ++i) tm = fmaxf(tm, fmaxf(s0[i], s1[i])); \
            tm = swap_max(tm); \
            const float mn = fmaxf(m, tm); \
            const float alpha = __builtin_amdgcn_exp2f(m - mn); \
            m = mn; \
            float ps = 0.f; \
_Pragma("unroll") \
            for (int i = 0; i < 16; ++i) { s0[i] = __builtin_amdgcn_exp2f(s0[i] - mn); s1[i] = __builtin_amdgcn_exp2f(s1[i] - mn); ps += s0[i] + s1[i]; } \
            lsum = lsum * alpha + ps; \
_Pragma("unroll") \
            for (int i = 0; i < 16; ++i) { o0[i] *= alpha; o1[i] *= alpha; } \
_Pragma("unroll") \
            for (int st = 0; st < 2; ++st) { \
                const bf16x8 pa = pack8(s0, st), pb = pack8(s1, st); \
                o0 = MFMA32(vt_frag(vt, 0, st, 0, lane), pa, o0); o1 = MFMA32(vt_frag(vt, 0, st, 1, lane), pa, o1); \
                o0 = MFMA32(vt_frag(vt, 1, st, 0, lane), pb, o0); o1 = MFMA32(vt_frag(vt, 1, st, 1, lane), pb, o1); \
            } \
        } \
        __builtin_amdgcn_sched_barrier(0); \
        kv_store(stg, smem + (cur ^ 1) * KV_TILE, smem + (2 + (cur ^ 1)) * KV_TILE); \
        __syncthreads(); \
    } while (0)
    for (int it = 0; it < nt; it += 2) {
        BAND_ITER(it, cA);
        if (it + 1 >= nt) break;
        BAND_ITER(it + 1, cB);
    }
#undef BAND_ITER
    CONV_STORE4(cA); CONV_STORE4(cB);
    const float inv = 1.0f / swap_sum(lsum);
    bf16_t* orow = p.mixed + (rowb + tq) * DM + h * 64 + 4 * hh;
#pragma unroll
    for (int g = 0; g < 4; ++g) {
        u32x2 w0, w1;
        w0.x = pack2(o0[4 * g] * inv, o0[4 * g + 1] * inv); w0.y = pack2(o0[4 * g + 2] * inv, o0[4 * g + 3] * inv);
        w1.x = pack2(o1[4 * g] * inv, o1[4 * g + 1] * inv); w1.y = pack2(o1[4 * g + 2] * inv, o1[4 * g + 3] * inv);
        *(u32x2*)(orow + 8 * g) = w0; *(u32x2*)(orow + 32 + 8 * g) = w1;
    }
}

DI void sb_attn_unit(const P& p, char* smem, volatile int* wdone, int unit, const ConvPlan& cv, int& cslot) {
    const int tid8 = opaque_tid(), tid = tid8 & 255, lane = tid & 63, wid = tid >> 6, r32 = lane & 31, hh = lane >> 5, wid8 = tid8 >> 6;
    const int qb = unit & 31, h = (unit >> 5) & 7, b = unit >> 8;
    const int tw = qb * 128 + wid * 32, t = tw + r32;
    const size_t rowb = (size_t)b * NS;
    const bf16_t* kbase = p.proj + rowb * ODD_IN + 1536 + h * 64;
    const bf16_t* vbase = p.proj + rowb * ODD_IN + 2048 + h * 64;
    __syncthreads();
    bf16x8 qf[4];
#pragma unroll
    for (int st = 0; st < 4; ++st) qf[st] = *(const bf16x8*)(p.proj + (rowb + t) * ODD_IN + 1024 + h * 64 + st * 16 + hh * 8);
    bf16x8 tf[2];
#pragma unroll
    for (int st = 0; st < 2; ++st)
#pragma unroll
        for (int j = 0; j < 8; ++j) tf[st][j] = (16 * st + 8 * (j >> 2) + 4 * hh + (j & 3)) >= r32 ? (short)0x3F80 : (short)0;
    f32x16 o0, o1;
#pragma unroll
    for (int i = 0; i < 16; ++i) { o0[i] = 0.f; o1[i] = 0.f; }
    float carry = 0.f; bool done = false;
    const int kt0 = 2 * qb + 1;
    KVStage stg;
    kv_load(stg, kbase, vbase, ODD_IN, kt0 * 64);
    kv_store(stg, smem, smem + 2 * KV_TILE);
    __syncthreads();
    bool all_done = false;
    CONV_DECL2(cA);
    CONV_LOAD2(cA, cslot++);
#define SB_ITER(it, CRX) do { \
        const int kt = kt0 - it, cur = it & 1; \
        kv_load(stg, kbase, vbase, ODD_IN, (kt > 0 ? kt - 1 : 0) * 64); \
        CONV_STORE2(CRX); CONV_LOAD2(CRX, cslot++); \
        __builtin_amdgcn_sched_barrier(0); \
        const char* ktile = smem + cur * KV_TILE; const char* vtile = smem + (2 + cur) * KV_TILE; \
        if (!done && kt * 64 < tw + 31) { \
_Pragma("unroll") \
            for (int sbi = 0; sbi < 2; ++sbi) { \
                const int sb = 1 - sbi; \
                f32x16 x; \
_Pragma("unroll") \
                for (int i = 0; i < 16; ++i) x[i] = 0.f; \
_Pragma("unroll") \
                for (int st = 0; st < 4; ++st) x = MFMA32(k_frag(ktile, sb, st, r32, hh), qf[st], x); \
                const int kb = kt * 64 + sb * 32 + 4 * hh; \
                f32x16 L; \
_Pragma("unroll") \
                for (int i = 0; i < 16; ++i) { \
                    const bool valid = kb + (i & 3) + 8 * (i >> 2) < t; \
                    const float z = x[i]; \
                    const float sp = fmaxf(z, 0.f) + __builtin_amdgcn_logf(1.0f + __builtin_amdgcn_exp2f(-fabsf(z))); \
                    L[i] = valid ? -sp : 0.f; \
                    x[i] = valid ? z : -1.0e30f; \
                } \
                f32x16 cum; \
_Pragma("unroll") \
                for (int i = 0; i < 16; ++i) cum[i] = carry; \
_Pragma("unroll") \
                for (int st = 0; st < 2; ++st) cum = MFMA32(tf[st], pack8(L, st), cum); \
                carry = bcast_lo(cum[0]); \
_Pragma("unroll") \
                for (int i = 0; i < 16; ++i) x[i] = __builtin_amdgcn_exp2f(x[i] + cum[i]); \
_Pragma("unroll") \
                for (int st = 0; st < 2; ++st) { \
                    const bf16x8 pa = pack8(x, st); \
                    o0 = MFMA32(vt_frag(vtile, sb, st, 0, lane), pa, o0); o1 = MFMA32(vt_frag(vtile, sb, st, 1, lane), pa, o1); \
                } \
            } \
            done = __all(carry < -150.0f); \
        } \
        __builtin_amdgcn_sched_barrier(0); \
        if (lane == 0) wdone[cur * 8 + wid8] = done ? 1 : 0; \
        kv_store(stg, smem + (cur ^ 1) * KV_TILE, smem + (2 + (cur ^ 1)) * KV_TILE); \
        __syncthreads(); \
        all_done = (wdone[cur * 8] + wdone[cur * 8 + 1] + wdone[cur * 8 + 2] + wdone[cur * 8 + 3] + wdone[cur * 8 + 4] + wdone[cur * 8 + 5] + wdone[cur * 8 + 6] + wdone[cur * 8 + 7] == 8); \
    } while (0)
#pragma nounroll
    for (int it = 0; it <= kt0; ++it) {
        SB_ITER(it, cA);
        if (all_done) break;
    }
#undef SB_ITER
    CONV_STORE2(cA);
    bf16_t* orow = p.mixed + (rowb + t) * DM + 512 + h * 64 + 4 * hh;
#pragma unroll
    for (int g = 0; g < 4; ++g) {
        u32x2 w0, w1;
        w0.x = pack2(o0[4 * g], o0[4 * g + 1]); w0.y = pack2(o0[4 * g + 2], o0[4 * g + 3]);
        w1.x = pack2(o1[4 * g], o1[4 * g + 1]); w1.y = pack2(o1[4 * g + 2], o1[4 * g + 3]);
        *(u32x2*)(orow + 8 * g) = w0; *(u32x2*)(orow + 32 + 8 * g) = w1;
    }
}

DI void pool_items(const P& p) {
    for (int it = blockIdx.x * 512 + threadIdx.x; it < NTOK * 64; it += gridDim.x * 512) {
        const int tok = it >> 6, ch8 = it & 63, g = ch8 >> 4, w = 2 << g, s = tok & (NS - 1);
        const int n = (s + 1 < w) ? s + 1 : w;
        float sum[8], own[8];
#pragma unroll
        for (int j = 0; j < 8; ++j) sum[j] = 0.f;
        const bf16_t* src = p.proj + (size_t)tok * EVEN_IN + 1536 + ch8 * 8;
        u32x4 wv[16];
#pragma unroll
        for (int t = 0; t < 16; ++t) wv[t] = (t < n) ? *(const u32x4*)(src - (size_t)t * EVEN_IN) : (u32x4){0u, 0u, 0u, 0u};
#pragma unroll
        for (int t = 0; t < 16; ++t) { unpack8(wv[t], own);
#pragma unroll
            for (int j = 0; j < 8; ++j) sum[j] += own[j]; }
        unpack8(wv[0], own);
        const float inv = 1.0f / (float)n;
        u32x4 o; o.x = pack2(sum[0] * inv - own[0], sum[1] * inv - own[1]); o.y = pack2(sum[2] * inv - own[2], sum[3] * inv - own[3]);
        o.z = pack2(sum[4] * inv - own[4], sum[5] * inv - own[5]); o.w = pack2(sum[6] * inv - own[6], sum[7] * inv - own[7]);
        *(u32x4*)(p.mixed + (size_t)tok * DM + 512 + ch8 * 8) = o;
    }
}

DI void sgu_unit(const P& p, char* smem, int unit) {
    const int tid = opaque_tid() & 255, lane = tid & 63, wid = tid >> 6, wm = wid >> 1, wn = wid & 1, fr = lane & 15, fq = lane >> 4;
    const int g = unit & 3; const size_t tok0 = (size_t)(unit >> 2) * 128;
    char* As = smem; char* Gs = smem + 32768; float* srstd = (float*)(smem + 65536);
    __syncthreads();
    {
        const int row = tid >> 1, half = tid & 1;
        const bf16_t* src = p.proj + (tok0 + row) * ODD_IN + 512 + half * 256;
        float ss = 0.f;
        for (int i = 0; i < 32; ++i) { float f[8]; unpack8(*(const u32x4*)(src + i * 8), f);
#pragma unroll
            for (int j = 0; j < 8; ++j) ss += f[j] * f[j]; }
        ss += __shfl_xor(ss, 1);
        if (half == 0) srstd[row] = rsqrtf(ss * (1.0f / 512.0f) + EPS);
    }
#pragma unroll
    for (int i = 0; i < 8; ++i) {
        const int idx = tid + 256 * i, s = idx >> 4, ch = idx & 15;
        const u32x4 v = *(const u32x4*)(p.proj + (tok0 + s) * ODD_IN + 512 + g * 128 + ch * 8);
        *(u32x4*)(Gs + s * 256 + (((ch >> 1) ^ kswz(s)) << 5) + ((ch & 1) << 4)) = v;
    }
    __syncthreads();
#pragma unroll
    for (int i = 0; i < 8; ++i) {
        const int idx = tid + 256 * i, t = idx >> 4, c8 = idx & 15, s0 = c8 * 8;
        const float* wr = p.sgu_w + ((size_t)g * 128 + t) * 128 + s0;
        const f32x4 a = *(const f32x4*)wr, b = *(const f32x4*)(wr + 4);
        float f[8] = {a[0], a[1], a[2], a[3], b[0], b[1], b[2], b[3]};
#pragma unroll
        for (int j = 0; j < 8; ++j) f[j] = (s0 + j <= t) ? f[j] * srstd[s0 + j] : 0.f;
        u32x4 w; w.x = pack2(f[0], f[1]); w.y = pack2(f[2], f[3]); w.z = pack2(f[4], f[5]); w.w = pack2(f[6], f[7]);
        *(u32x4*)(As + (c8 >> 3) * 16384 + t * 128 + (((c8 & 7) ^ (t & 7)) << 4)) = w;
    }
    __syncthreads();
    f32x4 acc[4][4];
#pragma unroll
    for (int a = 0; a < 4; ++a)
#pragma unroll
        for (int b = 0; b < 4; ++b) acc[a][b] = (f32x4){0.f, 0.f, 0.f, 0.f};
    const int qq = fr >> 2, pp = fr & 3;
#pragma unroll
    for (int kt = 0; kt < 2; ++kt) {
        if (kt == 1 && wm == 0) continue;
#pragma unroll
        for (int s2 = 0; s2 < 2; ++s2) {
            bf16x8 af[4], bfv[4];
#pragma unroll
            for (int i = 0; i < 4; ++i) {
                const int ra_ = wm * 64 + i * 16 + fr;
                af[i] = *(const bf16x8*)(As + kt * 16384 + ra_ * 128 + (((s2 * 4 + fq) ^ (fr & 7)) << 4));
                const int srow = kt * 64 + s2 * 32 + 8 * fq + qq, blk = wn * 4 + i;
                const s16x4 lo = tr_read(Gs + srow * 256 + ((blk ^ kswz(srow)) << 5) + pp * 8);
                const s16x4 hi = tr_read(Gs + (srow + 4) * 256 + ((blk ^ kswz(srow + 4)) << 5) + pp * 8);
                bfv[i] = (bf16x8){lo[0], lo[1], lo[2], lo[3], hi[0], hi[1], hi[2], hi[3]};
            }
#pragma unroll
            for (int mi = 0; mi < 4; ++mi)
#pragma unroll
                for (int ni = 0; ni < 4; ++ni) acc[mi][ni] = MFMA16(bfv[ni], af[mi], acc[mi][ni]);
        }
    }
#pragma unroll
    for (int mi = 0; mi < 4; ++mi) {
        const int t = wm * 64 + mi * 16 + fr;
        const float bias = p.sgu_b[g * 128 + t];
#pragma unroll
        for (int ni = 0; ni < 4; ++ni) {
            const int c = g * 128 + wn * 64 + ni * 16 + fq * 4;
            const f32x4 gn = *(const f32x4*)(p.sgu_v_norm + c);
            const u32x2 uu = *(const u32x2*)(p.proj + (tok0 + t) * ODD_IN + c);
            const float u0 = __uint_as_float(uu.x << 16), u1 = __uint_as_float(uu.x & 0xffff0000u), u2 = __uint_as_float(uu.y << 16), u3 = __uint_as_float(uu.y & 0xffff0000u);
            const f32x4 a = acc[mi][ni];
            u32x2 w; w.x = pack2(u0 * (gn[0] * a[0] + bias), u1 * (gn[1] * a[1] + bias)); w.y = pack2(u2 * (gn[2] * a[2] + bias), u3 * (gn[3] * a[3] + bias));
            *(u32x2*)(p.mixed + (tok0 + t) * DM + c) = w;
        }
    }
}

DI void router_unit(const P& p, char* smem, int layer, int unit) {
    const int tid = opaque_tid() & 255, lane = tid & 63, wid = tid >> 6, r32 = lane & 31, hh = lane >> 5;
    float (*part)[36][32] = (float (*)[36][32])smem;
    float (*wss)[32] = (float (*)[32])(smem + 18432);
    int* lcnt = (int*)(smem + 18432 + 512);
    int* lbase = lcnt + 32;
    int* cnt = p.cnt + layer * NEXP;
    const int tok = unit * 32 + r32, kq = wid * 256 + 8 * hh;
    __syncthreads();
    if (tid < 32) lcnt[tid] = 0;
    const bf16_t* hrow = p.hb + (size_t)tok * DM + kq;
    const bf16_t* whi = p.wr_hi + ((size_t)layer * 96 + r32) * DM + kq;
    const bf16_t* wlo = p.wr_lo + ((size_t)layer * 96 + r32) * DM + kq;
    f32x16 c0, c1, c2;
#pragma unroll
    for (int i = 0; i < 16; ++i) { c0[i] = 0.f; c1[i] = 0.f; c2[i] = 0.f; }
    float ss = 0.f;
#pragma unroll 4
    for (int st = 0; st < 16; ++st) {
        const u32x4 hw = *(const u32x4*)(hrow + 16 * st);
        float f[8]; unpack8(hw, f);
#pragma unroll
        for (int j = 0; j < 8; ++j) ss += f[j] * f[j];
        const bf16x8 hhi = __builtin_bit_cast(bf16x8, hw);
        bf16x8 wh, wl;
        wh = *(const bf16x8*)(whi + 16 * st); wl = *(const bf16x8*)(wlo + 16 * st);
        c0 = MFMA32(wh, hhi, c0); c0 = MFMA32(wl, hhi, c0);
        wh = *(const bf16x8*)(whi + 32 * DM + 16 * st); wl = *(const bf16x8*)(wlo + 32 * DM + 16 * st);
        c1 = MFMA32(wh, hhi, c1); c1 = MFMA32(wl, hhi, c1);
        wh = *(const bf16x8*)(whi + 64 * DM + 16 * st); wl = *(const bf16x8*)(wlo + 64 * DM + 16 * st);
        c2 = MFMA32(wh, hhi, c2); c2 = MFMA32(wl, hhi, c2);
    }
    {
        auto rr = __builtin_amdgcn_permlane32_swap(__float_as_uint(ss), __float_as_uint(ss), false, false);
        ss = __uint_as_float(rr[0]) + __uint_as_float(rr[1]);
        if (hh == 0) {
#pragma unroll
            for (int i = 0; i < 16; ++i) { part[wid][i][r32] = c0[i]; part[wid][16 + i][r32] = c1[i]; }
#pragma unroll
            for (int i = 0; i < 4; ++i) part[wid][32 + i][r32] = c2[i];
            wss[wid][r32] = ss;
        }
    }
    __syncthreads();
    int e1 = 0, e2 = 0, r1 = 0, r2 = 0; float w1 = 0.f, w2 = 0.f, rstd = 0.f;
    const int mytok = unit * 32 + tid;
    if (tid < 32) {
        rstd = rsqrtf((wss[0][tid] + wss[1][tid] + wss[2][tid] + wss[3][tid]) * (1.0f / DM) + EPS);
        float gl[4], ev[8];
#pragma unroll
        for (int j = 0; j < 4; ++j) gl[j] = (part[0][32 + j][tid] + part[1][32 + j][tid] + part[2][32 + j][tid] + part[3][32 + j][tid]) * rstd;
        int gs = 0; float gm = gl[0];
#pragma unroll
        for (int j = 1; j < 4; ++j) if (gl[j] > gm) { gm = gl[j]; gs = j; }
        const float gw = 1.0f / (__expf(gl[0] - gm) + __expf(gl[1] - gm) + __expf(gl[2] - gm) + __expf(gl[3] - gm));
#pragma unroll
        for (int j = 0; j < 8; ++j) { const int s = gs * 8 + j; ev[j] = (part[0][s][tid] + part[1][s][tid] + part[2][s][tid] + part[3][s][tid]) * rstd; }
        int i1 = 0; float v1 = ev[0];
#pragma unroll
        for (int j = 1; j < 8; ++j) if (ev[j] > v1) { v1 = ev[j]; i1 = j; }
        int i2 = -1; float v2 = -3.0e38f;
#pragma unroll
        for (int j = 0; j < 8; ++j) if (j != i1 && ev[j] > v2) { v2 = ev[j]; i2 = j; }
        w1 = 1.0f / (1.0f + __expf(v2 - v1)); w2 = (1.0f - w1) * gw; w1 *= gw;
        e1 = gs * 8 + i1; e2 = gs * 8 + i2;
        r1 = atomicAdd(lcnt + e1, 1); r2 = atomicAdd(lcnt + e2, 1);
    }
    __syncthreads();
    if (tid < 32) { const int n = lcnt[tid]; lbase[tid] = n ? atomicAdd(cnt + tid, n) : 0; }
    __syncthreads();
    if (tid < 32) {
        p.plist[(size_t)e1 * LISTCAP + lbase[e1] + r1] = mytok * 2; p.plist[(size_t)e2 * LISTCAP + lbase[e2] + r2] = mytok * 2 + 1;
        p.pw[mytok * 2] = w1; p.pw[mytok * 2 + 1] = w2; p.rs[mytok] = rstd;
    }
}
DI void ph_combine(const P& p, int layer) {
    const int wave = threadIdx.x >> 6, lane = threadIdx.x & 63;
    for (int u = blockIdx.x; u < NTOK / 16; u += gridDim.x) {
        const size_t tok0 = (size_t)u * 16 + wave * 2;
        u32x2 hv[2][4], ya[2][4], yb[2][4];
#pragma unroll
        for (int r = 0; r < 2; ++r)
#pragma unroll
            for (int i = 0; i < 4; ++i) {
                const int c = i * 256 + lane * 4;
                hv[r][i] = *(const u32x2*)(p.hb + (tok0 + r) * DM + c);
                ya[r][i] = *(const u32x2*)(p.y + ((tok0 + r) * 2) * DM + c); yb[r][i] = *(const u32x2*)(p.y + ((tok0 + r) * 2 + 1) * DM + c);
            }
#pragma unroll
        for (int r = 0; r < 2; ++r) {
            float ss = 0.f;
#pragma unroll
            for (int i = 0; i < 4; ++i) {
                const u32x2 h0 = hv[r][i], a = ya[r][i], b = yb[r][i];
                f32x4 h;
                h[0] = __uint_as_float(h0.x << 16) + __uint_as_float(a.x << 16) + __uint_as_float(b.x << 16);
                h[1] = __uint_as_float(h0.x & 0xffff0000u) + __uint_as_float(a.x & 0xffff0000u) + __uint_as_float(b.x & 0xffff0000u);
                h[2] = __uint_as_float(h0.y << 16) + __uint_as_float(a.y << 16) + __uint_as_float(b.y << 16);
                h[3] = __uint_as_float(h0.y & 0xffff0000u) + __uint_as_float(a.y & 0xffff0000u) + __uint_as_float(b.y & 0xffff0000u);
                ss += h[0] * h[0] + h[1] * h[1] + h[2] * h[2] + h[3] * h[3];
                if (layer == 0) { u32x2 w; w.x = pack2(h[0], h[1]); w.y = pack2(h[2], h[3]); *(u32x2*)(p.hb + (tok0 + r) * DM + i * 256 + lane * 4) = w; }
                else *(f32x4*)(p.out + (tok0 + r) * DM + i * 256 + lane * 4) = h;
            }
            if (layer == 0) { ss = wave_sum(ss); if (lane == 0) p.rsm[tok0 + r] = rsqrtf(ss * (1.0f / DM) + EPS); }
        }
    }
}

DI void ph_mix_even(const P& p, char* smem) {
    const int half = threadIdx.x >> 8;
    const ConvPlan cv = conv_plan<4>(p, 0); int cslot = 0;
    for (int u = blockIdx.x; u < NB * 4 * 32; u += gridDim.x) {
        const int cp = u & 31, hp = (u >> 5) & 3, b = u >> 7;
        band_attn_unit(p, smem + half * HALF_LDS, (b << 8) | ((hp * 2 + half) << 5) | cp, cv, cslot);
    }
    for (; cslot < cv.nslots; ++cslot) { CONV_DECL4(cR); CONV_LOAD4(cR, cslot); CONV_STORE4(cR); }
    pool_items(p);
}
DI void ph_mix_odd(const P& p, char* smem) {
    const int half = threadIdx.x >> 8;
    volatile int* wdone = (volatile int*)(smem + 2 * HALF_LDS);
    const ConvPlan cv = conv_plan<2>(p, 1); int cslot = 0;
    for (int u = blockIdx.x; u < NB * 4 * 32; u += gridDim.x) {
        const int qb = 31 - (u >> 4), hp = (u >> 2) & 3, b = u & 3;
        sb_attn_unit(p, smem + half * HALF_LDS, wdone, (b << 8) | ((hp * 2 + half) << 5) | qb, cv, cslot);
    }
    for (; cslot < cv.nslots; ++cslot) { CONV_DECL2(cR); CONV_LOAD2(cR, cslot); CONV_STORE2(cR); }
    for (int u = blockIdx.x; u < (NTOK / 128) * 2; u += gridDim.x) sgu_unit(p, smem + half * HALF_LDS, u * 2 + half);
}
DI void ph_router(const P& p, char* smem, int layer) {
    const int half = threadIdx.x >> 8;
    for (int u = blockIdx.x; u < NTOK / 64; u += gridDim.x) router_unit(p, smem + half * HALF_LDS, layer, u * 2 + half);
}

constexpr int NPHASE = 13;
#ifndef REPS
#define REPS {1,1,1,1,1,1,1,1,1,1,1,1,1}
#endif
__device__ constexpr int REP[13] = REPS;
__global__ __launch_bounds__(512, 2) void mega(P p, int ph0, int ph1) {
    __shared__ __attribute__((aligned(16))) char smem[SMEM_BYTES + 64 + 16 + 16];
    volatile LDSAS unsigned* xst = (volatile LDSAS unsigned*)(smem + SMEM_BYTES + 64);
    if (threadIdx.x < 4) xst[threadIdx.x] = 0u;
    __syncthreads();
    const XcdBarrier xb = xcd_barrier_post(p.bar, xst);
#define PHASE(i, call) if (ph0 <= (i) && (i) < ph1) { for (int r_ = 0; r_ < REP[i]; ++r_) { call; if (r_ + 1 < REP[i] || (i) + 1 < ph1) xcd_barrier(xb); } }
    PHASE(0, ph_prologue(p, smem))
    PHASE(1, (ph_gemm_dense<EPI_IN_EVEN, 4>(p, smem, p.hb, DM, p.wb_in_even, DM, EVEN_IN, 0, 0, 8)))
    PHASE(2, ph_mix_even(p, smem))
    PHASE(3, (ph_gemm_dense<EPI_OUT, 4>(p, smem, p.mixed, DM, p.wb_out_even, DM, DM, 0, 0, 4)))
    PHASE(4, ph_router(p, smem, 0))
    PHASE(5, ph_moe(p, smem, 0))
    PHASE(6, ph_combine(p, 0))
    PHASE(7, (ph_gemm_dense<EPI_IN_ODD, 4>(p, smem, p.hb, DM, p.wb_in_odd, DM, ODD_IN, 1, 0, 8), ph_gemm_dense<EPI_IN_ODD, 2>(p, smem, p.hb, DM, p.wb_in_odd, DM, ODD_IN, 1, 8, 2)))
    PHASE(8, ph_mix_odd(p, smem))
    PHASE(9, (ph_gemm_dense<EPI_OUT, 4>(p, smem, p.mixed, DM, p.wb_out_odd, DM, DM, 1, 0, 4)))
    PHASE(10, ph_router(p, smem, 1))
    PHASE(11, ph_moe(p, smem, 1))
    PHASE(12, ph_combine(p, 1))
}

extern "C" void kernel_launch(void* const* d_in, const int* in_sizes, int n_in, void* d_out, int out_size, void* d_ws, size_t ws_size, hipStream_t stream) {
    P p{};
    p.x = (const float*)d_in[0]; p.mix_norm_even = (const float*)d_in[1]; p.w_in_even = (const float*)d_in[2]; p.att_q_norm = (const float*)d_in[3];
    p.att_k_norm = (const float*)d_in[4]; p.att_rel_bias = (const float*)d_in[5]; p.pool_w = (const float*)d_in[6]; p.pool_scale = (const float*)d_in[7];
    p.w_out_even = (const float*)d_in[8]; p.mix_norm_odd = (const float*)d_in[9]; p.w_in_odd = (const float*)d_in[10]; p.sgu_v_norm = (const float*)d_in[11];
    p.sgu_w = (const float*)d_in[12]; p.sgu_b = (const float*)d_in[13]; p.w_out_odd = (const float*)d_in[14]; p.ffn_norm = (const float*)d_in[15];
    p.w_rg = (const float*)d_in[16]; p.w_re = (const float*)d_in[17]; p.w_gate = (const float*)d_in[18]; p.w_up = (const float*)d_in[19]; p.w_down = (const float*)d_in[20];
    p.out = (float*)d_out;
    char* ws = (char*)d_ws; size_t off = 0;
    auto take = [&](size_t bytes) { char* r = ws + off; off += (bytes + 255) & ~(size_t)255; return r; };
    p.wb_in_even = (bf16_t*)take((size_t)EVEN_IN * DM * 2);
    p.wb_out_even = (bf16_t*)take((size_t)DM * DM * 2);
    p.wb_in_odd = (bf16_t*)take((size_t)ODD_IN * DM * 2);
    p.wb_out_odd = (bf16_t*)take((size_t)DM * DM * 2);
    p.wb_gate = (bf16_t*)take((size_t)2 * NEXP * DM * FF * 2);
    p.wb_up = (bf16_t*)take((size_t)2 * NEXP * DM * FF * 2);
    p.wb_down = (bf16_t*)take((size_t)2 * NEXP * DM * FF * 2);
    p.wr_hi = (bf16_t*)take((size_t)2 * 96 * DM * 2);
    p.wr_lo = (bf16_t*)take((size_t)2 * 96 * DM * 2);
    p.hb = (bf16_t*)take((size_t)NTOK * DM * 2);
    p.proj = (bf16_t*)take((size_t)NTOK * ODD_IN * 2);
    p.y = p.proj;
    p.mixed = (bf16_t*)take((size_t)NTOK * DM * 2);
    p.hid = p.mixed;
    p.pw = (float*)take((size_t)NTOK * 2 * 4);
    p.rs = (float*)take((size_t)NTOK * 4);
    p.rsm = (float*)take((size_t)NTOK * 4);
    p.plist = (int*)take((size_t)NEXP * LISTCAP * 4);
    p.cnt = (int*)take(256);
    p.ones = (const float*)take(256);
    p.dump = (bf16_t*)take((size_t)512 * 512 * 32);
    p.gdone = (int*)take(640 * 4);
    p.bar = (unsigned*)take(XCD_BAR_WORDS * 4);
    (void)hipMemsetAsync(p.bar, 0, XCD_BAR_WORDS * 4, stream);
    for (int l = 0; l < 2; ++l) {
        const size_t o = (size_t)l * NEXP * DM * FF;
        p.cs[l * 5 + 0] = p.w_gate + o; p.cd[l * 5 + 0] = p.wb_gate + o;
        p.cs[l * 5 + 1] = p.w_up + o;   p.cd[l * 5 + 1] = p.wb_up + o;
        p.cs[l * 5 + 2] = p.w_down + o; p.cd[l * 5 + 2] = p.wb_down + o;
        p.cs[l * 5 + 3] = p.w_in_odd;   p.cd[l * 5 + 3] = p.wb_in_odd;
        p.cs[l * 5 + 4] = p.w_out_odd;  p.cd[l * 5 + 4] = p.wb_out_odd;
    }

    static int grid_blocks = 0;
    if (!grid_blocks) {
        int dev = 0, cus = 0, per_cu = 0;
        (void)hipGetDevice(&dev);
        (void)hipDeviceGetAttribute(&cus, hipDeviceAttributeMultiprocessorCount, dev);
        (void)hipOccupancyMaxActiveBlocksPerMultiprocessor(&per_cu, mega, 512, 0);
        if (per_cu < 1) per_cu = 1;
        grid_blocks = cus;
    }
    int ph0 = 0, ph1 = NPHASE;
    void* args[] = {&p, &ph0, &ph1};
    hipError_t e = hipLaunchCooperativeKernel((void*)mega, dim3(grid_blocks), dim3(512), args, 0, stream);
    if (e != hipSuccess) fprintf(stderr, "cooperative launch failed: %s (grid %d)\n", hipGetErrorString(e), grid_blocks);
}
```

```cpp
#include <hip/hip_runtime.h>
#include <hip/hip_cooperative_groups.h>
#include <stdint.h>
#include <stdio.h>

typedef unsigned short bf16_t;
typedef short bf16x8 __attribute__((ext_vector_type(8)));
typedef short s16x4 __attribute__((ext_vector_type(4)));
typedef float f32x2 __attribute__((ext_vector_type(2)));
typedef float f32x4 __attribute__((ext_vector_type(4)));
typedef float f32x16 __attribute__((ext_vector_type(16)));
typedef unsigned u32x4 __attribute__((ext_vector_type(4)));
typedef unsigned u32x2 __attribute__((ext_vector_type(2)));
typedef __bf16 bf16x2n __attribute__((ext_vector_type(2)));

#define DI __device__ __forceinline__
#define LDSAS __attribute__((address_space(3)))
#define MFMA32(a, b, c) __builtin_amdgcn_mfma_f32_32x32x16_bf16((a), (b), (c), 0, 0, 0)
#define MFMA16(a, b, c) __builtin_amdgcn_mfma_f32_16x16x32_bf16((a), (b), (c), 0, 0, 0)

constexpr int NB = 4, NS = 4096, NTOK = NB * NS, DM = 1024;
constexpr int EVEN_IN = 2048, ODD_IN = 2560;
constexpr int NEXP = 32, FF = 256;
constexpr int LISTCAP = NTOK;
constexpr float EPS = 1e-6f;
constexpr float LOG2E = 1.4426950408889634f;
constexpr float QSCALE = 0.125f * LOG2E;

DI int opaque_tid() { int t = threadIdx.x; asm volatile("" : "+v"(t)); return t; }
DI float bf2f(bf16_t b) { return __uint_as_float(((unsigned)b) << 16); }
DI unsigned pack2(float lo, float hi) { f32x2 v = {lo, hi}; bf16x2n r = __builtin_convertvector(v, bf16x2n); return __builtin_bit_cast(unsigned, r); }
DI float wave_sum(float v) { for (int o = 32; o > 0; o >>= 1) v += __shfl_xor(v, o); return v; }
DI float gelu_exact(float x) { return 0.5f * x * (1.0f + erff(x * 0.70710678118654752f)); }
DI s16x4 tr_read(const char* p) { return __builtin_bit_cast(s16x4, __builtin_amdgcn_ds_read_tr16_b64_v4i16((LDSAS s16x4*)p)); }
DI void unpack8(const u32x4 v, float* f) {
    f[0] = __uint_as_float(v.x << 16); f[1] = __uint_as_float(v.x & 0xffff0000u); f[2] = __uint_as_float(v.y << 16); f[3] = __uint_as_float(v.y & 0xffff0000u);
    f[4] = __uint_as_float(v.z << 16); f[5] = __uint_as_float(v.z & 0xffff0000u); f[6] = __uint_as_float(v.w << 16); f[7] = __uint_as_float(v.w & 0xffff0000u);
}
DI int kswz(int k) { return (k & 3) | ((k >> 1) & 4); }

struct P {
    const float *x, *mix_norm_even, *w_in_even, *att_q_norm, *att_k_norm, *att_rel_bias, *pool_w, *pool_scale, *w_out_even;
    const float *mix_norm_odd, *w_in_odd, *sgu_v_norm, *sgu_w, *sgu_b, *w_out_odd, *ffn_norm, *w_rg, *w_re, *w_gate, *w_up, *w_down;
    float* out;
    bf16_t *wb_in_even, *wb_out_even, *wb_in_odd, *wb_out_odd, *wb_gate, *wb_up, *wb_down, *wr_hi, *wr_lo;
    bf16_t *hb, *proj, *mixed, *hid, *y;
    float *pw, *rs, *rsm, *vss; int* plist; int* cnt; unsigned* bar; int* gdone;
    const float* cs[10]; bf16_t* cd[10]; const float* ones; bf16_t* dump;
};

enum { EPI_IN_EVEN = 0, EPI_IN_ODD = 1, EPI_OUT = 2, EPI_GU = 3, EPI_DOWN = 4 };
constexpr int G_ROWID = 131072;
constexpr int SMEM_BYTES = 131072 + 1024;
constexpr int HALF_LDS = 66048;

struct GemmArgs {
    const bf16_t* A; int lda; const int* gather; int mvalid; int gshift;
    const bf16_t* B0; const bf16_t* B1; int ldb; int gu;
    int K, m0, n0;
    bool rowid_ready;
};

DI f32x2 gelu_pk(f32x2 v) {
    const f32x2 av = __builtin_elementwise_abs(v), d = av * 0.2316418882f + 1.0f;
    f32x2 t; t.x = __builtin_amdgcn_rcpf(d.x); t.y = __builtin_amdgcn_rcpf(d.y);
    f32x2 q = t * 0.5307027145f + (-0.7265760135f); q = q * t + 0.7107068705f; q = q * t + (-0.142248368f); q = q * t + 0.127414796f; q = q * t;
    const f32x2 s = (v * v) * (-0.72134752044f);
    f32x2 e; e.x = __builtin_amdgcn_exp2f(s.x); e.y = __builtin_amdgcn_exp2f(s.y);
    const f32x2 m = v * (q * e), r = v - m;
    f32x2 o; o.x = v.x < 0.f ? m.x : r.x; o.y = v.y < 0.f ? m.y : r.y; return o;
}

DI void glds16(const void* gsrc, unsigned lds_dst) {
    unsigned keep;
    asm volatile("s_mov_b32 %0, m0\n\ts_mov_b32 m0, %2\n\ts_nop 0\n\tglobal_load_lds_dwordx4 %1, off\n\ts_mov_b32 m0, %0" : "=&s"(keep) : "v"(gsrc), "s"(lds_dst) : "memory");
}
DI void glds16_sc1(const void* gsrc, unsigned lds_dst) {
    unsigned keep;
    asm volatile("s_mov_b32 %0, m0\n\ts_mov_b32 m0, %2\n\ts_nop 0\n\tglobal_load_lds_dwordx4 %1, off sc1\n\ts_mov_b32 m0, %0" : "=&s"(keep) : "v"(gsrc), "s"(lds_dst) : "memory");
}
DI void st16_sc1(void* q, u32x4 v) { asm volatile("global_store_dwordx4 %0, %1, off sc1\n\ts_nop 1" :: "v"(q), "v"(v) : "memory"); }
template <int EPI, int MT>
DI void gemm_tile(const P& p, char* smem, const GemmArgs& g, int layer) {
    const int tid = opaque_tid(), lane = tid & 63, wid = tid >> 6, wm = wid >> 2, wn = wid & 3, r32 = lane & 31, hh = lane >> 5;
    int* rowid = (int*)(smem + G_ROWID);
    constexpr int NA = MT / 2;
    constexpr int IPT = NA + 2;
    const bf16_t* ap[NA]; const bf16_t* bp[2];
    if (g.gather && !g.rowid_ready) { if (tid < 64 * MT) rowid[tid] = (tid < g.mvalid) ? g.gather[tid] : -1; __syncthreads(); }
#pragma unroll
    for (int i = 0; i < NA; ++i) {
        const int r = (wid * NA + i) * 16 + (lane >> 2), kc = (lane & 3) ^ ((r >> 2) & 3);
        size_t arow;
        if (g.gather) { int id = rowid[r]; if (id < 0) id = rowid[0]; arow = (size_t)(id >> g.gshift); } else arow = (size_t)(g.m0 + r);
        ap[i] = g.A + arow * g.lda + kc * 8;
    }
#pragma unroll
    for (int i = 0; i < 2; ++i) {
        const int k = (wid * 2 + i) * 2 + (lane >> 5), sl = lane & 31, ch = (((sl >> 2) ^ (k & 7)) << 2) | (sl & 3);
        const bf16_t* bcol = g.gu ? ((((ch >> 2) & 1) ? g.B1 : g.B0) + (g.n0 >> 1) + (ch >> 3) * 32 + (ch & 3) * 8) : (g.B0 + g.n0 + ch * 8);
        bp[i] = bcol + (size_t)k * g.ldb;
    }
    const size_t bstep = (size_t)32 * g.ldb;
    float gu_w[MT], gu_rs[MT];
    if (EPI == EPI_GU) {
#pragma unroll
        for (int mt = 0; mt < MT; ++mt) { const int id = rowid[wm * 32 * MT + mt * 32 + r32]; gu_w[mt] = id >= 0 ? p.pw[id] : 0.f; gu_rs[mt] = id >= 0 ? p.rs[id >> 1] : 0.f; }
    }
    f32x16 acc[MT][2];
#pragma unroll
    for (int a = 0; a < MT; ++a)
#pragma unroll
        for (int b = 0; b < 2; ++b)
#pragma unroll
            for (int i = 0; i < 16; ++i) acc[a][b][i] = 0.f;
    const int nk = g.K / 32;
    const int arow0 = wm * 32 * MT + r32;
    const int asw = (r32 >> 2) & 3;
    const int g1 = (lane >> 4) & 1, qq = (lane & 15) >> 2, pp = lane & 3;
    const int bk0 = 8 * hh + qq;
    const unsigned ldsb = (unsigned)(size_t)(LDSAS char*)smem;
    const unsigned adst = ldsb + (wid * NA) * 1024, bdst = ldsb + 16384 + (wid * 2) * 1024;
#define G_LOAD(KT) do { const unsigned so_ = (unsigned)((KT) & 3) * 32768u; \
        _Pragma("unroll") for (int i = 0; i < NA; ++i) { if (EPI == EPI_DOWN) glds16_sc1(ap[i] + (KT) * 32, (unsigned)__builtin_amdgcn_readfirstlane(adst + so_ + i * 1024)); \
                                                        else glds16(ap[i] + (KT) * 32, (unsigned)__builtin_amdgcn_readfirstlane(adst + so_ + i * 1024)); } \
        _Pragma("unroll") for (int i = 0; i < 2; ++i) glds16(bp[i] + (size_t)(KT) * bstep, (unsigned)__builtin_amdgcn_readfirstlane(bdst + so_ + i * 1024)); } while (0)
#define G_COMPUTE(KT) do { const char* Ac = smem + ((KT) & 3) * 32768; const char* Bc = Ac + 16384; \
        _Pragma("unroll") for (int st = 0; st < 2; ++st) { bf16x8 af[MT], bfv[2]; \
            _Pragma("unroll") for (int mt = 0; mt < MT; ++mt) af[mt] = *(const bf16x8*)(Ac + (arow0 + mt * 32) * 64 + (((2 * st + hh) ^ asw) << 4)); \
            _Pragma("unroll") for (int nt = 0; nt < 2; ++nt) { const int k = 16 * st + bk0; \
                const char* b0_ = Bc + k * 512 + (((wn * 2 + nt) ^ (k & 7)) << 6) + g1 * 32 + pp * 8; \
                const char* b1_ = Bc + (k + 4) * 512 + (((wn * 2 + nt) ^ ((k + 4) & 7)) << 6) + g1 * 32 + pp * 8; \
                const s16x4 lo = tr_read(b0_), hi = tr_read(b1_); \
                bfv[nt] = (bf16x8){lo[0], lo[1], lo[2], lo[3], hi[0], hi[1], hi[2], hi[3]}; } \
            _Pragma("unroll") for (int mt = 0; mt < MT; ++mt) _Pragma("unroll") for (int nt = 0; nt < 2; ++nt) acc[mt][nt] = MFMA32(bfv[nt], af[mt], acc[mt][nt]); } } while (0)
#define G_WAIT(N) do { if ((N) == 2) { if (IPT == 4) asm volatile("s_waitcnt vmcnt(8)" ::: "memory"); else asm volatile("s_waitcnt vmcnt(6)" ::: "memory"); } \
                       else if ((N) == 1) { if (IPT == 4) asm volatile("s_waitcnt vmcnt(4)" ::: "memory"); else asm volatile("s_waitcnt vmcnt(3)" ::: "memory"); } \
                       else asm volatile("s_waitcnt vmcnt(0)" ::: "memory"); } while (0)
    G_LOAD(0); G_LOAD(1); G_LOAD(2);
    G_WAIT(2); __syncthreads();
#pragma nounroll
    for (int kt = 0; kt < nk; ++kt) {
        if (kt + 3 < nk) G_LOAD(kt + 3);
        G_COMPUTE(kt);
        if (kt + 3 < nk) G_WAIT(2); else if (kt + 2 < nk) G_WAIT(1); else G_WAIT(0);
        __syncthreads();
    }
#undef G_LOAD
#undef G_COMPUTE
#undef G_WAIT
    const int colw = g.n0 + wn * 64;
    char* wsl = smem + wid * 16384;
    const int rowb = wm * 32 * MT;
    if (EPI == EPI_IN_EVEN || EPI == EPI_IN_ODD || EPI == EPI_DOWN) {
        const int region = colw >> 9;
        const float* gn = region == 0 ? p.att_q_norm : p.att_k_norm;
        const bool act = colw < 1024;
        const float qs = (colw >= 1024 && colw < 1536) ? QSCALE : 1.0f;
#pragma unroll
        for (int mt = 0; mt < MT; ++mt) {
            float sc = 1.f;
            if (EPI == EPI_IN_EVEN || EPI == EPI_IN_ODD) {
                const float rr_ = p.rsm[g.m0 + rowb + mt * 32 + r32];
#pragma unroll
                for (int nt = 0; nt < 2; ++nt) acc[mt][nt] = acc[mt][nt] * rr_;
            }
            if (EPI == EPI_IN_EVEN && region < 2) {
                float ss = 0.f;
#pragma unroll
                for (int nt = 0; nt < 2; ++nt)
#pragma unroll
                    for (int i = 0; i < 16; ++i) ss += acc[mt][nt][i] * acc[mt][nt][i];
                auto rr = __builtin_amdgcn_permlane32_swap(__float_as_uint(ss), __float_as_uint(ss), false, false);
                ss = __uint_as_float(rr[0]) + __uint_as_float(rr[1]);
                sc = rsqrtf(ss * (1.0f / 64.0f) + EPS) * (region == 0 ? QSCALE : 1.0f);
            }
            float vsum = 0.f;
#pragma unroll
            for (int nt = 0; nt < 2; ++nt)
#pragma unroll
                for (int gq = 0; gq < 4; ++gq) {
                    f32x2 v0 = {acc[mt][nt][4 * gq], acc[mt][nt][4 * gq + 1]}, v1 = {acc[mt][nt][4 * gq + 2], acc[mt][nt][4 * gq + 3]};
                    if (EPI == EPI_IN_EVEN) { if (region < 2) { const f32x4 gg = *(const f32x4*)(gn + nt * 32 + 8 * gq + 4 * hh); v0.x *= sc * gg[0]; v0.y *= sc * gg[1]; v1.x *= sc * gg[2]; v1.y *= sc * gg[3]; } }
                    else if (EPI == EPI_IN_ODD) { if (act) { v0 = gelu_pk(v0); v1 = gelu_pk(v1); vsum += v0.x * v0.x + v0.y * v0.y + v1.x * v1.x + v1.y * v1.y; } else { v0 = v0 * qs; v1 = v1 * qs; } }
                    u32x2 w; w.x = pack2(v0.x, v0.y); w.y = pack2(v1.x, v1.y);
                    *(u32x2*)(wsl + r32 * 128 + (((nt * 4 + gq) ^ (r32 & 7)) << 4) + hh * 8) = w;
                }
            if (EPI == EPI_IN_ODD && colw >= 512 && colw < 1024) {
                auto rr = __builtin_amdgcn_permlane32_swap(__float_as_uint(vsum), __float_as_uint(vsum), false, false);
                vsum = __uint_as_float(rr[0]) + __uint_as_float(rr[1]);
                if (hh == 0) atomicAdd(p.vss + g.m0 + rowb + mt * 32 + r32, vsum);
            }
#pragma unroll
            for (int ps = 0; ps < 4; ++ps) {
                const int row = ps * 8 + (lane >> 3), chunk = lane & 7;
                const u32x4 v = *(const u32x4*)(wsl + row * 128 + ((chunk ^ (row & 7)) << 4));
                const int trow = rowb + mt * 32 + row;
                if (EPI == EPI_DOWN) { const int id = rowid[trow]; if (id >= 0) *(u32x4*)(p.y + (size_t)id * DM + colw + chunk * 8) = v; }
                else if (EPI == EPI_IN_EVEN) *(u32x4*)(p.proj + (size_t)(g.m0 + trow) * EVEN_IN + colw + chunk * 8) = v;
                else *(u32x4*)(p.proj + (size_t)(g.m0 + trow) * ODD_IN + colw + chunk * 8) = v;
            }
        }
    } else if (EPI == EPI_OUT) {
#pragma unroll
        for (int mt = 0; mt < MT; ++mt) {
#pragma unroll
            for (int nt = 0; nt < 2; ++nt)
#pragma unroll
                for (int gq = 0; gq < 4; ++gq) {
                    const f32x4 v = {acc[mt][nt][4 * gq], acc[mt][nt][4 * gq + 1], acc[mt][nt][4 * gq + 2], acc[mt][nt][4 * gq + 3]};
                    *(f32x4*)(wsl + r32 * 256 + (((nt * 8 + 2 * gq + hh) ^ (r32 & 15)) << 4)) = v;
                }
#pragma unroll
            for (int ps = 0; ps < 8; ++ps) {
                const int row = ps * 4 + (lane >> 4), chunk = lane & 15;
                const f32x4 v = *(const f32x4*)(wsl + row * 256 + ((chunk ^ (row & 15)) << 4));
                const size_t off = (size_t)(g.m0 + rowb + mt * 32 + row) * DM + colw + chunk * 4;
                f32x4 r;
                if (layer == 0) r = *(const f32x4*)(p.x + off);
                else { const u32x2 hb = *(const u32x2*)(p.hb + off); r = (f32x4){__uint_as_float(hb.x << 16), __uint_as_float(hb.x & 0xffff0000u), __uint_as_float(hb.y << 16), __uint_as_float(hb.y & 0xffff0000u)}; }
                r = r + v;
                u32x2 w; w.x = pack2(r[0], r[1]); w.y = pack2(r[2], r[3]);
                *(u32x2*)(p.hb + off) = w;
            }
        }
    } else if (EPI == EPI_GU) {
        const int f0 = (g.n0 >> 1) + wn * 32;
#pragma unroll
        for (int mt = 0; mt < MT; ++mt) {
            const float w = gu_w[mt], rs = gu_rs[mt];
#pragma unroll
            for (int gq = 0; gq < 4; ++gq) {
                float h[4];
#pragma unroll
                for (int j = 0; j < 4; ++j) { const float gt = acc[mt][0][4 * gq + j] * rs, up = acc[mt][1][4 * gq + j] * (rs * w);
                    h[j] = gt * __builtin_amdgcn_rcpf(1.0f + __builtin_amdgcn_exp2f(-LOG2E * gt)) * up; }
                u32x2 ww; ww.x = pack2(h[0], h[1]); ww.y = pack2(h[2], h[3]);
                *(u32x2*)(wsl + r32 * 64 + ((gq ^ (r32 & 3)) << 4) + hh * 8) = ww;
            }
#pragma unroll
            for (int ps = 0; ps < 2; ++ps) {
                const int row = ps * 16 + (lane >> 2), chunk = lane & 3;
                const u32x4 v = *(const u32x4*)(wsl + row * 64 + ((chunk ^ (row & 3)) << 4));
                const int id2 = rowid[rowb + mt * 32 + row];
                if (id2 >= 0) st16_sc1(p.hid + (size_t)id2 * FF + f0 + chunk * 8, v);
            }
        }
        asm volatile("s_waitcnt vmcnt(0)" ::: "memory");
    }
    __syncthreads();
}

template <int EPI, int MT>
DI void ph_gemm_dense(const P& p, char* smem, const bf16_t* A, int lda, const bf16_t* B, int K, int N, int layer, int nt0, int ntc) {
    const int ntm = NTOK / (64 * MT), per_xcd = (ntm / 8) * ntc;
    const bool xcd = (gridDim.x & 7) == 0;
    const int x = blockIdx.x & 7, gx = gridDim.x >> 3;
    const int jend = xcd ? per_xcd : ntm * ntc, jstep = xcd ? gx : (int)gridDim.x;
    for (int j = xcd ? (int)(blockIdx.x >> 3) : (int)blockIdx.x; j < jend; j += jstep) {
        GemmArgs g; g.A = A; g.lda = lda; g.gather = nullptr; g.mvalid = 64 * MT; g.gshift = 0; g.rowid_ready = false; g.B0 = B; g.B1 = B; g.ldb = N; g.gu = 0; g.K = K;
        g.m0 = ((xcd ? x * (ntm / 8) : 0) + j / ntc) * (64 * MT); g.n0 = (nt0 + j % ntc) * 256;
        gemm_tile<EPI, MT>(p, smem, g, layer);
    }
}

DI void moe_locate(const int* cnt, int mt, int& e, int& c, int& mtl) {
    e = 0; c = 0;
    for (; e < NEXP; ++e) { c = cnt[e]; const int t = (c + 127) >> 7; if (mt < t) break; mt -= t; }
    mtl = mt;
}
DI void ph_moe(const P& p, char* smem, int layer) {
    const int* cnt = p.cnt + layer * NEXP;
    int* gdone = p.gdone + layer * 320;
    int* queue = p.gdone + 600 + layer;
    volatile int* s_next = (volatile int*)(smem + SMEM_BYTES + 80);
    int total = 0;
    for (int e = 0; e < NEXP; ++e) total += (cnt[e] + 127) >> 7;
    const int ngu = total * 2, nall = total * 6;
    int mine = 0;
    if (threadIdx.x == 0) mine = __hip_atomic_fetch_add(queue, 1, __ATOMIC_RELAXED, __HIP_MEMORY_SCOPE_AGENT);
    for (;;) {
        if (threadIdx.x == 0) s_next[0] = mine;
        __syncthreads();
        const int u = s_next[0];
        if (u >= nall) break;
        if (threadIdx.x == 0) mine = __hip_atomic_fetch_add(queue, 1, __ATOMIC_RELAXED, __HIP_MEMORY_SCOPE_AGENT);
        if (u < ngu) {
            int e, c, mt; moe_locate(cnt, u >> 1, e, c, mt);
            GemmArgs g; g.gather = p.plist + (size_t)e * LISTCAP + mt * 128; g.mvalid = c - mt * 128 < 128 ? c - mt * 128 : 128;
            g.m0 = 0; g.n0 = (u & 1) * 256;
            const size_t ex = (size_t)(layer * NEXP + e);
            g.rowid_ready = false; g.A = p.hb; g.lda = DM; g.gshift = 1; g.B0 = p.wb_gate + ex * DM * FF; g.B1 = p.wb_up + ex * DM * FF; g.ldb = FF; g.gu = 1; g.K = DM;
            gemm_tile<EPI_GU, 2>(p, smem, g, layer);
            if (threadIdx.x == 0) __hip_atomic_fetch_add(gdone + (u >> 1), 1, __ATOMIC_RELAXED, __HIP_MEMORY_SCOPE_AGENT);
        } else {
            const int v = u - ngu;
            int e, c, mt; moe_locate(cnt, v >> 2, e, c, mt);
            GemmArgs g; g.gather = p.plist + (size_t)e * LISTCAP + mt * 128; g.mvalid = c - mt * 128 < 128 ? c - mt * 128 : 128;
            {
                int* rowid = (int*)(smem + G_ROWID);
                const int rid = (threadIdx.x < 128 && (int)threadIdx.x < g.mvalid) ? g.gather[threadIdx.x] : -1;
                if (threadIdx.x == 0) { unsigned sp = 0;
                    while (__hip_atomic_load(gdone + (v >> 2), __ATOMIC_RELAXED, __HIP_MEMORY_SCOPE_AGENT) < 2) { __builtin_amdgcn_s_sleep(2); if (++sp > (1u << 22)) break; } }
                if (threadIdx.x < 128) rowid[threadIdx.x] = rid;
                __syncthreads();
            }
            g.m0 = 0; g.n0 = (v & 3) * 256;
            const size_t ex = (size_t)(layer * NEXP + e);
            g.rowid_ready = true; g.A = p.hid; g.lda = FF; g.gshift = 0; g.B0 = p.wb_down + ex * FF * DM; g.B1 = g.B0; g.ldb = DM; g.gu = 0; g.K = FF;
            gemm_tile<EPI_DOWN, 2>(p, smem, g, layer);
        }
    }
}

DI void convert_flat(const float* __restrict__ src, bf16_t* __restrict__ dst, size_t n8, const float* __restrict__ gain = nullptr, int rowlen = 1) {
    for (size_t i = (size_t)blockIdx.x * 512 + threadIdx.x; i < n8; i += (size_t)gridDim.x * 512) {
        f32x4 a = *(const f32x4*)(src + i * 8), b = *(const f32x4*)(src + i * 8 + 4);
        if (gain) { const float gk = gain[(i * 8) / (size_t)rowlen]; a = a * gk; b = b * gk; }
        u32x4 w; w.x = pack2(a[0], a[1]); w.y = pack2(a[2], a[3]); w.z = pack2(b[0], b[1]); w.w = pack2(b[2], b[3]);
        *(u32x4*)(dst + i * 8) = w;
    }
}
DI void poolfold_unit(const P& p, char* smem, int unit) {
    float (*At)[32] = (float (*)[32])smem;
    float (*Bs)[64] = (float (*)[64])(smem + 16384);
    const int tid = opaque_tid() & 255, g = unit >> 6, c0 = ((unit >> 4) & 3) * 32, n0 = (unit & 15) * 64;
    __syncthreads();
    for (int i = 0; i < 16; ++i) { const int idx = tid + 256 * i, d = idx >> 5, c = idx & 31;
        At[d][c] = p.pool_w[(size_t)(g * 128 + c0 + c) * 128 + d] * p.pool_scale[g * 128 + d]; }
    for (int i = 0; i < 8; ++i) { const int idx = tid + 256 * i, d = idx >> 4, n4 = (idx & 15) * 4;
        *(f32x4*)&Bs[d][n4] = *(const f32x4*)(p.w_out_even + (size_t)(512 + g * 128 + d) * DM + n0 + n4); }
    __syncthreads();
    const int tc = (tid >> 4) * 2, tn = (tid & 15) * 4;
    f32x4 acc[2] = {(f32x4){0.f, 0.f, 0.f, 0.f}, (f32x4){0.f, 0.f, 0.f, 0.f}};
#pragma unroll 8
    for (int d = 0; d < 128; ++d) {
        const f32x2 a = *(const f32x2*)&At[d][tc]; const f32x4 b = *(const f32x4*)&Bs[d][tn];
        acc[0] += a.x * b; acc[1] += a.y * b;
    }
#pragma unroll
    for (int i = 0; i < 2; ++i) { u32x2 w; w.x = pack2(acc[i][0], acc[i][1]); w.y = pack2(acc[i][2], acc[i][3]);
        *(u32x2*)(p.wb_out_even + (size_t)(512 + g * 128 + c0 + tc + i) * DM + n0 + tn) = w; }
}
DI void cast_rows2(const P& p, int tok, int lane) {
    f32x4 v[2][4];
#pragma unroll
    for (int r = 0; r < 2; ++r)
#pragma unroll
        for (int i = 0; i < 4; ++i) v[r][i] = *(const f32x4*)(p.x + (size_t)(tok + r) * DM + i * 256 + lane * 4);
#pragma unroll
    for (int r = 0; r < 2; ++r) {
        float ss = 0.f;
#pragma unroll
        for (int i = 0; i < 4; ++i) { ss += v[r][i][0] * v[r][i][0] + v[r][i][1] * v[r][i][1] + v[r][i][2] * v[r][i][2] + v[r][i][3] * v[r][i][3];
            u32x2 w; w.x = pack2(v[r][i][0], v[r][i][1]); w.y = pack2(v[r][i][2], v[r][i][3]);
            *(u32x2*)(p.hb + (size_t)(tok + r) * DM + i * 256 + lane * 4) = w; }
        ss = wave_sum(ss);
        if (lane == 0) p.rsm[tok + r] = rsqrtf(ss * (1.0f / DM) + EPS);
    }
}
DI void ph_prologue(const P& p, char* smem) {
    if (blockIdx.x == 0 && threadIdx.x < 64) p.cnt[threadIdx.x] = 0;
    if (blockIdx.x == 2 && threadIdx.x == 0) ((float*)p.ones)[0] = 1.0f;
    if (blockIdx.x == 1) for (int i = threadIdx.x; i < 640; i += 512) p.gdone[i] = 0;
    for (int i = blockIdx.x * 512 + threadIdx.x; i < NTOK; i += gridDim.x * 512) p.vss[i] = 0.f;
    for (int u = blockIdx.x; u < 128; u += gridDim.x) poolfold_unit(p, smem + (threadIdx.x >> 8) * HALF_LDS, u * 2 + (threadIdx.x >> 8));
    for (int i = blockIdx.x * 512 + threadIdx.x; i < 2 * 96 * DM; i += gridDim.x * 512) {
        const int k = i & (DM - 1), R = (i >> 10) % 96, layer = i / (96 * DM);
        const int T = R >> 5, r = R & 31, L = 16 * T + (r & 3) + 4 * (r >> 3);
        float w = 0.f;
        if (L < 32) w = p.w_re[((size_t)layer * DM + k) * 32 + L]; else if (L < 36) w = p.w_rg[((size_t)layer * DM + k) * 4 + (L - 32)];
        w *= p.ffn_norm[layer * DM + k];
        const unsigned hi = pack2(w, 0.f) & 0xffffu;
        p.wr_hi[i] = (bf16_t)hi; p.wr_lo[i] = (bf16_t)(pack2(w - __uint_as_float(hi << 16), 0.f) & 0xffffu);
    }
    const int wave = threadIdx.x >> 6, lane = threadIdx.x & 63;
    for (int u = blockIdx.x; u < NTOK / 16; u += gridDim.x) {
        const int tok = u * 16 + wave * 2;
        cast_rows2(p, tok, lane);
    }
    convert_flat(p.w_in_even, p.wb_in_even, (size_t)DM * EVEN_IN / 8, p.mix_norm_even, EVEN_IN);
    convert_flat(p.w_out_even, p.wb_out_even, (size_t)512 * DM / 8);
}
DI void convert_experts(const P& p, int layer) {
    const size_t o = (size_t)layer * NEXP * DM * FF;
    convert_flat(p.w_gate + o, p.wb_gate + o, (size_t)NEXP * DM * FF / 8);
    convert_flat(p.w_up + o, p.wb_up + o, (size_t)NEXP * DM * FF / 8);
    convert_flat(p.w_down + o, p.wb_down + o, (size_t)NEXP * DM * FF / 8);
}

DI int crow(int i, int h) { return (i & 3) + 8 * (i >> 2) + 4 * h; }
DI float swap_max(float v) { auto rr = __builtin_amdgcn_permlane32_swap(__float_as_uint(v), __float_as_uint(v), false, false); return fmaxf(__uint_as_float(rr[0]), __uint_as_float(rr[1])); }
DI float swap_sum(float v) { auto rr = __builtin_amdgcn_permlane32_swap(__float_as_uint(v), __float_as_uint(v), false, false); return __uint_as_float(rr[0]) + __uint_as_float(rr[1]); }
DI float bcast_lo(float v) { auto rr = __builtin_amdgcn_permlane32_swap(__float_as_uint(v), __float_as_uint(v), false, false); return __uint_as_float(rr[0]); }
DI bf16x8 pack8(const f32x16& x, int s) {
    u32x4 w; w.x = pack2(x[8 * s], x[8 * s + 1]); w.y = pack2(x[8 * s + 2], x[8 * s + 3]); w.z = pack2(x[8 * s + 4], x[8 * s + 5]); w.w = pack2(x[8 * s + 6], x[8 * s + 7]);
    return __builtin_bit_cast(bf16x8, w);
}
constexpr int KV_TILE = 8192;
struct KVStage { u32x4 k[2], v[2]; };
DI void kv_load(KVStage& st, const bf16_t* kbase, const bf16_t* vbase, int ld, int key0) {
    const int tid = opaque_tid() & 255, c = tid & 7, r0 = tid >> 3;
#pragma unroll
    for (int i = 0; i < 2; ++i) { const size_t off = (size_t)(key0 + r0 + 32 * i) * ld + c * 8; st.k[i] = *(const u32x4*)(kbase + off); st.v[i] = *(const u32x4*)(vbase + off); }
}
DI void kv_store(const KVStage& st, char* kt, char* vt) {
    const int tid = opaque_tid() & 255, c = tid & 7, r0 = tid >> 3;
#pragma unroll
    for (int i = 0; i < 2; ++i) { const int r = r0 + 32 * i;
        *(u32x4*)(kt + r * 128 + ((c ^ ((r >> 1) & 7)) << 4)) = st.k[i];
        *(u32x4*)(vt + r * 128 + ((((c >> 2) ^ ((r >> 1) & 1))) << 6) + ((c & 3) << 4)) = st.v[i]; }
}
DI bf16x8 k_frag(const char* kt, int sb, int st, int r32, int hh) {
    const int row = sb * 32 + r32;
    return *(const bf16x8*)(kt + row * 128 + (((2 * st + hh) ^ ((row >> 1) & 7)) << 4));
}
DI bf16x8 vt_frag(const char* vt, int sb, int st, int dh, int lane) {
    const int hh = lane >> 5, g1 = (lane >> 4) & 1, pp = lane & 3, q = (lane & 15) >> 2;
    const int key = sb * 32 + 16 * st + 4 * hh + q;
    const char* a = vt + key * 128 + ((dh ^ ((q >> 1) & 1)) << 6) + g1 * 32 + pp * 8;
    const s16x4 lo = tr_read(a), hi = tr_read(a + 8 * 128);
    return (bf16x8){lo[0], lo[1], lo[2], lo[3], hi[0], hi[1], hi[2], hi[3]};
}


#define XB_TMO      128
#define XB_XCNT(j)  (256  + 64 * (j))
#define XB_XSUB(j)  (1280 + 64 * (j))
#define XB_XGEN(j)  (2304 + 64 * (j))
#define XB_TOP      3328
#define XB_TOPGEN   3392
#define XCD_BAR_WORDS 3456
#define XB_SPIN_CAP (1u << 22)
DI unsigned xb_ld(unsigned* q)              { return __hip_atomic_load(q, __ATOMIC_RELAXED, __HIP_MEMORY_SCOPE_AGENT); }
DI unsigned xb_add(unsigned* q, unsigned v) { return __hip_atomic_fetch_add(q, v, __ATOMIC_RELAXED, __HIP_MEMORY_SCOPE_AGENT); }
DI unsigned xb_xcc_id() { return (unsigned)__builtin_amdgcn_s_getreg((3 << 11) | 20) & 0xFu; }
#define XB_SPIN(cond, bar) do { unsigned _sp = 0; while (cond) { __builtin_amdgcn_s_sleep(1); \
    if ((++_sp & 255u) == 0u) { if (xb_ld(&(bar)[XB_TMO])) break; if (_sp > XB_SPIN_CAP) { atomicAdd(&(bar)[XB_TMO], 1u); break; } } } } while (0)
struct XcdBarrier { unsigned* bar; unsigned x; volatile LDSAS unsigned* st; };
DI XcdBarrier xcd_barrier_post(unsigned* bar, volatile LDSAS unsigned* st) {
    XcdBarrier b; b.bar = bar; b.x = xb_xcc_id(); b.st = st;
    if (threadIdx.x == 0) (void)xb_add(&bar[XB_XCNT(b.x)], 1u);
    return b;
}
DI void xcd_barrier_complete(unsigned* bar, unsigned x, unsigned& nloc, unsigned& nx) {
    const unsigned G = gridDim.x * gridDim.y * gridDim.z;
    unsigned sum, cnt, mine, sp = 0u;
    for (;;) {
        sum = 0u; cnt = 0u; mine = 0u;
#pragma unroll
        for (unsigned j = 0; j < 16; ++j) { const unsigned c = xb_ld(&bar[XB_XCNT(j)]); sum += c; cnt += (c > 0u) ? 1u : 0u; mine = (j == x) ? c : mine; }
        if (sum == G) break;
        __builtin_amdgcn_s_sleep(1);
        if ((++sp & 255u) == 0u) { if (xb_ld(&bar[XB_TMO])) break; if (sp > XB_SPIN_CAP) { atomicAdd(&bar[XB_TMO], 1u); break; } }
    }
    nloc = mine > 0u ? mine : 1u; nx = cnt > 0u ? cnt : 1u;
}
DI void xcd_barrier(const XcdBarrier& b) {
    asm volatile("s_waitcnt vmcnt(0)" ::: "memory");
    __syncthreads();
    if (threadIdx.x == 0) {
        unsigned* bar = b.bar;
        __builtin_amdgcn_s_waitcnt(0);
        unsigned nloc = b.st[0], nx = b.st[1];
        if (nloc == 0u) { xcd_barrier_complete(bar, b.x, nloc, nx); b.st[0] = nloc; b.st[1] = nx; }
        const unsigned old = xb_add(&bar[XB_XSUB(b.x)], 1u);
        const unsigned gen = old / nloc;
        if (old + 1u == (gen + 1u) * nloc) {
            __builtin_amdgcn_fence(__ATOMIC_RELEASE, "agent");
            asm volatile("s_waitcnt vmcnt(0)" ::: "memory");
            const unsigned og = xb_add(&bar[XB_TOP], 1u);
            const unsigned tg = og / nx;
            if (og + 1u == (tg + 1u) * nx) xb_add(&bar[XB_TOPGEN], 1u);
            else XB_SPIN(xb_ld(&bar[XB_TOPGEN]) == tg, bar);
            __builtin_amdgcn_fence(__ATOMIC_ACQUIRE, "agent");
            xb_add(&bar[XB_XGEN(b.x)], 1u);
            asm volatile("s_waitcnt vmcnt(0)" ::: "memory");
        } else {
            XB_SPIN(xb_ld(&bar[XB_XGEN(b.x)]) == gen, bar);
            __builtin_amdgcn_fence(__ATOMIC_ACQUIRE, "agent");
            asm volatile("s_waitcnt vmcnt(0)" ::: "memory");
        }
    }
    __syncthreads();
}


struct ConvPlan { int layer; int sl_e, sl_in, sl_out, nslots; };
template <int NV> DI ConvPlan conv_plan(const P& p, int layer) {
    ConvPlan c; c.layer = layer;
    const unsigned per = gridDim.x * 512u, gsz = 4 * NV;
    c.sl_e = (int)((NEXP * DM * FF / gsz + per - 1) / per);
    c.sl_in = layer == 0 ? (int)((DM * ODD_IN / gsz + per - 1) / per) : 0;
    c.sl_out = layer == 0 ? (int)((DM * DM / gsz + per - 1) / per) : 0;
    c.nslots = 3 * c.sl_e + c.sl_in + c.sl_out;
    return c;
}
template <int NV> DI void conv_locate(const P& p, const ConvPlan& c, int slot, const float*& s, bf16_t*& d, const float*& gp) {
    constexpr unsigned gsz = 4 * NV;
    int seg = 0, ls = slot;
    if (ls < 3 * c.sl_e) { seg = ls / c.sl_e; ls -= seg * c.sl_e; }
    else if ((ls -= 3 * c.sl_e) < c.sl_in) seg = 3;
    else { ls -= c.sl_in; seg = 4; }
    const unsigned ng = seg < 3 ? NEXP * DM * FF / gsz : (seg == 3 ? DM * ODD_IN / gsz : DM * DM / gsz);
    const unsigned gi = ((unsigned)ls * gridDim.x + blockIdx.x) * 512u + threadIdx.x;
    const bool live = slot < c.nslots && gi < ng;
    const size_t e = live ? (size_t)gi * gsz : 0;
    const int tix = c.layer * 5 + __builtin_amdgcn_readfirstlane(seg);
    s = p.cs[tix] + e;
    d = live ? p.cd[tix] + e : p.dump + ((size_t)blockIdx.x * 512 + threadIdx.x) * 16;
    gp = p.ones;
    if (live && seg < 2) gp = p.ffn_norm + c.layer * DM + ((e >> 8) & (DM - 1));
    else if (live && seg == 3) gp = p.mix_norm_odd + e / ODD_IN;
}
#define CONV_DECL4(N) f32x4 N##0, N##1, N##2, N##3; float N##g; bf16_t* N##d
#define CONV_DECL2(N) f32x4 N##0, N##1; float N##g; bf16_t* N##d
#define CONV_LOAD4(N, SLOT) do { const float* s_; const float* g_; conv_locate<4>(p, cv, (SLOT), s_, N##d, g_); \
        N##g = *g_; N##0 = *(const f32x4*)s_; N##1 = *(const f32x4*)(s_ + 4); N##2 = *(const f32x4*)(s_ + 8); N##3 = *(const f32x4*)(s_ + 12); } while (0)
#define CONV_LOAD2(N, SLOT) do { const float* s_; const float* g_; conv_locate<2>(p, cv, (SLOT), s_, N##d, g_); \
        N##g = *g_; N##0 = *(const f32x4*)s_; N##1 = *(const f32x4*)(s_ + 4); } while (0)
#define CONV_STORE4(N) do { const f32x4 a_ = N##0 * N##g, b_ = N##1 * N##g, c_ = N##2 * N##g, e_ = N##3 * N##g; u32x4 w_; \
        w_.x = pack2(a_[0], a_[1]); w_.y = pack2(a_[2], a_[3]); w_.z = pack2(b_[0], b_[1]); w_.w = pack2(b_[2], b_[3]); *(u32x4*)N##d = w_; \
        w_.x = pack2(c_[0], c_[1]); w_.y = pack2(c_[2], c_[3]); w_.z = pack2(e_[0], e_[1]); w_.w = pack2(e_[2], e_[3]); *(u32x4*)(N##d + 8) = w_; } while (0)
#define CONV_STORE2(N) do { const f32x4 a_ = N##0 * N##g, b_ = N##1 * N##g; u32x4 w_; \
        w_.x = pack2(a_[0], a_[1]); w_.y = pack2(a_[2], a_[3]); w_.z = pack2(b_[0], b_[1]); w_.w = pack2(b_[2], b_[3]); *(u32x4*)N##d = w_; } while (0)

DI void band_attn_unit(const P& p, char* smem, int unit, const ConvPlan& cv, int& cslot) {
    const int tid = opaque_tid() & 255, lane = tid & 63, wid = tid >> 6, r32 = lane & 31, hh = lane >> 5;
    const int cp = unit & 31, h = (unit >> 5) & 7, b = unit >> 8;
    const int c = 2 * cp + (wid >> 1);
    const int tq = c * 64 + (wid & 1) * 32 + r32;
    const size_t rowb = (size_t)b * NS;
    const bf16_t* kbase = p.proj + rowb * EVEN_IN + 512 + h * 64;
    const bf16_t* vbase = p.proj + rowb * EVEN_IN + 1024 + h * 64;
    float* sbias = (float*)(smem + 4 * KV_TILE);
    __syncthreads();
    bf16x8 qf[4];
#pragma unroll
    for (int st = 0; st < 4; ++st) qf[st] = *(const bf16x8*)(p.proj + (rowb + tq) * EVEN_IN + h * 64 + st * 16 + hh * 8);
    const int ck0 = (2 * cp - 8) > 0 ? (2 * cp - 8) : 0, nt = 2 * cp + 2 - ck0;
    float m = -3.0e38f, lsum = 0.f;
    f32x16 o0, o1;
#pragma unroll
    for (int i = 0; i < 16; ++i) { o0[i] = 0.f; o1[i] = 0.f; }
    KVStage stg;
    kv_load(stg, kbase, vbase, EVEN_IN, ck0 * 64);
    {
        const float b0 = p.att_rel_bias[h * 257 + tid], b1 = p.att_rel_bias[h * 257 + 256];
        sbias[tid] = b0 * LOG2E; if (tid == 0) sbias[256] = b1 * LOG2E;
    }
    kv_store(stg, smem, smem + 2 * KV_TILE);
    __syncthreads();
    CONV_DECL4(cA); CONV_DECL4(cB);
    CONV_LOAD4(cA, cslot++); CONV_LOAD4(cB, cslot++);
#define BAND_ITER(it, CRX) do { \
        const int ck = ck0 + it, cur = it & 1; \
        kv_load(stg, kbase, vbase, EVEN_IN, ((it + 1 < nt) ? ck + 1 : ck) * 64); \
        CONV_STORE4(CRX); CONV_LOAD4(CRX, cslot++); \
        __builtin_amdgcn_sched_barrier(0); \
        const char* kt = smem + cur * KV_TILE; const char* vt = smem + (2 + cur) * KV_TILE; \
        if (ck >= c - 8 && ck <= c) { \
            f32x16 s0, s1; \
_Pragma("unroll") \
            for (int i = 0; i < 16; ++i) { s0[i] = 0.f; s1[i] = 0.f; } \
_Pragma("unroll") \
            for (int st = 0; st < 4; ++st) { s0 = MFMA32(k_frag(kt, 0, st, r32, hh), qf[st], s0); s1 = MFMA32(k_frag(kt, 1, st, r32, hh), qf[st], s1); } \
            if (c - ck >= 3) { const float bb = sbias[256]; \
_Pragma("unroll") \
                for (int i = 0; i < 16; ++i) { s0[i] += bb; s1[i] += bb; } \
            } else { \
                const int d0 = tq - ck * 64 - 4 * hh; \
_Pragma("unroll") \
                for (int i = 0; i < 16; ++i) { \
                    int da = d0 - ((i & 3) + 8 * (i >> 2)), db = da - 32; \
                    da = da > 128 ? 128 : da; db = db > 128 ? 128 : db; \
                    s0[i] += sbias[da + 128]; s1[i] += sbias[db + 128]; \
                } \
            } \
            float tm = fmaxf(s0[0], s1[0]); \
_Pragma("unroll") \
            for (int i = 1; i < 16; ++i) tm = fmaxf(tm, fmaxf(s0[i], s1[i])); \
            tm = swap_max(tm); \
            const float mn = fmaxf(m, tm); \
            const float alpha = __builtin_amdgcn_exp2f(m - mn); \
            m = mn; \
            float ps = 0.f; \
_Pragma("unroll") \
            for (int i = 0; i < 16; ++i) { s0[i] = __builtin_amdgcn_exp2f(s0[i] - mn); s1[i] = __builtin_amdgcn_exp2f(s1[i] - mn); ps += s0[i] + s1[i]; } \
            lsum = lsum * alpha + ps; \
_Pragma("unroll") \
            for (int i = 0; i < 16; ++i) { o0[i] *= alpha; o1[i] *= alpha; } \
_Pragma("unroll") \
            for (int st = 0; st < 2; ++st) { \
                const bf16x8 pa = pack8(s0, st), pb = pack8(s1, st); \
                o0 = MFMA32(vt_frag(vt, 0, st, 0, lane), pa, o0); o1 = MFMA32(vt_frag(vt, 0, st, 1, lane), pa, o1); \
                o0 = MFMA32(vt_frag(vt, 1, st, 0, lane), pb, o0); o1 = MFMA32(vt_frag(vt, 1, st, 1, lane), pb, o1); \
            } \
        } \
        __builtin_amdgcn_sched_barrier(0); \
        kv_store(stg, smem + (cur ^ 1) * KV_TILE, smem + (2 + (cur ^ 1)) * KV_TILE); \
        __syncthreads(); \
    } while (0)
    for (int it = 0; it < nt; it += 2) {
        BAND_ITER(it, cA);
        if (it + 1 >= nt) break;
        BAND_ITER(it + 1, cB);
    }
#undef BAND_ITER
    CONV_STORE4(cA); CONV_STORE4(cB);
    const float inv = 1.0f / swap_sum(lsum);
    bf16_t* orow = p.mixed + (rowb + tq) * DM + h * 64 + 4 * hh;
#pragma unroll
    for (int g = 0; g < 4; ++g) {
        u32x2 w0, w1;
        w0.x = pack2(o0[4 * g] * inv, o0[4 * g + 1] * inv); w0.y = pack2(o0[4 * g + 2] * inv, o0[4 * g + 3] * inv);
        w1.x = pack2(o1[4 * g] * inv, o1[4 * g + 1] * inv); w1.y = pack2(o1[4 * g + 2] * inv, o1[4 * g + 3] * inv);
        *(u32x2*)(orow + 8 * g) = w0; *(u32x2*)(orow + 32 + 8 * g) = w1;
    }
}

DI void sb_attn_unit(const P& p, char* smem, volatile int* wdone, int unit, const ConvPlan& cv, int& cslot) {
    const int tid8 = opaque_tid(), tid = tid8 & 255, lane = tid & 63, wid = tid >> 6, r32 = lane & 31, hh = lane >> 5, wid8 = tid8 >> 6;
    const int qb = unit & 31, h = (unit >> 5) & 7, b = unit >> 8;
    const int tw = qb * 128 + wid * 32, t = tw + r32;
    const size_t rowb = (size_t)b * NS;
    const bf16_t* kbase = p.proj + rowb * ODD_IN + 1536 + h * 64;
    const bf16_t* vbase = p.proj + rowb * ODD_IN + 2048 + h * 64;
    __syncthreads();
    bf16x8 qf[4];
#pragma unroll
    for (int st = 0; st < 4; ++st) qf[st] = *(const bf16x8*)(p.proj + (rowb + t) * ODD_IN + 1024 + h * 64 + st * 16 + hh * 8);
    bf16x8 tf[2];
#pragma unroll
    for (int st = 0; st < 2; ++st)
#pragma unroll
        for (int j = 0; j < 8; ++j) tf[st][j] = (16 * st + 8 * (j >> 2) + 4 * hh + (j & 3)) >= r32 ? (short)0x3F80 : (short)0;
    f32x16 o0, o1;
#pragma unroll
    for (int i = 0; i < 16; ++i) { o0[i] = 0.f; o1[i] = 0.f; }
    float carry = 0.f; bool done = false;
    const int kt0 = 2 * qb + 1;
    KVStage stg;
    kv_load(stg, kbase, vbase, ODD_IN, kt0 * 64);
    kv_store(stg, smem, smem + 2 * KV_TILE);
    __syncthreads();
    bool all_done = false;
    CONV_DECL2(cA);
    CONV_LOAD2(cA, cslot++);
#define SB_ITER(it, CRX) do { \
        const int kt = kt0 - it, cur = it & 1; \
        kv_load(stg, kbase, vbase, ODD_IN, (kt > 0 ? kt - 1 : 0) * 64); \
        CONV_STORE2(CRX); CONV_LOAD2(CRX, cslot++); \
        __builtin_amdgcn_sched_barrier(0); \
        const char* ktile = smem + cur * KV_TILE; const char* vtile = smem + (2 + cur) * KV_TILE; \
        if (!done && kt * 64 < tw + 31) { \
_Pragma("unroll") \
            for (int sbi = 0; sbi < 2; ++sbi) { \
                const int sb = 1 - sbi; \
                f32x16 x; \
_Pragma("unroll") \
                for (int i = 0; i < 16; ++i) x[i] = 0.f; \
_Pragma("unroll") \
                for (int st = 0; st < 4; ++st) x = MFMA32(k_frag(ktile, sb, st, r32, hh), qf[st], x); \
                const int kb = kt * 64 + sb * 32 + 4 * hh; \
                f32x16 L; \
_Pragma("unroll") \
                for (int i = 0; i < 16; ++i) { \
                    const bool valid = kb + (i & 3) + 8 * (i >> 2) < t; \
                    const float z = x[i]; \
                    const float sp = fmaxf(z, 0.f) + __builtin_amdgcn_logf(1.0f + __builtin_amdgcn_exp2f(-fabsf(z))); \
                    L[i] = valid ? -sp : 0.f; \
                    x[i] = valid ? z : -1.0e30f; \
                } \
                f32x16 cum; \
_Pragma("unroll") \
                for (int i = 0; i < 16; ++i) cum[i] = carry; \
_Pragma("unroll") \
                for (int st = 0; st < 2; ++st) cum = MFMA32(tf[st], pack8(L, st), cum); \
                carry = bcast_lo(cum[0]); \
_Pragma("unroll") \
                for (int i = 0; i < 16; ++i) x[i] = __builtin_amdgcn_exp2f(x[i] + cum[i]); \
_Pragma("unroll") \
                for (int st = 0; st < 2; ++st) { \
                    const bf16x8 pa = pack8(x, st); \
                    o0 = MFMA32(vt_frag(vtile, sb, st, 0, lane), pa, o0); o1 = MFMA32(vt_frag(vtile, sb, st, 1, lane), pa, o1); \
                } \
            } \
            done = __all(carry < -150.0f); \
        } \
        __builtin_amdgcn_sched_barrier(0); \
        if (lane == 0) wdone[cur * 8 + wid8] = done ? 1 : 0; \
        kv_store(stg, smem + (cur ^ 1) * KV_TILE, smem + (2 + (cur ^ 1)) * KV_TILE); \
        __syncthreads(); \
        all_done = (wdone[cur * 8] + wdone[cur * 8 + 1] + wdone[cur * 8 + 2] + wdone[cur * 8 + 3] + wdone[cur * 8 + 4] + wdone[cur * 8 + 5] + wdone[cur * 8 + 6] + wdone[cur * 8 + 7] == 8); \
    } while (0)
#pragma nounroll
    for (int it = 0; it <= kt0; ++it) {
        SB_ITER(it, cA);
        if (all_done) break;
    }
#undef SB_ITER
    CONV_STORE2(cA);
    bf16_t* orow = p.mixed + (rowb + t) * DM + 512 + h * 64 + 4 * hh;
#pragma unroll
    for (int g = 0; g < 4; ++g) {
        u32x2 w0, w1;
        w0.x = pack2(o0[4 * g], o0[4 * g + 1]); w0.y = pack2(o0[4 * g + 2], o0[4 * g + 3]);
        w1.x = pack2(o1[4 * g], o1[4 * g + 1]); w1.y = pack2(o1[4 * g + 2], o1[4 * g + 3]);
        *(u32x2*)(orow + 8 * g) = w0; *(u32x2*)(orow + 32 + 8 * g) = w1;
    }
}

DI void pool_items(const P& p) {
    for (int it = blockIdx.x * 512 + threadIdx.x; it < NTOK * 64; it += gridDim.x * 512) {
        const int tok = it >> 6, ch8 = it & 63, g = ch8 >> 4, w = 2 << g, s = tok & (NS - 1);
        const int n = (s + 1 < w) ? s + 1 : w;
        float sum[8], own[8];
#pragma unroll
        for (int j = 0; j < 8; ++j) sum[j] = 0.f;
        const bf16_t* src = p.proj + (size_t)tok * EVEN_IN + 1536 + ch8 * 8;
        u32x4 wv[16];
#pragma unroll
        for (int t = 0; t < 16; ++t) wv[t] = (t < n) ? *(const u32x4*)(src - (size_t)t * EVEN_IN) : (u32x4){0u, 0u, 0u, 0u};
#pragma unroll
        for (int t = 0; t < 16; ++t) { unpack8(wv[t], own);
#pragma unroll
            for (int j = 0; j < 8; ++j) sum[j] += own[j]; }
        unpack8(wv[0], own);
        const float inv = 1.0f / (float)n;
        u32x4 o; o.x = pack2(sum[0] * inv - own[0], sum[1] * inv - own[1]); o.y = pack2(sum[2] * inv - own[2], sum[3] * inv - own[3]);
        o.z = pack2(sum[4] * inv - own[4], sum[5] * inv - own[5]); o.w = pack2(sum[6] * inv - own[6], sum[7] * inv - own[7]);
        *(u32x4*)(p.mixed + (size_t)tok * DM + 512 + ch8 * 8) = o;
    }
}

DI void sgu_unit(const P& p, char* smem, int unit) {
    const int tid = opaque_tid() & 255, lane = tid & 63, wid = tid >> 6, wm = wid >> 1, wn = wid & 1, fr = lane & 15, fq = lane >> 4;
    const int g = unit & 3; const size_t tok0 = (size_t)(unit >> 2) * 128;
    char* As = smem; char* Gs = smem + 32768; float* srstd = (float*)(smem + 65536);
    __syncthreads();
    if (tid < 128) srstd[tid] = rsqrtf(p.vss[tok0 + tid] * (1.0f / 512.0f) + EPS);
#pragma unroll
    for (int i = 0; i < 8; ++i) {
        const int idx = tid + 256 * i, s = idx >> 4, ch = idx & 15;
        const u32x4 v = *(const u32x4*)(p.proj + (tok0 + s) * ODD_IN + 512 + g * 128 + ch * 8);
        *(u32x4*)(Gs + s * 256 + (((ch >> 1) ^ kswz(s)) << 5) + ((ch & 1) << 4)) = v;
    }
    __syncthreads();
#pragma unroll
    for (int i = 0; i < 8; ++i) {
        const int idx = tid + 256 * i, t = idx >> 4, c8 = idx & 15, s0 = c8 * 8;
        const float* wr = p.sgu_w + ((size_t)g * 128 + t) * 128 + s0;
        const f32x4 a = *(const f32x4*)wr, b = *(const f32x4*)(wr + 4);
        float f[8] = {a[0], a[1], a[2], a[3], b[0], b[1], b[2], b[3]};
#pragma unroll
        for (int j = 0; j < 8; ++j) f[j] = (s0 + j <= t) ? f[j] * srstd[s0 + j] : 0.f;
        u32x4 w; w.x = pack2(f[0], f[1]); w.y = pack2(f[2], f[3]); w.z = pack2(f[4], f[5]); w.w = pack2(f[6], f[7]);
        *(u32x4*)(As + (c8 >> 3) * 16384 + t * 128 + (((c8 & 7) ^ (t & 7)) << 4)) = w;
    }
    __syncthreads();
    f32x4 acc[4][4];
#pragma unroll
    for (int a = 0; a < 4; ++a)
#pragma unroll
        for (int b = 0; b < 4; ++b) acc[a][b] = (f32x4){0.f, 0.f, 0.f, 0.f};
    const int qq = fr >> 2, pp = fr & 3;
#pragma unroll
    for (int kt = 0; kt < 2; ++kt) {
        if (kt == 1 && wm == 0) continue;
#pragma unroll
        for (int s2 = 0; s2 < 2; ++s2) {
            bf16x8 af[4], bfv[4];
#pragma unroll
            for (int i = 0; i < 4; ++i) {
                const int ra_ = wm * 64 + i * 16 + fr;
                af[i] = *(const bf16x8*)(As + kt * 16384 + ra_ * 128 + (((s2 * 4 + fq) ^ (fr & 7)) << 4));
                const int srow = kt * 64 + s2 * 32 + 8 * fq + qq, blk = wn * 4 + i;
                const s16x4 lo = tr_read(Gs + srow * 256 + ((blk ^ kswz(srow)) << 5) + pp * 8);
                const s16x4 hi = tr_read(Gs + (srow + 4) * 256 + ((blk ^ kswz(srow + 4)) << 5) + pp * 8);
                bfv[i] = (bf16x8){lo[0], lo[1], lo[2], lo[3], hi[0], hi[1], hi[2], hi[3]};
            }
#pragma unroll
            for (int mi = 0; mi < 4; ++mi)
#pragma unroll
                for (int ni = 0; ni < 4; ++ni) acc[mi][ni] = MFMA16(bfv[ni], af[mi], acc[mi][ni]);
        }
    }
#pragma unroll
    for (int mi = 0; mi < 4; ++mi) {
        const int t = wm * 64 + mi * 16 + fr;
        const float bias = p.sgu_b[g * 128 + t];
#pragma unroll
        for (int ni = 0; ni < 4; ++ni) {
            const int c = g * 128 + wn * 64 + ni * 16 + fq * 4;
            const f32x4 gn = *(const f32x4*)(p.sgu_v_norm + c);
            const u32x2 uu = *(const u32x2*)(p.proj + (tok0 + t) * ODD_IN + c);
            const float u0 = __uint_as_float(uu.x << 16), u1 = __uint_as_float(uu.x & 0xffff0000u), u2 = __uint_as_float(uu.y << 16), u3 = __uint_as_float(uu.y & 0xffff0000u);
            const f32x4 a = acc[mi][ni];
            u32x2 w; w.x = pack2(u0 * (gn[0] * a[0] + bias), u1 * (gn[1] * a[1] + bias)); w.y = pack2(u2 * (gn[2] * a[2] + bias), u3 * (gn[3] * a[3] + bias));
            *(u32x2*)(p.mixed + (tok0 + t) * DM + c) = w;
        }
    }
}

DI void router_unit(const P& p, char* smem, int layer, int unit) {
    const int tid = opaque_tid() & 255, lane = tid & 63, wid = tid >> 6, r32 = lane & 31, hh = lane >> 5;
    float (*part)[36][32] = (float (*)[36][32])smem;
    float (*wss)[32] = (float (*)[32])(smem + 18432);
    int* lcnt = (int*)(smem + 18432 + 512);
    int* lbase = lcnt + 32;
    int* cnt = p.cnt + layer * NEXP;
    const int tok = unit * 32 + r32, kq = wid * 256 + 8 * hh;
    __syncthreads();
    if (tid < 32) lcnt[tid] = 0;
    const bf16_t* hrow = p.hb + (size_t)tok * DM + kq;
    const bf16_t* whi = p.wr_hi + ((size_t)layer * 96 + r32) * DM + kq;
    const bf16_t* wlo = p.wr_lo + ((size_t)layer * 96 + r32) * DM + kq;
    f32x16 c0, c1, c2;
#pragma unroll
    for (int i = 0; i < 16; ++i) { c0[i] = 0.f; c1[i] = 0.f; c2[i] = 0.f; }
    float ss = 0.f;
#pragma unroll 4
    for (int st = 0; st < 16; ++st) {
        const u32x4 hw = *(const u32x4*)(hrow + 16 * st);
        float f[8]; unpack8(hw, f);
#pragma unroll
        for (int j = 0; j < 8; ++j) ss += f[j] * f[j];
        const bf16x8 hhi = __builtin_bit_cast(bf16x8, hw);
        bf16x8 wh, wl;
        wh = *(const bf16x8*)(whi + 16 * st); wl = *(const bf16x8*)(wlo + 16 * st);
        c0 = MFMA32(wh, hhi, c0); c0 = MFMA32(wl, hhi, c0);
        wh = *(const bf16x8*)(whi + 32 * DM + 16 * st); wl = *(const bf16x8*)(wlo + 32 * DM + 16 * st);
        c1 = MFMA32(wh, hhi, c1); c1 = MFMA32(wl, hhi, c1);
        wh = *(const bf16x8*)(whi + 64 * DM + 16 * st); wl = *(const bf16x8*)(wlo + 64 * DM + 16 * st);
        c2 = MFMA32(wh, hhi, c2); c2 = MFMA32(wl, hhi, c2);
    }
    {
        auto rr = __builtin_amdgcn_permlane32_swap(__float_as_uint(ss), __float_as_uint(ss), false, false);
        ss = __uint_as_float(rr[0]) + __uint_as_float(rr[1]);
        if (hh == 0) {
#pragma unroll
            for (int i = 0; i < 16; ++i) { part[wid][i][r32] = c0[i]; part[wid][16 + i][r32] = c1[i]; }
#pragma unroll
            for (int i = 0; i < 4; ++i) part[wid][32 + i][r32] = c2[i];
            wss[wid][r32] = ss;
        }
    }
    __syncthreads();
    int e1 = 0, e2 = 0, r1 = 0, r2 = 0; float w1 = 0.f, w2 = 0.f, rstd = 0.f;
    const int mytok = unit * 32 + tid;
    if (tid < 32) {
        rstd = rsqrtf((wss[0][tid] + wss[1][tid] + wss[2][tid] + wss[3][tid]) * (1.0f / DM) + EPS);
        float gl[4], ev[8];
#pragma unroll
        for (int j = 0; j < 4; ++j) gl[j] = (part[0][32 + j][tid] + part[1][32 + j][tid] + part[2][32 + j][tid] + part[3][32 + j][tid]) * rstd;
        int gs = 0; float gm = gl[0];
#pragma unroll
        for (int j = 1; j < 4; ++j) if (gl[j] > gm) { gm = gl[j]; gs = j; }
        const float gw = 1.0f / (__expf(gl[0] - gm) + __expf(gl[1] - gm) + __expf(gl[2] - gm) + __expf(gl[3] - gm));
#pragma unroll
        for (int j = 0; j < 8; ++j) { const int s = gs * 8 + j; ev[j] = (part[0][s][tid] + part[1][s][tid] + part[2][s][tid] + part[3][s][tid]) * rstd; }
        int i1 = 0; float v1 = ev[0];
#pragma unroll
        for (int j = 1; j < 8; ++j) if (ev[j] > v1) { v1 = ev[j]; i1 = j; }
        int i2 = -1; float v2 = -3.0e38f;
#pragma unroll
        for (int j = 0; j < 8; ++j) if (j != i1 && ev[j] > v2) { v2 = ev[j]; i2 = j; }
        w1 = 1.0f / (1.0f + __expf(v2 - v1)); w2 = (1.0f - w1) * gw; w1 *= gw;
        e1 = gs * 8 + i1; e2 = gs * 8 + i2;
        r1 = atomicAdd(lcnt + e1, 1); r2 = atomicAdd(lcnt + e2, 1);
    }
    __syncthreads();
    if (tid < 32) { const int n = lcnt[tid]; lbase[tid] = n ? atomicAdd(cnt + tid, n) : 0; }
    __syncthreads();
    if (tid < 32) {
        p.plist[(size_t)e1 * LISTCAP + lbase[e1] + r1] = mytok * 2; p.plist[(size_t)e2 * LISTCAP + lbase[e2] + r2] = mytok * 2 + 1;
        p.pw[mytok * 2] = w1; p.pw[mytok * 2 + 1] = w2; p.rs[mytok] = rstd;
    }
}
DI void ph_combine(const P& p, int layer) {
    const int wave = threadIdx.x >> 6, lane = threadIdx.x & 63;
    for (int u = blockIdx.x; u < NTOK / 16; u += gridDim.x) {
        const size_t tok0 = (size_t)u * 16 + wave * 2;
        u32x2 hv[2][4], ya[2][4], yb[2][4];
#pragma unroll
        for (int r = 0; r < 2; ++r)
#pragma unroll
            for (int i = 0; i < 4; ++i) {
                const int c = i * 256 + lane * 4;
                hv[r][i] = *(const u32x2*)(p.hb + (tok0 + r) * DM + c);
                ya[r][i] = *(const u32x2*)(p.y + ((tok0 + r) * 2) * DM + c); yb[r][i] = *(const u32x2*)(p.y + ((tok0 + r) * 2 + 1) * DM + c);
            }
#pragma unroll
        for (int r = 0; r < 2; ++r) {
            float ss = 0.f;
#pragma unroll
            for (int i = 0; i < 4; ++i) {
                const u32x2 h0 = hv[r][i], a = ya[r][i], b = yb[r][i];
                f32x4 h;
                h[0] = __uint_as_float(h0.x << 16) + __uint_as_float(a.x << 16) + __uint_as_float(b.x << 16);
                h[1] = __uint_as_float(h0.x & 0xffff0000u) + __uint_as_float(a.x & 0xffff0000u) + __uint_as_float(b.x & 0xffff0000u);
                h[2] = __uint_as_float(h0.y << 16) + __uint_as_float(a.y << 16) + __uint_as_float(b.y << 16);
                h[3] = __uint_as_float(h0.y & 0xffff0000u) + __uint_as_float(a.y & 0xffff0000u) + __uint_as_float(b.y & 0xffff0000u);
                ss += h[0] * h[0] + h[1] * h[1] + h[2] * h[2] + h[3] * h[3];
                if (layer == 0) { u32x2 w; w.x = pack2(h[0], h[1]); w.y = pack2(h[2], h[3]); *(u32x2*)(p.hb + (tok0 + r) * DM + i * 256 + lane * 4) = w; }
                else *(f32x4*)(p.out + (tok0 + r) * DM + i * 256 + lane * 4) = h;
            }
            if (layer == 0) { ss = wave_sum(ss); if (lane == 0) p.rsm[tok0 + r] = rsqrtf(ss * (1.0f / DM) + EPS); }
        }
    }
}

DI void ph_mix_even(const P& p, char* smem) {
    const int half = threadIdx.x >> 8;
    const ConvPlan cv = conv_plan<4>(p, 0); int cslot = 0;
    for (int u = blockIdx.x; u < NB * 4 * 32; u += gridDim.x) {
        const int cp = u & 31, hp = (u >> 5) & 3, b = u >> 7;
        band_attn_unit(p, smem + half * HALF_LDS, (b << 8) | ((hp * 2 + half) << 5) | cp, cv, cslot);
    }
    for (; cslot < cv.nslots; ++cslot) { CONV_DECL4(cR); CONV_LOAD4(cR, cslot); CONV_STORE4(cR); }
    pool_items(p);
}
DI void ph_mix_odd(const P& p, char* smem) {
    const int half = threadIdx.x >> 8;
    volatile int* wdone = (volatile int*)(smem + 2 * HALF_LDS);
    const ConvPlan cv = conv_plan<2>(p, 1); int cslot = 0;
    for (int u = blockIdx.x; u < NB * 4 * 32; u += gridDim.x) {
        const int qb = 31 - (u >> 4), hp = (u >> 2) & 3, b = u & 3;
        sb_attn_unit(p, smem + half * HALF_LDS, wdone, (b << 8) | ((hp * 2 + half) << 5) | qb, cv, cslot);
    }
    for (; cslot < cv.nslots; ++cslot) { CONV_DECL2(cR); CONV_LOAD2(cR, cslot); CONV_STORE2(cR); }
    for (int u = blockIdx.x; u < (NTOK / 128) * 2; u += gridDim.x) sgu_unit(p, smem + half * HALF_LDS, u * 2 + half);
}
DI void ph_router(const P& p, char* smem, int layer) {
    const int half = threadIdx.x >> 8;
    for (int u = blockIdx.x; u < NTOK / 64; u += gridDim.x) router_unit(p, smem + half * HALF_LDS, layer, u * 2 + half);
}

constexpr int NPHASE = 13;
#ifndef REPS
#define REPS {1,1,1,1,1,1,1,1,1,1,1,1,1}
#endif
__device__ constexpr int REP[13] = REPS;
__global__ __launch_bounds__(512, 2) void mega(P p, int ph0, int ph1) {
    __shared__ __attribute__((aligned(16))) char smem[SMEM_BYTES + 64 + 16 + 16];
    volatile LDSAS unsigned* xst = (volatile LDSAS unsigned*)(smem + SMEM_BYTES + 64);
    if (threadIdx.x < 4) xst[threadIdx.x] = 0u;
    __syncthreads();
    const XcdBarrier xb = xcd_barrier_post(p.bar, xst);
#define PHASE(i, call) if (ph0 <= (i) && (i) < ph1) { for (int r_ = 0; r_ < REP[i]; ++r_) { call; if (r_ + 1 < REP[i] || (i) + 1 < ph1) xcd_barrier(xb); } }
    PHASE(0, ph_prologue(p, smem))
    PHASE(1, (ph_gemm_dense<EPI_IN_EVEN, 4>(p, smem, p.hb, DM, p.wb_in_even, DM, EVEN_IN, 0, 0, 8)))
    PHASE(2, ph_mix_even(p, smem))
    PHASE(3, (ph_gemm_dense<EPI_OUT, 4>(p, smem, p.mixed, DM, p.wb_out_even, DM, DM, 0, 0, 4)))
    PHASE(4, ph_router(p, smem, 0))
    PHASE(5, ph_moe(p, smem, 0))
    PHASE(6, ph_combine(p, 0))
    PHASE(7, (ph_gemm_dense<EPI_IN_ODD, 4>(p, smem, p.hb, DM, p.wb_in_odd, DM, ODD_IN, 1, 0, 8), ph_gemm_dense<EPI_IN_ODD, 2>(p, smem, p.hb, DM, p.wb_in_odd, DM, ODD_IN, 1, 8, 2)))
    PHASE(8, ph_mix_odd(p, smem))
    PHASE(9, (ph_gemm_dense<EPI_OUT, 4>(p, smem, p.mixed, DM, p.wb_out_odd, DM, DM, 1, 0, 4)))
    PHASE(10, ph_router(p, smem, 1))
    PHASE(11, ph_moe(p, smem, 1))
    PHASE(12, ph_combine(p, 1))
}

extern "C" void kernel_launch(void* const* d_in, const int* in_sizes, int n_in, void* d_out, int out_size, void* d_ws, size_t ws_size, hipStream_t stream) {
    P p{};
    p.x = (const float*)d_in[0]; p.mix_norm_even = (const float*)d_in[1]; p.w_in_even = (const float*)d_in[2]; p.att_q_norm = (const float*)d_in[3];
    p.att_k_norm = (const float*)d_in[4]; p.att_rel_bias = (const float*)d_in[5]; p.pool_w = (const float*)d_in[6]; p.pool_scale = (const float*)d_in[7];
    p.w_out_even = (const float*)d_in[8]; p.mix_norm_odd = (const float*)d_in[9]; p.w_in_odd = (const float*)d_in[10]; p.sgu_v_norm = (const float*)d_in[11];
    p.sgu_w = (const float*)d_in[12]; p.sgu_b = (const float*)d_in[13]; p.w_out_odd = (const float*)d_in[14]; p.ffn_norm = (const float*)d_in[15];
    p.w_rg = (const float*)d_in[16]; p.w_re = (const float*)d_in[17]; p.w_gate = (const float*)d_in[18]; p.w_up = (const float*)d_in[19]; p.w_down = (const float*)d_in[20];
    p.out = (float*)d_out;
    char* ws = (char*)d_ws; size_t off = 0;
    auto take = [&](size_t bytes) { char* r = ws + off; off += (bytes + 255) & ~(size_t)255; return r; };
    p.wb_in_even = (bf16_t*)take((size_t)EVEN_IN * DM * 2);
    p.wb_out_even = (bf16_t*)take((size_t)DM * DM * 2);
    p.wb_in_odd = (bf16_t*)take((size_t)ODD_IN * DM * 2);
    p.wb_out_odd = (bf16_t*)take((size_t)DM * DM * 2);
    p.wb_gate = (bf16_t*)take((size_t)2 * NEXP * DM * FF * 2);
    p.wb_up = (bf16_t*)take((size_t)2 * NEXP * DM * FF * 2);
    p.wb_down = (bf16_t*)take((size_t)2 * NEXP * DM * FF * 2);
    p.wr_hi = (bf16_t*)take((size_t)2 * 96 * DM * 2);
    p.wr_lo = (bf16_t*)take((size_t)2 * 96 * DM * 2);
    p.hb = (bf16_t*)take((size_t)NTOK * DM * 2);
    p.proj = (bf16_t*)take((size_t)NTOK * ODD_IN * 2);
    p.y = p.proj;
    p.mixed = (bf16_t*)take((size_t)NTOK * DM * 2);
    p.hid = p.mixed;
    p.pw = (float*)take((size_t)NTOK * 2 * 4);
    p.rs = (float*)take((size_t)NTOK * 4);
    p.rsm = (float*)take((size_t)NTOK * 4);
    p.vss = (float*)take((size_t)NTOK * 4);
    p.plist = (int*)take((size_t)NEXP * LISTCAP * 4);
    p.cnt = (int*)take(256);
    p.ones = (const float*)take(256);
    p.dump = (bf16_t*)take((size_t)512 * 512 * 32);
    p.gdone = (int*)take(640 * 4);
    p.bar = (unsigned*)take(XCD_BAR_WORDS * 4);
    (void)hipMemsetAsync(p.bar, 0, XCD_BAR_WORDS * 4, stream);
    for (int l = 0; l < 2; ++l) {
        const size_t o = (size_t)l * NEXP * DM * FF;
        p.cs[l * 5 + 0] = p.w_gate + o; p.cd[l * 5 + 0] = p.wb_gate + o;
        p.cs[l * 5 + 1] = p.w_up + o;   p.cd[l * 5 + 1] = p.wb_up + o;
        p.cs[l * 5 + 2] = p.w_down + o; p.cd[l * 5 + 2] = p.wb_down + o;
        p.cs[l * 5 + 3] = p.w_in_odd;   p.cd[l * 5 + 3] = p.wb_in_odd;
        p.cs[l * 5 + 4] = p.w_out_odd;  p.cd[l * 5 + 4] = p.wb_out_odd;
    }

    static int grid_blocks = 0;
    if (!grid_blocks) {
        int dev = 0, cus = 0, per_cu = 0;
        (void)hipGetDevice(&dev);
        (void)hipDeviceGetAttribute(&cus, hipDeviceAttributeMultiprocessorCount, dev);
        (void)hipOccupancyMaxActiveBlocksPerMultiprocessor(&per_cu, mega, 512, 0);
        if (per_cu < 1) per_cu = 1;
        grid_blocks = cus;
    }
    int ph0 = 0, ph1 = NPHASE;
    void* args[] = {&p, &ph0, &ph1};
    hipError_t e = hipLaunchCooperativeKernel((void*)mega, dim3(grid_blocks), dim3(512), args, 0, stream);
    if (e != hipSuccess) fprintf(stderr, "cooperative launch failed: %s (grid %d)\n", hipGetErrorString(e), grid_blocks);
}
```

```cpp
#include <hip/hip_runtime.h>
#include <hip/hip_cooperative_groups.h>
#include <stdint.h>
#include <stdio.h>

typedef unsigned short bf16_t;
typedef short bf16x8 __attribute__((ext_vector_type(8)));
typedef short s16x4 __attribute__((ext_vector_type(4)));
typedef float f32x2 __attribute__((ext_vector_type(2)));
typedef float f32x4 __attribute__((ext_vector_type(4)));
typedef float f32x16 __attribute__((ext_vector_type(16)));
typedef unsigned u32x4 __attribute__((ext_vector_type(4)));
typedef unsigned u32x2 __attribute__((ext_vector_type(2)));
typedef __bf16 bf16x2n __attribute__((ext_vector_type(2)));

#define DI __device__ __forceinline__
#define LDSAS __attribute__((address_space(3)))
#define MFMA32(a, b, c) __builtin_amdgcn_mfma_f32_32x32x16_bf16((a), (b), (c), 0, 0, 0)
#define MFMA16(a, b, c) __builtin_amdgcn_mfma_f32_16x16x32_bf16((a), (b), (c), 0, 0, 0)

constexpr int NB = 4, NS = 4096, NTOK = NB * NS, DM = 1024;
constexpr int EVEN_IN = 2048, ODD_IN = 2560;
constexpr int NEXP = 32, FF = 256;
constexpr int LISTCAP = NTOK;
constexpr float EPS = 1e-6f;
constexpr float LOG2E = 1.4426950408889634f;
constexpr float QSCALE = 0.125f * LOG2E;

DI int opaque_tid() { int t = threadIdx.x; asm volatile("" : "+v"(t)); return t; }
DI float bf2f(bf16_t b) { return __uint_as_float(((unsigned)b) << 16); }
DI unsigned pack2(float lo, float hi) { f32x2 v = {lo, hi}; bf16x2n r = __builtin_convertvector(v, bf16x2n); return __builtin_bit_cast(unsigned, r); }
DI float wave_sum(float v) { for (int o = 32; o > 0; o >>= 1) v += __shfl_xor(v, o); return v; }
DI float gelu_exact(float x) { return 0.5f * x * (1.0f + erff(x * 0.70710678118654752f)); }
DI s16x4 tr_read(const char* p) { return __builtin_bit_cast(s16x4, __builtin_amdgcn_ds_read_tr16_b64_v4i16((LDSAS s16x4*)p)); }
DI void unpack8(const u32x4 v, float* f) {
    f[0] = __uint_as_float(v.x << 16); f[1] = __uint_as_float(v.x & 0xffff0000u); f[2] = __uint_as_float(v.y << 16); f[3] = __uint_as_float(v.y & 0xffff0000u);
    f[4] = __uint_as_float(v.z << 16); f[5] = __uint_as_float(v.z & 0xffff0000u); f[6] = __uint_as_float(v.w << 16); f[7] = __uint_as_float(v.w & 0xffff0000u);
}
DI int kswz(int k) { return (k & 3) | ((k >> 1) & 4); }

struct P {
    const float *x, *mix_norm_even, *w_in_even, *att_q_norm, *att_k_norm, *att_rel_bias, *pool_w, *pool_scale, *w_out_even;
    const float *mix_norm_odd, *w_in_odd, *sgu_v_norm, *sgu_w, *sgu_b, *w_out_odd, *ffn_norm, *w_rg, *w_re, *w_gate, *w_up, *w_down;
    float* out;
    bf16_t *wb_in_even, *wb_out_even, *wb_in_odd, *wb_out_odd, *wb_gate, *wb_up, *wb_down, *wr_hi, *wr_lo;
    bf16_t *hb, *proj, *mixed, *hid, *y;
    float *pw, *rs, *rsm, *vss; int* plist; int* cnt; unsigned* bar; int* gdone;
    const float* cs[10]; bf16_t* cd[10]; const float* ones; bf16_t* dump;
};

enum { EPI_IN_EVEN = 0, EPI_IN_ODD = 1, EPI_OUT = 2, EPI_GU = 3, EPI_DOWN = 4 };
constexpr int G_ROWID = 131072;
constexpr int SMEM_BYTES = 131072 + 1024;
constexpr int HALF_LDS = 66048;

struct GemmArgs {
    const bf16_t* A; int lda; const int* gather; int mvalid; int gshift;
    const bf16_t* B0; const bf16_t* B1; int ldb; int gu;
    int K, m0, n0;
    bool rowid_ready;
};

DI f32x2 gelu_pk(f32x2 v) {
    const f32x2 av = __builtin_elementwise_abs(v), d = av * 0.2316418882f + 1.0f;
    f32x2 t; t.x = __builtin_amdgcn_rcpf(d.x); t.y = __builtin_amdgcn_rcpf(d.y);
    f32x2 q = t * 0.5307027145f + (-0.7265760135f); q = q * t + 0.7107068705f; q = q * t + (-0.142248368f); q = q * t + 0.127414796f; q = q * t;
    const f32x2 s = (v * v) * (-0.72134752044f);
    f32x2 e; e.x = __builtin_amdgcn_exp2f(s.x); e.y = __builtin_amdgcn_exp2f(s.y);
    const f32x2 m = v * (q * e), r = v - m;
    f32x2 o; o.x = v.x < 0.f ? m.x : r.x; o.y = v.y < 0.f ? m.y : r.y; return o;
}

DI void glds16(const void* gsrc, unsigned lds_dst) {
    unsigned keep;
    asm volatile("s_mov_b32 %0, m0\n\ts_mov_b32 m0, %2\n\ts_nop 0\n\tglobal_load_lds_dwordx4 %1, off\n\ts_mov_b32 m0, %0" : "=&s"(keep) : "v"(gsrc), "s"(lds_dst) : "memory");
}
DI void glds16_sc1(const void* gsrc, unsigned lds_dst) {
    unsigned keep;
    asm volatile("s_mov_b32 %0, m0\n\ts_mov_b32 m0, %2\n\ts_nop 0\n\tglobal_load_lds_dwordx4 %1, off sc1\n\ts_mov_b32 m0, %0" : "=&s"(keep) : "v"(gsrc), "s"(lds_dst) : "memory");
}
DI void st16_sc1(void* q, u32x4 v) { asm volatile("global_store_dwordx4 %0, %1, off sc1\n\ts_nop 1" :: "v"(q), "v"(v) : "memory"); }
template <int EPI, int MT>
DI void gemm_tile(const P& p, char* smem, const GemmArgs& g, int layer) {
    const int tid = opaque_tid(), lane = tid & 63, wid = tid >> 6, wm = wid >> 2, wn = wid & 3, r32 = lane & 31, hh = lane >> 5;
    int* rowid = (int*)(smem + G_ROWID);
    constexpr int NA = MT / 2;
    constexpr int IPT = NA + 2;
    const bf16_t* ap[NA]; const bf16_t* bp[2];
    if (g.gather && !g.rowid_ready) { if (tid < 64 * MT) rowid[tid] = (tid < g.mvalid) ? g.gather[tid] : -1; __syncthreads(); }
#pragma unroll
    for (int i = 0; i < NA; ++i) {
        const int r = (wid * NA + i) * 16 + (lane >> 2), kc = (lane & 3) ^ ((r >> 2) & 3);
        size_t arow;
        if (g.gather) { int id = rowid[r]; if (id < 0) id = rowid[0]; arow = (size_t)(id >> g.gshift); } else arow = (size_t)(g.m0 + r);
        ap[i] = g.A + arow * g.lda + kc * 8;
    }
#pragma unroll
    for (int i = 0; i < 2; ++i) {
        const int k = (wid * 2 + i) * 2 + (lane >> 5), sl = lane & 31, ch = (((sl >> 2) ^ (k & 7)) << 2) | (sl & 3);
        const bf16_t* bcol = g.gu ? ((((ch >> 2) & 1) ? g.B1 : g.B0) + (g.n0 >> 1) + (ch >> 3) * 32 + (ch & 3) * 8) : (g.B0 + g.n0 + ch * 8);
        bp[i] = bcol + (size_t)k * g.ldb;
    }
    const size_t bstep = (size_t)32 * g.ldb;
    float gu_w[MT], gu_rs[MT];
    if (EPI == EPI_GU) {
#pragma unroll
        for (int mt = 0; mt < MT; ++mt) { const int id = rowid[wm * 32 * MT + mt * 32 + r32]; gu_w[mt] = id >= 0 ? p.pw[id] : 0.f; gu_rs[mt] = id >= 0 ? p.rs[id >> 1] : 0.f; }
    } else if (EPI == EPI_IN_EVEN || EPI == EPI_IN_ODD) {
#pragma unroll
        for (int mt = 0; mt < MT; ++mt) gu_rs[mt] = p.rsm[g.m0 + wm * 32 * MT + mt * 32 + r32];
    }
    f32x16 acc[MT][2];
#pragma unroll
    for (int a = 0; a < MT; ++a)
#pragma unroll
        for (int b = 0; b < 2; ++b)
#pragma unroll
            for (int i = 0; i < 16; ++i) acc[a][b][i] = 0.f;
    const int nk = g.K / 32;
    const int arow0 = wm * 32 * MT + r32;
    const int asw = (r32 >> 2) & 3;
    const int g1 = (lane >> 4) & 1, qq = (lane & 15) >> 2, pp = lane & 3;
    const int bk0 = 8 * hh + qq;
    const unsigned ldsb = (unsigned)(size_t)(LDSAS char*)smem;
    const unsigned adst = ldsb + (wid * NA) * 1024, bdst = ldsb + 16384 + (wid * 2) * 1024;
#define G_LOAD(KT) do { const unsigned so_ = (unsigned)((KT) & 3) * 32768u; \
        _Pragma("unroll") for (int i = 0; i < NA; ++i) { if (EPI == EPI_DOWN) glds16_sc1(ap[i] + (KT) * 32, (unsigned)__builtin_amdgcn_readfirstlane(adst + so_ + i * 1024)); \
                                                        else glds16(ap[i] + (KT) * 32, (unsigned)__builtin_amdgcn_readfirstlane(adst + so_ + i * 1024)); } \
        _Pragma("unroll") for (int i = 0; i < 2; ++i) glds16(bp[i] + (size_t)(KT) * bstep, (unsigned)__builtin_amdgcn_readfirstlane(bdst + so_ + i * 1024)); } while (0)
#define G_COMPUTE(KT) do { const char* Ac = smem + ((KT) & 3) * 32768; const char* Bc = Ac + 16384; \
        _Pragma("unroll") for (int st = 0; st < 2; ++st) { bf16x8 af[MT], bfv[2]; \
            _Pragma("unroll") for (int mt = 0; mt < MT; ++mt) af[mt] = *(const bf16x8*)(Ac + (arow0 + mt * 32) * 64 + (((2 * st + hh) ^ asw) << 4)); \
            _Pragma("unroll") for (int nt = 0; nt < 2; ++nt) { const int k = 16 * st + bk0; \
                const char* b0_ = Bc + k * 512 + (((wn * 2 + nt) ^ (k & 7)) << 6) + g1 * 32 + pp * 8; \
                const char* b1_ = Bc + (k + 4) * 512 + (((wn * 2 + nt) ^ ((k + 4) & 7)) << 6) + g1 * 32 + pp * 8; \
                const s16x4 lo = tr_read(b0_), hi = tr_read(b1_); \
                bfv[nt] = (bf16x8){lo[0], lo[1], lo[2], lo[3], hi[0], hi[1], hi[2], hi[3]}; } \
            _Pragma("unroll") for (int mt = 0; mt < MT; ++mt) _Pragma("unroll") for (int nt = 0; nt < 2; ++nt) acc[mt][nt] = MFMA32(bfv[nt], af[mt], acc[mt][nt]); } } while (0)
#define G_WAIT(N) do { if ((N) == 2) { if (IPT == 4) asm volatile("s_waitcnt vmcnt(8)" ::: "memory"); else asm volatile("s_waitcnt vmcnt(6)" ::: "memory"); } \
                       else if ((N) == 1) { if (IPT == 4) asm volatile("s_waitcnt vmcnt(4)" ::: "memory"); else asm volatile("s_waitcnt vmcnt(3)" ::: "memory"); } \
                       else asm volatile("s_waitcnt vmcnt(0)" ::: "memory"); } while (0)
    G_LOAD(0); G_LOAD(1); G_LOAD(2);
    G_WAIT(2); __syncthreads();
#pragma nounroll
    for (int kt = 0; kt < nk; ++kt) {
        if (kt + 3 < nk) G_LOAD(kt + 3);
        G_COMPUTE(kt);
        if (kt + 3 < nk) G_WAIT(2); else if (kt + 2 < nk) G_WAIT(1); else G_WAIT(0);
        __syncthreads();
    }
#undef G_LOAD
#undef G_COMPUTE
#undef G_WAIT
    const int colw = g.n0 + wn * 64;
    char* wsl = smem + wid * 16384;
    const int rowb = wm * 32 * MT;
    if (EPI == EPI_IN_EVEN || EPI == EPI_IN_ODD || EPI == EPI_DOWN) {
        const int region = colw >> 9;
        const float* gn = region == 0 ? p.att_q_norm : p.att_k_norm;
        const bool act = colw < 1024;
        const float qs = (colw >= 1024 && colw < 1536) ? QSCALE : 1.0f;
#pragma unroll
        for (int mt = 0; mt < MT; ++mt) {
            float sc = 1.f;
            if (EPI == EPI_IN_EVEN || EPI == EPI_IN_ODD) {
                const float rr_ = gu_rs[mt];
#pragma unroll
                for (int nt = 0; nt < 2; ++nt) acc[mt][nt] = acc[mt][nt] * rr_;
            }
            if (EPI == EPI_IN_EVEN && region < 2) {
                float ss = 0.f;
#pragma unroll
                for (int nt = 0; nt < 2; ++nt)
#pragma unroll
                    for (int i = 0; i < 16; ++i) ss += acc[mt][nt][i] * acc[mt][nt][i];
                auto rr = __builtin_amdgcn_permlane32_swap(__float_as_uint(ss), __float_as_uint(ss), false, false);
                ss = __uint_as_float(rr[0]) + __uint_as_float(rr[1]);
                sc = rsqrtf(ss * (1.0f / 64.0f) + EPS) * (region == 0 ? QSCALE : 1.0f);
            }
            float vsum = 0.f;
#pragma unroll
            for (int nt = 0; nt < 2; ++nt)
#pragma unroll
                for (int gq = 0; gq < 4; ++gq) {
                    f32x2 v0 = {acc[mt][nt][4 * gq], acc[mt][nt][4 * gq + 1]}, v1 = {acc[mt][nt][4 * gq + 2], acc[mt][nt][4 * gq + 3]};
                    if (EPI == EPI_IN_EVEN) { if (region < 2) { const f32x4 gg = *(const f32x4*)(gn + nt * 32 + 8 * gq + 4 * hh); v0.x *= sc * gg[0]; v0.y *= sc * gg[1]; v1.x *= sc * gg[2]; v1.y *= sc * gg[3]; } }
                    else if (EPI == EPI_IN_ODD) { if (act) { v0 = gelu_pk(v0); v1 = gelu_pk(v1); vsum += v0.x * v0.x + v0.y * v0.y + v1.x * v1.x + v1.y * v1.y; } else { v0 = v0 * qs; v1 = v1 * qs; } }
                    u32x2 w; w.x = pack2(v0.x, v0.y); w.y = pack2(v1.x, v1.y);
                    *(u32x2*)(wsl + r32 * 128 + (((nt * 4 + gq) ^ (r32 & 7)) << 4) + hh * 8) = w;
                }
            if (EPI == EPI_IN_ODD && colw >= 512 && colw < 1024) {
                auto rr = __builtin_amdgcn_permlane32_swap(__float_as_uint(vsum), __float_as_uint(vsum), false, false);
                vsum = __uint_as_float(rr[0]) + __uint_as_float(rr[1]);
                if (hh == 0) atomicAdd(p.vss + g.m0 + rowb + mt * 32 + r32, vsum);
            }
#pragma unroll
            for (int ps = 0; ps < 4; ++ps) {
                const int row = ps * 8 + (lane >> 3), chunk = lane & 7;
                const u32x4 v = *(const u32x4*)(wsl + row * 128 + ((chunk ^ (row & 7)) << 4));
                const int trow = rowb + mt * 32 + row;
                if (EPI == EPI_DOWN) { const int id = rowid[trow]; if (id >= 0) *(u32x4*)(p.y + (size_t)id * DM + colw + chunk * 8) = v; }
                else if (EPI == EPI_IN_EVEN) *(u32x4*)(p.proj + (size_t)(g.m0 + trow) * EVEN_IN + colw + chunk * 8) = v;
                else *(u32x4*)(p.proj + (size_t)(g.m0 + trow) * ODD_IN + colw + chunk * 8) = v;
            }
        }
    } else if (EPI == EPI_OUT) {
#pragma unroll
        for (int mt = 0; mt < MT; ++mt) {
            f32x4 rx[8]; u32x2 rh[8];
#pragma unroll
            for (int ps = 0; ps < 8; ++ps) {
                const size_t off = (size_t)(g.m0 + rowb + mt * 32 + ps * 4 + (lane >> 4)) * DM + colw + (lane & 15) * 4;
                if (layer == 0) rx[ps] = *(const f32x4*)(p.x + off); else rh[ps] = *(const u32x2*)(p.hb + off);
            }
#pragma unroll
            for (int nt = 0; nt < 2; ++nt)
#pragma unroll
                for (int gq = 0; gq < 4; ++gq) {
                    const f32x4 v = {acc[mt][nt][4 * gq], acc[mt][nt][4 * gq + 1], acc[mt][nt][4 * gq + 2], acc[mt][nt][4 * gq + 3]};
                    *(f32x4*)(wsl + r32 * 256 + (((nt * 8 + 2 * gq + hh) ^ (r32 & 15)) << 4)) = v;
                }
#pragma unroll
            for (int ps = 0; ps < 8; ++ps) {
                const int row = ps * 4 + (lane >> 4), chunk = lane & 15;
                const f32x4 v = *(const f32x4*)(wsl + row * 256 + ((chunk ^ (row & 15)) << 4));
                const size_t off = (size_t)(g.m0 + rowb + mt * 32 + row) * DM + colw + chunk * 4;
                f32x4 r;
                if (layer == 0) r = rx[ps];
                else r = (f32x4){__uint_as_float(rh[ps].x << 16), __uint_as_float(rh[ps].x & 0xffff0000u), __uint_as_float(rh[ps].y << 16), __uint_as_float(rh[ps].y & 0xffff0000u)};
                r = r + v;
                u32x2 w; w.x = pack2(r[0], r[1]); w.y = pack2(r[2], r[3]);
                *(u32x2*)(p.hb + off) = w;
            }
        }
    } else if (EPI == EPI_GU) {
        const int f0 = (g.n0 >> 1) + wn * 32;
#pragma unroll
        for (int mt = 0; mt < MT; ++mt) {
            const float w = gu_w[mt], rs = gu_rs[mt];
#pragma unroll
            for (int gq = 0; gq < 4; ++gq) {
                float h[4];
#pragma unroll
                for (int j = 0; j < 4; ++j) { const float gt = acc[mt][0][4 * gq + j] * rs, up = acc[mt][1][4 * gq + j] * (rs * w);
                    h[j] = gt * __builtin_amdgcn_rcpf(1.0f + __builtin_amdgcn_exp2f(-LOG2E * gt)) * up; }
                u32x2 ww; ww.x = pack2(h[0], h[1]); ww.y = pack2(h[2], h[3]);
                *(u32x2*)(wsl + r32 * 64 + ((gq ^ (r32 & 3)) << 4) + hh * 8) = ww;
            }
#pragma unroll
            for (int ps = 0; ps < 2; ++ps) {
                const int row = ps * 16 + (lane >> 2), chunk = lane & 3;
                const u32x4 v = *(const u32x4*)(wsl + row * 64 + ((chunk ^ (row & 3)) << 4));
                const int id2 = rowid[rowb + mt * 32 + row];
                if (id2 >= 0) st16_sc1(p.hid + (size_t)id2 * FF + f0 + chunk * 8, v);
            }
        }
        asm volatile("s_waitcnt vmcnt(0)" ::: "memory");
    }
    __syncthreads();
}

template <int EPI, int MT>
DI void ph_gemm_dense(const P& p, char* smem, const bf16_t* A, int lda, const bf16_t* B, int K, int N, int layer, int nt0, int ntc) {
    const int ntm = NTOK / (64 * MT), per_xcd = (ntm / 8) * ntc;
    const bool xcd = (gridDim.x & 7) == 0;
    const int x = blockIdx.x & 7, gx = gridDim.x >> 3;
    const int jend = xcd ? per_xcd : ntm * ntc, jstep = xcd ? gx : (int)gridDim.x;
    for (int j = xcd ? (int)(blockIdx.x >> 3) : (int)blockIdx.x; j < jend; j += jstep) {
        GemmArgs g; g.A = A; g.lda = lda; g.gather = nullptr; g.mvalid = 64 * MT; g.gshift = 0; g.rowid_ready = false; g.B0 = B; g.B1 = B; g.ldb = N; g.gu = 0; g.K = K;
        const int rot = ((j / jstep) & 1) * (ntc >> 1);
        g.m0 = ((xcd ? x * (ntm / 8) : 0) + j / ntc) * (64 * MT); g.n0 = (nt0 + (j % ntc + rot) % ntc) * 256;
        gemm_tile<EPI, MT>(p, smem, g, layer);
    }
}

DI void moe_locate(const int* cnt, int mt, int& e, int& c, int& mtl) {
    e = 0; c = 0;
    for (; e < NEXP; ++e) { c = cnt[e]; const int t = (c + 127) >> 7; if (mt < t) break; mt -= t; }
    mtl = mt;
}
DI void ph_moe(const P& p, char* smem, int layer) {
    const int* cnt = p.cnt + layer * NEXP;
    int* gdone = p.gdone + layer * 320;
    int* queue = p.gdone + 600 + layer;
    volatile int* s_next = (volatile int*)(smem + SMEM_BYTES + 80);
    int total = 0;
    for (int e = 0; e < NEXP; ++e) total += (cnt[e] + 127) >> 7;
    const int ngu = total * 2, nall = total * 6;
    int mine = 0;
    if (threadIdx.x == 0) mine = __hip_atomic_fetch_add(queue, 1, __ATOMIC_RELAXED, __HIP_MEMORY_SCOPE_AGENT);
    for (;;) {
        if (threadIdx.x == 0) s_next[0] = mine;
        __syncthreads();
        const int u = s_next[0];
        if (u >= nall) break;
        if (threadIdx.x == 0) mine = __hip_atomic_fetch_add(queue, 1, __ATOMIC_RELAXED, __HIP_MEMORY_SCOPE_AGENT);
        if (u < ngu) {
            int e, c, mt; moe_locate(cnt, u >> 1, e, c, mt);
            GemmArgs g; g.gather = p.plist + (size_t)e * LISTCAP + mt * 128; g.mvalid = c - mt * 128 < 128 ? c - mt * 128 : 128;
            g.m0 = 0; g.n0 = (u & 1) * 256;
            const size_t ex = (size_t)(layer * NEXP + e);
            g.rowid_ready = false; g.A = p.hb; g.lda = DM; g.gshift = 1; g.B0 = p.wb_gate + ex * DM * FF; g.B1 = p.wb_up + ex * DM * FF; g.ldb = FF; g.gu = 1; g.K = DM;
            gemm_tile<EPI_GU, 2>(p, smem, g, layer);
            if (threadIdx.x == 0) __hip_atomic_fetch_add(gdone + (u >> 1), 1, __ATOMIC_RELAXED, __HIP_MEMORY_SCOPE_AGENT);
        } else {
            const int v = u - ngu;
            int e, c, mt; moe_locate(cnt, v >> 2, e, c, mt);
            GemmArgs g; g.gather = p.plist + (size_t)e * LISTCAP + mt * 128; g.mvalid = c - mt * 128 < 128 ? c - mt * 128 : 128;
            {
                int* rowid = (int*)(smem + G_ROWID);
                const int rid = (threadIdx.x < 128 && (int)threadIdx.x < g.mvalid) ? g.gather[threadIdx.x] : -1;
                if (threadIdx.x == 0) { unsigned sp = 0;
                    while (__hip_atomic_load(gdone + (v >> 2), __ATOMIC_RELAXED, __HIP_MEMORY_SCOPE_AGENT) < 2) { __builtin_amdgcn_s_sleep(2); if (++sp > (1u << 22)) break; } }
                if (threadIdx.x < 128) rowid[threadIdx.x] = rid;
                __syncthreads();
            }
            g.m0 = 0; g.n0 = (v & 3) * 256;
            const size_t ex = (size_t)(layer * NEXP + e);
            g.rowid_ready = true; g.A = p.hid; g.lda = FF; g.gshift = 0; g.B0 = p.wb_down + ex * FF * DM; g.B1 = g.B0; g.ldb = DM; g.gu = 0; g.K = FF;
            gemm_tile<EPI_DOWN, 2>(p, smem, g, layer);
        }
    }
}

DI void convert_flat(const float* __restrict__ src, bf16_t* __restrict__ dst, size_t n8, const float* __restrict__ gain = nullptr, int rowlen = 1) {
    for (size_t i = (size_t)blockIdx.x * 512 + threadIdx.x; i < n8; i += (size_t)gridDim.x * 512) {
        f32x4 a = *(const f32x4*)(src + i * 8), b = *(const f32x4*)(src + i * 8 + 4);
        if (gain) { const float gk = gain[(i * 8) / (size_t)rowlen]; a = a * gk; b = b * gk; }
        u32x4 w; w.x = pack2(a[0], a[1]); w.y = pack2(a[2], a[3]); w.z = pack2(b[0], b[1]); w.w = pack2(b[2], b[3]);
        *(u32x4*)(dst + i * 8) = w;
    }
}
DI void poolfold_unit(const P& p, char* smem, int unit) {
    float (*At)[32] = (float (*)[32])smem;
    float (*Bs)[64] = (float (*)[64])(smem + 16384);
    const int tid = opaque_tid() & 255, g = unit >> 6, c0 = ((unit >> 4) & 3) * 32, n0 = (unit & 15) * 64;
    __syncthreads();
    for (int i = 0; i < 16; ++i) { const int idx = tid + 256 * i, d = idx >> 5, c = idx & 31;
        At[d][c] = p.pool_w[(size_t)(g * 128 + c0 + c) * 128 + d] * p.pool_scale[g * 128 + d]; }
    for (int i = 0; i < 8; ++i) { const int idx = tid + 256 * i, d = idx >> 4, n4 = (idx & 15) * 4;
        *(f32x4*)&Bs[d][n4] = *(const f32x4*)(p.w_out_even + (size_t)(512 + g * 128 + d) * DM + n0 + n4); }
    __syncthreads();
    const int tc = (tid >> 4) * 2, tn = (tid & 15) * 4;
    f32x4 acc[2] = {(f32x4){0.f, 0.f, 0.f, 0.f}, (f32x4){0.f, 0.f, 0.f, 0.f}};
#pragma unroll 8
    for (int d = 0; d < 128; ++d) {
        const f32x2 a = *(const f32x2*)&At[d][tc]; const f32x4 b = *(const f32x4*)&Bs[d][tn];
        acc[0] += a.x * b; acc[1] += a.y * b;
    }
#pragma unroll
    for (int i = 0; i < 2; ++i) { u32x2 w; w.x = pack2(acc[i][0], acc[i][1]); w.y = pack2(acc[i][2], acc[i][3]);
        *(u32x2*)(p.wb_out_even + (size_t)(512 + g * 128 + c0 + tc + i) * DM + n0 + tn) = w; }
}
DI void cast_rows2(const P& p, int tok, int lane) {
    f32x4 v[2][4];
#pragma unroll
    for (int r = 0; r < 2; ++r)
#pragma unroll
        for (int i = 0; i < 4; ++i) v[r][i] = *(const f32x4*)(p.x + (size_t)(tok + r) * DM + i * 256 + lane * 4);
#pragma unroll
    for (int r = 0; r < 2; ++r) {
        float ss = 0.f;
#pragma unroll
        for (int i = 0; i < 4; ++i) { ss += v[r][i][0] * v[r][i][0] + v[r][i][1] * v[r][i][1] + v[r][i][2] * v[r][i][2] + v[r][i][3] * v[r][i][3];
            u32x2 w; w.x = pack2(v[r][i][0], v[r][i][1]); w.y = pack2(v[r][i][2], v[r][i][3]);
            *(u32x2*)(p.hb + (size_t)(tok + r) * DM + i * 256 + lane * 4) = w; }
        ss = wave_sum(ss);
        if (lane == 0) p.rsm[tok + r] = rsqrtf(ss * (1.0f / DM) + EPS);
    }
}
DI void ph_prologue(const P& p, char* smem) {
    if (blockIdx.x == 0 && threadIdx.x < 64) p.cnt[threadIdx.x] = 0;
    if (blockIdx.x == 2 && threadIdx.x == 0) ((float*)p.ones)[0] = 1.0f;
    if (blockIdx.x == 1) for (int i = threadIdx.x; i < 640; i += 512) p.gdone[i] = 0;
    for (int i = blockIdx.x * 512 + threadIdx.x; i < NTOK; i += gridDim.x * 512) p.vss[i] = 0.f;
    for (int u = blockIdx.x; u < 128; u += gridDim.x) poolfold_unit(p, smem + (threadIdx.x >> 8) * HALF_LDS, u * 2 + (threadIdx.x >> 8));
    for (int i = blockIdx.x * 512 + threadIdx.x; i < 2 * 96 * DM; i += gridDim.x * 512) {
        const int k = i & (DM - 1), R = (i >> 10) % 96, layer = i / (96 * DM);
        const int T = R >> 5, r = R & 31, L = 16 * T + (r & 3) + 4 * (r >> 3);
        float w = 0.f;
        if (L < 32) w = p.w_re[((size_t)layer * DM + k) * 32 + L]; else if (L < 36) w = p.w_rg[((size_t)layer * DM + k) * 4 + (L - 32)];
        w *= p.ffn_norm[layer * DM + k];
        const unsigned hi = pack2(w, 0.f) & 0xffffu;
        p.wr_hi[i] = (bf16_t)hi; p.wr_lo[i] = (bf16_t)(pack2(w - __uint_as_float(hi << 16), 0.f) & 0xffffu);
    }
    const int wave = threadIdx.x >> 6, lane = threadIdx.x & 63;
    for (int u = blockIdx.x; u < NTOK / 16; u += gridDim.x) {
        const int tok = u * 16 + wave * 2;
        cast_rows2(p, tok, lane);
    }
    convert_flat(p.w_in_even, p.wb_in_even, (size_t)DM * EVEN_IN / 8, p.mix_norm_even, EVEN_IN);
    convert_flat(p.w_out_even, p.wb_out_even, (size_t)512 * DM / 8);
}
DI void convert_experts(const P& p, int layer) {
    const size_t o = (size_t)layer * NEXP * DM * FF;
    convert_flat(p.w_gate + o, p.wb_gate + o, (size_t)NEXP * DM * FF / 8);
    convert_flat(p.w_up + o, p.wb_up + o, (size_t)NEXP * DM * FF / 8);
    convert_flat(p.w_down + o, p.wb_down + o, (size_t)NEXP * DM * FF / 8);
}

DI int crow(int i, int h) { return (i & 3) + 8 * (i >> 2) + 4 * h; }
DI float swap_max(float v) { auto rr = __builtin_amdgcn_permlane32_swap(__float_as_uint(v), __float_as_uint(v), false, false); return fmaxf(__uint_as_float(rr[0]), __uint_as_float(rr[1])); }
DI float swap_sum(float v) { auto rr = __builtin_amdgcn_permlane32_swap(__float_as_uint(v), __float_as_uint(v), false, false); return __uint_as_float(rr[0]) + __uint_as_float(rr[1]); }
DI float bcast_lo(float v) { auto rr = __builtin_amdgcn_permlane32_swap(__float_as_uint(v), __float_as_uint(v), false, false); return __uint_as_float(rr[0]); }
DI bf16x8 pack8(const f32x16& x, int s) {
    u32x4 w; w.x = pack2(x[8 * s], x[8 * s + 1]); w.y = pack2(x[8 * s + 2], x[8 * s + 3]); w.z = pack2(x[8 * s + 4], x[8 * s + 5]); w.w = pack2(x[8 * s + 6], x[8 * s + 7]);
    return __builtin_bit_cast(bf16x8, w);
}
constexpr int KV_TILE = 8192;
struct KVStage { u32x4 k[2], v[2]; };
DI void kv_load(KVStage& st, const bf16_t* kbase, const bf16_t* vbase, int ld, int key0) {
    const int tid = opaque_tid() & 255, c = tid & 7, r0 = tid >> 3;
#pragma unroll
    for (int i = 0; i < 2; ++i) { const size_t off = (size_t)(key0 + r0 + 32 * i) * ld + c * 8; st.k[i] = *(const u32x4*)(kbase + off); st.v[i] = *(const u32x4*)(vbase + off); }
}
DI void kv_store(const KVStage& st, char* kt, char* vt) {
    const int tid = opaque_tid() & 255, c = tid & 7, r0 = tid >> 3;
#pragma unroll
    for (int i = 0; i < 2; ++i) { const int r = r0 + 32 * i;
        *(u32x4*)(kt + r * 128 + ((c ^ ((r >> 1) & 7)) << 4)) = st.k[i];
        *(u32x4*)(vt + r * 128 + ((((c >> 2) ^ ((r >> 1) & 1))) << 6) + ((c & 3) << 4)) = st.v[i]; }
}
DI bf16x8 k_frag(const char* kt, int sb, int st, int r32, int hh) {
    const int row = sb * 32 + r32;
    return *(const bf16x8*)(kt + row * 128 + (((2 * st + hh) ^ ((row >> 1) & 7)) << 4));
}
DI bf16x8 vt_frag(const char* vt, int sb, int st, int dh, int lane) {
    const int hh = lane >> 5, g1 = (lane >> 4) & 1, pp = lane & 3, q = (lane & 15) >> 2;
    const int key = sb * 32 + 16 * st + 4 * hh + q;
    const char* a = vt + key * 128 + ((dh ^ ((q >> 1) & 1)) << 6) + g1 * 32 + pp * 8;
    const s16x4 lo = tr_read(a), hi = tr_read(a + 8 * 128);
    return (bf16x8){lo[0], lo[1], lo[2], lo[3], hi[0], hi[1], hi[2], hi[3]};
}


#define XB_TMO      128
#define XB_XCNT(j)  (256  + 64 * (j))
#define XB_XSUB(j)  (1280 + 64 * (j))
#define XB_XGEN(j)  (2304 + 64 * (j))
#define XB_TOP      3328
#define XB_TOPGEN   3392
#define XCD_BAR_WORDS 3456
#define XB_SPIN_CAP (1u << 22)
DI unsigned xb_ld(unsigned* q)              { return __hip_atomic_load(q, __ATOMIC_RELAXED, __HIP_MEMORY_SCOPE_AGENT); }
DI unsigned xb_add(unsigned* q, unsigned v) { return __hip_atomic_fetch_add(q, v, __ATOMIC_RELAXED, __HIP_MEMORY_SCOPE_AGENT); }
DI unsigned xb_xcc_id() { return (unsigned)__builtin_amdgcn_s_getreg((3 << 11) | 20) & 0xFu; }
#define XB_SPIN(cond, bar) do { unsigned _sp = 0; while (cond) { __builtin_amdgcn_s_sleep(1); \
    if ((++_sp & 255u) == 0u) { if (xb_ld(&(bar)[XB_TMO])) break; if (_sp > XB_SPIN_CAP) { atomicAdd(&(bar)[XB_TMO], 1u); break; } } } } while (0)
struct XcdBarrier { unsigned* bar; unsigned x; volatile LDSAS unsigned* st; };
DI XcdBarrier xcd_barrier_post(unsigned* bar, volatile LDSAS unsigned* st) {
    XcdBarrier b; b.bar = bar; b.x = xb_xcc_id(); b.st = st;
    if (threadIdx.x == 0) (void)xb_add(&bar[XB_XCNT(b.x)], 1u);
    return b;
}
DI void xcd_barrier_complete(unsigned* bar, unsigned x, unsigned& nloc, unsigned& nx) {
    const unsigned G = gridDim.x * gridDim.y * gridDim.z;
    unsigned sum, cnt, mine, sp = 0u;
    for (;;) {
        sum = 0u; cnt = 0u; mine = 0u;
#pragma unroll
        for (unsigned j = 0; j < 16; ++j) { const unsigned c = xb_ld(&bar[XB_XCNT(j)]); sum += c; cnt += (c > 0u) ? 1u : 0u; mine = (j == x) ? c : mine; }
        if (sum == G) break;
        __builtin_amdgcn_s_sleep(1);
        if ((++sp & 255u) == 0u) { if (xb_ld(&bar[XB_TMO])) break; if (sp > XB_SPIN_CAP) { atomicAdd(&bar[XB_TMO], 1u); break; } }
    }
    nloc = mine > 0u ? mine : 1u; nx = cnt > 0u ? cnt : 1u;
}
DI void xcd_barrier(const XcdBarrier& b) {
    asm volatile("s_waitcnt vmcnt(0)" ::: "memory");
    __syncthreads();
    if (threadIdx.x == 0) {
        unsigned* bar = b.bar;
        __builtin_amdgcn_s_waitcnt(0);
        unsigned nloc = b.st[0], nx = b.st[1];
        if (nloc == 0u) { xcd_barrier_complete(bar, b.x, nloc, nx); b.st[0] = nloc; b.st[1] = nx; }
        const unsigned old = xb_add(&bar[XB_XSUB(b.x)], 1u);
        const unsigned gen = old / nloc;
        if (old + 1u == (gen + 1u) * nloc) {
            __builtin_amdgcn_fence(__ATOMIC_RELEASE, "agent");
            asm volatile("s_waitcnt vmcnt(0)" ::: "memory");
            const unsigned og = xb_add(&bar[XB_TOP], 1u);
            const unsigned tg = og / nx;
            if (og + 1u == (tg + 1u) * nx) xb_add(&bar[XB_TOPGEN], 1u);
            else XB_SPIN(xb_ld(&bar[XB_TOPGEN]) == tg, bar);
            __builtin_amdgcn_fence(__ATOMIC_ACQUIRE, "agent");
            xb_add(&bar[XB_XGEN(b.x)], 1u);
            asm volatile("s_waitcnt vmcnt(0)" ::: "memory");
        } else {
            XB_SPIN(xb_ld(&bar[XB_XGEN(b.x)]) == gen, bar);
            __builtin_amdgcn_fence(__ATOMIC_ACQUIRE, "agent");
            asm volatile("s_waitcnt vmcnt(0)" ::: "memory");
        }
    }
    __syncthreads();
}


struct ConvPlan { int layer; int sl_e, sl_in, sl_out, nslots; };
template <int NV> DI ConvPlan conv_plan(const P& p, int layer) {
    ConvPlan c; c.layer = layer;
    const unsigned per = gridDim.x * 512u, gsz = 4 * NV;
    c.sl_e = (int)((NEXP * DM * FF / gsz + per - 1) / per);
    c.sl_in = layer == 0 ? (int)((DM * ODD_IN / gsz + per - 1) / per) : 0;
    c.sl_out = layer == 0 ? (int)((DM * DM / gsz + per - 1) / per) : 0;
    c.nslots = 3 * c.sl_e + c.sl_in + c.sl_out;
    return c;
}
template <int NV> DI void conv_locate(const P& p, const ConvPlan& c, int slot, const float*& s, bf16_t*& d, const float*& gp) {
    constexpr unsigned gsz = 4 * NV;
    int seg = 0, ls = slot;
    if (ls < 3 * c.sl_e) { seg = ls / c.sl_e; ls -= seg * c.sl_e; }
    else if ((ls -= 3 * c.sl_e) < c.sl_in) seg = 3;
    else { ls -= c.sl_in; seg = 4; }
    const unsigned ng = seg < 3 ? NEXP * DM * FF / gsz : (seg == 3 ? DM * ODD_IN / gsz : DM * DM / gsz);
    const unsigned gi = ((unsigned)ls * gridDim.x + blockIdx.x) * 512u + threadIdx.x;
    const bool live = slot < c.nslots && gi < ng;
    const size_t e = live ? (size_t)gi * gsz : 0;
    const int tix = c.layer * 5 + __builtin_amdgcn_readfirstlane(seg);
    s = p.cs[tix] + e;
    d = live ? p.cd[tix] + e : p.dump + ((size_t)blockIdx.x * 512 + threadIdx.x) * 16;
    gp = p.ones;
    if (live && seg < 2) gp = p.ffn_norm + c.layer * DM + ((e >> 8) & (DM - 1));
    else if (live && seg == 3) gp = p.mix_norm_odd + e / ODD_IN;
}
#define CONV_DECL4(N) f32x4 N##0, N##1, N##2, N##3; float N##g; bf16_t* N##d
#define CONV_DECL2(N) f32x4 N##0, N##1; float N##g; bf16_t* N##d
#define CONV_LOAD4(N, SLOT) do { const float* s_; const float* g_; conv_locate<4>(p, cv, (SLOT), s_, N##d, g_); \
        N##g = *g_; N##0 = *(const f32x4*)s_; N##1 = *(const f32x4*)(s_ + 4); N##2 = *(const f32x4*)(s_ + 8); N##3 = *(const f32x4*)(s_ + 12); } while (0)
#define CONV_LOAD2(N, SLOT) do { const float* s_; const float* g_; conv_locate<2>(p, cv, (SLOT), s_, N##d, g_); \
        N##g = *g_; N##0 = *(const f32x4*)s_; N##1 = *(const f32x4*)(s_ + 4); } while (0)
#define CONV_STORE4(N) do { const f32x4 a_ = N##0 * N##g, b_ = N##1 * N##g, c_ = N##2 * N##g, e_ = N##3 * N##g; u32x4 w_; \
        w_.x = pack2(a_[0], a_[1]); w_.y = pack2(a_[2], a_[3]); w_.z = pack2(b_[0], b_[1]); w_.w = pack2(b_[2], b_[3]); *(u32x4*)N##d = w_; \
        w_.x = pack2(c_[0], c_[1]); w_.y = pack2(c_[2], c_[3]); w_.z = pack2(e_[0], e_[1]); w_.w = pack2(e_[2], e_[3]); *(u32x4*)(N##d + 8) = w_; } while (0)
#define CONV_STORE2(N) do { const f32x4 a_ = N##0 * N##g, b_ = N##1 * N##g; u32x4 w_; \
        w_.x = pack2(a_[0], a_[1]); w_.y = pack2(a_[2], a_[3]); w_.z = pack2(b_[0], b_[1]); w_.w = pack2(b_[2], b_[3]); *(u32x4*)N##d = w_; } while (0)

DI void band_attn_unit(const P& p, char* smem, int unit, const ConvPlan& cv, int& cslot) {
    const int tid = opaque_tid() & 255, lane = tid & 63, wid = tid >> 6, r32 = lane & 31, hh = lane >> 5;
    const int cp = unit & 31, h = (unit >> 5) & 7, b = unit >> 8;
    const int c = 2 * cp + (wid >> 1);
    const int tq = c * 64 + (wid & 1) * 32 + r32;
    const size_t rowb = (size_t)b * NS;
    const bf16_t* kbase = p.proj + rowb * EVEN_IN + 512 + h * 64;
    const bf16_t* vbase = p.proj + rowb * EVEN_IN + 1024 + h * 64;
    float* sbias = (float*)(smem + 4 * KV_TILE);
    __syncthreads();
    bf16x8 qf[4];
#pragma unroll
    for (int st = 0; st < 4; ++st) qf[st] = *(const bf16x8*)(p.proj + (rowb + tq) * EVEN_IN + h * 64 + st * 16 + hh * 8);
    const int ck0 = (2 * cp - 8) > 0 ? (2 * cp - 8) : 0, nt = 2 * cp + 2 - ck0;
    float m = -3.0e38f, lsum = 0.f;
    f32x16 o0, o1;
#pragma unroll
    for (int i = 0; i < 16; ++i) { o0[i] = 0.f; o1[i] = 0.f; }
    KVStage stg;
    kv_load(stg, kbase, vbase, EVEN_IN, ck0 * 64);
    {
        const float b0 = p.att_rel_bias[h * 257 + tid], b1 = p.att_rel_bias[h * 257 + 256];
        sbias[tid] = b0 * LOG2E; if (tid == 0) sbias[256] = b1 * LOG2E;
    }
    kv_store(stg, smem, smem + 2 * KV_TILE);
    __syncthreads();
    CONV_DECL4(cA); CONV_DECL4(cB);
    CONV_LOAD4(cA, cslot++); CONV_LOAD4(cB, cslot++);
#define BAND_ITER(it, CRX) do { \
        const int ck = ck0 + it, cur = it & 1; \
        kv_load(stg, kbase, vbase, EVEN_IN, ((it + 1 < nt) ? ck + 1 : ck) * 64); \
        CONV_STORE4(CRX); CONV_LOAD4(CRX, cslot++); \
        __builtin_amdgcn_sched_barrier(0); \
        const char* kt = smem + cur * KV_TILE; const char* vt = smem + (2 + cur) * KV_TILE; \
        if (ck >= c - 8 && ck <= c) { \
            f32x16 s0, s1; \
_Pragma("unroll") \
            for (int i = 0; i < 16; ++i) { s0[i] = 0.f; s1[i] = 0.f; } \
_Pragma("unroll") \
            for (int st = 0; st < 4; ++st) { s0 = MFMA32(k_frag(kt, 0, st, r32, hh), qf[st], s0); s1 = MFMA32(k_frag(kt, 1, st, r32, hh), qf[st], s1); } \
            if (c - ck >= 3) { const float bb = sbias[256]; \
_Pragma("unroll") \
                for (int i = 0; i < 16; ++i) { s0[i] += bb; s1[i] += bb; } \
            } else { \
                const int d0 = tq - ck * 64 - 4 * hh; \
_Pragma("unroll") \
                for (int i = 0; i < 16; ++i) { \
                    int da = d0 - ((i & 3) + 8 * (i >> 2)), db = da - 32; \
                    da = da > 128 ? 128 : da; db = db > 128 ? 128 : db; \
                    s0[i] += sbias[da + 128]; s1[i] += sbias[db + 128]; \
                } \
            } \
            float tm = fmaxf(s0[0], s1[0]); \
_Pragma("unroll") \
            for (int i = 1; i < 16; ++i) tm = fmaxf(tm, fmaxf(s0[i], s1[i])); \
            tm = swap_max(tm); \
            const float mn = fmaxf(m, tm); \
            const float alpha = __builtin_amdgcn_exp2f(m - mn); \
            m = mn; \
            float ps = 0.f; \
_Pragma("unroll") \
            for (int i = 0; i < 16; ++i) { s0[i] = __builtin_amdgcn_exp2f(s0[i] - mn); s1[i] = __builtin_amdgcn_exp2f(s1[i] - mn); ps += s0[i] + s1[i]; } \
            lsum = lsum * alpha + ps; \
_Pragma("unroll") \
            for (int i = 0; i < 16; ++i) { o0[i] *= alpha; o1[i] *= alpha; } \
_Pragma("unroll") \
            for (int st = 0; st < 2; ++st) { \
                const bf16x8 pa = pack8(s0, st), pb = pack8(s1, st); \
                o0 = MFMA32(vt_frag(vt, 0, st, 0, lane), pa, o0); o1 = MFMA32(vt_frag(vt, 0, st, 1, lane), pa, o1); \
                o0 = MFMA32(vt_frag(vt, 1, st, 0, lane), pb, o0); o1 = MFMA32(vt_frag(vt, 1, st, 1, lane), pb, o1); \
            } \
        } \
        __builtin_amdgcn_sched_barrier(0); \
        kv_store(stg, smem + (cur ^ 1) * KV_TILE, smem + (2 + (cur ^ 1)) * KV_TILE); \
        __syncthreads(); \
    } while (0)
    for (int it = 0; it < nt; it += 2) {
        BAND_ITER(it, cA);
        if (it + 1 >= nt) break;
        BAND_ITER(it + 1, cB);
    }
#undef BAND_ITER
    CONV_STORE4(cA); CONV_STORE4(cB);
    const float inv = 1.0f / swap_sum(lsum);
    bf16_t* orow = p.mixed + (rowb + tq) * DM + h * 64 + 4 * hh;
#pragma unroll
    for (int g = 0; g < 4; ++g) {
        u32x2 w0, w1;
        w0.x = pack2(o0[4 * g] * inv, o0[4 * g + 1] * inv); w0.y = pack2(o0[4 * g + 2] * inv, o0[4 * g + 3] * inv);
        w1.x = pack2(o1[4 * g] * inv, o1[4 * g + 1] * inv); w1.y = pack2(o1[4 * g + 2] * inv, o1[4 * g + 3] * inv);
        *(u32x2*)(orow + 8 * g) = w0; *(u32x2*)(orow + 32 + 8 * g) = w1;
    }
}

DI void sb_attn_unit(const P& p, char* smem, volatile int* wdone, int unit, const ConvPlan& cv, int& cslot) {
    const int tid8 = opaque_tid(), tid = tid8 & 255, lane = tid & 63, wid = tid >> 6, r32 = lane & 31, hh = lane >> 5, wid8 = tid8 >> 6;
    const int qb = unit & 31, h = (unit >> 5) & 7, b = unit >> 8;
    const int tw = qb * 128 + wid * 32, t = tw + r32;
    const size_t rowb = (size_t)b * NS;
    const bf16_t* kbase = p.proj + rowb * ODD_IN + 1536 + h * 64;
    const bf16_t* vbase = p.proj + rowb * ODD_IN + 2048 + h * 64;
    __syncthreads();
    bf16x8 qf[4];
#pragma unroll
    for (int st = 0; st < 4; ++st) qf[st] = *(const bf16x8*)(p.proj + (rowb + t) * ODD_IN + 1024 + h * 64 + st * 16 + hh * 8);
    bf16x8 tf[2];
#pragma unroll
    for (int st = 0; st < 2; ++st)
#pragma unroll
        for (int j = 0; j < 8; ++j) tf[st][j] = (16 * st + 8 * (j >> 2) + 4 * hh + (j & 3)) >= r32 ? (short)0x3F80 : (short)0;
    f32x16 o0, o1;
#pragma unroll
    for (int i = 0; i < 16; ++i) { o0[i] = 0.f; o1[i] = 0.f; }
    float carry = 0.f; bool done = false;
    const int kt0 = 2 * qb + 1;
    KVStage stg;
    kv_load(stg, kbase, vbase, ODD_IN, kt0 * 64);
    kv_store(stg, smem, smem + 2 * KV_TILE);
    __syncthreads();
    bool all_done = false;
    CONV_DECL2(cA);
    CONV_LOAD2(cA, cslot++);
#define SB_ITER(it, CRX) do { \
        const int kt = kt0 - it, cur = it & 1; \
        kv_load(stg, kbase, vbase, ODD_IN, (kt > 0 ? kt - 1 : 0) * 64); \
        CONV_STORE2(CRX); CONV_LOAD2(CRX, cslot++); \
        __builtin_amdgcn_sched_barrier(0); \
        const char* ktile = smem + cur * KV_TILE; const char* vtile = smem + (2 + cur) * KV_TILE; \
        if (!done && kt * 64 < tw + 31) { \
_Pragma("unroll") \
            for (int sbi = 0; sbi < 2; ++sbi) { \
                const int sb = 1 - sbi; \
                f32x16 x; \
_Pragma("unroll") \
                for (int i = 0; i < 16; ++i) x[i] = 0.f; \
_Pragma("unroll") \
                for (int st = 0; st < 4; ++st) x = MFMA32(k_frag(ktile, sb, st, r32, hh), qf[st], x); \
                const int kb = kt * 64 + sb * 32 + 4 * hh; \
                f32x16 L; \
_Pragma("unroll") \
                for (int i = 0; i < 16; ++i) { \
                    const bool valid = kb + (i & 3) + 8 * (i >> 2) < t; \
                    const float z = x[i]; \
                    const float sp = fmaxf(z, 0.f) + __builtin_amdgcn_logf(1.0f + __builtin_amdgcn_exp2f(-fabsf(z))); \
                    L[i] = valid ? -sp : 0.f; \
                    x[i] = valid ? z : -1.0e30f; \
                } \
                f32x16 cum; \
_Pragma("unroll") \
                for (int i = 0; i < 16; ++i) cum[i] = carry; \
_Pragma("unroll") \
                for (int st = 0; st < 2; ++st) cum = MFMA32(tf[st], pack8(L, st), cum); \
                carry = bcast_lo(cum[0]); \
_Pragma("unroll") \
                for (int i = 0; i < 16; ++i) x[i] = __builtin_amdgcn_exp2f(x[i] + cum[i]); \
_Pragma("unroll") \
                for (int st = 0; st < 2; ++st) { \
                    const bf16x8 pa = pack8(x, st); \
                    o0 = MFMA32(vt_frag(vtile, sb, st, 0, lane), pa, o0); o1 = MFMA32(vt_frag(vtile, sb, st, 1, lane), pa, o1); \
                } \
            } \
            done = __all(carry < -150.0f); \
        } \
        __builtin_amdgcn_sched_barrier(0); \
        if (lane == 0) wdone[cur * 8 + wid8] = done ? 1 : 0; \
        kv_store(stg, smem + (cur ^ 1) * KV_TILE, smem + (2 + (cur ^ 1)) * KV_TILE); \
        __syncthreads(); \
        all_done = (wdone[cur * 8] + wdone[cur * 8 + 1] + wdone[cur * 8 + 2] + wdone[cur * 8 + 3] + wdone[cur * 8 + 4] + wdone[cur * 8 + 5] + wdone[cur * 8 + 6] + wdone[cur * 8 + 7] == 8); \
    } while (0)
#pragma nounroll
    for (int it = 0; it <= kt0; ++it) {
        SB_ITER(it, cA);
        if (all_done) break;
    }
#undef SB_ITER
    CONV_STORE2(cA);
    bf16_t* orow = p.mixed + (rowb + t) * DM + 512 + h * 64 + 4 * hh;
#pragma unroll
    for (int g = 0; g < 4; ++g) {
        u32x2 w0, w1;
        w0.x = pack2(o0[4 * g], o0[4 * g + 1]); w0.y = pack2(o0[4 * g + 2], o0[4 * g + 3]);
        w1.x = pack2(o1[4 * g], o1[4 * g + 1]); w1.y = pack2(o1[4 * g + 2], o1[4 * g + 3]);
        *(u32x2*)(orow + 8 * g) = w0; *(u32x2*)(orow + 32 + 8 * g) = w1;
    }
}

DI void pool_items(const P& p) {
    for (int it = blockIdx.x * 512 + threadIdx.x; it < NTOK * 64; it += gridDim.x * 512) {
        const int tok = it >> 6, ch8 = it & 63, g = ch8 >> 4, w = 2 << g, s = tok & (NS - 1);
        const int n = (s + 1 < w) ? s + 1 : w;
        float sum[8], own[8];
#pragma unroll
        for (int j = 0; j < 8; ++j) sum[j] = 0.f;
        const bf16_t* src = p.proj + (size_t)tok * EVEN_IN + 1536 + ch8 * 8;
        u32x4 wv[16];
#pragma unroll
        for (int t = 0; t < 16; ++t) wv[t] = (t < n) ? *(const u32x4*)(src - (size_t)t * EVEN_IN) : (u32x4){0u, 0u, 0u, 0u};
#pragma unroll
        for (int t = 0; t < 16; ++t) { unpack8(wv[t], own);
#pragma unroll
            for (int j = 0; j < 8; ++j) sum[j] += own[j]; }
        unpack8(wv[0], own);
        const float inv = 1.0f / (float)n;
        u32x4 o; o.x = pack2(sum[0] * inv - own[0], sum[1] * inv - own[1]); o.y = pack2(sum[2] * inv - own[2], sum[3] * inv - own[3]);
        o.z = pack2(sum[4] * inv - own[4], sum[5] * inv - own[5]); o.w = pack2(sum[6] * inv - own[6], sum[7] * inv - own[7]);
        *(u32x4*)(p.mixed + (size_t)tok * DM + 512 + ch8 * 8) = o;
    }
}

DI void sgu_unit(const P& p, char* smem, int unit) {
    const int tid = opaque_tid() & 255, lane = tid & 63, wid = tid >> 6, wm = wid >> 1, wn = wid & 1, fr = lane & 15, fq = lane >> 4;
    const int g = unit & 3; const size_t tok0 = (size_t)(unit >> 2) * 128;
    char* As = smem; char* Gs = smem + 32768; float* srstd = (float*)(smem + 65536);
    __syncthreads();
    if (tid < 128) srstd[tid] = rsqrtf(p.vss[tok0 + tid] * (1.0f / 512.0f) + EPS);
#pragma unroll
    for (int i = 0; i < 8; ++i) {
        const int idx = tid + 256 * i, s = idx >> 4, ch = idx & 15;
        const u32x4 v = *(const u32x4*)(p.proj + (tok0 + s) * ODD_IN + 512 + g * 128 + ch * 8);
        *(u32x4*)(Gs + s * 256 + (((ch >> 1) ^ kswz(s)) << 5) + ((ch & 1) << 4)) = v;
    }
    __syncthreads();
#pragma unroll
    for (int i = 0; i < 8; ++i) {
        const int idx = tid + 256 * i, t = idx >> 4, c8 = idx & 15, s0 = c8 * 8;
        const float* wr = p.sgu_w + ((size_t)g * 128 + t) * 128 + s0;
        const f32x4 a = *(const f32x4*)wr, b = *(const f32x4*)(wr + 4);
        float f[8] = {a[0], a[1], a[2], a[3], b[0], b[1], b[2], b[3]};
#pragma unroll
        for (int j = 0; j < 8; ++j) f[j] = (s0 + j <= t) ? f[j] * srstd[s0 + j] : 0.f;
        u32x4 w; w.x = pack2(f[0], f[1]); w.y = pack2(f[2], f[3]); w.z = pack2(f[4], f[5]); w.w = pack2(f[6], f[7]);
        *(u32x4*)(As + (c8 >> 3) * 16384 + t * 128 + (((c8 & 7) ^ (t & 7)) << 4)) = w;
    }
    __syncthreads();
    f32x4 acc[4][4];
#pragma unroll
    for (int a = 0; a < 4; ++a)
#pragma unroll
        for (int b = 0; b < 4; ++b) acc[a][b] = (f32x4){0.f, 0.f, 0.f, 0.f};
    const int qq = fr >> 2, pp = fr & 3;
#pragma unroll
    for (int kt = 0; kt < 2; ++kt) {
        if (kt == 1 && wm == 0) continue;
#pragma unroll
        for (int s2 = 0; s2 < 2; ++s2) {
            bf16x8 af[4], bfv[4];
#pragma unroll
            for (int i = 0; i < 4; ++i) {
                const int ra_ = wm * 64 + i * 16 + fr;
                af[i] = *(const bf16x8*)(As + kt * 16384 + ra_ * 128 + (((s2 * 4 + fq) ^ (fr & 7)) << 4));
                const int srow = kt * 64 + s2 * 32 + 8 * fq + qq, blk = wn * 4 + i;
                const s16x4 lo = tr_read(Gs + srow * 256 + ((blk ^ kswz(srow)) << 5) + pp * 8);
                const s16x4 hi = tr_read(Gs + (srow + 4) * 256 + ((blk ^ kswz(srow + 4)) << 5) + pp * 8);
                bfv[i] = (bf16x8){lo[0], lo[1], lo[2], lo[3], hi[0], hi[1], hi[2], hi[3]};
            }
#pragma unroll
            for (int mi = 0; mi < 4; ++mi)
#pragma unroll
                for (int ni = 0; ni < 4; ++ni) acc[mi][ni] = MFMA16(bfv[ni], af[mi], acc[mi][ni]);
        }
    }
#pragma unroll
    for (int mi = 0; mi < 4; ++mi) {
        const int t = wm * 64 + mi * 16 + fr;
        const float bias = p.sgu_b[g * 128 + t];
#pragma unroll
        for (int ni = 0; ni < 4; ++ni) {
            const int c = g * 128 + wn * 64 + ni * 16 + fq * 4;
            const f32x4 gn = *(const f32x4*)(p.sgu_v_norm + c);
            const u32x2 uu = *(const u32x2*)(p.proj + (tok0 + t) * ODD_IN + c);
            const float u0 = __uint_as_float(uu.x << 16), u1 = __uint_as_float(uu.x & 0xffff0000u), u2 = __uint_as_float(uu.y << 16), u3 = __uint_as_float(uu.y & 0xffff0000u);
            const f32x4 a = acc[mi][ni];
            u32x2 w; w.x = pack2(u0 * (gn[0] * a[0] + bias), u1 * (gn[1] * a[1] + bias)); w.y = pack2(u2 * (gn[2] * a[2] + bias), u3 * (gn[3] * a[3] + bias));
            *(u32x2*)(p.mixed + (tok0 + t) * DM + c) = w;
        }
    }
}

DI void router_unit(const P& p, char* smem, int layer, int unit) {
    const int tid = opaque_tid() & 255, lane = tid & 63, wid = tid >> 6, r32 = lane & 31, hh = lane >> 5;
    float (*part)[36][32] = (float (*)[36][32])smem;
    float (*wss)[32] = (float (*)[32])(smem + 18432);
    int* lcnt = (int*)(smem + 18432 + 512);
    int* lbase = lcnt + 32;
    int* cnt = p.cnt + layer * NEXP;
    const int tok = unit * 32 + r32, kq = wid * 256 + 8 * hh;
    __syncthreads();
    if (tid < 32) lcnt[tid] = 0;
    const bf16_t* hrow = p.hb + (size_t)tok * DM + kq;
    const bf16_t* whi = p.wr_hi + ((size_t)layer * 96 + r32) * DM + kq;
    const bf16_t* wlo = p.wr_lo + ((size_t)layer * 96 + r32) * DM + kq;
    f32x16 c0, c1, c2;
#pragma unroll
    for (int i = 0; i < 16; ++i) { c0[i] = 0.f; c1[i] = 0.f; c2[i] = 0.f; }
    float ss = 0.f;
#pragma unroll 4
    for (int st = 0; st < 16; ++st) {
        const u32x4 hw = *(const u32x4*)(hrow + 16 * st);
        float f[8]; unpack8(hw, f);
#pragma unroll
        for (int j = 0; j < 8; ++j) ss += f[j] * f[j];
        const bf16x8 hhi = __builtin_bit_cast(bf16x8, hw);
        bf16x8 wh, wl;
        wh = *(const bf16x8*)(whi + 16 * st); wl = *(const bf16x8*)(wlo + 16 * st);
        c0 = MFMA32(wh, hhi, c0); c0 = MFMA32(wl, hhi, c0);
        wh = *(const bf16x8*)(whi + 32 * DM + 16 * st); wl = *(const bf16x8*)(wlo + 32 * DM + 16 * st);
        c1 = MFMA32(wh, hhi, c1); c1 = MFMA32(wl, hhi, c1);
        wh = *(const bf16x8*)(whi + 64 * DM + 16 * st); wl = *(const bf16x8*)(wlo + 64 * DM + 16 * st);
        c2 = MFMA32(wh, hhi, c2); c2 = MFMA32(wl, hhi, c2);
    }
    {
        auto rr = __builtin_amdgcn_permlane32_swap(__float_as_uint(ss), __float_as_uint(ss), false, false);
        ss = __uint_as_float(rr[0]) + __uint_as_float(rr[1]);
        if (hh == 0) {
#pragma unroll
            for (int i = 0; i < 16; ++i) { part[wid][i][r32] = c0[i]; part[wid][16 + i][r32] = c1[i]; }
#pragma unroll
            for (int i = 0; i < 4; ++i) part[wid][32 + i][r32] = c2[i];
            wss[wid][r32] = ss;
        }
    }
    __syncthreads();
    int e1 = 0, e2 = 0, r1 = 0, r2 = 0; float w1 = 0.f, w2 = 0.f, rstd = 0.f;
    const int mytok = unit * 32 + tid;
    if (tid < 32) {
        rstd = rsqrtf((wss[0][tid] + wss[1][tid] + wss[2][tid] + wss[3][tid]) * (1.0f / DM) + EPS);
        float gl[4], ev[8];
#pragma unroll
        for (int j = 0; j < 4; ++j) gl[j] = (part[0][32 + j][tid] + part[1][32 + j][tid] + part[2][32 + j][tid] + part[3][32 + j][tid]) * rstd;
        int gs = 0; float gm = gl[0];
#pragma unroll
        for (int j = 1; j < 4; ++j) if (gl[j] > gm) { gm = gl[j]; gs = j; }
        const float gw = 1.0f / (__expf(gl[0] - gm) + __expf(gl[1] - gm) + __expf(gl[2] - gm) + __expf(gl[3] - gm));
#pragma unroll
        for (int j = 0; j < 8; ++j) { const int s = gs * 8 + j; ev[j] = (part[0][s][tid] + part[1][s][tid] + part[2][s][tid] + part[3][s][tid]) * rstd; }
        int i1 = 0; float v1 = ev[0];
#pragma unroll
        for (int j = 1; j < 8; ++j) if (ev[j] > v1) { v1 = ev[j]; i1 = j; }
        int i2 = -1; float v2 = -3.0e38f;
#pragma unroll
        for (int j = 0; j < 8; ++j) if (j != i1 && ev[j] > v2) { v2 = ev[j]; i2 = j; }
        w1 = 1.0f / (1.0f + __expf(v2 - v1)); w2 = (1.0f - w1) * gw; w1 *= gw;
        e1 = gs * 8 + i1; e2 = gs * 8 + i2;
        r1 = atomicAdd(lcnt + e1, 1); r2 = atomicAdd(lcnt + e2, 1);
    }
    __syncthreads();
    if (tid < 32) { const int n = lcnt[tid]; lbase[tid] = n ? atomicAdd(cnt + tid, n) : 0; }
    __syncthreads();
    if (tid < 32) {
        p.plist[(size_t)e1 * LISTCAP + lbase[e1] + r1] = mytok * 2; p.plist[(size_t)e2 * LISTCAP + lbase[e2] + r2] = mytok * 2 + 1;
        p.pw[mytok * 2] = w1; p.pw[mytok * 2 + 1] = w2; p.rs[mytok] = rstd;
    }
}
DI void ph_combine(const P& p, int layer) {
    const int wave = threadIdx.x >> 6, lane = threadIdx.x & 63;
    for (int u = blockIdx.x; u < NTOK / 16; u += gridDim.x) {
        const size_t tok0 = (size_t)u * 16 + wave * 2;
        u32x2 hv[2][4], ya[2][4], yb[2][4];
#pragma unroll
        for (int r = 0; r < 2; ++r)
#pragma unroll
            for (int i = 0; i < 4; ++i) {
                const int c = i * 256 + lane * 4;
                hv[r][i] = *(const u32x2*)(p.hb + (tok0 + r) * DM + c);
                ya[r][i] = *(const u32x2*)(p.y + ((tok0 + r) * 2) * DM + c); yb[r][i] = *(const u32x2*)(p.y + ((tok0 + r) * 2 + 1) * DM + c);
            }
#pragma unroll
        for (int r = 0; r < 2; ++r) {
            float ss = 0.f;
#pragma unroll
            for (int i = 0; i < 4; ++i) {
                const u32x2 h0 = hv[r][i], a = ya[r][i], b = yb[r][i];
                f32x4 h;
                h[0] = __uint_as_float(h0.x << 16) + __uint_as_float(a.x << 16) + __uint_as_float(b.x << 16);
                h[1] = __uint_as_float(h0.x & 0xffff0000u) + __uint_as_float(a.x & 0xffff0000u) + __uint_as_float(b.x & 0xffff0000u);
                h[2] = __uint_as_float(h0.y << 16) + __uint_as_float(a.y << 16) + __uint_as_float(b.y << 16);
                h[3] = __uint_as_float(h0.y & 0xffff0000u) + __uint_as_float(a.y & 0xffff0000u) + __uint_as_float(b.y & 0xffff0000u);
                ss += h[0] * h[0] + h[1] * h[1] + h[2] * h[2] + h[3] * h[3];
                if (layer == 0) { u32x2 w; w.x = pack2(h[0], h[1]); w.y = pack2(h[2], h[3]); *(u32x2*)(p.hb + (tok0 + r) * DM + i * 256 + lane * 4) = w; }
                else *(f32x4*)(p.out + (tok0 + r) * DM + i * 256 + lane * 4) = h;
            }
            if (layer == 0) { ss = wave_sum(ss); if (lane == 0) p.rsm[tok0 + r] = rsqrtf(ss * (1.0f / DM) + EPS); }
        }
    }
}

DI void ph_mix_even(const P& p, char* smem) {
    const int half = threadIdx.x >> 8;
    const ConvPlan cv = conv_plan<4>(p, 0); int cslot = 0;
    for (int u = blockIdx.x; u < NB * 4 * 32; u += gridDim.x) {
        const int cp = u & 31, hp = (u >> 5) & 3, b = u >> 7;
        band_attn_unit(p, smem + half * HALF_LDS, (b << 8) | ((hp * 2 + half) << 5) | cp, cv, cslot);
    }
    for (; cslot < cv.nslots; ++cslot) { CONV_DECL4(cR); CONV_LOAD4(cR, cslot); CONV_STORE4(cR); }
    pool_items(p);
}
DI void ph_mix_odd(const P& p, char* smem) {
    const int half = threadIdx.x >> 8;
    volatile int* wdone = (volatile int*)(smem + 2 * HALF_LDS);
    const ConvPlan cv = conv_plan<2>(p, 1); int cslot = 0;
    for (int u = blockIdx.x; u < NB * 4 * 32; u += gridDim.x) {
        const int qb = 31 - (u >> 4), hp = (u >> 2) & 3, b = u & 3;
        sb_attn_unit(p, smem + half * HALF_LDS, wdone, (b << 8) | ((hp * 2 + half) << 5) | qb, cv, cslot);
    }
    for (; cslot < cv.nslots; ++cslot) { CONV_DECL2(cR); CONV_LOAD2(cR, cslot); CONV_STORE2(cR); }
    for (int u = blockIdx.x; u < (NTOK / 128) * 2; u += gridDim.x) sgu_unit(p, smem + half * HALF_LDS, u * 2 + half);
}
DI void ph_router(const P& p, char* smem, int layer) {
    const int half = threadIdx.x >> 8;
    for (int u = blockIdx.x; u < NTOK / 64; u += gridDim.x) router_unit(p, smem + half * HALF_LDS, layer, u * 2 + half);
}

constexpr int NPHASE = 13;
#ifndef REPS
#define REPS {1,1,1,1,1,1,1,1,1,1,1,1,1}
#endif
__device__ constexpr int REP[13] = REPS;
__global__ __launch_bounds__(512, 2) void mega(P p, int ph0, int ph1) {
    __shared__ __attribute__((aligned(16))) char smem[SMEM_BYTES + 64 + 16 + 16];
    volatile LDSAS unsigned* xst = (volatile LDSAS unsigned*)(smem + SMEM_BYTES + 64);
    if (threadIdx.x < 4) xst[threadIdx.x] = 0u;
    __syncthreads();
    const XcdBarrier xb = xcd_barrier_post(p.bar, xst);
#define PHASE(i, call) if (ph0 <= (i) && (i) < ph1) { for (int r_ = 0; r_ < REP[i]; ++r_) { call; if (r_ + 1 < REP[i] || (i) + 1 < ph1) xcd_barrier(xb); } }
    PHASE(0, ph_prologue(p, smem))
    PHASE(1, (ph_gemm_dense<EPI_IN_EVEN, 4>(p, smem, p.hb, DM, p.wb_in_even, DM, EVEN_IN, 0, 0, 8)))
    PHASE(2, ph_mix_even(p, smem))
    PHASE(3, (ph_gemm_dense<EPI_OUT, 4>(p, smem, p.mixed, DM, p.wb_out_even, DM, DM, 0, 0, 4)))
    PHASE(4, ph_router(p, smem, 0))
    PHASE(5, ph_moe(p, smem, 0))
    PHASE(6, ph_combine(p, 0))
    PHASE(7, (ph_gemm_dense<EPI_IN_ODD, 4>(p, smem, p.hb, DM, p.wb_in_odd, DM, ODD_IN, 1, 0, 8), ph_gemm_dense<EPI_IN_ODD, 2>(p, smem, p.hb, DM, p.wb_in_odd, DM, ODD_IN, 1, 8, 2)))
    PHASE(8, ph_mix_odd(p, smem))
    PHASE(9, (ph_gemm_dense<EPI_OUT, 4>(p, smem, p.mixed, DM, p.wb_out_odd, DM, DM, 1, 0, 4)))
    PHASE(10, ph_router(p, smem, 1))
    PHASE(11, ph_moe(p, smem, 1))
    PHASE(12, ph_combine(p, 1))
}

extern "C" void kernel_launch(void* const* d_in, const int* in_sizes, int n_in, void* d_out, int out_size, void* d_ws, size_t ws_size, hipStream_t stream) {
    P p{};
    p.x = (const float*)d_in[0]; p.mix_norm_even = (const float*)d_in[1]; p.w_in_even = (const float*)d_in[2]; p.att_q_norm = (const float*)d_in[3];
    p.att_k_norm = (const float*)d_in[4]; p.att_rel_bias = (const float*)d_in[5]; p.pool_w = (const float*)d_in[6]; p.pool_scale = (const float*)d_in[7];
    p.w_out_even = (const float*)d_in[8]; p.mix_norm_odd = (const float*)d_in[9]; p.w_in_odd = (const float*)d_in[10]; p.sgu_v_norm = (const float*)d_in[11];
    p.sgu_w = (const float*)d_in[12]; p.sgu_b = (const float*)d_in[13]; p.w_out_odd = (const float*)d_in[14]; p.ffn_norm = (const float*)d_in[15];
    p.w_rg = (const float*)d_in[16]; p.w_re = (const float*)d_in[17]; p.w_gate = (const float*)d_in[18]; p.w_up = (const float*)d_in[19]; p.w_down = (const float*)d_in[20];
    p.out = (float*)d_out;
    char* ws = (char*)d_ws; size_t off = 0;
    auto take = [&](size_t bytes) { char* r = ws + off; off += (bytes + 255) & ~(size_t)255; return r; };
    p.wb_in_even = (bf16_t*)take((size_t)EVEN_IN * DM * 2);
    p.wb_out_even = (bf16_t*)take((size_t)DM * DM * 2);
    p.wb_in_odd = (bf16_t*)take((size_t)ODD_IN * DM * 2);
    p.wb_out_odd = (bf16_t*)take((size_t)DM * DM * 2);
    p.wb_gate = (bf16_t*)take((size_t)2 * NEXP * DM * FF * 2);
    p.wb_up = (bf16_t*)take((size_t)2 * NEXP * DM * FF * 2);
    p.wb_down = (bf16_t*)take((size_t)2 * NEXP * DM * FF * 2);
    p.wr_hi = (bf16_t*)take((size_t)2 * 96 * DM * 2);
    p.wr_lo = (bf16_t*)take((size_t)2 * 96 * DM * 2);
    p.hb = (bf16_t*)take((size_t)NTOK * DM * 2);
    p.proj = (bf16_t*)take((size_t)NTOK * ODD_IN * 2);
    p.y = p.proj;
    p.mixed = (bf16_t*)take((size_t)NTOK * DM * 2);
    p.hid = p.mixed;
    p.pw = (float*)take((size_t)NTOK * 2 * 4);
    p.rs = (float*)take((size_t)NTOK * 4);
    p.rsm = (float*)take((size_t)NTOK * 4);
    p.vss = (float*)take((size_t)NTOK * 4);
    p.plist = (int*)take((size_t)NEXP * LISTCAP * 4);
    p.cnt = (int*)take(256);
    p.ones = (const float*)take(256);
    p.dump = (bf16_t*)take((size_t)512 * 512 * 32);
    p.gdone = (int*)take(640 * 4);
    p.bar = (unsigned*)take(XCD_BAR_WORDS * 4);
    (void)hipMemsetAsync(p.bar, 0, XCD_BAR_WORDS * 4, stream);
    for (int l = 0; l < 2; ++l) {
        const size_t o = (size_t)l * NEXP * DM * FF;
        p.cs[l * 5 + 0] = p.w_gate + o; p.cd[l * 5 + 0] = p.wb_gate + o;
        p.cs[l * 5 + 1] = p.w_up + o;   p.cd[l * 5 + 1] = p.wb_up + o;
        p.cs[l * 5 + 2] = p.w_down + o; p.cd[l * 5 + 2] = p.wb_down + o;
        p.cs[l * 5 + 3] = p.w_in_odd;   p.cd[l * 5 + 3] = p.wb_in_odd;
        p.cs[l * 5 + 4] = p.w_out_odd;  p.cd[l * 5 + 4] = p.wb_out_odd;
    }

    static int grid_blocks = 0;
    if (!grid_blocks) {
        int dev = 0, cus = 0, per_cu = 0;
        (void)hipGetDevice(&dev);
        (void)hipDeviceGetAttribute(&cus, hipDeviceAttributeMultiprocessorCount, dev);
        (void)hipOccupancyMaxActiveBlocksPerMultiprocessor(&per_cu, mega, 512, 0);
        if (per_cu < 1) per_cu = 1;
        grid_blocks = cus;
    }
    int ph0 = 0, ph1 = NPHASE;
    void* args[] = {&p, &ph0, &ph1};
    hipError_t e = hipLaunchCooperativeKernel((void*)mega, dim3(grid_blocks), dim3(512), args, 0, stream);
    if (e != hipSuccess) fprintf(stderr, "cooperative launch failed: %s (grid %d)\n", hipGetErrorString(e), grid_blocks);
}
```

```cpp
#include <hip/hip_runtime.h>
#include <hip/hip_cooperative_groups.h>
#include <stdint.h>
#include <stdio.h>

typedef unsigned short bf16_t;
typedef short bf16x8 __attribute__((ext_vector_type(8)));
typedef short s16x4 __attribute__((ext_vector_type(4)));
typedef float f32x2 __attribute__((ext_vector_type(2)));
typedef float f32x4 __attribute__((ext_vector_type(4)));
typedef float f32x16 __attribute__((ext_vector_type(16)));
typedef unsigned u32x4 __attribute__((ext_vector_type(4)));
typedef unsigned u32x2 __attribute__((ext_vector_type(2)));
typedef __bf16 bf16x2n __attribute__((ext_vector_type(2)));

#define DI __device__ __forceinline__
#define LDSAS __attribute__((address_space(3)))
#define MFMA32(a, b, c) __builtin_amdgcn_mfma_f32_32x32x16_bf16((a), (b), (c), 0, 0, 0)
#define MFMA16(a, b, c) __builtin_amdgcn_mfma_f32_16x16x32_bf16((a), (b), (c), 0, 0, 0)

constexpr int NB = 4, NS = 4096, NTOK = NB * NS, DM = 1024;
constexpr int EVEN_IN = 2048, ODD_IN = 2560;
constexpr int NEXP = 32, FF = 256;
constexpr int LISTCAP = NTOK;
constexpr float EPS = 1e-6f;
constexpr float LOG2E = 1.4426950408889634f;
constexpr float QSCALE = 0.125f * LOG2E;

DI int opaque_tid() { int t = threadIdx.x; asm volatile("" : "+v"(t)); return t; }
DI float bf2f(bf16_t b) { return __uint_as_float(((unsigned)b) << 16); }
DI unsigned pack2(float lo, float hi) { f32x2 v = {lo, hi}; bf16x2n r = __builtin_convertvector(v, bf16x2n); return __builtin_bit_cast(unsigned, r); }
DI float wave_sum(float v) { for (int o = 32; o > 0; o >>= 1) v += __shfl_xor(v, o); return v; }
DI float gelu_exact(float x) { return 0.5f * x * (1.0f + erff(x * 0.70710678118654752f)); }
DI s16x4 tr_read(const char* p) { return __builtin_bit_cast(s16x4, __builtin_amdgcn_ds_read_tr16_b64_v4i16((LDSAS s16x4*)p)); }
DI void unpack8(const u32x4 v, float* f) {
    f[0] = __uint_as_float(v.x << 16); f[1] = __uint_as_float(v.x & 0xffff0000u); f[2] = __uint_as_float(v.y << 16); f[3] = __uint_as_float(v.y & 0xffff0000u);
    f[4] = __uint_as_float(v.z << 16); f[5] = __uint_as_float(v.z & 0xffff0000u); f[6] = __uint_as_float(v.w << 16); f[7] = __uint_as_float(v.w & 0xffff0000u);
}
DI int kswz(int k) { return (k & 3) | ((k >> 1) & 4); }

struct P {
    const float *x, *mix_norm_even, *w_in_even, *att_q_norm, *att_k_norm, *att_rel_bias, *pool_w, *pool_scale, *w_out_even;
    const float *mix_norm_odd, *w_in_odd, *sgu_v_norm, *sgu_w, *sgu_b, *w_out_odd, *ffn_norm, *w_rg, *w_re, *w_gate, *w_up, *w_down;
    float* out;
    bf16_t *wb_in_even, *wb_out_even, *wb_in_odd, *wb_out_odd, *wb_gate, *wb_up, *wb_down, *wr_hi, *wr_lo;
    bf16_t *hb, *proj, *mixed, *hid, *y;
    float *pw, *rs, *rsm, *vss; int* plist; int* cnt; unsigned* bar; int* gdone;
    const float* cs[10]; bf16_t* cd[10]; const float* ones; bf16_t* dump;
};

enum { EPI_IN_EVEN = 0, EPI_IN_ODD = 1, EPI_OUT = 2, EPI_GU = 3, EPI_DOWN = 4 };
constexpr int G_ROWID = 131072;
constexpr int SMEM_BYTES = 131072 + 1024;
constexpr int HALF_LDS = 66048;

struct GemmArgs {
    const bf16_t* A; int lda; const int* gather; int mvalid; int gshift;
    const bf16_t* B0; const bf16_t* B1; int ldb; int gu;
    int K, m0, n0;
    bool rowid_ready;
};

DI f32x2 gelu_pk(f32x2 v) {
    const f32x2 av = __builtin_elementwise_abs(v), d = av * 0.2316418882f + 1.0f;
    f32x2 t; t.x = __builtin_amdgcn_rcpf(d.x); t.y = __builtin_amdgcn_rcpf(d.y);
    f32x2 q = t * 0.5307027145f + (-0.7265760135f); q = q * t + 0.7107068705f; q = q * t + (-0.142248368f); q = q * t + 0.127414796f; q = q * t;
    const f32x2 s = (v * v) * (-0.72134752044f);
    f32x2 e; e.x = __builtin_amdgcn_exp2f(s.x); e.y = __builtin_amdgcn_exp2f(s.y);
    const f32x2 m = v * (q * e), r = v - m;
    f32x2 o; o.x = v.x < 0.f ? m.x : r.x; o.y = v.y < 0.f ? m.y : r.y; return o;
}

DI void glds16(const void* gsrc, unsigned lds_dst) {
    unsigned keep;
    asm volatile("s_mov_b32 %0, m0\n\ts_mov_b32 m0, %2\n\ts_nop 0\n\tglobal_load_lds_dwordx4 %1, off\n\ts_mov_b32 m0, %0" : "=&s"(keep) : "v"(gsrc), "s"(lds_dst) : "memory");
}
DI void glds16_sc1(const void* gsrc, unsigned lds_dst) {
    unsigned keep;
    asm volatile("s_mov_b32 %0, m0\n\ts_mov_b32 m0, %2\n\ts_nop 0\n\tglobal_load_lds_dwordx4 %1, off sc1\n\ts_mov_b32 m0, %0" : "=&s"(keep) : "v"(gsrc), "s"(lds_dst) : "memory");
}
DI void st16_sc1(void* q, u32x4 v) { asm volatile("global_store_dwordx4 %0, %1, off sc1\n\ts_nop 1" :: "v"(q), "v"(v) : "memory"); }
template <int EPI, int MT>
DI void gemm_tile(const P& p, char* smem, const GemmArgs& g, int layer) {
    const int tid = opaque_tid(), lane = tid & 63, wid = tid >> 6, wm = wid >> 2, wn = wid & 3, r32 = lane & 31, hh = lane >> 5;
    int* rowid = (int*)(smem + G_ROWID);
    constexpr int NA = MT / 2;
    constexpr int IPT = NA + 2;
    const bf16_t* ap[NA]; const bf16_t* bp[2];
    if (g.gather && !g.rowid_ready) { if (tid < 64 * MT) rowid[tid] = (tid < g.mvalid) ? g.gather[tid] : -1; __syncthreads(); }
#pragma unroll
    for (int i = 0; i < NA; ++i) {
        const int r = (wid * NA + i) * 16 + (lane >> 2), kc = (lane & 3) ^ ((r >> 2) & 3);
        size_t arow;
        if (g.gather) { int id = rowid[r]; if (id < 0) id = rowid[0]; arow = (size_t)(id >> g.gshift); } else arow = (size_t)(g.m0 + r);
        ap[i] = g.A + arow * g.lda + kc * 8;
    }
#pragma unroll
    for (int i = 0; i < 2; ++i) {
        const int k = (wid * 2 + i) * 2 + (lane >> 5), sl = lane & 31, ch = (((sl >> 2) ^ (k & 7)) << 2) | (sl & 3);
        const bf16_t* bcol = g.gu ? ((((ch >> 2) & 1) ? g.B1 : g.B0) + (g.n0 >> 1) + (ch >> 3) * 32 + (ch & 3) * 8) : (g.B0 + g.n0 + ch * 8);
        bp[i] = bcol + (size_t)k * g.ldb;
    }
    const size_t bstep = (size_t)32 * g.ldb;
    float gu_w[MT], gu_rs[MT];
    if (EPI == EPI_GU) {
#pragma unroll
        for (int mt = 0; mt < MT; ++mt) { const int id = rowid[wm * 32 * MT + mt * 32 + r32]; gu_w[mt] = id >= 0 ? p.pw[id] : 0.f; gu_rs[mt] = id >= 0 ? p.rs[id >> 1] : 0.f; }
    } else if (EPI == EPI_IN_EVEN || EPI == EPI_IN_ODD) {
#pragma unroll
        for (int mt = 0; mt < MT; ++mt) gu_rs[mt] = p.rsm[g.m0 + wm * 32 * MT + mt * 32 + r32];
    }
    f32x16 acc[MT][2];
#pragma unroll
    for (int a = 0; a < MT; ++a)
#pragma unroll
        for (int b = 0; b < 2; ++b)
#pragma unroll
            for (int i = 0; i < 16; ++i) acc[a][b][i] = 0.f;
    const int nk = g.K / 32;
    const int arow0 = wm * 32 * MT + r32;
    const int asw = (r32 >> 2) & 3;
    const int g1 = (lane >> 4) & 1, qq = (lane & 15) >> 2, pp = lane & 3;
    const int bk0 = 8 * hh + qq;
    const unsigned ldsb = (unsigned)(size_t)(LDSAS char*)smem;
    const unsigned adst = ldsb + (wid * NA) * 1024, bdst = ldsb + 16384 + (wid * 2) * 1024;
#define G_LOAD(KT) do { const unsigned so_ = (unsigned)((KT) & 3) * 32768u; \
        _Pragma("unroll") for (int i = 0; i < NA; ++i) { if (EPI == EPI_DOWN) glds16_sc1(ap[i] + (KT) * 32, (unsigned)__builtin_amdgcn_readfirstlane(adst + so_ + i * 1024)); \
                                                        else glds16(ap[i] + (KT) * 32, (unsigned)__builtin_amdgcn_readfirstlane(adst + so_ + i * 1024)); } \
        _Pragma("unroll") for (int i = 0; i < 2; ++i) glds16(bp[i] + (size_t)(KT) * bstep, (unsigned)__builtin_amdgcn_readfirstlane(bdst + so_ + i * 1024)); } while (0)
#define G_COMPUTE(KT) do { const char* Ac = smem + ((KT) & 3) * 32768; const char* Bc = Ac + 16384; \
        _Pragma("unroll") for (int st = 0; st < 2; ++st) { bf16x8 af[MT], bfv[2]; \
            _Pragma("unroll") for (int mt = 0; mt < MT; ++mt) af[mt] = *(const bf16x8*)(Ac + (arow0 + mt * 32) * 64 + (((2 * st + hh) ^ asw) << 4)); \
            _Pragma("unroll") for (int nt = 0; nt < 2; ++nt) { const int k = 16 * st + bk0; \
                const char* b0_ = Bc + k * 512 + (((wn * 2 + nt) ^ (k & 7)) << 6) + g1 * 32 + pp * 8; \
                const char* b1_ = Bc + (k + 4) * 512 + (((wn * 2 + nt) ^ ((k + 4) & 7)) << 6) + g1 * 32 + pp * 8; \
                const s16x4 lo = tr_read(b0_), hi = tr_read(b1_); \
                bfv[nt] = (bf16x8){lo[0], lo[1], lo[2], lo[3], hi[0], hi[1], hi[2], hi[3]}; } \
            _Pragma("unroll") for (int mt = 0; mt < MT; ++mt) _Pragma("unroll") for (int nt = 0; nt < 2; ++nt) acc[mt][nt] = MFMA32(bfv[nt], af[mt], acc[mt][nt]); } } while (0)
#define G_WAIT(N) do { if ((N) == 2) { if (IPT == 4) asm volatile("s_waitcnt vmcnt(8)" ::: "memory"); else asm volatile("s_waitcnt vmcnt(6)" ::: "memory"); } \
                       else if ((N) == 1) { if (IPT == 4) asm volatile("s_waitcnt vmcnt(4)" ::: "memory"); else asm volatile("s_waitcnt vmcnt(3)" ::: "memory"); } \
                       else asm volatile("s_waitcnt vmcnt(0)" ::: "memory"); } while (0)
    G_LOAD(0); G_LOAD(1); G_LOAD(2);
    G_WAIT(2); __syncthreads();
#pragma nounroll
    for (int kt = 0; kt < nk; ++kt) {
        if (kt + 3 < nk) G_LOAD(kt + 3);
        G_COMPUTE(kt);
        if (kt + 3 < nk) G_WAIT(2); else if (kt + 2 < nk) G_WAIT(1); else G_WAIT(0);
        __syncthreads();
    }
#undef G_LOAD
#undef G_COMPUTE
#undef G_WAIT
    const int colw = g.n0 + wn * 64;
    char* wsl = smem + wid * 16384;
    const int rowb = wm * 32 * MT;
    if (EPI == EPI_IN_EVEN || EPI == EPI_IN_ODD || EPI == EPI_DOWN) {
        const int region = colw >> 9;
        const float* gn = region == 0 ? p.att_q_norm : p.att_k_norm;
        const bool act = colw < 1024;
        const float qs = (colw >= 1024 && colw < 1536) ? QSCALE : 1.0f;
#pragma unroll
        for (int mt = 0; mt < MT; ++mt) {
            float sc = 1.f;
            if (EPI == EPI_IN_EVEN || EPI == EPI_IN_ODD) {
                const float rr_ = gu_rs[mt];
#pragma unroll
                for (int nt = 0; nt < 2; ++nt) acc[mt][nt] = acc[mt][nt] * rr_;
            }
            if (EPI == EPI_IN_EVEN && region < 2) {
                float ss = 0.f;
#pragma unroll
                for (int nt = 0; nt < 2; ++nt)
#pragma unroll
                    for (int i = 0; i < 16; ++i) ss += acc[mt][nt][i] * acc[mt][nt][i];
                auto rr = __builtin_amdgcn_permlane32_swap(__float_as_uint(ss), __float_as_uint(ss), false, false);
                ss = __uint_as_float(rr[0]) + __uint_as_float(rr[1]);
                sc = rsqrtf(ss * (1.0f / 64.0f) + EPS) * (region == 0 ? QSCALE : 1.0f);
            }
            float vsum = 0.f;
#pragma unroll
            for (int nt = 0; nt < 2; ++nt)
#pragma unroll
                for (int gq = 0; gq < 4; ++gq) {
                    f32x2 v0 = {acc[mt][nt][4 * gq], acc[mt][nt][4 * gq + 1]}, v1 = {acc[mt][nt][4 * gq + 2], acc[mt][nt][4 * gq + 3]};
                    if (EPI == EPI_IN_EVEN) { if (region < 2) { const f32x4 gg = *(const f32x4*)(gn + nt * 32 + 8 * gq + 4 * hh); v0.x *= sc * gg[0]; v0.y *= sc * gg[1]; v1.x *= sc * gg[2]; v1.y *= sc * gg[3]; } }
                    else if (EPI == EPI_IN_ODD) { if (act) { v0 = gelu_pk(v0); v1 = gelu_pk(v1); vsum += v0.x * v0.x + v0.y * v0.y + v1.x * v1.x + v1.y * v1.y; } else { v0 = v0 * qs; v1 = v1 * qs; } }
                    u32x2 w; w.x = pack2(v0.x, v0.y); w.y = pack2(v1.x, v1.y);
                    *(u32x2*)(wsl + r32 * 128 + (((nt * 4 + gq) ^ (r32 & 7)) << 4) + hh * 8) = w;
                }
            if (EPI == EPI_IN_ODD && colw >= 512 && colw < 1024) {
                auto rr = __builtin_amdgcn_permlane32_swap(__float_as_uint(vsum), __float_as_uint(vsum), false, false);
                vsum = __uint_as_float(rr[0]) + __uint_as_float(rr[1]);
                if (hh == 0) atomicAdd(p.vss + g.m0 + rowb + mt * 32 + r32, vsum);
            }
#pragma unroll
            for (int ps = 0; ps < 4; ++ps) {
                const int row = ps * 8 + (lane >> 3), chunk = lane & 7;
                const u32x4 v = *(const u32x4*)(wsl + row * 128 + ((chunk ^ (row & 7)) << 4));
                const int trow = rowb + mt * 32 + row;
                if (EPI == EPI_DOWN) { const int id = rowid[trow]; if (id >= 0) *(u32x4*)(p.y + (size_t)id * DM + colw + chunk * 8) = v; }
                else if (EPI == EPI_IN_EVEN) *(u32x4*)(p.proj + (size_t)(g.m0 + trow) * EVEN_IN + colw + chunk * 8) = v;
                else *(u32x4*)(p.proj + (size_t)(g.m0 + trow) * ODD_IN + colw + chunk * 8) = v;
            }
        }
    } else if (EPI == EPI_OUT) {
#pragma unroll
        for (int mt = 0; mt < MT; ++mt) {
            f32x4 rx[8]; u32x2 rh[8];
#pragma unroll
            for (int ps = 0; ps < 8; ++ps) {
                const size_t off = (size_t)(g.m0 + rowb + mt * 32 + ps * 4 + (lane >> 4)) * DM + colw + (lane & 15) * 4;
                if (layer == 0) rx[ps] = *(const f32x4*)(p.x + off); else rh[ps] = *(const u32x2*)(p.hb + off);
            }
#pragma unroll
            for (int nt = 0; nt < 2; ++nt)
#pragma unroll
                for (int gq = 0; gq < 4; ++gq) {
                    const f32x4 v = {acc[mt][nt][4 * gq], acc[mt][nt][4 * gq + 1], acc[mt][nt][4 * gq + 2], acc[mt][nt][4 * gq + 3]};
                    *(f32x4*)(wsl + r32 * 256 + (((nt * 8 + 2 * gq + hh) ^ (r32 & 15)) << 4)) = v;
                }
#pragma unroll
            for (int ps = 0; ps < 8; ++ps) {
                const int row = ps * 4 + (lane >> 4), chunk = lane & 15;
                const f32x4 v = *(const f32x4*)(wsl + row * 256 + ((chunk ^ (row & 15)) << 4));
                const size_t off = (size_t)(g.m0 + rowb + mt * 32 + row) * DM + colw + chunk * 4;
                f32x4 r;
                if (layer == 0) r = rx[ps];
                else r = (f32x4){__uint_as_float(rh[ps].x << 16), __uint_as_float(rh[ps].x & 0xffff0000u), __uint_as_float(rh[ps].y << 16), __uint_as_float(rh[ps].y & 0xffff0000u)};
                r = r + v;
                u32x2 w; w.x = pack2(r[0], r[1]); w.y = pack2(r[2], r[3]);
                *(u32x2*)(p.hb + off) = w;
            }
        }
    } else if (EPI == EPI_GU) {
        const int f0 = (g.n0 >> 1) + wn * 32;
#pragma unroll
        for (int mt = 0; mt < MT; ++mt) {
            const float w = gu_w[mt], rs = gu_rs[mt];
#pragma unroll
            for (int gq = 0; gq < 4; ++gq) {
                float h[4];
#pragma unroll
                for (int j = 0; j < 4; ++j) { const float gt = acc[mt][0][4 * gq + j] * rs, up = acc[mt][1][4 * gq + j] * (rs * w);
                    h[j] = gt * __builtin_amdgcn_rcpf(1.0f + __builtin_amdgcn_exp2f(-LOG2E * gt)) * up; }
                u32x2 ww; ww.x = pack2(h[0], h[1]); ww.y = pack2(h[2], h[3]);
                *(u32x2*)(wsl + r32 * 64 + ((gq ^ (r32 & 3)) << 4) + hh * 8) = ww;
            }
#pragma unroll
            for (int ps = 0; ps < 2; ++ps) {
                const int row = ps * 16 + (lane >> 2), chunk = lane & 3;
                const u32x4 v = *(const u32x4*)(wsl + row * 64 + ((chunk ^ (row & 3)) << 4));
                const int id2 = rowid[rowb + mt * 32 + row];
                if (id2 >= 0) st16_sc1(p.hid + (size_t)id2 * FF + f0 + chunk * 8, v);
            }
        }
        asm volatile("s_waitcnt vmcnt(0)" ::: "memory");
    }
    __syncthreads();
}

template <int EPI, int MT>
DI void ph_gemm_dense(const P& p, char* smem, const bf16_t* A, int lda, const bf16_t* B, int K, int N, int layer, int nt0, int ntc) {
    const int ntm = NTOK / (64 * MT), per_xcd = (ntm / 8) * ntc;
    const bool xcd = (gridDim.x & 7) == 0;
    const int x = blockIdx.x & 7, gx = gridDim.x >> 3;
    const int jend = xcd ? per_xcd : ntm * ntc, jstep = xcd ? gx : (int)gridDim.x;
    for (int j = xcd ? (int)(blockIdx.x >> 3) : (int)blockIdx.x; j < jend; j += jstep) {
        GemmArgs g; g.A = A; g.lda = lda; g.gather = nullptr; g.mvalid = 64 * MT; g.gshift = 0; g.rowid_ready = false; g.B0 = B; g.B1 = B; g.ldb = N; g.gu = 0; g.K = K;
        const int rot = ((j / jstep) & 1) * (ntc >> 1);
        g.m0 = ((xcd ? x * (ntm / 8) : 0) + j / ntc) * (64 * MT); g.n0 = (nt0 + (j % ntc + rot) % ntc) * 256;
        gemm_tile<EPI, MT>(p, smem, g, layer);
    }
}

DI void moe_locate(const int* cnt, int mt, int& e, int& c, int& mtl) {
    e = 0; c = 0;
    for (; e < NEXP; ++e) { c = cnt[e]; const int t = (c + 127) >> 7; if (mt < t) break; mt -= t; }
    mtl = mt;
}
DI void ph_moe(const P& p, char* smem, int layer) {
    const int* cnt = p.cnt + layer * NEXP;
    int* gdone = p.gdone + layer * 320;
    int* queue = p.gdone + 600 + layer;
    volatile int* s_next = (volatile int*)(smem + SMEM_BYTES + 80);
    int total = 0;
    for (int e = 0; e < NEXP; ++e) total += (cnt[e] + 127) >> 7;
    const int ngu = total * 2, nall = total * 6;
    int mine = 0;
    if (threadIdx.x == 0) mine = __hip_atomic_fetch_add(queue, 1, __ATOMIC_RELAXED, __HIP_MEMORY_SCOPE_AGENT);
    for (;;) {
        if (threadIdx.x == 0) s_next[0] = mine;
        __syncthreads();
        const int u = s_next[0];
        if (u >= nall) break;
        if (threadIdx.x == 0) mine = __hip_atomic_fetch_add(queue, 1, __ATOMIC_RELAXED, __HIP_MEMORY_SCOPE_AGENT);
        if (u < ngu) {
            int e, c, mt; moe_locate(cnt, u >> 1, e, c, mt);
            GemmArgs g; g.gather = p.plist + (size_t)e * LISTCAP + mt * 128; g.mvalid = c - mt * 128 < 128 ? c - mt * 128 : 128;
            g.m0 = 0; g.n0 = (u & 1) * 256;
            const size_t ex = (size_t)(layer * NEXP + e);
            g.rowid_ready = false; g.A = p.hb; g.lda = DM; g.gshift = 1; g.B0 = p.wb_gate + ex * DM * FF; g.B1 = p.wb_up + ex * DM * FF; g.ldb = FF; g.gu = 1; g.K = DM;
            gemm_tile<EPI_GU, 2>(p, smem, g, layer);
            if (threadIdx.x == 0) __hip_atomic_fetch_add(gdone + (u >> 1), 1, __ATOMIC_RELAXED, __HIP_MEMORY_SCOPE_AGENT);
        } else {
            const int v = u - ngu;
            int e, c, mt; moe_locate(cnt, v >> 2, e, c, mt);
            GemmArgs g; g.gather = p.plist + (size_t)e * LISTCAP + mt * 128; g.mvalid = c - mt * 128 < 128 ? c - mt * 128 : 128;
            {
                int* rowid = (int*)(smem + G_ROWID);
                const int rid = (threadIdx.x < 128 && (int)threadIdx.x < g.mvalid) ? g.gather[threadIdx.x] : -1;
                if (threadIdx.x == 0) { unsigned sp = 0;
                    while (__hip_atomic_load(gdone + (v >> 2), __ATOMIC_RELAXED, __HIP_MEMORY_SCOPE_AGENT) < 2) { __builtin_amdgcn_s_sleep(2); if (++sp > (1u << 22)) break; } }
                if (threadIdx.x < 128) rowid[threadIdx.x] = rid;
                __syncthreads();
            }
            g.m0 = 0; g.n0 = (v & 3) * 256;
            const size_t ex = (size_t)(layer * NEXP + e);
            g.rowid_ready = true; g.A = p.hid; g.lda = FF; g.gshift = 0; g.B0 = p.wb_down + ex * FF * DM; g.B1 = g.B0; g.ldb = DM; g.gu = 0; g.K = FF;
            gemm_tile<EPI_DOWN, 2>(p, smem, g, layer);
        }
    }
}

DI void convert_flat(const float* __restrict__ src, bf16_t* __restrict__ dst, size_t n8, const float* __restrict__ gain = nullptr, int rowlen = 1) {
    for (size_t i = (size_t)blockIdx.x * 512 + threadIdx.x; i < n8; i += (size_t)gridDim.x * 512) {
        f32x4 a = *(const f32x4*)(src + i * 8), b = *(const f32x4*)(src + i * 8 + 4);
        if (gain) { const float gk = gain[(i * 8) / (size_t)rowlen]; a = a * gk; b = b * gk; }
        u32x4 w; w.x = pack2(a[0], a[1]); w.y = pack2(a[2], a[3]); w.z = pack2(b[0], b[1]); w.w = pack2(b[2], b[3]);
        *(u32x4*)(dst + i * 8) = w;
    }
}
DI void poolfold_unit(const P& p, char* smem, int unit) {
    float (*At)[32] = (float (*)[32])smem;
    float (*Bs)[64] = (float (*)[64])(smem + 16384);
    const int tid = opaque_tid() & 255, g = unit >> 6, c0 = ((unit >> 4) & 3) * 32, n0 = (unit & 15) * 64;
    __syncthreads();
    for (int i = 0; i < 16; ++i) { const int idx = tid + 256 * i, d = idx >> 5, c = idx & 31;
        At[d][c] = p.pool_w[(size_t)(g * 128 + c0 + c) * 128 + d] * p.pool_scale[g * 128 + d]; }
    for (int i = 0; i < 8; ++i) { const int idx = tid + 256 * i, d = idx >> 4, n4 = (idx & 15) * 4;
        *(f32x4*)&Bs[d][n4] = *(const f32x4*)(p.w_out_even + (size_t)(512 + g * 128 + d) * DM + n0 + n4); }
    __syncthreads();
    const int tc = (tid >> 4) * 2, tn = (tid & 15) * 4;
    f32x4 acc[2] = {(f32x4){0.f, 0.f, 0.f, 0.f}, (f32x4){0.f, 0.f, 0.f, 0.f}};
#pragma unroll 8
    for (int d = 0; d < 128; ++d) {
        const f32x2 a = *(const f32x2*)&At[d][tc]; const f32x4 b = *(const f32x4*)&Bs[d][tn];
        acc[0] += a.x * b; acc[1] += a.y * b;
    }
#pragma unroll
    for (int i = 0; i < 2; ++i) { u32x2 w; w.x = pack2(acc[i][0], acc[i][1]); w.y = pack2(acc[i][2], acc[i][3]);
        *(u32x2*)(p.wb_out_even + (size_t)(512 + g * 128 + c0 + tc + i) * DM + n0 + tn) = w; }
}
DI void cast_rows2(const P& p, int tok, int lane) {
    f32x4 v[2][4];
#pragma unroll
    for (int r = 0; r < 2; ++r)
#pragma unroll
        for (int i = 0; i < 4; ++i) v[r][i] = *(const f32x4*)(p.x + (size_t)(tok + r) * DM + i * 256 + lane * 4);
#pragma unroll
    for (int r = 0; r < 2; ++r) {
        float ss = 0.f;
#pragma unroll
        for (int i = 0; i < 4; ++i) { ss += v[r][i][0] * v[r][i][0] + v[r][i][1] * v[r][i][1] + v[r][i][2] * v[r][i][2] + v[r][i][3] * v[r][i][3];
            u32x2 w; w.x = pack2(v[r][i][0], v[r][i][1]); w.y = pack2(v[r][i][2], v[r][i][3]);
            *(u32x2*)(p.hb + (size_t)(tok + r) * DM + i * 256 + lane * 4) = w; }
        ss = wave_sum(ss);
        if (lane == 0) p.rsm[tok + r] = rsqrtf(ss * (1.0f / DM) + EPS);
    }
}
DI void ph_prologue(const P& p, char* smem) {
    if (blockIdx.x == 0 && threadIdx.x < 64) p.cnt[threadIdx.x] = 0;
    if (blockIdx.x == 2 && threadIdx.x == 0) ((float*)p.ones)[0] = 1.0f;
    if (blockIdx.x == 1) for (int i = threadIdx.x; i < 640; i += 512) p.gdone[i] = 0;
    for (int i = blockIdx.x * 512 + threadIdx.x; i < NTOK; i += gridDim.x * 512) p.vss[i] = 0.f;
    for (int u = blockIdx.x; u < 128; u += gridDim.x) poolfold_unit(p, smem + (threadIdx.x >> 8) * HALF_LDS, u * 2 + (threadIdx.x >> 8));
    for (int i = blockIdx.x * 512 + threadIdx.x; i < 2 * 96 * DM; i += gridDim.x * 512) {
        const int k = i & (DM - 1), R = (i >> 10) % 96, layer = i / (96 * DM);
        const int T = R >> 5, r = R & 31, L = 16 * T + (r & 3) + 4 * (r >> 3);
        float w = 0.f;
        if (L < 32) w = p.w_re[((size_t)layer * DM + k) * 32 + L]; else if (L < 36) w = p.w_rg[((size_t)layer * DM + k) * 4 + (L - 32)];
        w *= p.ffn_norm[layer * DM + k];
        const unsigned hi = pack2(w, 0.f) & 0xffffu;
        p.wr_hi[i] = (bf16_t)hi; p.wr_lo[i] = (bf16_t)(pack2(w - __uint_as_float(hi << 16), 0.f) & 0xffffu);
    }
    const int wave = threadIdx.x >> 6, lane = threadIdx.x & 63;
    for (int u = blockIdx.x; u < NTOK / 16; u += gridDim.x) {
        const int tok = u * 16 + wave * 2;
        cast_rows2(p, tok, lane);
    }
    convert_flat(p.w_in_even, p.wb_in_even, (size_t)DM * EVEN_IN / 8, p.mix_norm_even, EVEN_IN);
    convert_flat(p.w_out_even, p.wb_out_even, (size_t)512 * DM / 8);
}
DI void convert_experts(const P& p, int layer) {
    const size_t o = (size_t)layer * NEXP * DM * FF;
    convert_flat(p.w_gate + o, p.wb_gate + o, (size_t)NEXP * DM * FF / 8);
    convert_flat(p.w_up + o, p.wb_up + o, (size_t)NEXP * DM * FF / 8);
    convert_flat(p.w_down + o, p.wb_down + o, (size_t)NEXP * DM * FF / 8);
}

DI int crow(int i, int h) { return (i & 3) + 8 * (i >> 2) + 4 * h; }
DI float swap_max(float v) { auto rr = __builtin_amdgcn_permlane32_swap(__float_as_uint(v), __float_as_uint(v), false, false); return fmaxf(__uint_as_float(rr[0]), __uint_as_float(rr[1])); }
DI float swap_sum(float v) { auto rr = __builtin_amdgcn_permlane32_swap(__float_as_uint(v), __float_as_uint(v), false, false); return __uint_as_float(rr[0]) + __uint_as_float(rr[1]); }
DI float bcast_lo(float v) { auto rr = __builtin_amdgcn_permlane32_swap(__float_as_uint(v), __float_as_uint(v), false, false); return __uint_as_float(rr[0]); }
DI bf16x8 pack8(const f32x16& x, int s) {
    u32x4 w; w.x = pack2(x[8 * s], x[8 * s + 1]); w.y = pack2(x[8 * s + 2], x[8 * s + 3]); w.z = pack2(x[8 * s + 4], x[8 * s + 5]); w.w = pack2(x[8 * s + 6], x[8 * s + 7]);
    return __builtin_bit_cast(bf16x8, w);
}
constexpr int KV_TILE = 8192;
struct KVStage { u32x4 k[2], v[2]; };
DI void kv_load(KVStage& st, const bf16_t* kbase, const bf16_t* vbase, int ld, int key0) {
    const int tid = opaque_tid() & 255, c = tid & 7, r0 = tid >> 3;
#pragma unroll
    for (int i = 0; i < 2; ++i) { const size_t off = (size_t)(key0 + r0 + 32 * i) * ld + c * 8; st.k[i] = *(const u32x4*)(kbase + off); st.v[i] = *(const u32x4*)(vbase + off); }
}
DI void kv_store(const KVStage& st, char* kt, char* vt) {
    const int tid = opaque_tid() & 255, c = tid & 7, r0 = tid >> 3;
#pragma unroll
    for (int i = 0; i < 2; ++i) { const int r = r0 + 32 * i;
        *(u32x4*)(kt + r * 128 + ((c ^ ((r >> 1) & 7)) << 4)) = st.k[i];
        *(u32x4*)(vt + r * 128 + ((((c >> 2) ^ ((r >> 1) & 1))) << 6) + ((c & 3) << 4)) = st.v[i]; }
}
DI bf16x8 k_frag(const char* kt, int sb, int st, int r32, int hh) {
    const int row = sb * 32 + r32;
    return *(const bf16x8*)(kt + row * 128 + (((2 * st + hh) ^ ((row >> 1) & 7)) << 4));
}
DI bf16x8 vt_frag(const char* vt, int sb, int st, int dh, int lane) {
    const int hh = lane >> 5, g1 = (lane >> 4) & 1, pp = lane & 3, q = (lane & 15) >> 2;
    const int key = sb * 32 + 16 * st + 4 * hh + q;
    const char* a = vt + key * 128 + ((dh ^ ((q >> 1) & 1)) << 6) + g1 * 32 + pp * 8;
    const s16x4 lo = tr_read(a), hi = tr_read(a + 8 * 128);
    return (bf16x8){lo[0], lo[1], lo[2], lo[3], hi[0], hi[1], hi[2], hi[3]};
}


#define XB_TMO      128
#define XB_XCNT(j)  (256  + 64 * (j))
#define XB_XSUB(j)  (1280 + 64 * (j))
#define XB_XGEN(j)  (2304 + 64 * (j))
#define XB_TOP      3328
#define XB_TOPGEN   3392
#define XCD_BAR_WORDS 3456
#define XB_SPIN_CAP (1u << 22)
DI unsigned xb_ld(unsigned* q)              { return __hip_atomic_load(q, __ATOMIC_RELAXED, __HIP_MEMORY_SCOPE_AGENT); }
DI unsigned xb_add(unsigned* q, unsigned v) { return __hip_atomic_fetch_add(q, v, __ATOMIC_RELAXED, __HIP_MEMORY_SCOPE_AGENT); }
DI unsigned xb_xcc_id() { return (unsigned)__builtin_amdgcn_s_getreg((3 << 11) | 20) & 0xFu; }
#define XB_SPIN(cond, bar) do { unsigned _sp = 0; while (cond) { __builtin_amdgcn_s_sleep(1); \
    if ((++_sp & 255u) == 0u) { if (xb_ld(&(bar)[XB_TMO])) break; if (_sp > XB_SPIN_CAP) { atomicAdd(&(bar)[XB_TMO], 1u); break; } } } } while (0)
struct XcdBarrier { unsigned* bar; unsigned x; volatile LDSAS unsigned* st; };
DI XcdBarrier xcd_barrier_post(unsigned* bar, volatile LDSAS unsigned* st) {
    XcdBarrier b; b.bar = bar; b.x = xb_xcc_id(); b.st = st;
    if (threadIdx.x == 0) (void)xb_add(&bar[XB_XCNT(b.x)], 1u);
    return b;
}
DI void xcd_barrier_complete(unsigned* bar, unsigned x, unsigned& nloc, unsigned& nx) {
    const unsigned G = gridDim.x * gridDim.y * gridDim.z;
    unsigned sum, cnt, mine, sp = 0u;
    for (;;) {
        sum = 0u; cnt = 0u; mine = 0u;
#pragma unroll
        for (unsigned j = 0; j < 16; ++j) { const unsigned c = xb_ld(&bar[XB_XCNT(j)]); sum += c; cnt += (c > 0u) ? 1u : 0u; mine = (j == x) ? c : mine; }
        if (sum == G) break;
        __builtin_amdgcn_s_sleep(1);
        if ((++sp & 255u) == 0u) { if (xb_ld(&bar[XB_TMO])) break; if (sp > XB_SPIN_CAP) { atomicAdd(&bar[XB_TMO], 1u); break; } }
    }
    nloc = mine > 0u ? mine : 1u; nx = cnt > 0u ? cnt : 1u;
}
DI void xcd_barrier(const XcdBarrier& b) {
    asm volatile("s_waitcnt vmcnt(0)" ::: "memory");
    __syncthreads();
    if (threadIdx.x == 0) {
        unsigned* bar = b.bar;
        __builtin_amdgcn_s_waitcnt(0);
        unsigned nloc = b.st[0], nx = b.st[1];
        if (nloc == 0u) { xcd_barrier_complete(bar, b.x, nloc, nx); b.st[0] = nloc; b.st[1] = nx; }
        const unsigned old = xb_add(&bar[XB_XSUB(b.x)], 1u);
        const unsigned gen = old / nloc;
        if (old + 1u == (gen + 1u) * nloc) {
            __builtin_amdgcn_fence(__ATOMIC_RELEASE, "agent");
            asm volatile("s_waitcnt vmcnt(0)" ::: "memory");
            const unsigned og = xb_add(&bar[XB_TOP], 1u);
            const unsigned tg = og / nx;
            if (og + 1u == (tg + 1u) * nx) xb_add(&bar[XB_TOPGEN], 1u);
            else XB_SPIN(xb_ld(&bar[XB_TOPGEN]) == tg, bar);
            __builtin_amdgcn_fence(__ATOMIC_ACQUIRE, "agent");
            xb_add(&bar[XB_XGEN(b.x)], 1u);
            asm volatile("s_waitcnt vmcnt(0)" ::: "memory");
        } else {
            XB_SPIN(xb_ld(&bar[XB_XGEN(b.x)]) == gen, bar);
            __builtin_amdgcn_fence(__ATOMIC_ACQUIRE, "agent");
            asm volatile("s_waitcnt vmcnt(0)" ::: "memory");
        }
    }
    __syncthreads();
}


struct ConvPlan { int layer; int sl_e, sl_in, sl_out, nslots; };
template <int NV> DI ConvPlan conv_plan(const P& p, int layer) {
    ConvPlan c; c.layer = layer;
    const unsigned per = gridDim.x * 512u, gsz = 4 * NV;
    c.sl_e = (int)((NEXP * DM * FF / gsz + per - 1) / per);
    c.sl_in = layer == 0 ? (int)((DM * ODD_IN / gsz + per - 1) / per) : 0;
    c.sl_out = layer == 0 ? (int)((DM * DM / gsz + per - 1) / per) : 0;
    c.nslots = 3 * c.sl_e + c.sl_in + c.sl_out;
    return c;
}
template <int NV> DI void conv_locate(const P& p, const ConvPlan& c, int slot, const float*& s, bf16_t*& d, const float*& gp) {
    constexpr unsigned gsz = 4 * NV;
    int seg = 0, ls = slot;
    if (ls < 3 * c.sl_e) { seg = ls / c.sl_e; ls -= seg * c.sl_e; }
    else if ((ls -= 3 * c.sl_e) < c.sl_in) seg = 3;
    else { ls -= c.sl_in; seg = 4; }
    const unsigned ng = seg < 3 ? NEXP * DM * FF / gsz : (seg == 3 ? DM * ODD_IN / gsz : DM * DM / gsz);
    const unsigned gi = ((unsigned)ls * gridDim.x + blockIdx.x) * 512u + threadIdx.x;
    const bool live = slot < c.nslots && gi < ng;
    const size_t e = live ? (size_t)gi * gsz : 0;
    const int tix = c.layer * 5 + __builtin_amdgcn_readfirstlane(seg);
    s = p.cs[tix] + e;
    d = live ? p.cd[tix] + e : p.dump + ((size_t)blockIdx.x * 512 + threadIdx.x) * 16;
    gp = p.ones;
    if (live && seg < 2) gp = p.ffn_norm + c.layer * DM + ((e >> 8) & (DM - 1));
    else if (live && seg == 3) gp = p.mix_norm_odd + e / ODD_IN;
}
#define CONV_DECL4(N) f32x4 N##0, N##1, N##2, N##3; float N##g; bf16_t* N##d
#define CONV_DECL2(N) f32x4 N##0, N##1; float N##g; bf16_t* N##d
#define CONV_LOAD4(N, SLOT) do { const float* s_; const float* g_; conv_locate<4>(p, cv, (SLOT), s_, N##d, g_); \
        N##g = *g_; N##0 = *(const f32x4*)s_; N##1 = *(const f32x4*)(s_ + 4); N##2 = *(const f32x4*)(s_ + 8); N##3 = *(const f32x4*)(s_ + 12); } while (0)
#define CONV_LOAD2(N, SLOT) do { const float* s_; const float* g_; conv_locate<2>(p, cv, (SLOT), s_, N##d, g_); \
        N##g = *g_; N##0 = *(const f32x4*)s_; N##1 = *(const f32x4*)(s_ + 4); } while (0)
#define CONV_STORE4(N) do { const f32x4 a_ = N##0 * N##g, b_ = N##1 * N##g, c_ = N##2 * N##g, e_ = N##3 * N##g; u32x4 w_; \
        w_.x = pack2(a_[0], a_[1]); w_.y = pack2(a_[2], a_[3]); w_.z = pack2(b_[0], b_[1]); w_.w = pack2(b_[2], b_[3]); *(u32x4*)N##d = w_; \
        w_.x = pack2(c_[0], c_[1]); w_.y = pack2(c_[2], c_[3]); w_.z = pack2(e_[0], e_[1]); w_.w = pack2(e_[2], e_[3]); *(u32x4*)(N##d + 8) = w_; } while (0)
#define CONV_STORE2(N) do { const f32x4 a_ = N##0 * N##g, b_ = N##1 * N##g; u32x4 w_; \
        w_.x = pack2(a_[0], a_[1]); w_.y = pack2(a_[2], a_[3]); w_.z = pack2(b_[0], b_[1]); w_.w = pack2(b_[2], b_[3]); *(u32x4*)N##d = w_; } while (0)

DI void band_attn_unit(const P& p, char* smem, int unit, const ConvPlan& cv, int& cslot) {
    const int tid = opaque_tid() & 255, lane = tid & 63, wid = tid >> 6, r32 = lane & 31, hh = lane >> 5;
    const int cp = unit & 31, h = (unit >> 5) & 7, b = unit >> 8;
    const int c = 2 * cp + (wid >> 1);
    const int tq = c * 64 + (wid & 1) * 32 + r32;
    const size_t rowb = (size_t)b * NS;
    const bf16_t* kbase = p.proj + rowb * EVEN_IN + 512 + h * 64;
    const bf16_t* vbase = p.proj + rowb * EVEN_IN + 1024 + h * 64;
    float* sbias = (float*)(smem + 4 * KV_TILE);
    __syncthreads();
    bf16x8 qf[4];
#pragma unroll
    for (int st = 0; st < 4; ++st) qf[st] = *(const bf16x8*)(p.proj + (rowb + tq) * EVEN_IN + h * 64 + st * 16 + hh * 8);
    const int ck0 = (2 * cp - 8) > 0 ? (2 * cp - 8) : 0, nt = 2 * cp + 2 - ck0;
    float m = -3.0e38f, lsum = 0.f;
    f32x16 o0, o1;
#pragma unroll
    for (int i = 0; i < 16; ++i) { o0[i] = 0.f; o1[i] = 0.f; }
    KVStage stg;
    kv_load(stg, kbase, vbase, EVEN_IN, ck0 * 64);
    {
        const float b0 = p.att_rel_bias[h * 257 + tid], b1 = p.att_rel_bias[h * 257 + 256];
        sbias[tid] = b0 * LOG2E; if (tid == 0) sbias[256] = b1 * LOG2E;
    }
    kv_store(stg, smem, smem + 2 * KV_TILE);
    __syncthreads();
    CONV_DECL4(cA); CONV_DECL4(cB);
    CONV_LOAD4(cA, cslot++); CONV_LOAD4(cB, cslot++);
#define BAND_ITER(it, CRX) do { \
        const int ck = ck0 + it, cur = it & 1; \
        kv_load(stg, kbase, vbase, EVEN_IN, ((it + 1 < nt) ? ck + 1 : ck) * 64); \
        CONV_STORE4(CRX); CONV_LOAD4(CRX, cslot++); \
        __builtin_amdgcn_sched_barrier(0); \
        const char* kt = smem + cur * KV_TILE; const char* vt = smem + (2 + cur) * KV_TILE; \
        if (ck >= c - 8 && ck <= c) { \
            f32x16 s0, s1; \
_Pragma("unroll") \
            for (int i = 0; i < 16; ++i) { s0[i] = 0.f; s1[i] = 0.f; } \
_Pragma("unroll") \
            for (int st = 0; st < 4; ++st) { s0 = MFMA32(k_frag(kt, 0, st, r32, hh), qf[st], s0); s1 = MFMA32(k_frag(kt, 1, st, r32, hh), qf[st], s1); } \
            if (c - ck >= 3) { const float bb = sbias[256]; \
_Pragma("unroll") \
                for (int i = 0; i < 16; ++i) { s0[i] += bb; s1[i] += bb; } \
            } else { \
                const int d0 = tq - ck * 64 - 4 * hh; \
_Pragma("unroll") \
                for (int i = 0; i < 16; ++i) { \
                    int da = d0 - ((i & 3) + 8 * (i >> 2)), db = da - 32; \
                    da = da > 128 ? 128 : da; db = db > 128 ? 128 : db; \
                    s0[i] += sbias[da + 128]; s1[i] += sbias[db + 128]; \
                } \
            } \
            float tm = fmaxf(s0[0], s1[0]); \
_Pragma("unroll") \
            for (int i = 1; i < 16; ++i) tm = fmaxf(tm, fmaxf(s0[i], s1[i])); \
            tm = swap_max(tm); \
            const float mn = fmaxf(m, tm); \
            const float alpha = __builtin_amdgcn_exp2f(m - mn); \
            m = mn; \
            float ps = 0.f; \
_Pragma("unroll") \
            for (int i = 0; i < 16; ++i) { s0[i] = __builtin_amdgcn_exp2f(s0[i] - mn); s1[i] = __builtin_amdgcn_exp2f(s1[i] - mn); ps += s0[i] + s1[i]; } \
            lsum = lsum * alpha + ps; \
_Pragma("unroll") \
            for (int i = 0; i < 16; ++i) { o0[i] *= alpha; o1[i] *= alpha; } \
_Pragma("unroll") \
            for (int st = 0; st < 2; ++st) { \
                const bf16x8 pa = pack8(s0, st), pb = pack8(s1, st); \
                o0 = MFMA32(vt_frag(vt, 0, st, 0, lane), pa, o0); o1 = MFMA32(vt_frag(vt, 0, st, 1, lane), pa, o1); \
                o0 = MFMA32(vt_frag(vt, 1, st, 0, lane), pb, o0); o1 = MFMA32(vt_frag(vt, 1, st, 1, lane), pb, o1); \
            } \
        } \
        __builtin_amdgcn_sched_barrier(0); \
        kv_store(stg, smem + (cur ^ 1) * KV_TILE, smem + (2 + (cur ^ 1)) * KV_TILE); \
        __syncthreads(); \
    } while (0)
    for (int it = 0; it < nt; it += 2) {
        BAND_ITER(it, cA);
        if (it + 1 >= nt) break;
        BAND_ITER(it + 1, cB);
    }
#undef BAND_ITER
    CONV_STORE4(cA); CONV_STORE4(cB);
    const float inv = 1.0f / swap_sum(lsum);
    bf16_t* orow = p.mixed + (rowb + tq) * DM + h * 64 + 4 * hh;
#pragma unroll
    for (int g = 0; g < 4; ++g) {
        u32x2 w0, w1;
        w0.x = pack2(o0[4 * g] * inv, o0[4 * g + 1] * inv); w0.y = pack2(o0[4 * g + 2] * inv, o0[4 * g + 3] * inv);
        w1.x = pack2(o1[4 * g] * inv, o1[4 * g + 1] * inv); w1.y = pack2(o1[4 * g + 2] * inv, o1[4 * g + 3] * inv);
        *(u32x2*)(orow + 8 * g) = w0; *(u32x2*)(orow + 32 + 8 * g) = w1;
    }
}

DI void sb_attn_unit(const P& p, char* smem, volatile int* wdone, int unit, const ConvPlan& cv, int& cslot) {
    const int tid8 = opaque_tid(), tid = tid8 & 255, lane = tid & 63, wid = tid >> 6, r32 = lane & 31, hh = lane >> 5, wid8 = tid8 >> 6;
    const int qb = unit & 31, h = (unit >> 5) & 7, b = unit >> 8;
    const int tw = qb * 128 + wid * 32, t = tw + r32;
    const size_t rowb = (size_t)b * NS;
    const bf16_t* kbase = p.proj + rowb * ODD_IN + 1536 + h * 64;
    const bf16_t* vbase = p.proj + rowb * ODD_IN + 2048 + h * 64;
    __syncthreads();
    bf16x8 qf[4];
#pragma unroll
    for (int st = 0; st < 4; ++st) qf[st] = *(const bf16x8*)(p.proj + (rowb + t) * ODD_IN + 1024 + h * 64 + st * 16 + hh * 8);
    bf16x8 tf[2];
#pragma unroll
    for (int st = 0; st < 2; ++st)
#pragma unroll
        for (int j = 0; j < 8; ++j) tf[st][j] = (16 * st + 8 * (j >> 2) + 4 * hh + (j & 3)) >= r32 ? (short)0x3F80 : (short)0;
    f32x16 o0, o1;
#pragma unroll
    for (int i = 0; i < 16; ++i) { o0[i] = 0.f; o1[i] = 0.f; }
    float carry = 0.f; bool done = false;
    const int kt0 = 2 * qb + 1;
    KVStage stg;
    kv_load(stg, kbase, vbase, ODD_IN, kt0 * 64);
    kv_store(stg, smem, smem + 2 * KV_TILE);
    __syncthreads();
    bool all_done = false;
    CONV_DECL2(cA);
    CONV_LOAD2(cA, cslot++);
#define SB_ITER(it, CRX) do { \
        const int kt = kt0 - it, cur = it & 1; \
        kv_load(stg, kbase, vbase, ODD_IN, (kt > 0 ? kt - 1 : 0) * 64); \
        CONV_STORE2(CRX); CONV_LOAD2(CRX, cslot++); \
        __builtin_amdgcn_sched_barrier(0); \
        const char* ktile = smem + cur * KV_TILE; const char* vtile = smem + (2 + cur) * KV_TILE; \
        if (!done && kt * 64 < tw + 31) { \
_Pragma("unroll") \
            for (int sbi = 0; sbi < 2; ++sbi) { \
                const int sb = 1 - sbi; \
                f32x16 x; \
_Pragma("unroll") \
                for (int i = 0; i < 16; ++i) x[i] = 0.f; \
_Pragma("unroll") \
                for (int st = 0; st < 4; ++st) x = MFMA32(k_frag(ktile, sb, st, r32, hh), qf[st], x); \
                const int kb = kt * 64 + sb * 32 + 4 * hh; \
                f32x16 L; \
_Pragma("unroll") \
                for (int i = 0; i < 16; ++i) { \
                    const bool valid = kb + (i & 3) + 8 * (i >> 2) < t; \
                    const float z = x[i]; \
                    const float sp = fmaxf(z, 0.f) + __builtin_amdgcn_logf(1.0f + __builtin_amdgcn_exp2f(-fabsf(z))); \
                    L[i] = valid ? -sp : 0.f; \
                    x[i] = valid ? z : -1.0e30f; \
                } \
                f32x16 cum; \
_Pragma("unroll") \
                for (int i = 0; i < 16; ++i) cum[i] = carry; \
_Pragma("unroll") \
                for (int st = 0; st < 2; ++st) cum = MFMA32(tf[st], pack8(L, st), cum); \
                carry = bcast_lo(cum[0]); \
_Pragma("unroll") \
                for (int i = 0; i < 16; ++i) x[i] = __builtin_amdgcn_exp2f(x[i] + cum[i]); \
_Pragma("unroll") \
                for (int st = 0; st < 2; ++st) { \
                    const bf16x8 pa = pack8(x, st); \
                    o0 = MFMA32(vt_frag(vtile, sb, st, 0, lane), pa, o0); o1 = MFMA32(vt_frag(vtile, sb, st, 1, lane), pa, o1); \
                } \
            } \
            done = __all(carry < -150.0f); \
        } \
        __builtin_amdgcn_sched_barrier(0); \
        if (lane == 0) wdone[cur * 8 + wid8] = done ? 1 : 0; \
        kv_store(stg, smem + (cur ^ 1) * KV_TILE, smem + (2 + (cur ^ 1)) * KV_TILE); \
        __syncthreads(); \
        all_done = (wdone[cur * 8] + wdone[cur * 8 + 1] + wdone[cur * 8 + 2] + wdone[cur * 8 + 3] + wdone[cur * 8 + 4] + wdone[cur * 8 + 5] + wdone[cur * 8 + 6] + wdone[cur * 8 + 7] == 8); \
    } while (0)
#pragma nounroll
    for (int it = 0; it <= kt0; ++it) {
        SB_ITER(it, cA);
        if (all_done) break;
    }
#undef SB_ITER
    CONV_STORE2(cA);
    bf16_t* orow = p.mixed + (rowb + t) * DM + 512 + h * 64 + 4 * hh;
#pragma unroll
    for (int g = 0; g < 4; ++g) {
        u32x2 w0, w1;
        w0.x = pack2(o0[4 * g], o0[4 * g + 1]); w0.y = pack2(o0[4 * g + 2], o0[4 * g + 3]);
        w1.x = pack2(o1[4 * g], o1[4 * g + 1]); w1.y = pack2(o1[4 * g + 2], o1[4 * g + 3]);
        *(u32x2*)(orow + 8 * g) = w0; *(u32x2*)(orow + 32 + 8 * g) = w1;
    }
}

DI void pool_items(const P& p) {
    for (int it = blockIdx.x * 512 + threadIdx.x; it < (NTOK / 8) * 64; it += gridDim.x * 512) {
        const int run = it >> 6, ch8 = it & 63, g = ch8 >> 4, w = 2 << g;
        const int tok0 = run * 8, s0 = tok0 & (NS - 1);
        const bf16_t* src = p.proj + (size_t)tok0 * EVEN_IN + 1536 + ch8 * 8;
        u32x4 rows[23];
#pragma unroll
        for (int k = 0; k < 23; ++k) { const int ds = k - 15; const bool ok = s0 + ds >= 0;
            rows[k] = *(const u32x4*)(src + (ptrdiff_t)(ok ? ds : 0) * EVEN_IN); if (!ok) rows[k] = (u32x4){0u, 0u, 0u, 0u}; }
        float sum[8], f[8];
#pragma unroll
        for (int j = 0; j < 8; ++j) sum[j] = 0.f;
#pragma unroll
        for (int k = 0; k < 15; ++k) { unpack8(rows[k], f); const float mk = (15 - k) < w ? 1.f : 0.f;
#pragma unroll
            for (int j = 0; j < 8; ++j) sum[j] += f[j] * mk; }
#pragma unroll
        for (int t = 0; t < 8; ++t) {
            unpack8(rows[15 + t], f);
#pragma unroll
            for (int j = 0; j < 8; ++j) sum[j] += f[j];
            const int s = s0 + t; const float inv = 1.0f / (float)((s + 1 < w) ? s + 1 : w);
            u32x4 o; o.x = pack2(sum[0] * inv - f[0], sum[1] * inv - f[1]); o.y = pack2(sum[2] * inv - f[2], sum[3] * inv - f[3]);
            o.z = pack2(sum[4] * inv - f[4], sum[5] * inv - f[5]); o.w = pack2(sum[6] * inv - f[6], sum[7] * inv - f[7]);
            *(u32x4*)(p.mixed + (size_t)(tok0 + t) * DM + 512 + ch8 * 8) = o;
            float d[8];
            const u32x4 r2 = rows[15 + t - 1], r4 = rows[15 + t - 3], r8 = rows[15 + t - 7], r16 = rows[t];
            const u32x4 rd = g == 0 ? r2 : (g == 1 ? r4 : (g == 2 ? r8 : r16));
            unpack8(rd, d);
#pragma unroll
            for (int j = 0; j < 8; ++j) sum[j] -= d[j];
        }
    }
}

DI void sgu_unit(const P& p, char* smem, int unit) {
    const int tid = opaque_tid() & 255, lane = tid & 63, wid = tid >> 6, wm = wid >> 1, wn = wid & 1, fr = lane & 15, fq = lane >> 4;
    const int g = unit & 3; const size_t tok0 = (size_t)(unit >> 2) * 128;
    char* As = smem; char* Gs = smem + 32768; float* srstd = (float*)(smem + 65536);
    __syncthreads();
    if (tid < 128) srstd[tid] = rsqrtf(p.vss[tok0 + tid] * (1.0f / 512.0f) + EPS);
#pragma unroll
    for (int i = 0; i < 8; ++i) {
        const int idx = tid + 256 * i, s = idx >> 4, ch = idx & 15;
        const u32x4 v = *(const u32x4*)(p.proj + (tok0 + s) * ODD_IN + 512 + g * 128 + ch * 8);
        *(u32x4*)(Gs + s * 256 + (((ch >> 1) ^ kswz(s)) << 5) + ((ch & 1) << 4)) = v;
    }
    __syncthreads();
#pragma unroll
    for (int i = 0; i < 8; ++i) {
        const int idx = tid + 256 * i, t = idx >> 4, c8 = idx & 15, s0 = c8 * 8;
        const float* wr = p.sgu_w + ((size_t)g * 128 + t) * 128 + s0;
        const f32x4 a = *(const f32x4*)wr, b = *(const f32x4*)(wr + 4);
        float f[8] = {a[0], a[1], a[2], a[3], b[0], b[1], b[2], b[3]};
#pragma unroll
        for (int j = 0; j < 8; ++j) f[j] = (s0 + j <= t) ? f[j] * srstd[s0 + j] : 0.f;
        u32x4 w; w.x = pack2(f[0], f[1]); w.y = pack2(f[2], f[3]); w.z = pack2(f[4], f[5]); w.w = pack2(f[6], f[7]);
        *(u32x4*)(As + (c8 >> 3) * 16384 + t * 128 + (((c8 & 7) ^ (t & 7)) << 4)) = w;
    }
    __syncthreads();
    f32x4 acc[4][4];
#pragma unroll
    for (int a = 0; a < 4; ++a)
#pragma unroll
        for (int b = 0; b < 4; ++b) acc[a][b] = (f32x4){0.f, 0.f, 0.f, 0.f};
    const int qq = fr >> 2, pp = fr & 3;
#pragma unroll
    for (int kt = 0; kt < 2; ++kt) {
        if (kt == 1 && wm == 0) continue;
#pragma unroll
        for (int s2 = 0; s2 < 2; ++s2) {
            bf16x8 af[4], bfv[4];
#pragma unroll
            for (int i = 0; i < 4; ++i) {
                const int ra_ = wm * 64 + i * 16 + fr;
                af[i] = *(const bf16x8*)(As + kt * 16384 + ra_ * 128 + (((s2 * 4 + fq) ^ (fr & 7)) << 4));
                const int srow = kt * 64 + s2 * 32 + 8 * fq + qq, blk = wn * 4 + i;
                const s16x4 lo = tr_read(Gs + srow * 256 + ((blk ^ kswz(srow)) << 5) + pp * 8);
                const s16x4 hi = tr_read(Gs + (srow + 4) * 256 + ((blk ^ kswz(srow + 4)) << 5) + pp * 8);
                bfv[i] = (bf16x8){lo[0], lo[1], lo[2], lo[3], hi[0], hi[1], hi[2], hi[3]};
            }
#pragma unroll
            for (int mi = 0; mi < 4; ++mi)
#pragma unroll
                for (int ni = 0; ni < 4; ++ni) acc[mi][ni] = MFMA16(bfv[ni], af[mi], acc[mi][ni]);
        }
    }
#pragma unroll
    for (int mi = 0; mi < 4; ++mi) {
        const int t = wm * 64 + mi * 16 + fr;
        const float bias = p.sgu_b[g * 128 + t];
#pragma unroll
        for (int ni = 0; ni < 4; ++ni) {
            const int c = g * 128 + wn * 64 + ni * 16 + fq * 4;
            const f32x4 gn = *(const f32x4*)(p.sgu_v_norm + c);
            const u32x2 uu = *(const u32x2*)(p.proj + (tok0 + t) * ODD_IN + c);
            const float u0 = __uint_as_float(uu.x << 16), u1 = __uint_as_float(uu.x & 0xffff0000u), u2 = __uint_as_float(uu.y << 16), u3 = __uint_as_float(uu.y & 0xffff0000u);
            const f32x4 a = acc[mi][ni];
            u32x2 w; w.x = pack2(u0 * (gn[0] * a[0] + bias), u1 * (gn[1] * a[1] + bias)); w.y = pack2(u2 * (gn[2] * a[2] + bias), u3 * (gn[3] * a[3] + bias));
            *(u32x2*)(p.mixed + (tok0 + t) * DM + c) = w;
        }
    }
}

DI void router_unit(const P& p, char* smem, int layer, int unit) {
    const int tid = opaque_tid() & 255, lane = tid & 63, wid = tid >> 6, r32 = lane & 31, hh = lane >> 5;
    float (*part)[36][32] = (float (*)[36][32])smem;
    float (*wss)[32] = (float (*)[32])(smem + 18432);
    int* lcnt = (int*)(smem + 18432 + 512);
    int* lbase = lcnt + 32;
    int* cnt = p.cnt + layer * NEXP;
    const int tok = unit * 32 + r32, kq = wid * 256 + 8 * hh;
    __syncthreads();
    if (tid < 32) lcnt[tid] = 0;
    const bf16_t* hrow = p.hb + (size_t)tok * DM + kq;
    const bf16_t* whi = p.wr_hi + ((size_t)layer * 96 + r32) * DM + kq;
    const bf16_t* wlo = p.wr_lo + ((size_t)layer * 96 + r32) * DM + kq;
    f32x16 c0, c1, c2;
#pragma unroll
    for (int i = 0; i < 16; ++i) { c0[i] = 0.f; c1[i] = 0.f; c2[i] = 0.f; }
    float ss = 0.f;
#pragma unroll 4
    for (int st = 0; st < 16; ++st) {
        const u32x4 hw = *(const u32x4*)(hrow + 16 * st);
        float f[8]; unpack8(hw, f);
#pragma unroll
        for (int j = 0; j < 8; ++j) ss += f[j] * f[j];
        const bf16x8 hhi = __builtin_bit_cast(bf16x8, hw);
        bf16x8 wh, wl;
        wh = *(const bf16x8*)(whi + 16 * st); wl = *(const bf16x8*)(wlo + 16 * st);
        c0 = MFMA32(wh, hhi, c0); c0 = MFMA32(wl, hhi, c0);
        wh = *(const bf16x8*)(whi + 32 * DM + 16 * st); wl = *(const bf16x8*)(wlo + 32 * DM + 16 * st);
        c1 = MFMA32(wh, hhi, c1); c1 = MFMA32(wl, hhi, c1);
        wh = *(const bf16x8*)(whi + 64 * DM + 16 * st); wl = *(const bf16x8*)(wlo + 64 * DM + 16 * st);
        c2 = MFMA32(wh, hhi, c2); c2 = MFMA32(wl, hhi, c2);
    }
    {
        auto rr = __builtin_amdgcn_permlane32_swap(__float_as_uint(ss), __float_as_uint(ss), false, false);
        ss = __uint_as_float(rr[0]) + __uint_as_float(rr[1]);
        if (hh == 0) {
#pragma unroll
            for (int i = 0; i < 16; ++i) { part[wid][i][r32] = c0[i]; part[wid][16 + i][r32] = c1[i]; }
#pragma unroll
            for (int i = 0; i < 4; ++i) part[wid][32 + i][r32] = c2[i];
            wss[wid][r32] = ss;
        }
    }
    __syncthreads();
    int e1 = 0, e2 = 0, r1 = 0, r2 = 0; float w1 = 0.f, w2 = 0.f, rstd = 0.f;
    const int mytok = unit * 32 + tid;
    if (tid < 32) {
        rstd = rsqrtf((wss[0][tid] + wss[1][tid] + wss[2][tid] + wss[3][tid]) * (1.0f / DM) + EPS);
        float gl[4], ev[8];
#pragma unroll
        for (int j = 0; j < 4; ++j) gl[j] = (part[0][32 + j][tid] + part[1][32 + j][tid] + part[2][32 + j][tid] + part[3][32 + j][tid]) * rstd;
        int gs = 0; float gm = gl[0];
#pragma unroll
        for (int j = 1; j < 4; ++j) if (gl[j] > gm) { gm = gl[j]; gs = j; }
        const float gw = 1.0f / (__expf(gl[0] - gm) + __expf(gl[1] - gm) + __expf(gl[2] - gm) + __expf(gl[3] - gm));
#pragma unroll
        for (int j = 0; j < 8; ++j) { const int s = gs * 8 + j; ev[j] = (part[0][s][tid] + part[1][s][tid] + part[2][s][tid] + part[3][s][tid]) * rstd; }
        int i1 = 0; float v1 = ev[0];
#pragma unroll
        for (int j = 1; j < 8; ++j) if (ev[j] > v1) { v1 = ev[j]; i1 = j; }
        int i2 = -1; float v2 = -3.0e38f;
#pragma unroll
        for (int j = 0; j < 8; ++j) if (j != i1 && ev[j] > v2) { v2 = ev[j]; i2 = j; }
        w1 = 1.0f / (1.0f + __expf(v2 - v1)); w2 = (1.0f - w1) * gw; w1 *= gw;
        e1 = gs * 8 + i1; e2 = gs * 8 + i2;
        r1 = atomicAdd(lcnt + e1, 1); r2 = atomicAdd(lcnt + e2, 1);
    }
    __syncthreads();
    if (tid < 32) { const int n = lcnt[tid]; lbase[tid] = n ? atomicAdd(cnt + tid, n) : 0; }
    __syncthreads();
    if (tid < 32) {
        p.plist[(size_t)e1 * LISTCAP + lbase[e1] + r1] = mytok * 2; p.plist[(size_t)e2 * LISTCAP + lbase[e2] + r2] = mytok * 2 + 1;
        p.pw[mytok * 2] = w1; p.pw[mytok * 2 + 1] = w2; p.rs[mytok] = rstd;
    }
}
DI void ph_combine(const P& p, int layer) {
    const int wave = threadIdx.x >> 6, lane = threadIdx.x & 63;
    for (int u = blockIdx.x; u < NTOK / 16; u += gridDim.x) {
        const size_t tok0 = (size_t)u * 16 + wave * 2;
        u32x2 hv[2][4], ya[2][4], yb[2][4];
#pragma unroll
        for (int r = 0; r < 2; ++r)
#pragma unroll
            for (int i = 0; i < 4; ++i) {
                const int c = i * 256 + lane * 4;
                hv[r][i] = *(const u32x2*)(p.hb + (tok0 + r) * DM + c);
                ya[r][i] = *(const u32x2*)(p.y + ((tok0 + r) * 2) * DM + c); yb[r][i] = *(const u32x2*)(p.y + ((tok0 + r) * 2 + 1) * DM + c);
            }
#pragma unroll
        for (int r = 0; r < 2; ++r) {
            float ss = 0.f;
#pragma unroll
            for (int i = 0; i < 4; ++i) {
                const u32x2 h0 = hv[r][i], a = ya[r][i], b = yb[r][i];
                f32x4 h;
                h[0] = __uint_as_float(h0.x << 16) + __uint_as_float(a.x << 16) + __uint_as_float(b.x << 16);
                h[1] = __uint_as_float(h0.x & 0xffff0000u) + __uint_as_float(a.x & 0xffff0000u) + __uint_as_float(b.x & 0xffff0000u);
                h[2] = __uint_as_float(h0.y << 16) + __uint_as_float(a.y << 16) + __uint_as_float(b.y << 16);
                h[3] = __uint_as_float(h0.y & 0xffff0000u) + __uint_as_float(a.y & 0xffff0000u) + __uint_as_float(b.y & 0xffff0000u);
                ss += h[0] * h[0] + h[1] * h[1] + h[2] * h[2] + h[3] * h[3];
                if (layer == 0) { u32x2 w; w.x = pack2(h[0], h[1]); w.y = pack2(h[2], h[3]); *(u32x2*)(p.hb + (tok0 + r) * DM + i * 256 + lane * 4) = w; }
                else *(f32x4*)(p.out + (tok0 + r) * DM + i * 256 + lane * 4) = h;
            }
            if (layer == 0) { ss = wave_sum(ss); if (lane == 0) p.rsm[tok0 + r] = rsqrtf(ss * (1.0f / DM) + EPS); }
        }
    }
}

DI void ph_mix_even(const P& p, char* smem) {
    const int half = threadIdx.x >> 8;
    const ConvPlan cv = conv_plan<4>(p, 0); int cslot = 0;
    for (int u = blockIdx.x; u < NB * 4 * 32; u += gridDim.x) {
        const int cp = u & 31, hp = (u >> 5) & 3, b = u >> 7;
        band_attn_unit(p, smem + half * HALF_LDS, (b << 8) | ((hp * 2 + half) << 5) | cp, cv, cslot);
    }
    for (; cslot < cv.nslots; ++cslot) { CONV_DECL4(cR); CONV_LOAD4(cR, cslot); CONV_STORE4(cR); }
    pool_items(p);
}
DI void ph_mix_odd(const P& p, char* smem) {
    const int half = threadIdx.x >> 8;
    volatile int* wdone = (volatile int*)(smem + 2 * HALF_LDS);
    const ConvPlan cv = conv_plan<2>(p, 1); int cslot = 0;
    for (int u = blockIdx.x; u < NB * 4 * 32; u += gridDim.x) {
        const int qb = 31 - (u >> 4), hp = (u >> 2) & 3, b = u & 3;
        sb_attn_unit(p, smem + half * HALF_LDS, wdone, (b << 8) | ((hp * 2 + half) << 5) | qb, cv, cslot);
    }
    for (; cslot < cv.nslots; ++cslot) { CONV_DECL2(cR); CONV_LOAD2(cR, cslot); CONV_STORE2(cR); }
    for (int u = blockIdx.x; u < (NTOK / 128) * 2; u += gridDim.x) sgu_unit(p, smem + half * HALF_LDS, u * 2 + half);
}
DI void ph_router(const P& p, char* smem, int layer) {
    const int half = threadIdx.x >> 8;
    for (int u = blockIdx.x; u < NTOK / 64; u += gridDim.x) router_unit(p, smem + half * HALF_LDS, layer, u * 2 + half);
}

constexpr int NPHASE = 13;
#ifndef REPS
#define REPS {1,1,1,1,1,1,1,1,1,1,1,1,1}
#endif
__device__ constexpr int REP[13] = REPS;
__global__ __launch_bounds__(512, 2) void mega(P p, int ph0, int ph1) {
    __shared__ __attribute__((aligned(16))) char smem[SMEM_BYTES + 64 + 16 + 16];
    volatile LDSAS unsigned* xst = (volatile LDSAS unsigned*)(smem + SMEM_BYTES + 64);
    if (threadIdx.x < 4) xst[threadIdx.x] = 0u;
    __syncthreads();
    const XcdBarrier xb = xcd_barrier_post(p.bar, xst);
#define PHASE(i, call) if (ph0 <= (i) && (i) < ph1) { for (int r_ = 0; r_ < REP[i]; ++r_) { call; if (r_ + 1 < REP[i] || (i) + 1 < ph1) xcd_barrier(xb); } }
    PHASE(0, ph_prologue(p, smem))
    PHASE(1, (ph_gemm_dense<EPI_IN_EVEN, 4>(p, smem, p.hb, DM, p.wb_in_even, DM, EVEN_IN, 0, 0, 8)))
    PHASE(2, ph_mix_even(p, smem))
    PHASE(3, (ph_gemm_dense<EPI_OUT, 4>(p, smem, p.mixed, DM, p.wb_out_even, DM, DM, 0, 0, 4)))
    PHASE(4, ph_router(p, smem, 0))
    PHASE(5, ph_moe(p, smem, 0))
    PHASE(6, ph_combine(p, 0))
    PHASE(7, (ph_gemm_dense<EPI_IN_ODD, 4>(p, smem, p.hb, DM, p.wb_in_odd, DM, ODD_IN, 1, 0, 8), ph_gemm_dense<EPI_IN_ODD, 2>(p, smem, p.hb, DM, p.wb_in_odd, DM, ODD_IN, 1, 8, 2)))
    PHASE(8, ph_mix_odd(p, smem))
    PHASE(9, (ph_gemm_dense<EPI_OUT, 4>(p, smem, p.mixed, DM, p.wb_out_odd, DM, DM, 1, 0, 4)))
    PHASE(10, ph_router(p, smem, 1))
    PHASE(11, ph_moe(p, smem, 1))
    PHASE(12, ph_combine(p, 1))
}

extern "C" void kernel_launch(void* const* d_in, const int* in_sizes, int n_in, void* d_out, int out_size, void* d_ws, size_t ws_size, hipStream_t stream) {
    P p{};
    p.x = (const float*)d_in[0]; p.mix_norm_even = (const float*)d_in[1]; p.w_in_even = (const float*)d_in[2]; p.att_q_norm = (const float*)d_in[3];
    p.att_k_norm = (const float*)d_in[4]; p.att_rel_bias = (const float*)d_in[5]; p.pool_w = (const float*)d_in[6]; p.pool_scale = (const float*)d_in[7];
    p.w_out_even = (const float*)d_in[8]; p.mix_norm_odd = (const float*)d_in[9]; p.w_in_odd = (const float*)d_in[10]; p.sgu_v_norm = (const float*)d_in[11];
    p.sgu_w = (const float*)d_in[12]; p.sgu_b = (const float*)d_in[13]; p.w_out_odd = (const float*)d_in[14]; p.ffn_norm = (const float*)d_in[15];
    p.w_rg = (const float*)d_in[16]; p.w_re = (const float*)d_in[17]; p.w_gate = (const float*)d_in[18]; p.w_up = (const float*)d_in[19]; p.w_down = (const float*)d_in[20];
    p.out = (float*)d_out;
    char* ws = (char*)d_ws; size_t off = 0;
    auto take = [&](size_t bytes) { char* r = ws + off; off += (bytes + 255) & ~(size_t)255; return r; };
    p.wb_in_even = (bf16_t*)take((size_t)EVEN_IN * DM * 2);
    p.wb_out_even = (bf16_t*)take((size_t)DM * DM * 2);
    p.wb_in_odd = (bf16_t*)take((size_t)ODD_IN * DM * 2);
    p.wb_out_odd = (bf16_t*)take((size_t)DM * DM * 2);
    p.wb_gate = (bf16_t*)take((size_t)2 * NEXP * DM * FF * 2);
    p.wb_up = (bf16_t*)take((size_t)2 * NEXP * DM * FF * 2);
    p.wb_down = (bf16_t*)take((size_t)2 * NEXP * DM * FF * 2);
    p.wr_hi = (bf16_t*)take((size_t)2 * 96 * DM * 2);
    p.wr_lo = (bf16_t*)take((size_t)2 * 96 * DM * 2);
    p.hb = (bf16_t*)take((size_t)NTOK * DM * 2);
    p.proj = (bf16_t*)take((size_t)NTOK * ODD_IN * 2);
    p.y = p.proj;
    p.mixed = (bf16_t*)take((size_t)NTOK * DM * 2);
    p.hid = p.mixed;
    p.pw = (float*)take((size_t)NTOK * 2 * 4);
    p.rs = (float*)take((size_t)NTOK * 4);
    p.rsm = (float*)take((size_t)NTOK * 4);
    p.vss = (float*)take((size_t)NTOK * 4);
    p.plist = (int*)take((size_t)NEXP * LISTCAP * 4);
    p.cnt = (int*)take(256);
    p.ones = (const float*)take(256);
    p.dump = (bf16_t*)take((size_t)512 * 512 * 32);
    p.gdone = (int*)take(640 * 4);
    p.bar = (unsigned*)take(XCD_BAR_WORDS * 4);
    (void)hipMemsetAsync(p.bar, 0, XCD_BAR_WORDS * 4, stream);
    for (int l = 0; l < 2; ++l) {
        const size_t o = (size_t)l * NEXP * DM * FF;
        p.cs[l * 5 + 0] = p.w_gate + o; p.cd[l * 5 + 0] = p.wb_gate + o;
        p.cs[l * 5 + 1] = p.w_up + o;   p.cd[l * 5 + 1] = p.wb_up + o;
        p.cs[l * 5 + 2] = p.w_down + o; p.cd[l * 5 + 2] = p.wb_down + o;
        p.cs[l * 5 + 3] = p.w_in_odd;   p.cd[l * 5 + 3] = p.wb_in_odd;
        p.cs[l * 5 + 4] = p.w_out_odd;  p.cd[l * 5 + 4] = p.wb_out_odd;
    }

    static int grid_blocks = 0;
    if (!grid_blocks) {
        int dev = 0, cus = 0, per_cu = 0;
        (void)hipGetDevice(&dev);
        (void)hipDeviceGetAttribute(&cus, hipDeviceAttributeMultiprocessorCount, dev);
        (void)hipOccupancyMaxActiveBlocksPerMultiprocessor(&per_cu, mega, 512, 0);
        if (per_cu < 1) per_cu = 1;
        grid_blocks = cus;
    }
    int ph0 = 0, ph1 = NPHASE;
    void* args[] = {&p, &ph0, &ph1};
    hipError_t e = hipLaunchCooperativeKernel((void*)mega, dim3(grid_blocks), dim3(512), args, 0, stream);
    if (e != hipSuccess) fprintf(stderr, "cooperative launch failed: %s (grid %d)\n", hipGetErrorString(e), grid_blocks);
}
```

```cpp
#include <hip/hip_runtime.h>
#include <hip/hip_cooperative_groups.h>
#include <stdint.h>
#include <stdio.h>

typedef unsigned short bf16_t;
typedef short bf16x8 __attribute__((ext_vector_type(8)));
typedef short s16x4 __attribute__((ext_vector_type(4)));
typedef float f32x2 __attribute__((ext_vector_type(2)));
typedef float f32x4 __attribute__((ext_vector_type(4)));
typedef float f32x16 __attribute__((ext_vector_type(16)));
typedef unsigned u32x4 __attribute__((ext_vector_type(4)));
typedef unsigned u32x2 __attribute__((ext_vector_type(2)));
typedef __bf16 bf16x2n __attribute__((ext_vector_type(2)));

#define DI __device__ __forceinline__
#define LDSAS __attribute__((address_space(3)))
#define MFMA32(a, b, c) __builtin_amdgcn_mfma_f32_32x32x16_bf16((a), (b), (c), 0, 0, 0)
#define MFMA16(a, b, c) __builtin_amdgcn_mfma_f32_16x16x32_bf16((a), (b), (c), 0, 0, 0)

constexpr int NB = 4, NS = 4096, NTOK = NB * NS, DM = 1024;
constexpr int EVEN_IN = 2048, ODD_IN = 2560;
constexpr int NEXP = 32, FF = 256;
constexpr int LISTCAP = NTOK;
constexpr float EPS = 1e-6f;
constexpr float LOG2E = 1.4426950408889634f;
constexpr float QSCALE = 0.125f * LOG2E;

DI int opaque_tid() { int t = threadIdx.x; asm volatile("" : "+v"(t)); return t; }
DI float bf2f(bf16_t b) { return __uint_as_float(((unsigned)b) << 16); }
DI unsigned pack2(float lo, float hi) { f32x2 v = {lo, hi}; bf16x2n r = __builtin_convertvector(v, bf16x2n); return __builtin_bit_cast(unsigned, r); }
DI float wave_sum(float v) { for (int o = 32; o > 0; o >>= 1) v += __shfl_xor(v, o); return v; }
DI float gelu_exact(float x) { return 0.5f * x * (1.0f + erff(x * 0.70710678118654752f)); }
DI s16x4 tr_read(const char* p) { return __builtin_bit_cast(s16x4, __builtin_amdgcn_ds_read_tr16_b64_v4i16((LDSAS s16x4*)p)); }
DI void unpack8(const u32x4 v, float* f) {
    f[0] = __uint_as_float(v.x << 16); f[1] = __uint_as_float(v.x & 0xffff0000u); f[2] = __uint_as_float(v.y << 16); f[3] = __uint_as_float(v.y & 0xffff0000u);
    f[4] = __uint_as_float(v.z << 16); f[5] = __uint_as_float(v.z & 0xffff0000u); f[6] = __uint_as_float(v.w << 16); f[7] = __uint_as_float(v.w & 0xffff0000u);
}
DI int kswz(int k) { return (k & 3) | ((k >> 1) & 4); }

struct P {
    const float *x, *mix_norm_even, *w_in_even, *att_q_norm, *att_k_norm, *att_rel_bias, *pool_w, *pool_scale, *w_out_even;
    const float *mix_norm_odd, *w_in_odd, *sgu_v_norm, *sgu_w, *sgu_b, *w_out_odd, *ffn_norm, *w_rg, *w_re, *w_gate, *w_up, *w_down;
    float* out;
    bf16_t *wb_in_even, *wb_out_even, *wb_in_odd, *wb_out_odd, *wb_gate, *wb_up, *wb_down, *wr_hi, *wr_lo;
    bf16_t *hb, *proj, *mixed, *hid, *y;
    float *pw, *rs, *rsm, *vss; int* plist; int* cnt; unsigned* bar; int* gdone;
    const float* cs[10]; bf16_t* cd[10]; const float* ones; bf16_t* dump;
};

enum { EPI_IN_EVEN = 0, EPI_IN_ODD = 1, EPI_OUT = 2, EPI_GU = 3, EPI_DOWN = 4 };
constexpr int G_ROWID = 131072;
constexpr int SMEM_BYTES = 131072 + 1024;
constexpr int HALF_LDS = 66048;

struct GemmArgs {
    const bf16_t* A; int lda; const int* gather; int mvalid; int gshift;
    const bf16_t* B0; const bf16_t* B1; int ldb; int gu;
    int K, m0, n0;
    bool rowid_ready;
};

DI f32x2 gelu_pk(f32x2 v) {
    const f32x2 av = __builtin_elementwise_abs(v), d = av * 0.2316418882f + 1.0f;
    f32x2 t; t.x = __builtin_amdgcn_rcpf(d.x); t.y = __builtin_amdgcn_rcpf(d.y);
    f32x2 q = t * 0.5307027145f + (-0.7265760135f); q = q * t + 0.7107068705f; q = q * t + (-0.142248368f); q = q * t + 0.127414796f; q = q * t;
    const f32x2 s = (v * v) * (-0.72134752044f);
    f32x2 e; e.x = __builtin_amdgcn_exp2f(s.x); e.y = __builtin_amdgcn_exp2f(s.y);
    const f32x2 m = v * (q * e), r = v - m;
    f32x2 o; o.x = v.x < 0.f ? m.x : r.x; o.y = v.y < 0.f ? m.y : r.y; return o;
}

DI void glds16(const void* gsrc, unsigned lds_dst) {
    unsigned keep;
    asm volatile("s_mov_b32 %0, m0\n\ts_mov_b32 m0, %2\n\ts_nop 0\n\tglobal_load_lds_dwordx4 %1, off\n\ts_mov_b32 m0, %0" : "=&s"(keep) : "v"(gsrc), "s"(lds_dst) : "memory");
}
DI void glds16_sc1(const void* gsrc, unsigned lds_dst) {
    unsigned keep;
    asm volatile("s_mov_b32 %0, m0\n\ts_mov_b32 m0, %2\n\ts_nop 0\n\tglobal_load_lds_dwordx4 %1, off sc1\n\ts_mov_b32 m0, %0" : "=&s"(keep) : "v"(gsrc), "s"(lds_dst) : "memory");
}
DI void st16_sc1(void* q, u32x4 v) { asm volatile("global_store_dwordx4 %0, %1, off sc1\n\ts_nop 1" :: "v"(q), "v"(v) : "memory"); }
template <int EPI, int MT>
DI void gemm_tile(const P& p, char* smem, const GemmArgs& g, int layer) {
    const int tid = opaque_tid(), lane = tid & 63, wid = tid >> 6, wm = wid >> 2, wn = wid & 3, r32 = lane & 31, hh = lane >> 5;
    int* rowid = (int*)(smem + G_ROWID);
    constexpr int NA = MT / 2;
    constexpr int IPT = NA + 2;
    const bf16_t* ap[NA]; const bf16_t* bp[2];
    if (g.gather && !g.rowid_ready) { if (tid < 64 * MT) rowid[tid] = (tid < g.mvalid) ? g.gather[tid] : -1; __syncthreads(); }
#pragma unroll
    for (int i = 0; i < NA; ++i) {
        const int r = (wid * NA + i) * 16 + (lane >> 2), kc = (lane & 3) ^ ((r >> 2) & 3);
        size_t arow;
        if (g.gather) { int id = rowid[r]; if (id < 0) id = rowid[0]; arow = (size_t)(id >> g.gshift); } else arow = (size_t)(g.m0 + r);
        ap[i] = g.A + arow * g.lda + kc * 8;
    }
#pragma unroll
    for (int i = 0; i < 2; ++i) {
        const int k = (wid * 2 + i) * 2 + (lane >> 5), sl = lane & 31, ch = (((sl >> 2) ^ (k & 7)) << 2) | (sl & 3);
        const bf16_t* bcol = g.gu ? ((((ch >> 2) & 1) ? g.B1 : g.B0) + (g.n0 >> 1) + (ch >> 3) * 32 + (ch & 3) * 8) : (g.B0 + g.n0 + ch * 8);
        bp[i] = bcol + (size_t)k * g.ldb;
    }
    const size_t bstep = (size_t)32 * g.ldb;
    float gu_w[MT], gu_rs[MT];
    if (EPI == EPI_GU) {
#pragma unroll
        for (int mt = 0; mt < MT; ++mt) { const int id = rowid[wm * 32 * MT + mt * 32 + r32]; gu_w[mt] = id >= 0 ? p.pw[id] : 0.f; gu_rs[mt] = id >= 0 ? p.rs[id >> 1] : 0.f; }
    } else if (EPI == EPI_IN_EVEN || EPI == EPI_IN_ODD) {
#pragma unroll
        for (int mt = 0; mt < MT; ++mt) gu_rs[mt] = p.rsm[g.m0 + wm * 32 * MT + mt * 32 + r32];
    }
    f32x16 acc[MT][2];
#pragma unroll
    for (int a = 0; a < MT; ++a)
#pragma unroll
        for (int b = 0; b < 2; ++b)
#pragma unroll
            for (int i = 0; i < 16; ++i) acc[a][b][i] = 0.f;
    const int nk = g.K / 32;
    const int arow0 = wm * 32 * MT + r32;
    const int asw = (r32 >> 2) & 3;
    const int g1 = (lane >> 4) & 1, qq = (lane & 15) >> 2, pp = lane & 3;
    const int bk0 = 8 * hh + qq;
    const unsigned ldsb = (unsigned)(size_t)(LDSAS char*)smem;
    const unsigned adst = (unsigned)__builtin_amdgcn_readfirstlane(ldsb + (wid * NA) * 1024), bdst = (unsigned)__builtin_amdgcn_readfirstlane(ldsb + 16384 + (wid * 2) * 1024);
#define G_LOAD(KT) do { const unsigned so_ = (unsigned)((KT) & 3) * 32768u; \
        _Pragma("unroll") for (int i = 0; i < NA; ++i) { if (EPI == EPI_DOWN) glds16_sc1(ap[i] + (KT) * 32, adst + so_ + i * 1024); \
                                                        else glds16(ap[i] + (KT) * 32, adst + so_ + i * 1024); } \
        _Pragma("unroll") for (int i = 0; i < 2; ++i) glds16(bp[i] + (size_t)(KT) * bstep, bdst + so_ + i * 1024); } while (0)
#define G_COMPUTE(KT) do { const char* Ac = smem + ((KT) & 3) * 32768; const char* Bc = Ac + 16384; \
        _Pragma("unroll") for (int st = 0; st < 2; ++st) { bf16x8 af[MT], bfv[2]; \
            _Pragma("unroll") for (int mt = 0; mt < MT; ++mt) af[mt] = *(const bf16x8*)(Ac + (arow0 + mt * 32) * 64 + (((2 * st + hh) ^ asw) << 4)); \
            _Pragma("unroll") for (int nt = 0; nt < 2; ++nt) { const int k = 16 * st + bk0; \
                const char* b0_ = Bc + k * 512 + (((wn * 2 + nt) ^ (k & 7)) << 6) + g1 * 32 + pp * 8; \
                const char* b1_ = Bc + (k + 4) * 512 + (((wn * 2 + nt) ^ ((k + 4) & 7)) << 6) + g1 * 32 + pp * 8; \
                const s16x4 lo = tr_read(b0_), hi = tr_read(b1_); \
                bfv[nt] = (bf16x8){lo[0], lo[1], lo[2], lo[3], hi[0], hi[1], hi[2], hi[3]}; } \
            _Pragma("unroll") for (int mt = 0; mt < MT; ++mt) _Pragma("unroll") for (int nt = 0; nt < 2; ++nt) acc[mt][nt] = MFMA32(bfv[nt], af[mt], acc[mt][nt]); } } while (0)
#define G_WAIT(N) do { if ((N) == 2) { if (IPT == 4) asm volatile("s_waitcnt vmcnt(8)" ::: "memory"); else asm volatile("s_waitcnt vmcnt(6)" ::: "memory"); } \
                       else if ((N) == 1) { if (IPT == 4) asm volatile("s_waitcnt vmcnt(4)" ::: "memory"); else asm volatile("s_waitcnt vmcnt(3)" ::: "memory"); } \
                       else asm volatile("s_waitcnt vmcnt(0)" ::: "memory"); } while (0)
    G_LOAD(0); G_LOAD(1); G_LOAD(2);
    G_WAIT(2); __syncthreads();
#pragma nounroll
    for (int kt = 0; kt < nk; ++kt) {
        if (kt + 3 < nk) G_LOAD(kt + 3);
        G_COMPUTE(kt);
        if (kt + 3 < nk) G_WAIT(2); else if (kt + 2 < nk) G_WAIT(1); else G_WAIT(0);
        __syncthreads();
    }
#undef G_LOAD
#undef G_COMPUTE
#undef G_WAIT
    const int colw = g.n0 + wn * 64;
    char* wsl = smem + wid * 16384;
    const int rowb = wm * 32 * MT;
    if (EPI == EPI_IN_EVEN || EPI == EPI_IN_ODD || EPI == EPI_DOWN) {
        const int region = colw >> 9;
        const float* gn = region == 0 ? p.att_q_norm : p.att_k_norm;
        const bool act = colw < 1024;
        const float qs = (colw >= 1024 && colw < 1536) ? QSCALE : 1.0f;
#pragma unroll
        for (int mt = 0; mt < MT; ++mt) {
            float sc = 1.f;
            if (EPI == EPI_IN_EVEN || EPI == EPI_IN_ODD) {
                const float rr_ = gu_rs[mt];
#pragma unroll
                for (int nt = 0; nt < 2; ++nt) acc[mt][nt] = acc[mt][nt] * rr_;
            }
            if (EPI == EPI_IN_EVEN && region < 2) {
                float ss = 0.f;
#pragma unroll
                for (int nt = 0; nt < 2; ++nt)
#pragma unroll
                    for (int i = 0; i < 16; ++i) ss += acc[mt][nt][i] * acc[mt][nt][i];
                auto rr = __builtin_amdgcn_permlane32_swap(__float_as_uint(ss), __float_as_uint(ss), false, false);
                ss = __uint_as_float(rr[0]) + __uint_as_float(rr[1]);
                sc = rsqrtf(ss * (1.0f / 64.0f) + EPS) * (region == 0 ? QSCALE : 1.0f);
            }
            float vsum = 0.f;
#pragma unroll
            for (int nt = 0; nt < 2; ++nt)
#pragma unroll
                for (int gq = 0; gq < 4; ++gq) {
                    f32x2 v0 = {acc[mt][nt][4 * gq], acc[mt][nt][4 * gq + 1]}, v1 = {acc[mt][nt][4 * gq + 2], acc[mt][nt][4 * gq + 3]};
                    if (EPI == EPI_IN_EVEN) { if (region < 2) { const f32x4 gg = *(const f32x4*)(gn + nt * 32 + 8 * gq + 4 * hh); v0.x *= sc * gg[0]; v0.y *= sc * gg[1]; v1.x *= sc * gg[2]; v1.y *= sc * gg[3]; } }
                    else if (EPI == EPI_IN_ODD) { if (act) { v0 = gelu_pk(v0); v1 = gelu_pk(v1); vsum += v0.x * v0.x + v0.y * v0.y + v1.x * v1.x + v1.y * v1.y; } else { v0 = v0 * qs; v1 = v1 * qs; } }
                    u32x2 w; w.x = pack2(v0.x, v0.y); w.y = pack2(v1.x, v1.y);
                    *(u32x2*)(wsl + r32 * 128 + (((nt * 4 + gq) ^ (r32 & 7)) << 4) + hh * 8) = w;
                }
            if (EPI == EPI_IN_ODD && colw >= 512 && colw < 1024) {
                auto rr = __builtin_amdgcn_permlane32_swap(__float_as_uint(vsum), __float_as_uint(vsum), false, false);
                vsum = __uint_as_float(rr[0]) + __uint_as_float(rr[1]);
                if (hh == 0) atomicAdd(p.vss + g.m0 + rowb + mt * 32 + r32, vsum);
            }
#pragma unroll
            for (int ps = 0; ps < 4; ++ps) {
                const int row = ps * 8 + (lane >> 3), chunk = lane & 7;
                const u32x4 v = *(const u32x4*)(wsl + row * 128 + ((chunk ^ (row & 7)) << 4));
                const int trow = rowb + mt * 32 + row;
                if (EPI == EPI_DOWN) { const int id = rowid[trow]; if (id >= 0) *(u32x4*)(p.y + (size_t)id * DM + colw + chunk * 8) = v; }
                else if (EPI == EPI_IN_EVEN) *(u32x4*)(p.proj + (size_t)(g.m0 + trow) * EVEN_IN + colw + chunk * 8) = v;
                else *(u32x4*)(p.proj + (size_t)(g.m0 + trow) * ODD_IN + colw + chunk * 8) = v;
            }
        }
    } else if (EPI == EPI_OUT) {
#pragma unroll
        for (int mt = 0; mt < MT; ++mt) {
            f32x4 rx[8]; u32x2 rh[8];
#pragma unroll
            for (int ps = 0; ps < 8; ++ps) {
                const size_t off = (size_t)(g.m0 + rowb + mt * 32 + ps * 4 + (lane >> 4)) * DM + colw + (lane & 15) * 4;
                if (layer == 0) rx[ps] = *(const f32x4*)(p.x + off); else rh[ps] = *(const u32x2*)(p.hb + off);
            }
#pragma unroll
            for (int nt = 0; nt < 2; ++nt)
#pragma unroll
                for (int gq = 0; gq < 4; ++gq) {
                    const f32x4 v = {acc[mt][nt][4 * gq], acc[mt][nt][4 * gq + 1], acc[mt][nt][4 * gq + 2], acc[mt][nt][4 * gq + 3]};
                    *(f32x4*)(wsl + r32 * 256 + (((nt * 8 + 2 * gq + hh) ^ (r32 & 15)) << 4)) = v;
                }
#pragma unroll
            for (int ps = 0; ps < 8; ++ps) {
                const int row = ps * 4 + (lane >> 4), chunk = lane & 15;
                const f32x4 v = *(const f32x4*)(wsl + row * 256 + ((chunk ^ (row & 15)) << 4));
                const size_t off = (size_t)(g.m0 + rowb + mt * 32 + row) * DM + colw + chunk * 4;
                f32x4 r;
                if (layer == 0) r = rx[ps];
                else r = (f32x4){__uint_as_float(rh[ps].x << 16), __uint_as_float(rh[ps].x & 0xffff0000u), __uint_as_float(rh[ps].y << 16), __uint_as_float(rh[ps].y & 0xffff0000u)};
                r = r + v;
                u32x2 w; w.x = pack2(r[0], r[1]); w.y = pack2(r[2], r[3]);
                *(u32x2*)(p.hb + off) = w;
            }
        }
    } else if (EPI == EPI_GU) {
        const int f0 = (g.n0 >> 1) + wn * 32;
#pragma unroll
        for (int mt = 0; mt < MT; ++mt) {
            const float w = gu_w[mt], rs = gu_rs[mt];
#pragma unroll
            for (int gq = 0; gq < 4; ++gq) {
                float h[4];
#pragma unroll
                for (int j = 0; j < 4; ++j) { const float gt = acc[mt][0][4 * gq + j] * rs, up = acc[mt][1][4 * gq + j] * (rs * w);
                    h[j] = gt * __builtin_amdgcn_rcpf(1.0f + __builtin_amdgcn_exp2f(-LOG2E * gt)) * up; }
                u32x2 ww; ww.x = pack2(h[0], h[1]); ww.y = pack2(h[2], h[3]);
                *(u32x2*)(wsl + r32 * 64 + ((gq ^ (r32 & 3)) << 4) + hh * 8) = ww;
            }
#pragma unroll
            for (int ps = 0; ps < 2; ++ps) {
                const int row = ps * 16 + (lane >> 2), chunk = lane & 3;
                const u32x4 v = *(const u32x4*)(wsl + row * 64 + ((chunk ^ (row & 3)) << 4));
                const int id2 = rowid[rowb + mt * 32 + row];
                if (id2 >= 0) st16_sc1(p.hid + (size_t)id2 * FF + f0 + chunk * 8, v);
            }
        }
        asm volatile("s_waitcnt vmcnt(0)" ::: "memory");
    }
    __syncthreads();
}

template <int EPI, int MT>
DI void ph_gemm_dense(const P& p, char* smem, const bf16_t* A, int lda, const bf16_t* B, int K, int N, int layer, int nt0, int ntc) {
    const int ntm = NTOK / (64 * MT), per_xcd = (ntm / 8) * ntc;
    const bool xcd = (gridDim.x & 7) == 0;
    const int x = blockIdx.x & 7, gx = gridDim.x >> 3;
    const int jend = xcd ? per_xcd : ntm * ntc, jstep = xcd ? gx : (int)gridDim.x;
    for (int j = xcd ? (int)(blockIdx.x >> 3) : (int)blockIdx.x; j < jend; j += jstep) {
        GemmArgs g; g.A = A; g.lda = lda; g.gather = nullptr; g.mvalid = 64 * MT; g.gshift = 0; g.rowid_ready = false; g.B0 = B; g.B1 = B; g.ldb = N; g.gu = 0; g.K = K;
        const int rot = ((j / jstep) & 1) * (ntc >> 1);
        g.m0 = ((xcd ? x * (ntm / 8) : 0) + j / ntc) * (64 * MT); g.n0 = (nt0 + (j % ntc + rot) % ntc) * 256;
        gemm_tile<EPI, MT>(p, smem, g, layer);
    }
}

DI void moe_locate(const int* cnt, int mt, int& e, int& c, int& mtl) {
    e = 0; c = 0;
    for (; e < NEXP; ++e) { c = cnt[e]; const int t = (c + 127) >> 7; if (mt < t) break; mt -= t; }
    mtl = mt;
}
DI void ph_moe(const P& p, char* smem, int layer) {
    const int* cnt = p.cnt + layer * NEXP;
    int* gdone = p.gdone + layer * 320;
    int* queue = p.gdone + 600 + layer;
    volatile int* s_next = (volatile int*)(smem + SMEM_BYTES + 80);
    int total = 0;
    for (int e = 0; e < NEXP; ++e) total += (cnt[e] + 127) >> 7;
    const int ngu = total * 2, nall = total * 6;
    int mine = 0;
    if (threadIdx.x == 0) mine = __hip_atomic_fetch_add(queue, 1, __ATOMIC_RELAXED, __HIP_MEMORY_SCOPE_AGENT);
    for (;;) {
        if (threadIdx.x == 0) s_next[0] = mine;
        __syncthreads();
        const int u = s_next[0];
        if (u >= nall) break;
        if (threadIdx.x == 0) mine = __hip_atomic_fetch_add(queue, 1, __ATOMIC_RELAXED, __HIP_MEMORY_SCOPE_AGENT);
        if (u < ngu) {
            int e, c, mt; moe_locate(cnt, u >> 1, e, c, mt);
            GemmArgs g; g.gather = p.plist + (size_t)e * LISTCAP + mt * 128; g.mvalid = c - mt * 128 < 128 ? c - mt * 128 : 128;
            g.m0 = 0; g.n0 = (u & 1) * 256;
            const size_t ex = (size_t)(layer * NEXP + e);
            g.rowid_ready = false; g.A = p.hb; g.lda = DM; g.gshift = 1; g.B0 = p.wb_gate + ex * DM * FF; g.B1 = p.wb_up + ex * DM * FF; g.ldb = FF; g.gu = 1; g.K = DM;
            gemm_tile<EPI_GU, 2>(p, smem, g, layer);
            if (threadIdx.x == 0) __hip_atomic_fetch_add(gdone + (u >> 1), 1, __ATOMIC_RELAXED, __HIP_MEMORY_SCOPE_AGENT);
        } else {
            const int v = u - ngu;
            int e, c, mt; moe_locate(cnt, v >> 2, e, c, mt);
            GemmArgs g; g.gather = p.plist + (size_t)e * LISTCAP + mt * 128; g.mvalid = c - mt * 128 < 128 ? c - mt * 128 : 128;
            {
                int* rowid = (int*)(smem + G_ROWID);
                const int rid = (threadIdx.x < 128 && (int)threadIdx.x < g.mvalid) ? g.gather[threadIdx.x] : -1;
                if (threadIdx.x == 0) { unsigned sp = 0;
                    while (__hip_atomic_load(gdone + (v >> 2), __ATOMIC_RELAXED, __HIP_MEMORY_SCOPE_AGENT) < 2) { __builtin_amdgcn_s_sleep(2); if (++sp > (1u << 22)) break; } }
                if (threadIdx.x < 128) rowid[threadIdx.x] = rid;
                __syncthreads();
            }
            g.m0 = 0; g.n0 = (v & 3) * 256;
            const size_t ex = (size_t)(layer * NEXP + e);
            g.rowid_ready = true; g.A = p.hid; g.lda = FF; g.gshift = 0; g.B0 = p.wb_down + ex * FF * DM; g.B1 = g.B0; g.ldb = DM; g.gu = 0; g.K = FF;
            gemm_tile<EPI_DOWN, 2>(p, smem, g, layer);
        }
    }
}

DI void convert_flat(const float* __restrict__ src, bf16_t* __restrict__ dst, size_t n8, const float* __restrict__ gain = nullptr, int rowlen = 1) {
    for (size_t i = (size_t)blockIdx.x * 512 + threadIdx.x; i < n8; i += (size_t)gridDim.x * 512) {
        f32x4 a = *(const f32x4*)(src + i * 8), b = *(const f32x4*)(src + i * 8 + 4);
        if (gain) { const float gk = gain[(i * 8) / (size_t)rowlen]; a = a * gk; b = b * gk; }
        u32x4 w; w.x = pack2(a[0], a[1]); w.y = pack2(a[2], a[3]); w.z = pack2(b[0], b[1]); w.w = pack2(b[2], b[3]);
        *(u32x4*)(dst + i * 8) = w;
    }
}
DI void poolfold_unit(const P& p, char* smem, int unit) {
    float (*At)[32] = (float (*)[32])smem;
    float (*Bs)[64] = (float (*)[64])(smem + 16384);
    const int tid = opaque_tid() & 255, g = unit >> 6, c0 = ((unit >> 4) & 3) * 32, n0 = (unit & 15) * 64;
    __syncthreads();
    for (int i = 0; i < 16; ++i) { const int idx = tid + 256 * i, d = idx >> 5, c = idx & 31;
        At[d][c] = p.pool_w[(size_t)(g * 128 + c0 + c) * 128 + d] * p.pool_scale[g * 128 + d]; }
    for (int i = 0; i < 8; ++i) { const int idx = tid + 256 * i, d = idx >> 4, n4 = (idx & 15) * 4;
        *(f32x4*)&Bs[d][n4] = *(const f32x4*)(p.w_out_even + (size_t)(512 + g * 128 + d) * DM + n0 + n4); }
    __syncthreads();
    const int tc = (tid >> 4) * 2, tn = (tid & 15) * 4;
    f32x4 acc[2] = {(f32x4){0.f, 0.f, 0.f, 0.f}, (f32x4){0.f, 0.f, 0.f, 0.f}};
#pragma unroll 8
    for (int d = 0; d < 128; ++d) {
        const f32x2 a = *(const f32x2*)&At[d][tc]; const f32x4 b = *(const f32x4*)&Bs[d][tn];
        acc[0] += a.x * b; acc[1] += a.y * b;
    }
#pragma unroll
    for (int i = 0; i < 2; ++i) { u32x2 w; w.x = pack2(acc[i][0], acc[i][1]); w.y = pack2(acc[i][2], acc[i][3]);
        *(u32x2*)(p.wb_out_even + (size_t)(512 + g * 128 + c0 + tc + i) * DM + n0 + tn) = w; }
}
DI void cast_rows2(const P& p, int tok, int lane) {
    f32x4 v[2][4];
#pragma unroll
    for (int r = 0; r < 2; ++r)
#pragma unroll
        for (int i = 0; i < 4; ++i) v[r][i] = *(const f32x4*)(p.x + (size_t)(tok + r) * DM + i * 256 + lane * 4);
#pragma unroll
    for (int r = 0; r < 2; ++r) {
        float ss = 0.f;
#pragma unroll
        for (int i = 0; i < 4; ++i) { ss += v[r][i][0] * v[r][i][0] + v[r][i][1] * v[r][i][1] + v[r][i][2] * v[r][i][2] + v[r][i][3] * v[r][i][3];
            u32x2 w; w.x = pack2(v[r][i][0], v[r][i][1]); w.y = pack2(v[r][i][2], v[r][i][3]);
            *(u32x2*)(p.hb + (size_t)(tok + r) * DM + i * 256 + lane * 4) = w; }
        ss = wave_sum(ss);
        if (lane == 0) p.rsm[tok + r] = rsqrtf(ss * (1.0f / DM) + EPS);
    }
}
DI void ph_prologue(const P& p, char* smem) {
    if (blockIdx.x == 0 && threadIdx.x < 64) p.cnt[threadIdx.x] = 0;
    if (blockIdx.x == 2 && threadIdx.x == 0) ((float*)p.ones)[0] = 1.0f;
    if (blockIdx.x == 1) for (int i = threadIdx.x; i < 640; i += 512) p.gdone[i] = 0;
    for (int i = blockIdx.x * 512 + threadIdx.x; i < NTOK; i += gridDim.x * 512) p.vss[i] = 0.f;
    for (int u = blockIdx.x; u < 128; u += gridDim.x) poolfold_unit(p, smem + (threadIdx.x >> 8) * HALF_LDS, u * 2 + (threadIdx.x >> 8));
    for (int i = blockIdx.x * 512 + threadIdx.x; i < 2 * 96 * DM; i += gridDim.x * 512) {
        const int k = i & (DM - 1), R = (i >> 10) % 96, layer = i / (96 * DM);
        const int T = R >> 5, r = R & 31, L = 16 * T + (r & 3) + 4 * (r >> 3);
        float w = 0.f;
        if (L < 32) w = p.w_re[((size_t)layer * DM + k) * 32 + L]; else if (L < 36) w = p.w_rg[((size_t)layer * DM + k) * 4 + (L - 32)];
        w *= p.ffn_norm[layer * DM + k];
        const unsigned hi = pack2(w, 0.f) & 0xffffu;
        p.wr_hi[i] = (bf16_t)hi; p.wr_lo[i] = (bf16_t)(pack2(w - __uint_as_float(hi << 16), 0.f) & 0xffffu);
    }
    const int wave = threadIdx.x >> 6, lane = threadIdx.x & 63;
    for (int u = blockIdx.x; u < NTOK / 16; u += gridDim.x) {
        const int tok = u * 16 + wave * 2;
        cast_rows2(p, tok, lane);
    }
    convert_flat(p.w_in_even, p.wb_in_even, (size_t)DM * EVEN_IN / 8, p.mix_norm_even, EVEN_IN);
    convert_flat(p.w_out_even, p.wb_out_even, (size_t)512 * DM / 8);
}
DI void convert_experts(const P& p, int layer) {
    const size_t o = (size_t)layer * NEXP * DM * FF;
    convert_flat(p.w_gate + o, p.wb_gate + o, (size_t)NEXP * DM * FF / 8);
    convert_flat(p.w_up + o, p.wb_up + o, (size_t)NEXP * DM * FF / 8);
    convert_flat(p.w_down + o, p.wb_down + o, (size_t)NEXP * DM * FF / 8);
}

DI int crow(int i, int h) { return (i & 3) + 8 * (i >> 2) + 4 * h; }
DI float swap_max(float v) { auto rr = __builtin_amdgcn_permlane32_swap(__float_as_uint(v), __float_as_uint(v), false, false); return fmaxf(__uint_as_float(rr[0]), __uint_as_float(rr[1])); }
DI float swap_sum(float v) { auto rr = __builtin_amdgcn_permlane32_swap(__float_as_uint(v), __float_as_uint(v), false, false); return __uint_as_float(rr[0]) + __uint_as_float(rr[1]); }
DI float bcast_lo(float v) { auto rr = __builtin_amdgcn_permlane32_swap(__float_as_uint(v), __float_as_uint(v), false, false); return __uint_as_float(rr[0]); }
DI bf16x8 pack8(const f32x16& x, int s) {
    u32x4 w; w.x = pack2(x[8 * s], x[8 * s + 1]); w.y = pack2(x[8 * s + 2], x[8 * s + 3]); w.z = pack2(x[8 * s + 4], x[8 * s + 5]); w.w = pack2(x[8 * s + 6], x[8 * s + 7]);
    return __builtin_bit_cast(bf16x8, w);
}
constexpr int KV_TILE = 8192;
struct KVStage { u32x4 k[2], v[2]; };
DI void kv_load(KVStage& st, const bf16_t* kbase, const bf16_t* vbase, int ld, int key0) {
    const int tid = opaque_tid() & 255, c = tid & 7, r0 = tid >> 3;
#pragma unroll
    for (int i = 0; i < 2; ++i) { const size_t off = (size_t)(key0 + r0 + 32 * i) * ld + c * 8; st.k[i] = *(const u32x4*)(kbase + off); st.v[i] = *(const u32x4*)(vbase + off); }
}
DI void kv_store(const KVStage& st, char* kt, char* vt) {
    const int tid = opaque_tid() & 255, c = tid & 7, r0 = tid >> 3;
#pragma unroll
    for (int i = 0; i < 2; ++i) { const int r = r0 + 32 * i;
        *(u32x4*)(kt + r * 128 + ((c ^ ((r >> 1) & 7)) << 4)) = st.k[i];
        *(u32x4*)(vt + r * 128 + ((((c >> 2) ^ ((r >> 1) & 1))) << 6) + ((c & 3) << 4)) = st.v[i]; }
}
DI bf16x8 k_frag(const char* kt, int sb, int st, int r32, int hh) {
    const int row = sb * 32 + r32;
    return *(const bf16x8*)(kt + row * 128 + (((2 * st + hh) ^ ((row >> 1) & 7)) << 4));
}
DI bf16x8 vt_frag(const char* vt, int sb, int st, int dh, int lane) {
    const int hh = lane >> 5, g1 = (lane >> 4) & 1, pp = lane & 3, q = (lane & 15) >> 2;
    const int key = sb * 32 + 16 * st + 4 * hh + q;
    const char* a = vt + key * 128 + ((dh ^ ((q >> 1) & 1)) << 6) + g1 * 32 + pp * 8;
    const s16x4 lo = tr_read(a), hi = tr_read(a + 8 * 128);
    return (bf16x8){lo[0], lo[1], lo[2], lo[3], hi[0], hi[1], hi[2], hi[3]};
}


#define XB_TMO      128
#define XB_XCNT(j)  (256  + 64 * (j))
#define XB_XSUB(j)  (1280 + 64 * (j))
#define XB_XGEN(j)  (2304 + 64 * (j))
#define XB_TOP      3328
#define XB_TOPGEN   3392
#define XCD_BAR_WORDS 3456
#define XB_SPIN_CAP (1u << 22)
DI unsigned xb_ld(unsigned* q)              { return __hip_atomic_load(q, __ATOMIC_RELAXED, __HIP_MEMORY_SCOPE_AGENT); }
DI unsigned xb_add(unsigned* q, unsigned v) { return __hip_atomic_fetch_add(q, v, __ATOMIC_RELAXED, __HIP_MEMORY_SCOPE_AGENT); }
DI unsigned xb_xcc_id() { return (unsigned)__builtin_amdgcn_s_getreg((3 << 11) | 20) & 0xFu; }
#define XB_SPIN(cond, bar) do { unsigned _sp = 0; while (cond) { __builtin_amdgcn_s_sleep(1); \
    if ((++_sp & 255u) == 0u) { if (xb_ld(&(bar)[XB_TMO])) break; if (_sp > XB_SPIN_CAP) { atomicAdd(&(bar)[XB_TMO], 1u); break; } } } } while (0)
struct XcdBarrier { unsigned* bar; unsigned x; volatile LDSAS unsigned* st; };
DI XcdBarrier xcd_barrier_post(unsigned* bar, volatile LDSAS unsigned* st) {
    XcdBarrier b; b.bar = bar; b.x = xb_xcc_id(); b.st = st;
    if (threadIdx.x == 0) (void)xb_add(&bar[XB_XCNT(b.x)], 1u);
    return b;
}
DI void xcd_barrier_complete(unsigned* bar, unsigned x, unsigned& nloc, unsigned& nx) {
    const unsigned G = gridDim.x * gridDim.y * gridDim.z;
    unsigned sum, cnt, mine, sp = 0u;
    for (;;) {
        sum = 0u; cnt = 0u; mine = 0u;
#pragma unroll
        for (unsigned j = 0; j < 16; ++j) { const unsigned c = xb_ld(&bar[XB_XCNT(j)]); sum += c; cnt += (c > 0u) ? 1u : 0u; mine = (j == x) ? c : mine; }
        if (sum == G) break;
        __builtin_amdgcn_s_sleep(1);
        if ((++sp & 255u) == 0u) { if (xb_ld(&bar[XB_TMO])) break; if (sp > XB_SPIN_CAP) { atomicAdd(&bar[XB_TMO], 1u); break; } }
    }
    nloc = mine > 0u ? mine : 1u; nx = cnt > 0u ? cnt : 1u;
}
DI void xcd_barrier(const XcdBarrier& b) {
    asm volatile("s_waitcnt vmcnt(0)" ::: "memory");
    __syncthreads();
    if (threadIdx.x == 0) {
        unsigned* bar = b.bar;
        __builtin_amdgcn_s_waitcnt(0);
        unsigned nloc = b.st[0], nx = b.st[1];
        if (nloc == 0u) { xcd_barrier_complete(bar, b.x, nloc, nx); b.st[0] = nloc; b.st[1] = nx; }
        const unsigned old = xb_add(&bar[XB_XSUB(b.x)], 1u);
        const unsigned gen = old / nloc;
        if (old + 1u == (gen + 1u) * nloc) {
            __builtin_amdgcn_fence(__ATOMIC_RELEASE, "agent");
            asm volatile("s_waitcnt vmcnt(0)" ::: "memory");
            const unsigned og = xb_add(&bar[XB_TOP], 1u);
            const unsigned tg = og / nx;
            if (og + 1u == (tg + 1u) * nx) xb_add(&bar[XB_TOPGEN], 1u);
            else XB_SPIN(xb_ld(&bar[XB_TOPGEN]) == tg, bar);
            __builtin_amdgcn_fence(__ATOMIC_ACQUIRE, "agent");
            xb_add(&bar[XB_XGEN(b.x)], 1u);
            asm volatile("s_waitcnt vmcnt(0)" ::: "memory");
        } else {
            XB_SPIN(xb_ld(&bar[XB_XGEN(b.x)]) == gen, bar);
            __builtin_amdgcn_fence(__ATOMIC_ACQUIRE, "agent");
            asm volatile("s_waitcnt vmcnt(0)" ::: "memory");
        }
    }
    __syncthreads();
}


struct ConvPlan { int layer; int sl_e, sl_in, sl_out, nslots; };
template <int NV> DI ConvPlan conv_plan(const P& p, int layer) {
    ConvPlan c; c.layer = layer;
    const unsigned per = gridDim.x * 512u, gsz = 4 * NV;
    c.sl_e = (int)((NEXP * DM * FF / gsz + per - 1) / per);
    c.sl_in = layer == 0 ? (int)((DM * ODD_IN / gsz + per - 1) / per) : 0;
    c.sl_out = layer == 0 ? (int)((DM * DM / gsz + per - 1) / per) : 0;
    c.nslots = 3 * c.sl_e + c.sl_in + c.sl_out;
    return c;
}
template <int NV> DI void conv_locate(const P& p, const ConvPlan& c, int slot, const float*& s, bf16_t*& d, const float*& gp) {
    constexpr unsigned gsz = 4 * NV;
    int seg = 0, ls = slot;
    if (ls < 3 * c.sl_e) { seg = ls / c.sl_e; ls -= seg * c.sl_e; }
    else if ((ls -= 3 * c.sl_e) < c.sl_in) seg = 3;
    else { ls -= c.sl_in; seg = 4; }
    const unsigned ng = seg < 3 ? NEXP * DM * FF / gsz : (seg == 3 ? DM * ODD_IN / gsz : DM * DM / gsz);
    const unsigned gi = ((unsigned)ls * gridDim.x + blockIdx.x) * 512u + threadIdx.x;
    const bool live = slot < c.nslots && gi < ng;
    const size_t e = live ? (size_t)gi * gsz : 0;
    const int tix = c.layer * 5 + __builtin_amdgcn_readfirstlane(seg);
    s = p.cs[tix] + e;
    d = live ? p.cd[tix] + e : p.dump + ((size_t)blockIdx.x * 512 + threadIdx.x) * 16;
    gp = p.ones;
    if (live && seg < 2) gp = p.ffn_norm + c.layer * DM + ((e >> 8) & (DM - 1));
    else if (live && seg == 3) gp = p.mix_norm_odd + e / ODD_IN;
}
#define CONV_DECL4(N) f32x4 N##0, N##1, N##2, N##3; float N##g; bf16_t* N##d
#define CONV_DECL2(N) f32x4 N##0, N##1; float N##g; bf16_t* N##d
#define CONV_LOAD4(N, SLOT) do { const float* s_; const float* g_; conv_locate<4>(p, cv, (SLOT), s_, N##d, g_); \
        N##g = *g_; N##0 = *(const f32x4*)s_; N##1 = *(const f32x4*)(s_ + 4); N##2 = *(const f32x4*)(s_ + 8); N##3 = *(const f32x4*)(s_ + 12); } while (0)
#define CONV_LOAD2(N, SLOT) do { const float* s_; const float* g_; conv_locate<2>(p, cv, (SLOT), s_, N##d, g_); \
        N##g = *g_; N##0 = *(const f32x4*)s_; N##1 = *(const f32x4*)(s_ + 4); } while (0)
#define CONV_STORE4(N) do { const f32x4 a_ = N##0 * N##g, b_ = N##1 * N##g, c_ = N##2 * N##g, e_ = N##3 * N##g; u32x4 w_; \
        w_.x = pack2(a_[0], a_[1]); w_.y = pack2(a_[2], a_[3]); w_.z = pack2(b_[0], b_[1]); w_.w = pack2(b_[2], b_[3]); *(u32x4*)N##d = w_; \
        w_.x = pack2(c_[0], c_[1]); w_.y = pack2(c_[2], c_[3]); w_.z = pack2(e_[0], e_[1]); w_.w = pack2(e_[2], e_[3]); *(u32x4*)(N##d + 8) = w_; } while (0)
#define CONV_STORE2(N) do { const f32x4 a_ = N##0 * N##g, b_ = N##1 * N##g; u32x4 w_; \
        w_.x = pack2(a_[0], a_[1]); w_.y = pack2(a_[2], a_[3]); w_.z = pack2(b_[0], b_[1]); w_.w = pack2(b_[2], b_[3]); *(u32x4*)N##d = w_; } while (0)

DI void band_attn_unit(const P& p, char* smem, int unit, const ConvPlan& cv, int& cslot) {
    const int tid = opaque_tid() & 255, lane = tid & 63, wid = tid >> 6, r32 = lane & 31, hh = lane >> 5;
    const int cp = unit & 31, h = (unit >> 5) & 7, b = unit >> 8;
    const int c = 2 * cp + (wid >> 1);
    const int tq = c * 64 + (wid & 1) * 32 + r32;
    const size_t rowb = (size_t)b * NS;
    const bf16_t* kbase = p.proj + rowb * EVEN_IN + 512 + h * 64;
    const bf16_t* vbase = p.proj + rowb * EVEN_IN + 1024 + h * 64;
    float* sbias = (float*)(smem + 4 * KV_TILE);
    __syncthreads();
    bf16x8 qf[4];
#pragma unroll
    for (int st = 0; st < 4; ++st) qf[st] = *(const bf16x8*)(p.proj + (rowb + tq) * EVEN_IN + h * 64 + st * 16 + hh * 8);
    const int ck0 = (2 * cp - 8) > 0 ? (2 * cp - 8) : 0, nt = 2 * cp + 2 - ck0;
    float m = -3.0e38f, lsum = 0.f;
    f32x16 o0, o1;
#pragma unroll
    for (int i = 0; i < 16; ++i) { o0[i] = 0.f; o1[i] = 0.f; }
    KVStage stg;
    kv_load(stg, kbase, vbase, EVEN_IN, ck0 * 64);
    {
        const float b0 = p.att_rel_bias[h * 257 + tid], b1 = p.att_rel_bias[h * 257 + 256];
        sbias[tid] = b0 * LOG2E; if (tid == 0) sbias[256] = b1 * LOG2E;
    }
    kv_store(stg, smem, smem + 2 * KV_TILE);
    __syncthreads();
    CONV_DECL4(cA); CONV_DECL4(cB);
    CONV_LOAD4(cA, cslot++); CONV_LOAD4(cB, cslot++);
#define BAND_ITER(it, CRX) do { \
        const int ck = ck0 + it, cur = it & 1; \
        kv_load(stg, kbase, vbase, EVEN_IN, ((it + 1 < nt) ? ck + 1 : ck) * 64); \
        CONV_STORE4(CRX); CONV_LOAD4(CRX, cslot++); \
        __builtin_amdgcn_sched_barrier(0); \
        const char* kt = smem + cur * KV_TILE; const char* vt = smem + (2 + cur) * KV_TILE; \
        if (ck >= c - 8 && ck <= c) { \
            f32x16 s0, s1; \
_Pragma("unroll") \
            for (int i = 0; i < 16; ++i) { s0[i] = 0.f; s1[i] = 0.f; } \
_Pragma("unroll") \
            for (int st = 0; st < 4; ++st) { s0 = MFMA32(k_frag(kt, 0, st, r32, hh), qf[st], s0); s1 = MFMA32(k_frag(kt, 1, st, r32, hh), qf[st], s1); } \
            if (c - ck >= 3) { const float bb = sbias[256]; \
_Pragma("unroll") \
                for (int i = 0; i < 16; ++i) { s0[i] += bb; s1[i] += bb; } \
            } else { \
                const int d0 = tq - ck * 64 - 4 * hh; \
_Pragma("unroll") \
                for (int i = 0; i < 16; ++i) { \
                    int da = d0 - ((i & 3) + 8 * (i >> 2)), db = da - 32; \
                    da = da > 128 ? 128 : da; db = db > 128 ? 128 : db; \
                    s0[i] += sbias[da + 128]; s1[i] += sbias[db + 128]; \
                } \
            } \
            float tm = fmaxf(s0[0], s1[0]); \
_Pragma("unroll") \
            for (int i = 1; i < 16; ++i) tm = fmaxf(tm, fmaxf(s0[i], s1[i])); \
            tm = swap_max(tm); \
            const float mn = fmaxf(m, tm); \
            const float alpha = __builtin_amdgcn_exp2f(m - mn); \
            m = mn; \
            float ps = 0.f; \
_Pragma("unroll") \
            for (int i = 0; i < 16; ++i) { s0[i] = __builtin_amdgcn_exp2f(s0[i] - mn); s1[i] = __builtin_amdgcn_exp2f(s1[i] - mn); ps += s0[i] + s1[i]; } \
            lsum = lsum * alpha + ps; \
_Pragma("unroll") \
            for (int i = 0; i < 16; ++i) { o0[i] *= alpha; o1[i] *= alpha; } \
_Pragma("unroll") \
            for (int st = 0; st < 2; ++st) { \
                const bf16x8 pa = pack8(s0, st), pb = pack8(s1, st); \
                o0 = MFMA32(vt_frag(vt, 0, st, 0, lane), pa, o0); o1 = MFMA32(vt_frag(vt, 0, st, 1, lane), pa, o1); \
                o0 = MFMA32(vt_frag(vt, 1, st, 0, lane), pb, o0); o1 = MFMA32(vt_frag(vt, 1, st, 1, lane), pb, o1); \
            } \
        } \
        __builtin_amdgcn_sched_barrier(0); \
        kv_store(stg, smem + (cur ^ 1) * KV_TILE, smem + (2 + (cur ^ 1)) * KV_TILE); \
        __syncthreads(); \
    } while (0)
    for (int it = 0; it < nt; it += 2) {
        BAND_ITER(it, cA);
        if (it + 1 >= nt) break;
        BAND_ITER(it + 1, cB);
    }
#undef BAND_ITER
    CONV_STORE4(cA); CONV_STORE4(cB);
    const float inv = 1.0f / swap_sum(lsum);
    bf16_t* orow = p.mixed + (rowb + tq) * DM + h * 64 + 4 * hh;
#pragma unroll
    for (int g = 0; g < 4; ++g) {
        u32x2 w0, w1;
        w0.x = pack2(o0[4 * g] * inv, o0[4 * g + 1] * inv); w0.y = pack2(o0[4 * g + 2] * inv, o0[4 * g + 3] * inv);
        w1.x = pack2(o1[4 * g] * inv, o1[4 * g + 1] * inv); w1.y = pack2(o1[4 * g + 2] * inv, o1[4 * g + 3] * inv);
        *(u32x2*)(orow + 8 * g) = w0; *(u32x2*)(orow + 32 + 8 * g) = w1;
    }
}

DI void sb_attn_unit(const P& p, char* smem, volatile int* wdone, int unit, const ConvPlan& cv, int& cslot) {
    const int tid8 = opaque_tid(), tid = tid8 & 255, lane = tid & 63, wid = tid >> 6, r32 = lane & 31, hh = lane >> 5, wid8 = tid8 >> 6;
    const int qb = unit & 31, h = (unit >> 5) & 7, b = unit >> 8;
    const int tw = qb * 128 + wid * 32, t = tw + r32;
    const size_t rowb = (size_t)b * NS;
    const bf16_t* kbase = p.proj + rowb * ODD_IN + 1536 + h * 64;
    const bf16_t* vbase = p.proj + rowb * ODD_IN + 2048 + h * 64;
    __syncthreads();
    bf16x8 qf[4];
#pragma unroll
    for (int st = 0; st < 4; ++st) qf[st] = *(const bf16x8*)(p.proj + (rowb + t) * ODD_IN + 1024 + h * 64 + st * 16 + hh * 8);
    bf16x8 tf[2];
#pragma unroll
    for (int st = 0; st < 2; ++st)
#pragma unroll
        for (int j = 0; j < 8; ++j) tf[st][j] = (16 * st + 8 * (j >> 2) + 4 * hh + (j & 3)) >= r32 ? (short)0x3F80 : (short)0;
    f32x16 o0, o1;
#pragma unroll
    for (int i = 0; i < 16; ++i) { o0[i] = 0.f; o1[i] = 0.f; }
    float carry = 0.f; bool done = false;
    const int kt0 = 2 * qb + 1;
    KVStage stg;
    kv_load(stg, kbase, vbase, ODD_IN, kt0 * 64);
    kv_store(stg, smem, smem + 2 * KV_TILE);
    __syncthreads();
    bool all_done = false;
    CONV_DECL2(cA);
    CONV_LOAD2(cA, cslot++);
#define SB_ITER(it, CRX) do { \
        const int kt = kt0 - it, cur = it & 1; \
        kv_load(stg, kbase, vbase, ODD_IN, (kt > 0 ? kt - 1 : 0) * 64); \
        CONV_STORE2(CRX); CONV_LOAD2(CRX, cslot++); \
        __builtin_amdgcn_sched_barrier(0); \
        const char* ktile = smem + cur * KV_TILE; const char* vtile = smem + (2 + cur) * KV_TILE; \
        if (!done && kt * 64 < tw + 31) { \
_Pragma("unroll") \
            for (int sbi = 0; sbi < 2; ++sbi) { \
                const int sb = 1 - sbi; \
                f32x16 x; \
_Pragma("unroll") \
                for (int i = 0; i < 16; ++i) x[i] = 0.f; \
_Pragma("unroll") \
                for (int st = 0; st < 4; ++st) x = MFMA32(k_frag(ktile, sb, st, r32, hh), qf[st], x); \
                const int kb = kt * 64 + sb * 32 + 4 * hh; \
                f32x16 L; \
_Pragma("unroll") \
                for (int i = 0; i < 16; ++i) { \
                    const bool valid = kb + (i & 3) + 8 * (i >> 2) < t; \
                    const float z = x[i]; \
                    const float sp = fmaxf(z, 0.f) + __builtin_amdgcn_logf(1.0f + __builtin_amdgcn_exp2f(-fabsf(z))); \
                    L[i] = valid ? -sp : 0.f; \
                    x[i] = valid ? z : -1.0e30f; \
                } \
                f32x16 cum; \
_Pragma("unroll") \
                for (int i = 0; i < 16; ++i) cum[i] = carry; \
_Pragma("unroll") \
                for (int st = 0; st < 2; ++st) cum = MFMA32(tf[st], pack8(L, st), cum); \
                carry = bcast_lo(cum[0]); \
_Pragma("unroll") \
                for (int i = 0; i < 16; ++i) x[i] = __builtin_amdgcn_exp2f(x[i] + cum[i]); \
_Pragma("unroll") \
                for (int st = 0; st < 2; ++st) { \
                    const bf16x8 pa = pack8(x, st); \
                    o0 = MFMA32(vt_frag(vtile, sb, st, 0, lane), pa, o0); o1 = MFMA32(vt_frag(vtile, sb, st, 1, lane), pa, o1); \
                } \
            } \
            done = __all(carry < -150.0f); \
        } \
        __builtin_amdgcn_sched_barrier(0); \
        if (lane == 0) wdone[cur * 8 + wid8] = done ? 1 : 0; \
        kv_store(stg, smem + (cur ^ 1) * KV_TILE, smem + (2 + (cur ^ 1)) * KV_TILE); \
        __syncthreads(); \
        all_done = (wdone[cur * 8] + wdone[cur * 8 + 1] + wdone[cur * 8 + 2] + wdone[cur * 8 + 3] + wdone[cur * 8 + 4] + wdone[cur * 8 + 5] + wdone[cur * 8 + 6] + wdone[cur * 8 + 7] == 8); \
    } while (0)
#pragma nounroll
    for (int it = 0; it <= kt0; ++it) {
        SB_ITER(it, cA);
        if (all_done) break;
    }
#undef SB_ITER
    CONV_STORE2(cA);
    bf16_t* orow = p.mixed + (rowb + t) * DM + 512 + h * 64 + 4 * hh;
#pragma unroll
    for (int g = 0; g < 4; ++g) {
        u32x2 w0, w1;
        w0.x = pack2(o0[4 * g], o0[4 * g + 1]); w0.y = pack2(o0[4 * g + 2], o0[4 * g + 3]);
        w1.x = pack2(o1[4 * g], o1[4 * g + 1]); w1.y = pack2(o1[4 * g + 2], o1[4 * g + 3]);
        *(u32x2*)(orow + 8 * g) = w0; *(u32x2*)(orow + 32 + 8 * g) = w1;
    }
}

DI void pool_items(const P& p) {
    for (int it = blockIdx.x * 512 + threadIdx.x; it < (NTOK / 8) * 64; it += gridDim.x * 512) {
        const int run = it >> 6, ch8 = it & 63, g = ch8 >> 4, w = 2 << g;
        const int tok0 = run * 8, s0 = tok0 & (NS - 1);
        const bf16_t* src = p.proj + (size_t)tok0 * EVEN_IN + 1536 + ch8 * 8;
        u32x4 rows[23];
#pragma unroll
        for (int k = 0; k < 23; ++k) { const int ds = k - 15; const bool ok = s0 + ds >= 0;
            rows[k] = *(const u32x4*)(src + (ptrdiff_t)(ok ? ds : 0) * EVEN_IN); if (!ok) rows[k] = (u32x4){0u, 0u, 0u, 0u}; }
        float sum[8], f[8];
#pragma unroll
        for (int j = 0; j < 8; ++j) sum[j] = 0.f;
#pragma unroll
        for (int k = 0; k < 15; ++k) { unpack8(rows[k], f); const float mk = (15 - k) < w ? 1.f : 0.f;
#pragma unroll
            for (int j = 0; j < 8; ++j) sum[j] += f[j] * mk; }
#pragma unroll
        for (int t = 0; t < 8; ++t) {
            unpack8(rows[15 + t], f);
#pragma unroll
            for (int j = 0; j < 8; ++j) sum[j] += f[j];
            const int s = s0 + t; const float inv = 1.0f / (float)((s + 1 < w) ? s + 1 : w);
            u32x4 o; o.x = pack2(sum[0] * inv - f[0], sum[1] * inv - f[1]); o.y = pack2(sum[2] * inv - f[2], sum[3] * inv - f[3]);
            o.z = pack2(sum[4] * inv - f[4], sum[5] * inv - f[5]); o.w = pack2(sum[6] * inv - f[6], sum[7] * inv - f[7]);
            *(u32x4*)(p.mixed + (size_t)(tok0 + t) * DM + 512 + ch8 * 8) = o;
            float d[8];
            const u32x4 r2 = rows[15 + t - 1], r4 = rows[15 + t - 3], r8 = rows[15 + t - 7], r16 = rows[t];
            const u32x4 rd = g == 0 ? r2 : (g == 1 ? r4 : (g == 2 ? r8 : r16));
            unpack8(rd, d);
#pragma unroll
            for (int j = 0; j < 8; ++j) sum[j] -= d[j];
        }
    }
}

DI void sgu_unit(const P& p, char* smem, int unit) {
    const int tid = opaque_tid() & 255, lane = tid & 63, wid = tid >> 6, wm = wid >> 1, wn = wid & 1, fr = lane & 15, fq = lane >> 4;
    const int g = unit & 3; const size_t tok0 = (size_t)(unit >> 2) * 128;
    char* As = smem; char* Gs = smem + 32768; float* srstd = (float*)(smem + 65536);
    __syncthreads();
    if (tid < 128) srstd[tid] = rsqrtf(p.vss[tok0 + tid] * (1.0f / 512.0f) + EPS);
#pragma unroll
    for (int i = 0; i < 8; ++i) {
        const int idx = tid + 256 * i, s = idx >> 4, ch = idx & 15;
        const u32x4 v = *(const u32x4*)(p.proj + (tok0 + s) * ODD_IN + 512 + g * 128 + ch * 8);
        *(u32x4*)(Gs + s * 256 + (((ch >> 1) ^ kswz(s)) << 5) + ((ch & 1) << 4)) = v;
    }
    __syncthreads();
#pragma unroll
    for (int i = 0; i < 8; ++i) {
        const int idx = tid + 256 * i, t = idx >> 4, c8 = idx & 15, s0 = c8 * 8;
        const float* wr = p.sgu_w + ((size_t)g * 128 + t) * 128 + s0;
        const f32x4 a = *(const f32x4*)wr, b = *(const f32x4*)(wr + 4);
        float f[8] = {a[0], a[1], a[2], a[3], b[0], b[1], b[2], b[3]};
#pragma unroll
        for (int j = 0; j < 8; ++j) f[j] = (s0 + j <= t) ? f[j] * srstd[s0 + j] : 0.f;
        u32x4 w; w.x = pack2(f[0], f[1]); w.y = pack2(f[2], f[3]); w.z = pack2(f[4], f[5]); w.w = pack2(f[6], f[7]);
        *(u32x4*)(As + (c8 >> 3) * 16384 + t * 128 + (((c8 & 7) ^ (t & 7)) << 4)) = w;
    }
    __syncthreads();
    f32x4 acc[4][4];
#pragma unroll
    for (int a = 0; a < 4; ++a)
#pragma unroll
        for (int b = 0; b < 4; ++b) acc[a][b] = (f32x4){0.f, 0.f, 0.f, 0.f};
    const int qq = fr >> 2, pp = fr & 3;
#pragma unroll
    for (int kt = 0; kt < 2; ++kt) {
        if (kt == 1 && wm == 0) continue;
#pragma unroll
        for (int s2 = 0; s2 < 2; ++s2) {
            bf16x8 af[4], bfv[4];
#pragma unroll
            for (int i = 0; i < 4; ++i) {
                const int ra_ = wm * 64 + i * 16 + fr;
                af[i] = *(const bf16x8*)(As + kt * 16384 + ra_ * 128 + (((s2 * 4 + fq) ^ (fr & 7)) << 4));
                const int srow = kt * 64 + s2 * 32 + 8 * fq + qq, blk = wn * 4 + i;
                const s16x4 lo = tr_read(Gs + srow * 256 + ((blk ^ kswz(srow)) << 5) + pp * 8);
                const s16x4 hi = tr_read(Gs + (srow + 4) * 256 + ((blk ^ kswz(srow + 4)) << 5) + pp * 8);
                bfv[i] = (bf16x8){lo[0], lo[1], lo[2], lo[3], hi[0], hi[1], hi[2], hi[3]};
            }
#pragma unroll
            for (int mi = 0; mi < 4; ++mi)
#pragma unroll
                for (int ni = 0; ni < 4; ++ni) acc[mi][ni] = MFMA16(bfv[ni], af[mi], acc[mi][ni]);
        }
    }
#pragma unroll
    for (int mi = 0; mi < 4; ++mi) {
        const int t = wm * 64 + mi * 16 + fr;
        const float bias = p.sgu_b[g * 128 + t];
#pragma unroll
        for (int ni = 0; ni < 4; ++ni) {
            const int c = g * 128 + wn * 64 + ni * 16 + fq * 4;
            const f32x4 gn = *(const f32x4*)(p.sgu_v_norm + c);
            const u32x2 uu = *(const u32x2*)(p.proj + (tok0 + t) * ODD_IN + c);
            const float u0 = __uint_as_float(uu.x << 16), u1 = __uint_as_float(uu.x & 0xffff0000u), u2 = __uint_as_float(uu.y << 16), u3 = __uint_as_float(uu.y & 0xffff0000u);
            const f32x4 a = acc[mi][ni];
            u32x2 w; w.x = pack2(u0 * (gn[0] * a[0] + bias), u1 * (gn[1] * a[1] + bias)); w.y = pack2(u2 * (gn[2] * a[2] + bias), u3 * (gn[3] * a[3] + bias));
            *(u32x2*)(p.mixed + (tok0 + t) * DM + c) = w;
        }
    }
}

DI void router_unit(const P& p, char* smem, int layer, int unit) {
    const int tid = opaque_tid() & 255, lane = tid & 63, wid = tid >> 6, r32 = lane & 31, hh = lane >> 5;
    float (*part)[36][32] = (float (*)[36][32])smem;
    float (*wss)[32] = (float (*)[32])(smem + 18432);
    int* lcnt = (int*)(smem + 18432 + 512);
    int* lbase = lcnt + 32;
    int* cnt = p.cnt + layer * NEXP;
    const int tok = unit * 32 + r32, kq = wid * 256 + 8 * hh;
    __syncthreads();
    if (tid < 32) lcnt[tid] = 0;
    const bf16_t* hrow = p.hb + (size_t)tok * DM + kq;
    const bf16_t* whi = p.wr_hi + ((size_t)layer * 96 + r32) * DM + kq;
    const bf16_t* wlo = p.wr_lo + ((size_t)layer * 96 + r32) * DM + kq;
    f32x16 c0, c1, c2;
#pragma unroll
    for (int i = 0; i < 16; ++i) { c0[i] = 0.f; c1[i] = 0.f; c2[i] = 0.f; }
    float ss = 0.f;
#pragma unroll 4
    for (int st = 0; st < 16; ++st) {
        const u32x4 hw = *(const u32x4*)(hrow + 16 * st);
        float f[8]; unpack8(hw, f);
#pragma unroll
        for (int j = 0; j < 8; ++j) ss += f[j] * f[j];
        const bf16x8 hhi = __builtin_bit_cast(bf16x8, hw);
        bf16x8 wh, wl;
        wh = *(const bf16x8*)(whi + 16 * st); wl = *(const bf16x8*)(wlo + 16 * st);
        c0 = MFMA32(wh, hhi, c0); c0 = MFMA32(wl, hhi, c0);
        wh = *(const bf16x8*)(whi + 32 * DM + 16 * st); wl = *(const bf16x8*)(wlo + 32 * DM + 16 * st);
        c1 = MFMA32(wh, hhi, c1); c1 = MFMA32(wl, hhi, c1);
        wh = *(const bf16x8*)(whi + 64 * DM + 16 * st); wl = *(const bf16x8*)(wlo + 64 * DM + 16 * st);
        c2 = MFMA32(wh, hhi, c2); c2 = MFMA32(wl, hhi, c2);
    }
    {
        auto rr = __builtin_amdgcn_permlane32_swap(__float_as_uint(ss), __float_as_uint(ss), false, false);
        ss = __uint_as_float(rr[0]) + __uint_as_float(rr[1]);
        if (hh == 0) {
#pragma unroll
            for (int i = 0; i < 16; ++i) { part[wid][i][r32] = c0[i]; part[wid][16 + i][r32] = c1[i]; }
#pragma unroll
            for (int i = 0; i < 4; ++i) part[wid][32 + i][r32] = c2[i];
            wss[wid][r32] = ss;
        }
    }
    __syncthreads();
    int e1 = 0, e2 = 0, r1 = 0, r2 = 0; float w1 = 0.f, w2 = 0.f, rstd = 0.f;
    const int mytok = unit * 32 + tid;
    if (tid < 32) {
        rstd = rsqrtf((wss[0][tid] + wss[1][tid] + wss[2][tid] + wss[3][tid]) * (1.0f / DM) + EPS);
        float gl[4], ev[8];
#pragma unroll
        for (int j = 0; j < 4; ++j) gl[j] = (part[0][32 + j][tid] + part[1][32 + j][tid] + part[2][32 + j][tid] + part[3][32 + j][tid]) * rstd;
        int gs = 0; float gm = gl[0];
#pragma unroll
        for (int j = 1; j < 4; ++j) if (gl[j] > gm) { gm = gl[j]; gs = j; }
        const float gw = 1.0f / (__expf(gl[0] - gm) + __expf(gl[1] - gm) + __expf(gl[2] - gm) + __expf(gl[3] - gm));
#pragma unroll
        for (int j = 0; j < 8; ++j) { const int s = gs * 8 + j; ev[j] = (part[0][s][tid] + part[1][s][tid] + part[2][s][tid] + part[3][s][tid]) * rstd; }
        int i1 = 0; float v1 = ev[0];
#pragma unroll
        for (int j = 1; j < 8; ++j) if (ev[j] > v1) { v1 = ev[j]; i1 = j; }
        int i2 = -1; float v2 = -3.0e38f;
#pragma unroll
        for (int j = 0; j < 8; ++j) if (j != i1 && ev[j] > v2) { v2 = ev[j]; i2 = j; }
        w1 = 1.0f / (1.0f + __expf(v2 - v1)); w2 = (1.0f - w1) * gw; w1 *= gw;
        e1 = gs * 8 + i1; e2 = gs * 8 + i2;
        r1 = atomicAdd(lcnt + e1, 1); r2 = atomicAdd(lcnt + e2, 1);
    }
    __syncthreads();
    if (tid < 32) { const int n = lcnt[tid]; lbase[tid] = n ? atomicAdd(cnt + tid, n) : 0; }
    __syncthreads();
    if (tid < 32) {
        p.plist[(size_t)e1 * LISTCAP + lbase[e1] + r1] = mytok * 2; p.plist[(size_t)e2 * LISTCAP + lbase[e2] + r2] = mytok * 2 + 1;
        p.pw[mytok * 2] = w1; p.pw[mytok * 2 + 1] = w2; p.rs[mytok] = rstd;
    }
}
DI void ph_combine(const P& p, int layer) {
    const int wave = threadIdx.x >> 6, lane = threadIdx.x & 63;
    for (int u = blockIdx.x; u < NTOK / 16; u += gridDim.x) {
        const size_t tok0 = (size_t)u * 16 + wave * 2;
        u32x2 hv[2][4], ya[2][4], yb[2][4];
#pragma unroll
        for (int r = 0; r < 2; ++r)
#pragma unroll
            for (int i = 0; i < 4; ++i) {
                const int c = i * 256 + lane * 4;
                hv[r][i] = *(const u32x2*)(p.hb + (tok0 + r) * DM + c);
                ya[r][i] = *(const u32x2*)(p.y + ((tok0 + r) * 2) * DM + c); yb[r][i] = *(const u32x2*)(p.y + ((tok0 + r) * 2 + 1) * DM + c);
            }
#pragma unroll
        for (int r = 0; r < 2; ++r) {
            float ss = 0.f;
#pragma unroll
            for (int i = 0; i < 4; ++i) {
                const u32x2 h0 = hv[r][i], a = ya[r][i], b = yb[r][i];
                f32x4 h;
                h[0] = __uint_as_float(h0.x << 16) + __uint_as_float(a.x << 16) + __uint_as_float(b.x << 16);
                h[1] = __uint_as_float(h0.x & 0xffff0000u) + __uint_as_float(a.x & 0xffff0000u) + __uint_as_float(b.x & 0xffff0000u);
                h[2] = __uint_as_float(h0.y << 16) + __uint_as_float(a.y << 16) + __uint_as_float(b.y << 16);
                h[3] = __uint_as_float(h0.y & 0xffff0000u) + __uint_as_float(a.y & 0xffff0000u) + __uint_as_float(b.y & 0xffff0000u);
                ss += h[0] * h[0] + h[1] * h[1] + h[2] * h[2] + h[3] * h[3];
                if (layer == 0) { u32x2 w; w.x = pack2(h[0], h[1]); w.y = pack2(h[2], h[3]); *(u32x2*)(p.hb + (tok0 + r) * DM + i * 256 + lane * 4) = w; }
                else *(f32x4*)(p.out + (tok0 + r) * DM + i * 256 + lane * 4) = h;
            }
            if (layer == 0) { ss = wave_sum(ss); if (lane == 0) p.rsm[tok0 + r] = rsqrtf(ss * (1.0f / DM) + EPS); }
        }
    }
}

DI void ph_mix_even(const P& p, char* smem) {
    const int half = threadIdx.x >> 8;
    const ConvPlan cv = conv_plan<4>(p, 0); int cslot = 0;
    for (int u = blockIdx.x; u < NB * 4 * 32; u += gridDim.x) {
        const int cp = u & 31, hp = (u >> 5) & 3, b = u >> 7;
        band_attn_unit(p, smem + half * HALF_LDS, (b << 8) | ((hp * 2 + half) << 5) | cp, cv, cslot);
    }
    for (; cslot < cv.nslots; ++cslot) { CONV_DECL4(cR); CONV_LOAD4(cR, cslot); CONV_STORE4(cR); }
    pool_items(p);
}
DI void ph_mix_odd(const P& p, char* smem) {
    const int half = threadIdx.x >> 8;
    volatile int* wdone = (volatile int*)(smem + 2 * HALF_LDS);
    const ConvPlan cv = conv_plan<2>(p, 1); int cslot = 0;
    for (int u = blockIdx.x; u < NB * 4 * 32; u += gridDim.x) {
        const int qb = 31 - (u >> 4), hp = (u >> 2) & 3, b = u & 3;
        sb_attn_unit(p, smem + half * HALF_LDS, wdone, (b << 8) | ((hp * 2 + half) << 5) | qb, cv, cslot);
    }
    for (; cslot < cv.nslots; ++cslot) { CONV_DECL2(cR); CONV_LOAD2(cR, cslot); CONV_STORE2(cR); }
    for (int u = blockIdx.x; u < (NTOK / 128) * 2; u += gridDim.x) sgu_unit(p, smem + half * HALF_LDS, u * 2 + half);
}
DI void ph_router(const P& p, char* smem, int layer) {
    const int half = threadIdx.x >> 8;
    for (int u = blockIdx.x; u < NTOK / 64; u += gridDim.x) router_unit(p, smem + half * HALF_LDS, layer, u * 2 + half);
}

constexpr int NPHASE = 13;
#ifndef REPS
#define REPS {1,1,1,1,1,1,1,1,1,1,1,1,1}
#endif
__device__ constexpr int REP[13] = REPS;
__global__ __launch_bounds__(512, 2) void mega(P p, int ph0, int ph1) {
    __shared__ __attribute__((aligned(16))) char smem[SMEM_BYTES + 64 + 16 + 16];
    volatile LDSAS unsigned* xst = (volatile LDSAS unsigned*)(smem + SMEM_BYTES + 64);
    if (threadIdx.x < 4) xst[threadIdx.x] = 0u;
    __syncthreads();
    const XcdBarrier xb = xcd_barrier_post(p.bar, xst);
#define PHASE(i, call) if (ph0 <= (i) && (i) < ph1) { for (int r_ = 0; r_ < REP[i]; ++r_) { call; if (r_ + 1 < REP[i] || (i) + 1 < ph1) xcd_barrier(xb); } }
    PHASE(0, ph_prologue(p, smem))
    PHASE(1, (ph_gemm_dense<EPI_IN_EVEN, 4>(p, smem, p.hb, DM, p.wb_in_even, DM, EVEN_IN, 0, 0, 8)))
    PHASE(2, ph_mix_even(p, smem))
    PHASE(3, (ph_gemm_dense<EPI_OUT, 4>(p, smem, p.mixed, DM, p.wb_out_even, DM, DM, 0, 0, 4)))
    PHASE(4, ph_router(p, smem, 0))
    PHASE(5, ph_moe(p, smem, 0))
    PHASE(6, ph_combine(p, 0))
    PHASE(7, (ph_gemm_dense<EPI_IN_ODD, 4>(p, smem, p.hb, DM, p.wb_in_odd, DM, ODD_IN, 1, 0, 8), ph_gemm_dense<EPI_IN_ODD, 2>(p, smem, p.hb, DM, p.wb_in_odd, DM, ODD_IN, 1, 8, 2)))
    PHASE(8, ph_mix_odd(p, smem))
    PHASE(9, (ph_gemm_dense<EPI_OUT, 4>(p, smem, p.mixed, DM, p.wb_out_odd, DM, DM, 1, 0, 4)))
    PHASE(10, ph_router(p, smem, 1))
    PHASE(11, ph_moe(p, smem, 1))
    PHASE(12, ph_combine(p, 1))
}

extern "C" void kernel_launch(void* const* d_in, const int* in_sizes, int n_in, void* d_out, int out_size, void* d_ws, size_t ws_size, hipStream_t stream) {
    P p{};
    p.x = (const float*)d_in[0]; p.mix_norm_even = (const float*)d_in[1]; p.w_in_even = (const float*)d_in[2]; p.att_q_norm = (const float*)d_in[3];
    p.att_k_norm = (const float*)d_in[4]; p.att_rel_bias = (const float*)d_in[5]; p.pool_w = (const float*)d_in[6]; p.pool_scale = (const float*)d_in[7];
    p.w_out_even = (const float*)d_in[8]; p.mix_norm_odd = (const float*)d_in[9]; p.w_in_odd = (const float*)d_in[10]; p.sgu_v_norm = (const float*)d_in[11];
    p.sgu_w = (const float*)d_in[12]; p.sgu_b = (const float*)d_in[13]; p.w_out_odd = (const float*)d_in[14]; p.ffn_norm = (const float*)d_in[15];
    p.w_rg = (const float*)d_in[16]; p.w_re = (const float*)d_in[17]; p.w_gate = (const float*)d_in[18]; p.w_up = (const float*)d_in[19]; p.w_down = (const float*)d_in[20];
    p.out = (float*)d_out;
    char* ws = (char*)d_ws; size_t off = 0;
    auto take = [&](size_t bytes) { char* r = ws + off; off += (bytes + 255) & ~(size_t)255; return r; };
    p.wb_in_even = (bf16_t*)take((size_t)EVEN_IN * DM * 2);
    p.wb_out_even = (bf16_t*)take((size_t)DM * DM * 2);
    p.wb_in_odd = (bf16_t*)take((size_t)ODD_IN * DM * 2);
    p.wb_out_odd = (bf16_t*)take((size_t)DM * DM * 2);
    p.wb_gate = (bf16_t*)take((size_t)2 * NEXP * DM * FF * 2);
    p.wb_up = (bf16_t*)take((size_t)2 * NEXP * DM * FF * 2);
    p.wb_down = (bf16_t*)take((size_t)2 * NEXP * DM * FF * 2);
    p.wr_hi = (bf16_t*)take((size_t)2 * 96 * DM * 2);
    p.wr_lo = (bf16_t*)take((size_t)2 * 96 * DM * 2);
    p.hb = (bf16_t*)take((size_t)NTOK * DM * 2);
    p.proj = (bf16_t*)take((size_t)NTOK * ODD_IN * 2);
    p.y = p.proj;
    p.mixed = (bf16_t*)take((size_t)NTOK * DM * 2);
    p.hid = p.mixed;
    p.pw = (float*)take((size_t)NTOK * 2 * 4);
    p.rs = (float*)take((size_t)NTOK * 4);
    p.rsm = (float*)take((size_t)NTOK * 4);
    p.vss = (float*)take((size_t)NTOK * 4);
    p.plist = (int*)take((size_t)NEXP * LISTCAP * 4);
    p.cnt = (int*)take(256);
    p.ones = (const float*)take(256);
    p.dump = (bf16_t*)take((size_t)512 * 512 * 32);
    p.gdone = (int*)take(640 * 4);
    p.bar = (unsigned*)take(XCD_BAR_WORDS * 4);
    (void)hipMemsetAsync(p.bar, 0, XCD_BAR_WORDS * 4, stream);
    for (int l = 0; l < 2; ++l) {
        const size_t o = (size_t)l * NEXP * DM * FF;
        p.cs[l * 5 + 0] = p.w_gate + o; p.cd[l * 5 + 0] = p.wb_gate + o;
        p.cs[l * 5 + 1] = p.w_up + o;   p.cd[l * 5 + 1] = p.wb_up + o;
        p.cs[l * 5 + 2] = p.w_down + o; p.cd[l * 5 + 2] = p.wb_down + o;
        p.cs[l * 5 + 3] = p.w_in_odd;   p.cd[l * 5 + 3] = p.wb_in_odd;
        p.cs[l * 5 + 4] = p.w_out_odd;  p.cd[l * 5 + 4] = p.wb_out_odd;
    }

    static int grid_blocks = 0;
    if (!grid_blocks) {
        int dev = 0, cus = 0, per_cu = 0;
        (void)hipGetDevice(&dev);
        (void)hipDeviceGetAttribute(&cus, hipDeviceAttributeMultiprocessorCount, dev);
        (void)hipOccupancyMaxActiveBlocksPerMultiprocessor(&per_cu, mega, 512, 0);
        if (per_cu < 1) per_cu = 1;
        grid_blocks = cus;
    }
    int ph0 = 0, ph1 = NPHASE;
    void* args[] = {&p, &ph0, &ph1};
    hipError_t e = hipLaunchCooperativeKernel((void*)mega, dim3(grid_blocks), dim3(512), args, 0, stream);
    if (e != hipSuccess) fprintf(stderr, "cooperative launch failed: %s (grid %d)\n", hipGetErrorString(e), grid_blocks);
}
```

```cpp
#include <hip/hip_runtime.h>
#include <hip/hip_cooperative_groups.h>
#include <stdint.h>
#include <stdio.h>

typedef unsigned short bf16_t;
typedef short bf16x8 __attribute__((ext_vector_type(8)));
typedef short s16x4 __attribute__((ext_vector_type(4)));
typedef float f32x2 __attribute__((ext_vector_type(2)));
typedef float f32x4 __attribute__((ext_vector_type(4)));
typedef float f32x16 __attribute__((ext_vector_type(16)));
typedef unsigned u32x4 __attribute__((ext_vector_type(4)));
typedef unsigned u32x2 __attribute__((ext_vector_type(2)));
typedef __bf16 bf16x2n __attribute__((ext_vector_type(2)));

#define DI __device__ __forceinline__
#define LDSAS __attribute__((address_space(3)))
#define MFMA32(a, b, c) __builtin_amdgcn_mfma_f32_32x32x16_bf16((a), (b), (c), 0, 0, 0)
#define MFMA16(a, b, c) __builtin_amdgcn_mfma_f32_16x16x32_bf16((a), (b), (c), 0, 0, 0)

constexpr int NB = 4, NS = 4096, NTOK = NB * NS, DM = 1024;
constexpr int EVEN_IN = 2048, ODD_IN = 2560;
constexpr int NEXP = 32, FF = 256;
constexpr int LISTCAP = NTOK;
constexpr float EPS = 1e-6f;
constexpr float LOG2E = 1.4426950408889634f;
constexpr float QSCALE = 0.125f * LOG2E;

DI int opaque_tid() { int t = threadIdx.x; asm volatile("" : "+v"(t)); return t; }
DI float bf2f(bf16_t b) { return __uint_as_float(((unsigned)b) << 16); }
DI unsigned pack2(float lo, float hi) { f32x2 v = {lo, hi}; bf16x2n r = __builtin_convertvector(v, bf16x2n); return __builtin_bit_cast(unsigned, r); }
DI float wave_sum(float v) { for (int o = 32; o > 0; o >>= 1) v += __shfl_xor(v, o); return v; }
DI float gelu_exact(float x) { return 0.5f * x * (1.0f + erff(x * 0.70710678118654752f)); }
DI s16x4 tr_read(const char* p) { return __builtin_bit_cast(s16x4, __builtin_amdgcn_ds_read_tr16_b64_v4i16((LDSAS s16x4*)p)); }
DI void unpack8(const u32x4 v, float* f) {
    f[0] = __uint_as_float(v.x << 16); f[1] = __uint_as_float(v.x & 0xffff0000u); f[2] = __uint_as_float(v.y << 16); f[3] = __uint_as_float(v.y & 0xffff0000u);
    f[4] = __uint_as_float(v.z << 16); f[5] = __uint_as_float(v.z & 0xffff0000u); f[6] = __uint_as_float(v.w << 16); f[7] = __uint_as_float(v.w & 0xffff0000u);
}
DI int kswz(int k) { return (k & 3) | ((k >> 1) & 4); }

struct P {
    const float *x, *mix_norm_even, *w_in_even, *att_q_norm, *att_k_norm, *att_rel_bias, *pool_w, *pool_scale, *w_out_even;
    const float *mix_norm_odd, *w_in_odd, *sgu_v_norm, *sgu_w, *sgu_b, *w_out_odd, *ffn_norm, *w_rg, *w_re, *w_gate, *w_up, *w_down;
    float* out;
    bf16_t *wb_in_even, *wb_out_even, *wb_in_odd, *wb_out_odd, *wb_gate, *wb_up, *wb_down, *wr_hi, *wr_lo;
    bf16_t *hb, *proj, *mixed, *hid, *y;
    float *pw, *rs, *rsm, *vss; int* plist; int* cnt; unsigned* bar; int* gdone;
    const float* cs[10]; bf16_t* cd[10]; const float* ones; bf16_t* dump;
};

enum { EPI_IN_EVEN = 0, EPI_IN_ODD = 1, EPI_OUT = 2, EPI_GU = 3, EPI_DOWN = 4 };
constexpr int G_ROWID = 131072;
constexpr int SMEM_BYTES = 131072 + 1024;
constexpr int HALF_LDS = 66048;

struct GemmArgs {
    const bf16_t* A; int lda; const int* gather; int mvalid; int gshift;
    const bf16_t* B0; const bf16_t* B1; int ldb; int gu;
    int K, m0, n0;
    bool rowid_ready;
};

DI f32x2 gelu_pk(f32x2 v) {
    const f32x2 av = __builtin_elementwise_abs(v), d = av * 0.2316418882f + 1.0f;
    f32x2 t; t.x = __builtin_amdgcn_rcpf(d.x); t.y = __builtin_amdgcn_rcpf(d.y);
    f32x2 q = t * 0.5307027145f + (-0.7265760135f); q = q * t + 0.7107068705f; q = q * t + (-0.142248368f); q = q * t + 0.127414796f; q = q * t;
    const f32x2 s = (v * v) * (-0.72134752044f);
    f32x2 e; e.x = __builtin_amdgcn_exp2f(s.x); e.y = __builtin_amdgcn_exp2f(s.y);
    const f32x2 m = v * (q * e), r = v - m;
    f32x2 o; o.x = v.x < 0.f ? m.x : r.x; o.y = v.y < 0.f ? m.y : r.y; return o;
}

DI void glds16(const void* gsrc, unsigned lds_dst) {
    unsigned keep;
    asm volatile("s_mov_b32 %0, m0\n\ts_mov_b32 m0, %2\n\ts_nop 0\n\tglobal_load_lds_dwordx4 %1, off\n\ts_mov_b32 m0, %0" : "=&s"(keep) : "v"(gsrc), "s"(lds_dst) : "memory");
}
DI void glds16_sc1(const void* gsrc, unsigned lds_dst) {
    unsigned keep;
    asm volatile("s_mov_b32 %0, m0\n\ts_mov_b32 m0, %2\n\ts_nop 0\n\tglobal_load_lds_dwordx4 %1, off sc1\n\ts_mov_b32 m0, %0" : "=&s"(keep) : "v"(gsrc), "s"(lds_dst) : "memory");
}
DI void st16_sc1(void* q, u32x4 v) { asm volatile("global_store_dwordx4 %0, %1, off sc1\n\ts_nop 1" :: "v"(q), "v"(v) : "memory"); }
DI void bl_lds(unsigned voff, __amdgpu_buffer_rsrc_t rs, unsigned soff, unsigned m0v) {
    unsigned keep;
    asm volatile("s_mov_b32 %0, m0\n\ts_mov_b32 m0, %1\n\ts_nop 0\n\tbuffer_load_dwordx4 %2, %3, %4 offen lds\n\ts_mov_b32 m0, %0" : "=&s"(keep) : "s"(m0v), "v"(voff), "s"(rs), "s"(soff) : "memory");
}
DI void bl_lds_sc1(unsigned voff, __amdgpu_buffer_rsrc_t rs, unsigned soff, unsigned m0v) {
    unsigned keep;
    asm volatile("s_mov_b32 %0, m0\n\ts_mov_b32 m0, %1\n\ts_nop 0\n\tbuffer_load_dwordx4 %2, %3, %4 offen sc1 lds\n\ts_mov_b32 m0, %0" : "=&s"(keep) : "s"(m0v), "v"(voff), "s"(rs), "s"(soff) : "memory");
}
DI const void* uniform_ptr(const void* q) {
    const unsigned long long v = (unsigned long long)q;
    const unsigned lo = (unsigned)__builtin_amdgcn_readfirstlane((int)(unsigned)v), hi = (unsigned)__builtin_amdgcn_readfirstlane((int)(unsigned)(v >> 32));
    return (const void*)(((unsigned long long)hi << 32) | lo);
}
template <int EPI, int MT>
DI void gemm_tile(const P& p, char* smem, const GemmArgs& g, int layer) {
    const int tid = opaque_tid(), lane = tid & 63, wid = tid >> 6, wm = wid >> 2, wn = wid & 3, r32 = lane & 31, hh = lane >> 5;
    int* rowid = (int*)(smem + G_ROWID);
    constexpr int NA = MT / 2;
    constexpr int IPT = NA + 2;
    unsigned avo[NA], bvo[2];
    if (g.gather && !g.rowid_ready) { if (tid < 64 * MT) rowid[tid] = (tid < g.mvalid) ? g.gather[tid] : -1; __syncthreads(); }
#pragma unroll
    for (int i = 0; i < NA; ++i) {
        const int r = (wid * NA + i) * 16 + (lane >> 2), kc = (lane & 3) ^ ((r >> 2) & 3);
        unsigned arow;
        if (g.gather) { int id = rowid[r]; if (id < 0) id = rowid[0]; arow = (unsigned)(id >> g.gshift); } else arow = (unsigned)(g.m0 + r);
        avo[i] = (arow * (unsigned)g.lda + kc * 8) * 2u;
    }
#pragma unroll
    for (int i = 0; i < 2; ++i) {
        const int k = (wid * 2 + i) * 2 + (lane >> 5), sl = lane & 31, ch = (((sl >> 2) ^ (k & 7)) << 2) | (sl & 3);
        const unsigned col = g.gu ? ((((ch >> 2) & 1) ? (unsigned)(g.B1 - g.B0) : 0u) + (g.n0 >> 1) + (ch >> 3) * 32 + (ch & 3) * 8) : (unsigned)(g.n0 + ch * 8);
        bvo[i] = (col + (unsigned)k * (unsigned)g.ldb) * 2u;
    }
    const __amdgpu_buffer_rsrc_t srA = __builtin_amdgcn_make_buffer_rsrc((void*)uniform_ptr(g.A), (short)0, 0x7ffffff0, 0x00020000);
    const __amdgpu_buffer_rsrc_t srB = __builtin_amdgcn_make_buffer_rsrc((void*)uniform_ptr(g.B0), (short)0, 0x7ffffff0, 0x00020000);
    const unsigned bstepb = 64u * (unsigned)g.ldb;
    float gu_w[MT], gu_rs[MT];
    if (EPI == EPI_GU) {
#pragma unroll
        for (int mt = 0; mt < MT; ++mt) { const int id = rowid[wm * 32 * MT + mt * 32 + r32]; gu_w[mt] = id >= 0 ? p.pw[id] : 0.f; gu_rs[mt] = id >= 0 ? p.rs[id >> 1] : 0.f; }
    } else if (EPI == EPI_IN_EVEN || EPI == EPI_IN_ODD) {
#pragma unroll
        for (int mt = 0; mt < MT; ++mt) gu_rs[mt] = p.rsm[g.m0 + wm * 32 * MT + mt * 32 + r32];
    }
    f32x16 acc[MT][2];
#pragma unroll
    for (int a = 0; a < MT; ++a)
#pragma unroll
        for (int b = 0; b < 2; ++b)
#pragma unroll
            for (int i = 0; i < 16; ++i) acc[a][b][i] = 0.f;
    const int nk = g.K / 32;
    const int arow0 = wm * 32 * MT + r32;
    const int asw = (r32 >> 2) & 3;
    const int g1 = (lane >> 4) & 1, qq = (lane & 15) >> 2, pp = lane & 3;
    const int bk0 = 8 * hh + qq;
    const unsigned ldsb = (unsigned)(size_t)(LDSAS char*)smem;
    const unsigned adst = (unsigned)__builtin_amdgcn_readfirstlane(ldsb + (wid * NA) * 1024), bdst = (unsigned)__builtin_amdgcn_readfirstlane(ldsb + 16384 + (wid * 2) * 1024);
#define G_LOAD(KT) do { const unsigned so_ = (unsigned)((KT) & 3) * 32768u, ka_ = (unsigned)(KT) * 64u, kb_ = (unsigned)(KT) * bstepb; \
        _Pragma("unroll") for (int i = 0; i < NA; ++i) { if (EPI == EPI_DOWN) bl_lds_sc1(avo[i], srA, ka_, adst + so_ + i * 1024); else bl_lds(avo[i], srA, ka_, adst + so_ + i * 1024); } \
        _Pragma("unroll") for (int i = 0; i < 2; ++i) bl_lds(bvo[i], srB, kb_, bdst + so_ + i * 1024); } while (0)
#define G_COMPUTE(KT) do { const char* Ac = smem + ((KT) & 3) * 32768; const char* Bc = Ac + 16384; \
        _Pragma("unroll") for (int st = 0; st < 2; ++st) { bf16x8 af[MT], bfv[2]; \
            _Pragma("unroll") for (int mt = 0; mt < MT; ++mt) af[mt] = *(const bf16x8*)(Ac + (arow0 + mt * 32) * 64 + (((2 * st + hh) ^ asw) << 4)); \
            _Pragma("unroll") for (int nt = 0; nt < 2; ++nt) { const int k = 16 * st + bk0; \
                const char* b0_ = Bc + k * 512 + (((wn * 2 + nt) ^ (k & 7)) << 6) + g1 * 32 + pp * 8; \
                const char* b1_ = Bc + (k + 4) * 512 + (((wn * 2 + nt) ^ ((k + 4) & 7)) << 6) + g1 * 32 + pp * 8; \
                const s16x4 lo = tr_read(b0_), hi = tr_read(b1_); \
                bfv[nt] = (bf16x8){lo[0], lo[1], lo[2], lo[3], hi[0], hi[1], hi[2], hi[3]}; } \
            _Pragma("unroll") for (int mt = 0; mt < MT; ++mt) _Pragma("unroll") for (int nt = 0; nt < 2; ++nt) acc[mt][nt] = MFMA32(bfv[nt], af[mt], acc[mt][nt]); } } while (0)
#define G_WAIT(N) do { if ((N) == 2) { if (IPT == 4) asm volatile("s_waitcnt vmcnt(8)" ::: "memory"); else asm volatile("s_waitcnt vmcnt(6)" ::: "memory"); } \
                       else if ((N) == 1) { if (IPT == 4) asm volatile("s_waitcnt vmcnt(4)" ::: "memory"); else asm volatile("s_waitcnt vmcnt(3)" ::: "memory"); } \
                       else asm volatile("s_waitcnt vmcnt(0)" ::: "memory"); } while (0)
    G_LOAD(0); G_LOAD(1); G_LOAD(2);
    G_WAIT(2); __syncthreads();
#pragma nounroll
    for (int kt = 0; kt < nk; ++kt) {
        if (kt + 3 < nk) G_LOAD(kt + 3);
        G_COMPUTE(kt);
        if (kt + 3 < nk) G_WAIT(2); else if (kt + 2 < nk) G_WAIT(1); else G_WAIT(0);
        __syncthreads();
    }
#undef G_LOAD
#undef G_COMPUTE
#undef G_WAIT
    const int colw = g.n0 + wn * 64;
    char* wsl = smem + wid * 16384;
    const int rowb = wm * 32 * MT;
    if (EPI == EPI_IN_EVEN || EPI == EPI_IN_ODD || EPI == EPI_DOWN) {
        const int region = colw >> 9;
        const float* gn = region == 0 ? p.att_q_norm : p.att_k_norm;
        const bool act = colw < 1024;
        const float qs = (colw >= 1024 && colw < 1536) ? QSCALE : 1.0f;
#pragma unroll
        for (int mt = 0; mt < MT; ++mt) {
            float sc = 1.f;
            if (EPI == EPI_IN_EVEN || EPI == EPI_IN_ODD) {
                const float rr_ = gu_rs[mt];
#pragma unroll
                for (int nt = 0; nt < 2; ++nt) acc[mt][nt] = acc[mt][nt] * rr_;
            }
            if (EPI == EPI_IN_EVEN && region < 2) {
                float ss = 0.f;
#pragma unroll
                for (int nt = 0; nt < 2; ++nt)
#pragma unroll
                    for (int i = 0; i < 16; ++i) ss += acc[mt][nt][i] * acc[mt][nt][i];
                auto rr = __builtin_amdgcn_permlane32_swap(__float_as_uint(ss), __float_as_uint(ss), false, false);
                ss = __uint_as_float(rr[0]) + __uint_as_float(rr[1]);
                sc = rsqrtf(ss * (1.0f / 64.0f) + EPS) * (region == 0 ? QSCALE : 1.0f);
            }
            float vsum = 0.f;
#pragma unroll
            for (int nt = 0; nt < 2; ++nt)
#pragma unroll
                for (int gq = 0; gq < 4; ++gq) {
                    f32x2 v0 = {acc[mt][nt][4 * gq], acc[mt][nt][4 * gq + 1]}, v1 = {acc[mt][nt][4 * gq + 2], acc[mt][nt][4 * gq + 3]};
                    if (EPI == EPI_IN_EVEN) { if (region < 2) { const f32x4 gg = *(const f32x4*)(gn + nt * 32 + 8 * gq + 4 * hh); v0.x *= sc * gg[0]; v0.y *= sc * gg[1]; v1.x *= sc * gg[2]; v1.y *= sc * gg[3]; } }
                    else if (EPI == EPI_IN_ODD) { if (act) { v0 = gelu_pk(v0); v1 = gelu_pk(v1); vsum += v0.x * v0.x + v0.y * v0.y + v1.x * v1.x + v1.y * v1.y; } else { v0 = v0 * qs; v1 = v1 * qs; } }
                    u32x2 w; w.x = pack2(v0.x, v0.y); w.y = pack2(v1.x, v1.y);
                    *(u32x2*)(wsl + r32 * 128 + (((nt * 4 + gq) ^ (r32 & 7)) << 4) + hh * 8) = w;
                }
            if (EPI == EPI_IN_ODD && colw >= 512 && colw < 1024) {
                auto rr = __builtin_amdgcn_permlane32_swap(__float_as_uint(vsum), __float_as_uint(vsum), false, false);
                vsum = __uint_as_float(rr[0]) + __uint_as_float(rr[1]);
                if (hh == 0) atomicAdd(p.vss + g.m0 + rowb + mt * 32 + r32, vsum);
            }
#pragma unroll
            for (int ps = 0; ps < 4; ++ps) {
                const int row = ps * 8 + (lane >> 3), chunk = lane & 7;
                const u32x4 v = *(const u32x4*)(wsl + row * 128 + ((chunk ^ (row & 7)) << 4));
                const int trow = rowb + mt * 32 + row;
                if (EPI == EPI_DOWN) { const int id = rowid[trow]; if (id >= 0) *(u32x4*)(p.y + (size_t)id * DM + colw + chunk * 8) = v; }
                else if (EPI == EPI_IN_EVEN) *(u32x4*)(p.proj + (size_t)(g.m0 + trow) * EVEN_IN + colw + chunk * 8) = v;
                else *(u32x4*)(p.proj + (size_t)(g.m0 + trow) * ODD_IN + colw + chunk * 8) = v;
            }
        }
    } else if (EPI == EPI_OUT) {
#pragma unroll
        for (int mt = 0; mt < MT; ++mt) {
            f32x4 rx[8]; u32x2 rh[8];
#pragma unroll
            for (int ps = 0; ps < 8; ++ps) {
                const size_t off = (size_t)(g.m0 + rowb + mt * 32 + ps * 4 + (lane >> 4)) * DM + colw + (lane & 15) * 4;
                if (layer == 0) rx[ps] = *(const f32x4*)(p.x + off); else rh[ps] = *(const u32x2*)(p.hb + off);
            }
#pragma unroll
            for (int nt = 0; nt < 2; ++nt)
#pragma unroll
                for (int gq = 0; gq < 4; ++gq) {
                    const f32x4 v = {acc[mt][nt][4 * gq], acc[mt][nt][4 * gq + 1], acc[mt][nt][4 * gq + 2], acc[mt][nt][4 * gq + 3]};
                    *(f32x4*)(wsl + r32 * 256 + (((nt * 8 + 2 * gq + hh) ^ (r32 & 15)) << 4)) = v;
                }
#pragma unroll
            for (int ps = 0; ps < 8; ++ps) {
                const int row = ps * 4 + (lane >> 4), chunk = lane & 15;
                const f32x4 v = *(const f32x4*)(wsl + row * 256 + ((chunk ^ (row & 15)) << 4));
                const size_t off = (size_t)(g.m0 + rowb + mt * 32 + row) * DM + colw + chunk * 4;
                f32x4 r;
                if (layer == 0) r = rx[ps];
                else r = (f32x4){__uint_as_float(rh[ps].x << 16), __uint_as_float(rh[ps].x & 0xffff0000u), __uint_as_float(rh[ps].y << 16), __uint_as_float(rh[ps].y & 0xffff0000u)};
                r = r + v;
                u32x2 w; w.x = pack2(r[0], r[1]); w.y = pack2(r[2], r[3]);
                *(u32x2*)(p.hb + off) = w;
            }
        }
    } else if (EPI == EPI_GU) {
        const int f0 = (g.n0 >> 1) + wn * 32;
#pragma unroll
        for (int mt = 0; mt < MT; ++mt) {
            const float w = gu_w[mt], rs = gu_rs[mt];
#pragma unroll
            for (int gq = 0; gq < 4; ++gq) {
                float h[4];
#pragma unroll
                for (int j = 0; j < 4; ++j) { const float gt = acc[mt][0][4 * gq + j] * rs, up = acc[mt][1][4 * gq + j] * (rs * w);
                    h[j] = gt * __builtin_amdgcn_rcpf(1.0f + __builtin_amdgcn_exp2f(-LOG2E * gt)) * up; }
                u32x2 ww; ww.x = pack2(h[0], h[1]); ww.y = pack2(h[2], h[3]);
                *(u32x2*)(wsl + r32 * 64 + ((gq ^ (r32 & 3)) << 4) + hh * 8) = ww;
            }
#pragma unroll
            for (int ps = 0; ps < 2; ++ps) {
                const int row = ps * 16 + (lane >> 2), chunk = lane & 3;
                const u32x4 v = *(const u32x4*)(wsl + row * 64 + ((chunk ^ (row & 3)) << 4));
                const int id2 = rowid[rowb + mt * 32 + row];
                if (id2 >= 0) st16_sc1(p.hid + (size_t)id2 * FF + f0 + chunk * 8, v);
            }
        }
        asm volatile("s_waitcnt vmcnt(0)" ::: "memory");
    }
    __syncthreads();
}

template <int EPI, int MT>
DI void ph_gemm_dense(const P& p, char* smem, const bf16_t* A, int lda, const bf16_t* B, int K, int N, int layer, int nt0, int ntc) {
    const int ntm = NTOK / (64 * MT), per_xcd = (ntm / 8) * ntc;
    const bool xcd = (gridDim.x & 7) == 0;
    const int x = blockIdx.x & 7, gx = gridDim.x >> 3;
    const int jend = xcd ? per_xcd : ntm * ntc, jstep = xcd ? gx : (int)gridDim.x;
    for (int j = xcd ? (int)(blockIdx.x >> 3) : (int)blockIdx.x; j < jend; j += jstep) {
        GemmArgs g; g.A = A; g.lda = lda; g.gather = nullptr; g.mvalid = 64 * MT; g.gshift = 0; g.rowid_ready = false; g.B0 = B; g.B1 = B; g.ldb = N; g.gu = 0; g.K = K;
        const int rot = ((j / jstep) & 1) * (ntc >> 1);
        g.m0 = ((xcd ? x * (ntm / 8) : 0) + j / ntc) * (64 * MT); g.n0 = (nt0 + (j % ntc + rot) % ntc) * 256;
        gemm_tile<EPI, MT>(p, smem, g, layer);
    }
}

DI void moe_locate(const int* cnt, int mt, int& e, int& c, int& mtl) {
    e = 0; c = 0;
    for (; e < NEXP; ++e) { c = cnt[e]; const int t = (c + 127) >> 7; if (mt < t) break; mt -= t; }
    mtl = mt;
}
DI void ph_moe(const P& p, char* smem, int layer) {
    const int* cnt = p.cnt + layer * NEXP;
    int* gdone = p.gdone + layer * 320;
    int* queue = p.gdone + 600 + layer;
    volatile int* s_next = (volatile int*)(smem + SMEM_BYTES + 80);
    int total = 0;
    for (int e = 0; e < NEXP; ++e) total += (cnt[e] + 127) >> 7;
    const int ngu = total * 2, nall = total * 6;
    int mine = 0;
    if (threadIdx.x == 0) mine = __hip_atomic_fetch_add(queue, 1, __ATOMIC_RELAXED, __HIP_MEMORY_SCOPE_AGENT);
    for (;;) {
        if (threadIdx.x == 0) s_next[0] = mine;
        __syncthreads();
        const int u = s_next[0];
        if (u >= nall) break;
        if (threadIdx.x == 0) mine = __hip_atomic_fetch_add(queue, 1, __ATOMIC_RELAXED, __HIP_MEMORY_SCOPE_AGENT);
        if (u < ngu) {
            int e, c, mt; moe_locate(cnt, u >> 1, e, c, mt);
            GemmArgs g; g.gather = p.plist + (size_t)e * LISTCAP + mt * 128; g.mvalid = c - mt * 128 < 128 ? c - mt * 128 : 128;
            g.m0 = 0; g.n0 = (u & 1) * 256;
            const size_t ex = (size_t)(layer * NEXP + e);
            g.rowid_ready = false; g.A = p.hb; g.lda = DM; g.gshift = 1; g.B0 = p.wb_gate + ex * DM * FF; g.B1 = p.wb_up + ex * DM * FF; g.ldb = FF; g.gu = 1; g.K = DM;
            gemm_tile<EPI_GU, 2>(p, smem, g, layer);
            if (threadIdx.x == 0) __hip_atomic_fetch_add(gdone + (u >> 1), 1, __ATOMIC_RELAXED, __HIP_MEMORY_SCOPE_AGENT);
        } else {
            const int v = u - ngu;
            int e, c, mt; moe_locate(cnt, v >> 2, e, c, mt);
            GemmArgs g; g.gather = p.plist + (size_t)e * LISTCAP + mt * 128; g.mvalid = c - mt * 128 < 128 ? c - mt * 128 : 128;
            {
                int* rowid = (int*)(smem + G_ROWID);
                const int rid = (threadIdx.x < 128 && (int)threadIdx.x < g.mvalid) ? g.gather[threadIdx.x] : -1;
                if (threadIdx.x == 0) { unsigned sp = 0;
                    while (__hip_atomic_load(gdone + (v >> 2), __ATOMIC_RELAXED, __HIP_MEMORY_SCOPE_AGENT) < 2) { __builtin_amdgcn_s_sleep(2); if (++sp > (1u << 22)) break; } }
                if (threadIdx.x < 128) rowid[threadIdx.x] = rid;
                __syncthreads();
            }
            g.m0 = 0; g.n0 = (v & 3) * 256;
            const size_t ex = (size_t)(layer * NEXP + e);
            g.rowid_ready = true; g.A = p.hid; g.lda = FF; g.gshift = 0; g.B0 = p.wb_down + ex * FF * DM; g.B1 = g.B0; g.ldb = DM; g.gu = 0; g.K = FF;
            gemm_tile<EPI_DOWN, 2>(p, smem, g, layer);
        }
    }
}

DI void convert_flat(const float* __restrict__ src, bf16_t* __restrict__ dst, size_t n8, const float* __restrict__ gain = nullptr, int rowlen = 1) {
    for (size_t i = (size_t)blockIdx.x * 512 + threadIdx.x; i < n8; i += (size_t)gridDim.x * 512) {
        f32x4 a = *(const f32x4*)(src + i * 8), b = *(const f32x4*)(src + i * 8 + 4);
        if (gain) { const float gk = gain[(i * 8) / (size_t)rowlen]; a = a * gk; b = b * gk; }
        u32x4 w; w.x = pack2(a[0], a[1]); w.y = pack2(a[2], a[3]); w.z = pack2(b[0], b[1]); w.w = pack2(b[2], b[3]);
        *(u32x4*)(dst + i * 8) = w;
    }
}
DI void poolfold_unit(const P& p, char* smem, int unit) {
    float (*At)[32] = (float (*)[32])smem;
    float (*Bs)[64] = (float (*)[64])(smem + 16384);
    const int tid = opaque_tid() & 255, g = unit >> 6, c0 = ((unit >> 4) & 3) * 32, n0 = (unit & 15) * 64;
    __syncthreads();
    for (int i = 0; i < 16; ++i) { const int idx = tid + 256 * i, d = idx >> 5, c = idx & 31;
        At[d][c] = p.pool_w[(size_t)(g * 128 + c0 + c) * 128 + d] * p.pool_scale[g * 128 + d]; }
    for (int i = 0; i < 8; ++i) { const int idx = tid + 256 * i, d = idx >> 4, n4 = (idx & 15) * 4;
        *(f32x4*)&Bs[d][n4] = *(const f32x4*)(p.w_out_even + (size_t)(512 + g * 128 + d) * DM + n0 + n4); }
    __syncthreads();
    const int tc = (tid >> 4) * 2, tn = (tid & 15) * 4;
    f32x4 acc[2] = {(f32x4){0.f, 0.f, 0.f, 0.f}, (f32x4){0.f, 0.f, 0.f, 0.f}};
#pragma unroll 8
    for (int d = 0; d < 128; ++d) {
        const f32x2 a = *(const f32x2*)&At[d][tc]; const f32x4 b = *(const f32x4*)&Bs[d][tn];
        acc[0] += a.x * b; acc[1] += a.y * b;
    }
#pragma unroll
    for (int i = 0; i < 2; ++i) { u32x2 w; w.x = pack2(acc[i][0], acc[i][1]); w.y = pack2(acc[i][2], acc[i][3]);
        *(u32x2*)(p.wb_out_even + (size_t)(512 + g * 128 + c0 + tc + i) * DM + n0 + tn) = w; }
}
DI void cast_rows2(const P& p, int tok, int lane) {
    f32x4 v[2][4];
#pragma unroll
    for (int r = 0; r < 2; ++r)
#pragma unroll
        for (int i = 0; i < 4; ++i) v[r][i] = *(const f32x4*)(p.x + (size_t)(tok + r) * DM + i * 256 + lane * 4);
#pragma unroll
    for (int r = 0; r < 2; ++r) {
        float ss = 0.f;
#pragma unroll
        for (int i = 0; i < 4; ++i) { ss += v[r][i][0] * v[r][i][0] + v[r][i][1] * v[r][i][1] + v[r][i][2] * v[r][i][2] + v[r][i][3] * v[r][i][3];
            u32x2 w; w.x = pack2(v[r][i][0], v[r][i][1]); w.y = pack2(v[r][i][2], v[r][i][3]);
            *(u32x2*)(p.hb + (size_t)(tok + r) * DM + i * 256 + lane * 4) = w; }
        ss = wave_sum(ss);
        if (lane == 0) p.rsm[tok + r] = rsqrtf(ss * (1.0f / DM) + EPS);
    }
}
DI void ph_prologue(const P& p, char* smem) {
    if (blockIdx.x == 0 && threadIdx.x < 64) p.cnt[threadIdx.x] = 0;
    if (blockIdx.x == 2 && threadIdx.x == 0) ((float*)p.ones)[0] = 1.0f;
    if (blockIdx.x == 1) for (int i = threadIdx.x; i < 640; i += 512) p.gdone[i] = 0;
    for (int i = blockIdx.x * 512 + threadIdx.x; i < NTOK; i += gridDim.x * 512) p.vss[i] = 0.f;
    for (int u = blockIdx.x; u < 128; u += gridDim.x) poolfold_unit(p, smem + (threadIdx.x >> 8) * HALF_LDS, u * 2 + (threadIdx.x >> 8));
    for (int i = blockIdx.x * 512 + threadIdx.x; i < 2 * 96 * DM; i += gridDim.x * 512) {
        const int k = i & (DM - 1), R = (i >> 10) % 96, layer = i / (96 * DM);
        const int T = R >> 5, r = R & 31, L = 16 * T + (r & 3) + 4 * (r >> 3);
        float w = 0.f;
        if (L < 32) w = p.w_re[((size_t)layer * DM + k) * 32 + L]; else if (L < 36) w = p.w_rg[((size_t)layer * DM + k) * 4 + (L - 32)];
        w *= p.ffn_norm[layer * DM + k];
        const unsigned hi = pack2(w, 0.f) & 0xffffu;
        p.wr_hi[i] = (bf16_t)hi; p.wr_lo[i] = (bf16_t)(pack2(w - __uint_as_float(hi << 16), 0.f) & 0xffffu);
    }
    const int wave = threadIdx.x >> 6, lane = threadIdx.x & 63;
    for (int u = blockIdx.x; u < NTOK / 16; u += gridDim.x) {
        const int tok = u * 16 + wave * 2;
        cast_rows2(p, tok, lane);
    }
    convert_flat(p.w_in_even, p.wb_in_even, (size_t)DM * EVEN_IN / 8, p.mix_norm_even, EVEN_IN);
    convert_flat(p.w_out_even, p.wb_out_even, (size_t)512 * DM / 8);
}
DI void convert_experts(const P& p, int layer) {
    const size_t o = (size_t)layer * NEXP * DM * FF;
    convert_flat(p.w_gate + o, p.wb_gate + o, (size_t)NEXP * DM * FF / 8);
    convert_flat(p.w_up + o, p.wb_up + o, (size_t)NEXP * DM * FF / 8);
    convert_flat(p.w_down + o, p.wb_down + o, (size_t)NEXP * DM * FF / 8);
}

DI int crow(int i, int h) { return (i & 3) + 8 * (i >> 2) + 4 * h; }
DI float swap_max(float v) { auto rr = __builtin_amdgcn_permlane32_swap(__float_as_uint(v), __float_as_uint(v), false, false); return fmaxf(__uint_as_float(rr[0]), __uint_as_float(rr[1])); }
DI float swap_sum(float v) { auto rr = __builtin_amdgcn_permlane32_swap(__float_as_uint(v), __float_as_uint(v), false, false); return __uint_as_float(rr[0]) + __uint_as_float(rr[1]); }
DI float bcast_lo(float v) { auto rr = __builtin_amdgcn_permlane32_swap(__float_as_uint(v), __float_as_uint(v), false, false); return __uint_as_float(rr[0]); }
DI bf16x8 pack8(const f32x16& x, int s) {
    u32x4 w; w.x = pack2(x[8 * s], x[8 * s + 1]); w.y = pack2(x[8 * s + 2], x[8 * s + 3]); w.z = pack2(x[8 * s + 4], x[8 * s + 5]); w.w = pack2(x[8 * s + 6], x[8 * s + 7]);
    return __builtin_bit_cast(bf16x8, w);
}
constexpr int KV_TILE = 8192;
struct KVStage { u32x4 k[2], v[2]; };
DI void kv_load(KVStage& st, const bf16_t* kbase, const bf16_t* vbase, int ld, int key0) {
    const int tid = opaque_tid() & 255, c = tid & 7, r0 = tid >> 3;
#pragma unroll
    for (int i = 0; i < 2; ++i) { const size_t off = (size_t)(key0 + r0 + 32 * i) * ld + c * 8; st.k[i] = *(const u32x4*)(kbase + off); st.v[i] = *(const u32x4*)(vbase + off); }
}
DI void kv_store(const KVStage& st, char* kt, char* vt) {
    const int tid = opaque_tid() & 255, c = tid & 7, r0 = tid >> 3;
#pragma unroll
    for (int i = 0; i < 2; ++i) { const int r = r0 + 32 * i;
        *(u32x4*)(kt + r * 128 + ((c ^ ((r >> 1) & 7)) << 4)) = st.k[i];
        *(u32x4*)(vt + r * 128 + ((((c >> 2) ^ ((r >> 1) & 1))) << 6) + ((c & 3) << 4)) = st.v[i]; }
}
DI bf16x8 k_frag(const char* kt, int sb, int st, int r32, int hh) {
    const int row = sb * 32 + r32;
    return *(const bf16x8*)(kt + row * 128 + (((2 * st + hh) ^ ((row >> 1) & 7)) << 4));
}
DI bf16x8 vt_frag(const char* vt, int sb, int st, int dh, int lane) {
    const int hh = lane >> 5, g1 = (lane >> 4) & 1, pp = lane & 3, q = (lane & 15) >> 2;
    const int key = sb * 32 + 16 * st + 4 * hh + q;
    const char* a = vt + key * 128 + ((dh ^ ((q >> 1) & 1)) << 6) + g1 * 32 + pp * 8;
    const s16x4 lo = tr_read(a), hi = tr_read(a + 8 * 128);
    return (bf16x8){lo[0], lo[1], lo[2], lo[3], hi[0], hi[1], hi[2], hi[3]};
}


#define XB_TMO      128
#define XB_XCNT(j)  (256  + 64 * (j))
#define XB_XSUB(j)  (1280 + 64 * (j))
#define XB_XGEN(j)  (2304 + 64 * (j))
#define XB_TOP      3328
#define XB_TOPGEN   3392
#define XCD_BAR_WORDS 3456
#define XB_SPIN_CAP (1u << 22)
DI unsigned xb_ld(unsigned* q)              { return __hip_atomic_load(q, __ATOMIC_RELAXED, __HIP_MEMORY_SCOPE_AGENT); }
DI unsigned xb_add(unsigned* q, unsigned v) { return __hip_atomic_fetch_add(q, v, __ATOMIC_RELAXED, __HIP_MEMORY_SCOPE_AGENT); }
DI unsigned xb_xcc_id() { return (unsigned)__builtin_amdgcn_s_getreg((3 << 11) | 20) & 0xFu; }
#define XB_SPIN(cond, bar) do { unsigned _sp = 0; while (cond) { __builtin_amdgcn_s_sleep(1); \
    if ((++_sp & 255u) == 0u) { if (xb_ld(&(bar)[XB_TMO])) break; if (_sp > XB_SPIN_CAP) { atomicAdd(&(bar)[XB_TMO], 1u); break; } } } } while (0)
struct XcdBarrier { unsigned* bar; unsigned x; volatile LDSAS unsigned* st; };
DI XcdBarrier xcd_barrier_post(unsigned* bar, volatile LDSAS unsigned* st) {
    XcdBarrier b; b.bar = bar; b.x = xb_xcc_id(); b.st = st;
    if (threadIdx.x == 0) (void)xb_add(&bar[XB_XCNT(b.x)], 1u);
    return b;
}
DI void xcd_barrier_complete(unsigned* bar, unsigned x, unsigned& nloc, unsigned& nx) {
    const unsigned G = gridDim.x * gridDim.y * gridDim.z;
    unsigned sum, cnt, mine, sp = 0u;
    for (;;) {
        sum = 0u; cnt = 0u; mine = 0u;
#pragma unroll
        for (unsigned j = 0; j < 16; ++j) { const unsigned c = xb_ld(&bar[XB_XCNT(j)]); sum += c; cnt += (c > 0u) ? 1u : 0u; mine = (j == x) ? c : mine; }
        if (sum == G) break;
        __builtin_amdgcn_s_sleep(1);
        if ((++sp & 255u) == 0u) { if (xb_ld(&bar[XB_TMO])) break; if (sp > XB_SPIN_CAP) { atomicAdd(&bar[XB_TMO], 1u); break; } }
    }
    nloc = mine > 0u ? mine : 1u; nx = cnt > 0u ? cnt : 1u;
}
DI void xcd_barrier(const XcdBarrier& b) {
    asm volatile("s_waitcnt vmcnt(0)" ::: "memory");
    __syncthreads();
    if (threadIdx.x == 0) {
        unsigned* bar = b.bar;
        __builtin_amdgcn_s_waitcnt(0);
        unsigned nloc = b.st[0], nx = b.st[1];
        if (nloc == 0u) { xcd_barrier_complete(bar, b.x, nloc, nx); b.st[0] = nloc; b.st[1] = nx; }
        const unsigned old = xb_add(&bar[XB_XSUB(b.x)], 1u);
        const unsigned gen = old / nloc;
        if (old + 1u == (gen + 1u) * nloc) {
            __builtin_amdgcn_fence(__ATOMIC_RELEASE, "agent");
            asm volatile("s_waitcnt vmcnt(0)" ::: "memory");
            const unsigned og = xb_add(&bar[XB_TOP], 1u);
            const unsigned tg = og / nx;
            if (og + 1u == (tg + 1u) * nx) xb_add(&bar[XB_TOPGEN], 1u);
            else XB_SPIN(xb_ld(&bar[XB_TOPGEN]) == tg, bar);
            __builtin_amdgcn_fence(__ATOMIC_ACQUIRE, "agent");
            xb_add(&bar[XB_XGEN(b.x)], 1u);
            asm volatile("s_waitcnt vmcnt(0)" ::: "memory");
        } else {
            XB_SPIN(xb_ld(&bar[XB_XGEN(b.x)]) == gen, bar);
            __builtin_amdgcn_fence(__ATOMIC_ACQUIRE, "agent");
            asm volatile("s_waitcnt vmcnt(0)" ::: "memory");
        }
    }
    __syncthreads();
}


struct ConvPlan { int layer; int sl_e, sl_in, sl_out, nslots; };
template <int NV> DI ConvPlan conv_plan(const P& p, int layer) {
    ConvPlan c; c.layer = layer;
    const unsigned per = gridDim.x * 512u, gsz = 4 * NV;
    c.sl_e = (int)((NEXP * DM * FF / gsz + per - 1) / per);
    c.sl_in = layer == 0 ? (int)((DM * ODD_IN / gsz + per - 1) / per) : 0;
    c.sl_out = layer == 0 ? (int)((DM * DM / gsz + per - 1) / per) : 0;
    c.nslots = 3 * c.sl_e + c.sl_in + c.sl_out;
    return c;
}
template <int NV> DI void conv_locate(const P& p, const ConvPlan& c, int slot, const float*& s, bf16_t*& d, const float*& gp) {
    constexpr unsigned gsz = 4 * NV;
    int seg = 0, ls = slot;
    if (ls < 3 * c.sl_e) { seg = ls / c.sl_e; ls -= seg * c.sl_e; }
    else if ((ls -= 3 * c.sl_e) < c.sl_in) seg = 3;
    else { ls -= c.sl_in; seg = 4; }
    const unsigned ng = seg < 3 ? NEXP * DM * FF / gsz : (seg == 3 ? DM * ODD_IN / gsz : DM * DM / gsz);
    const unsigned gi = ((unsigned)ls * gridDim.x + blockIdx.x) * 512u + threadIdx.x;
    const bool live = slot < c.nslots && gi < ng;
    const size_t e = live ? (size_t)gi * gsz : 0;
    const int tix = c.layer * 5 + __builtin_amdgcn_readfirstlane(seg);
    s = p.cs[tix] + e;
    d = live ? p.cd[tix] + e : p.dump + ((size_t)blockIdx.x * 512 + threadIdx.x) * 16;
    gp = p.ones;
    if (live && seg < 2) gp = p.ffn_norm + c.layer * DM + ((e >> 8) & (DM - 1));
    else if (live && seg == 3) gp = p.mix_norm_odd + e / ODD_IN;
}
#define CONV_DECL4(N) f32x4 N##0, N##1, N##2, N##3; float N##g; bf16_t* N##d
#define CONV_DECL2(N) f32x4 N##0, N##1; float N##g; bf16_t* N##d
#define CONV_LOAD4(N, SLOT) do { const float* s_; const float* g_; conv_locate<4>(p, cv, (SLOT), s_, N##d, g_); \
        N##g = *g_; N##0 = *(const f32x4*)s_; N##1 = *(const f32x4*)(s_ + 4); N##2 = *(const f32x4*)(s_ + 8); N##3 = *(const f32x4*)(s_ + 12); } while (0)
#define CONV_LOAD2(N, SLOT) do { const float* s_; const float* g_; conv_locate<2>(p, cv, (SLOT), s_, N##d, g_); \
        N##g = *g_; N##0 = *(const f32x4*)s_; N##1 = *(const f32x4*)(s_ + 4); } while (0)
#define CONV_STORE4(N) do { const f32x4 a_ = N##0 * N##g, b_ = N##1 * N##g, c_ = N##2 * N##g, e_ = N##3 * N##g; u32x4 w_; \
        w_.x = pack2(a_[0], a_[1]); w_.y = pack2(a_[2], a_[3]); w_.z = pack2(b_[0], b_[1]); w_.w = pack2(b_[2], b_[3]); *(u32x4*)N##d = w_; \
        w_.x = pack2(c_[0], c_[1]); w_.y = pack2(c_[2], c_[3]); w_.z = pack2(e_[0], e_[1]); w_.w = pack2(e_[2], e_[3]); *(u32x4*)(N##d + 8) = w_; } while (0)
#define CONV_STORE2(N) do { const f32x4 a_ = N##0 * N##g, b_ = N##1 * N##g; u32x4 w_; \
        w_.x = pack2(a_[0], a_[1]); w_.y = pack2(a_[2], a_[3]); w_.z = pack2(b_[0], b_[1]); w_.w = pack2(b_[2], b_[3]); *(u32x4*)N##d = w_; } while (0)

DI void band_attn_unit(const P& p, char* smem, int unit, const ConvPlan& cv, int& cslot) {
    const int tid = opaque_tid() & 255, lane = tid & 63, wid = tid >> 6, r32 = lane & 31, hh = lane >> 5;
    const int cp = unit & 31, h = (unit >> 5) & 7, b = unit >> 8;
    const int c = 2 * cp + (wid >> 1);
    const int tq = c * 64 + (wid & 1) * 32 + r32;
    const size_t rowb = (size_t)b * NS;
    const bf16_t* kbase = p.proj + rowb * EVEN_IN + 512 + h * 64;
    const bf16_t* vbase = p.proj + rowb * EVEN_IN + 1024 + h * 64;
    float* sbias = (float*)(smem + 4 * KV_TILE);
    __syncthreads();
    bf16x8 qf[4];
#pragma unroll
    for (int st = 0; st < 4; ++st) qf[st] = *(const bf16x8*)(p.proj + (rowb + tq) * EVEN_IN + h * 64 + st * 16 + hh * 8);
    const int ck0 = (2 * cp - 8) > 0 ? (2 * cp - 8) : 0, nt = 2 * cp + 2 - ck0;
    float m = -3.0e38f, lsum = 0.f;
    f32x16 o0, o1;
#pragma unroll
    for (int i = 0; i < 16; ++i) { o0[i] = 0.f; o1[i] = 0.f; }
    KVStage stg;
    kv_load(stg, kbase, vbase, EVEN_IN, ck0 * 64);
    {
        const float b0 = p.att_rel_bias[h * 257 + tid], b1 = p.att_rel_bias[h * 257 + 256];
        sbias[tid] = b0 * LOG2E; if (tid == 0) sbias[256] = b1 * LOG2E;
    }
    kv_store(stg, smem, smem + 2 * KV_TILE);
    __syncthreads();
    CONV_DECL4(cA); CONV_DECL4(cB);
    CONV_LOAD4(cA, cslot++); CONV_LOAD4(cB, cslot++);
#define BAND_ITER(it, CRX) do { \
        const int ck = ck0 + it, cur = it & 1; \
        kv_load(stg, kbase, vbase, EVEN_IN, ((it + 1 < nt) ? ck + 1 : ck) * 64); \
        CONV_STORE4(CRX); CONV_LOAD4(CRX, cslot++); \
        __builtin_amdgcn_sched_barrier(0); \
        const char* kt = smem + cur * KV_TILE; const char* vt = smem + (2 + cur) * KV_TILE; \
        if (ck >= c - 8 && ck <= c) { \
            f32x16 s0, s1; \
_Pragma("unroll") \
            for (int i = 0; i < 16; ++i) { s0[i] = 0.f; s1[i] = 0.f; } \
_Pragma("unroll") \
            for (int st = 0; st < 4; ++st) { s0 = MFMA32(k_frag(kt, 0, st, r32, hh), qf[st], s0); s1 = MFMA32(k_frag(kt, 1, st, r32, hh), qf[st], s1); } \
            if (c - ck >= 3) { const float bb = sbias[256]; \
_Pragma("unroll") \
                for (int i = 0; i < 16; ++i) { s0[i] += bb; s1[i] += bb; } \
            } else { \
                const int d0 = tq - ck * 64 - 4 * hh; \
_Pragma("unroll") \
                for (int i = 0; i < 16; ++i) { \
                    int da = d0 - ((i & 3) + 8 * (i >> 2)), db = da - 32; \
                    da = da > 128 ? 128 : da; db = db > 128 ? 128 : db; \
                    s0[i] += sbias[da + 128]; s1[i] += sbias[db + 128]; \
                } \
            } \
            float tm = fmaxf(s0[0], s1[0]); \
_Pragma("unroll") \
            for (int i = 1; i < 16; ++i) tm = fmaxf(tm, fmaxf(s0[i], s1[i])); \
            tm = swap_max(tm); \
            const float mn = fmaxf(m, tm); \
            const float alpha = __builtin_amdgcn_exp2f(m - mn); \
            m = mn; \
            float ps = 0.f; \
_Pragma("unroll") \
            for (int i = 0; i < 16; ++i) { s0[i] = __builtin_amdgcn_exp2f(s0[i] - mn); s1[i] = __builtin_amdgcn_exp2f(s1[i] - mn); ps += s0[i] + s1[i]; } \
            lsum = lsum * alpha + ps; \
_Pragma("unroll") \
            for (int i = 0; i < 16; ++i) { o0[i] *= alpha; o1[i] *= alpha; } \
_Pragma("unroll") \
            for (int st = 0; st < 2; ++st) { \
                const bf16x8 pa = pack8(s0, st), pb = pack8(s1, st); \
                o0 = MFMA32(vt_frag(vt, 0, st, 0, lane), pa, o0); o1 = MFMA32(vt_frag(vt, 0, st, 1, lane), pa, o1); \
                o0 = MFMA32(vt_frag(vt, 1, st, 0, lane), pb, o0); o1 = MFMA32(vt_frag(vt, 1, st, 1, lane), pb, o1); \
            } \
        } \
        __builtin_amdgcn_sched_barrier(0); \
        kv_store(stg, smem + (cur ^ 1) * KV_TILE, smem + (2 + (cur ^ 1)) * KV_TILE); \
        __syncthreads(); \
    } while (0)
    for (int it = 0; it < nt; it += 2) {
        BAND_ITER(it, cA);
        if (it + 1 >= nt) break;
        BAND_ITER(it + 1, cB);
    }
#undef BAND_ITER
    CONV_STORE4(cA); CONV_STORE4(cB);
    const float inv = 1.0f / swap_sum(lsum);
    bf16_t* orow = p.mixed + (rowb + tq) * DM + h * 64 + 4 * hh;
#pragma unroll
    for (int g = 0; g < 4; ++g) {
        u32x2 w0, w1;
        w0.x = pack2(o0[4 * g] * inv, o0[4 * g + 1] * inv); w0.y = pack2(o0[4 * g + 2] * inv, o0[4 * g + 3] * inv);
        w1.x = pack2(o1[4 * g] * inv, o1[4 * g + 1] * inv); w1.y = pack2(o1[4 * g + 2] * inv, o1[4 * g + 3] * inv);
        *(u32x2*)(orow + 8 * g) = w0; *(u32x2*)(orow + 32 + 8 * g) = w1;
    }
}

DI void sb_attn_unit(const P& p, char* smem, volatile int* wdone, int unit, const ConvPlan& cv, int& cslot) {
    const int tid8 = opaque_tid(), tid = tid8 & 255, lane = tid & 63, wid = tid >> 6, r32 = lane & 31, hh = lane >> 5, wid8 = tid8 >> 6;
    const int qb = unit & 31, h = (unit >> 5) & 7, b = unit >> 8;
    const int tw = qb * 128 + wid * 32, t = tw + r32;
    const size_t rowb = (size_t)b * NS;
    const bf16_t* kbase = p.proj + rowb * ODD_IN + 1536 + h * 64;
    const bf16_t* vbase = p.proj + rowb * ODD_IN + 2048 + h * 64;
    __syncthreads();
    bf16x8 qf[4];
#pragma unroll
    for (int st = 0; st < 4; ++st) qf[st] = *(const bf16x8*)(p.proj + (rowb + t) * ODD_IN + 1024 + h * 64 + st * 16 + hh * 8);
    bf16x8 tf[2];
#pragma unroll
    for (int st = 0; st < 2; ++st)
#pragma unroll
        for (int j = 0; j < 8; ++j) tf[st][j] = (16 * st + 8 * (j >> 2) + 4 * hh + (j & 3)) >= r32 ? (short)0x3F80 : (short)0;
    f32x16 o0, o1;
#pragma unroll
    for (int i = 0; i < 16; ++i) { o0[i] = 0.f; o1[i] = 0.f; }
    float carry = 0.f; bool done = false;
    const int kt0 = 2 * qb + 1;
    KVStage stg;
    kv_load(stg, kbase, vbase, ODD_IN, kt0 * 64);
    kv_store(stg, smem, smem + 2 * KV_TILE);
    __syncthreads();
    bool all_done = false;
    CONV_DECL2(cA);
    CONV_LOAD2(cA, cslot++);
#define SB_ITER(it, CRX) do { \
        const int kt = kt0 - it, cur = it & 1; \
        kv_load(stg, kbase, vbase, ODD_IN, (kt > 0 ? kt - 1 : 0) * 64); \
        CONV_STORE2(CRX); CONV_LOAD2(CRX, cslot++); \
        __builtin_amdgcn_sched_barrier(0); \
        const char* ktile = smem + cur * KV_TILE; const char* vtile = smem + (2 + cur) * KV_TILE; \
        if (!done && kt * 64 < tw + 31) { \
_Pragma("unroll") \
            for (int sbi = 0; sbi < 2; ++sbi) { \
                const int sb = 1 - sbi; \
                f32x16 x; \
_Pragma("unroll") \
                for (int i = 0; i < 16; ++i) x[i] = 0.f; \
_Pragma("unroll") \
                for (int st = 0; st < 4; ++st) x = MFMA32(k_frag(ktile, sb, st, r32, hh), qf[st], x); \
                const int kb = kt * 64 + sb * 32 + 4 * hh; \
                f32x16 L; \
_Pragma("unroll") \
                for (int i = 0; i < 16; ++i) { \
                    const bool valid = kb + (i & 3) + 8 * (i >> 2) < t; \
                    const float z = x[i]; \
                    const float sp = fmaxf(z, 0.f) + __builtin_amdgcn_logf(1.0f + __builtin_amdgcn_exp2f(-fabsf(z))); \
                    L[i] = valid ? -sp : 0.f; \
                    x[i] = valid ? z : -1.0e30f; \
                } \
                f32x16 cum; \
_Pragma("unroll") \
                for (int i = 0; i < 16; ++i) cum[i] = carry; \
_Pragma("unroll") \
                for (int st = 0; st < 2; ++st) cum = MFMA32(tf[st], pack8(L, st), cum); \
                carry = bcast_lo(cum[0]); \
_Pragma("unroll") \
                for (int i = 0; i < 16; ++i) x[i] = __builtin_amdgcn_exp2f(x[i] + cum[i]); \
_Pragma("unroll") \
                for (int st = 0; st < 2; ++st) { \
                    const bf16x8 pa = pack8(x, st); \
                    o0 = MFMA32(vt_frag(vtile, sb, st, 0, lane), pa, o0); o1 = MFMA32(vt_frag(vtile, sb, st, 1, lane), pa, o1); \
                } \
            } \
            done = __all(carry < -150.0f); \
        } \
        __builtin_amdgcn_sched_barrier(0); \
        if (lane == 0) wdone[cur * 8 + wid8] = done ? 1 : 0; \
        kv_store(stg, smem + (cur ^ 1) * KV_TILE, smem + (2 + (cur ^ 1)) * KV_TILE); \
        __syncthreads(); \
        all_done = (wdone[cur * 8] + wdone[cur * 8 + 1] + wdone[cur * 8 + 2] + wdone[cur * 8 + 3] + wdone[cur * 8 + 4] + wdone[cur * 8 + 5] + wdone[cur * 8 + 6] + wdone[cur * 8 + 7] == 8); \
    } while (0)
#pragma nounroll
    for (int it = 0; it <= kt0; ++it) {
        SB_ITER(it, cA);
        if (all_done) break;
    }
#undef SB_ITER
    CONV_STORE2(cA);
    bf16_t* orow = p.mixed + (rowb + t) * DM + 512 + h * 64 + 4 * hh;
#pragma unroll
    for (int g = 0; g < 4; ++g) {
        u32x2 w0, w1;
        w0.x = pack2(o0[4 * g], o0[4 * g + 1]); w0.y = pack2(o0[4 * g + 2], o0[4 * g + 3]);
        w1.x = pack2(o1[4 * g], o1[4 * g + 1]); w1.y = pack2(o1[4 * g + 2], o1[4 * g + 3]);
        *(u32x2*)(orow + 8 * g) = w0; *(u32x2*)(orow + 32 + 8 * g) = w1;
    }
}

DI void pool_items(const P& p) {
    for (int it = blockIdx.x * 512 + threadIdx.x; it < (NTOK / 8) * 64; it += gridDim.x * 512) {
        const int run = it >> 6, ch8 = it & 63, g = ch8 >> 4, w = 2 << g;
        const int tok0 = run * 8, s0 = tok0 & (NS - 1);
        const bf16_t* src = p.proj + (size_t)tok0 * EVEN_IN + 1536 + ch8 * 8;
        u32x4 rows[23];
#pragma unroll
        for (int k = 0; k < 23; ++k) { const int ds = k - 15; const bool ok = s0 + ds >= 0;
            rows[k] = *(const u32x4*)(src + (ptrdiff_t)(ok ? ds : 0) * EVEN_IN); if (!ok) rows[k] = (u32x4){0u, 0u, 0u, 0u}; }
        float sum[8], f[8];
#pragma unroll
        for (int j = 0; j < 8; ++j) sum[j] = 0.f;
#pragma unroll
        for (int k = 0; k < 15; ++k) { unpack8(rows[k], f); const float mk = (15 - k) < w ? 1.f : 0.f;
#pragma unroll
            for (int j = 0; j < 8; ++j) sum[j] += f[j] * mk; }
#pragma unroll
        for (int t = 0; t < 8; ++t) {
            unpack8(rows[15 + t], f);
#pragma unroll
            for (int j = 0; j < 8; ++j) sum[j] += f[j];
            const int s = s0 + t; const float inv = 1.0f / (float)((s + 1 < w) ? s + 1 : w);
            u32x4 o; o.x = pack2(sum[0] * inv - f[0], sum[1] * inv - f[1]); o.y = pack2(sum[2] * inv - f[2], sum[3] * inv - f[3]);
            o.z = pack2(sum[4] * inv - f[4], sum[5] * inv - f[5]); o.w = pack2(sum[6] * inv - f[6], sum[7] * inv - f[7]);
            *(u32x4*)(p.mixed + (size_t)(tok0 + t) * DM + 512 + ch8 * 8) = o;
            float d[8];
            const u32x4 r2 = rows[15 + t - 1], r4 = rows[15 + t - 3], r8 = rows[15 + t - 7], r16 = rows[t];
            const u32x4 rd = g == 0 ? r2 : (g == 1 ? r4 : (g == 2 ? r8 : r16));
            unpack8(rd, d);
#pragma unroll
            for (int j = 0; j < 8; ++j) sum[j] -= d[j];
        }
    }
}

DI void sgu_unit(const P& p, char* smem, int unit) {
    const int tid = opaque_tid() & 255, lane = tid & 63, wid = tid >> 6, wm = wid >> 1, wn = wid & 1, fr = lane & 15, fq = lane >> 4;
    const int g = unit & 3; const size_t tok0 = (size_t)(unit >> 2) * 128;
    char* As = smem; char* Gs = smem + 32768; float* srstd = (float*)(smem + 65536);
    __syncthreads();
    if (tid < 128) srstd[tid] = rsqrtf(p.vss[tok0 + tid] * (1.0f / 512.0f) + EPS);
#pragma unroll
    for (int i = 0; i < 8; ++i) {
        const int idx = tid + 256 * i, s = idx >> 4, ch = idx & 15;
        const u32x4 v = *(const u32x4*)(p.proj + (tok0 + s) * ODD_IN + 512 + g * 128 + ch * 8);
        *(u32x4*)(Gs + s * 256 + (((ch >> 1) ^ kswz(s)) << 5) + ((ch & 1) << 4)) = v;
    }
    __syncthreads();
#pragma unroll
    for (int i = 0; i < 8; ++i) {
        const int idx = tid + 256 * i, t = idx >> 4, c8 = idx & 15, s0 = c8 * 8;
        const float* wr = p.sgu_w + ((size_t)g * 128 + t) * 128 + s0;
        const f32x4 a = *(const f32x4*)wr, b = *(const f32x4*)(wr + 4);
        float f[8] = {a[0], a[1], a[2], a[3], b[0], b[1], b[2], b[3]};
#pragma unroll
        for (int j = 0; j < 8; ++j) f[j] = (s0 + j <= t) ? f[j] * srstd[s0 + j] : 0.f;
        u32x4 w; w.x = pack2(f[0], f[1]); w.y = pack2(f[2], f[3]); w.z = pack2(f[4], f[5]); w.w = pack2(f[6], f[7]);
        *(u32x4*)(As + (c8 >> 3) * 16384 + t * 128 + (((c8 & 7) ^ (t & 7)) << 4)) = w;
    }
    __syncthreads();
    f32x4 acc[4][4];
#pragma unroll
    for (int a = 0; a < 4; ++a)
#pragma unroll
        for (int b = 0; b < 4; ++b) acc[a][b] = (f32x4){0.f, 0.f, 0.f, 0.f};
    const int qq = fr >> 2, pp = fr & 3;
#pragma unroll
    for (int kt = 0; kt < 2; ++kt) {
        if (kt == 1 && wm == 0) continue;
#pragma unroll
        for (int s2 = 0; s2 < 2; ++s2) {
            bf16x8 af[4], bfv[4];
#pragma unroll
            for (int i = 0; i < 4; ++i) {
                const int ra_ = wm * 64 + i * 16 + fr;
                af[i] = *(const bf16x8*)(As + kt * 16384 + ra_ * 128 + (((s2 * 4 + fq) ^ (fr & 7)) << 4));
                const int srow = kt * 64 + s2 * 32 + 8 * fq + qq, blk = wn * 4 + i;
                const s16x4 lo = tr_read(Gs + srow * 256 + ((blk ^ kswz(srow)) << 5) + pp * 8);
                const s16x4 hi = tr_read(Gs + (srow + 4) * 256 + ((blk ^ kswz(srow + 4)) << 5) + pp * 8);
                bfv[i] = (bf16x8){lo[0], lo[1], lo[2], lo[3], hi[0], hi[1], hi[2], hi[3]};
            }
#pragma unroll
            for (int mi = 0; mi < 4; ++mi)
#pragma unroll
                for (int ni = 0; ni < 4; ++ni) acc[mi][ni] = MFMA16(bfv[ni], af[mi], acc[mi][ni]);
        }
    }
#pragma unroll
    for (int mi = 0; mi < 4; ++mi) {
        const int t = wm * 64 + mi * 16 + fr;
        const float bias = p.sgu_b[g * 128 + t];
#pragma unroll
        for (int ni = 0; ni < 4; ++ni) {
            const int c = g * 128 + wn * 64 + ni * 16 + fq * 4;
            const f32x4 gn = *(const f32x4*)(p.sgu_v_norm + c);
            const u32x2 uu = *(const u32x2*)(p.proj + (tok0 + t) * ODD_IN + c);
            const float u0 = __uint_as_float(uu.x << 16), u1 = __uint_as_float(uu.x & 0xffff0000u), u2 = __uint_as_float(uu.y << 16), u3 = __uint_as_float(uu.y & 0xffff0000u);
            const f32x4 a = acc[mi][ni];
            u32x2 w; w.x = pack2(u0 * (gn[0] * a[0] + bias), u1 * (gn[1] * a[1] + bias)); w.y = pack2(u2 * (gn[2] * a[2] + bias), u3 * (gn[3] * a[3] + bias));
            *(u32x2*)(p.mixed + (tok0 + t) * DM + c) = w;
        }
    }
}

DI void router_unit(const P& p, char* smem, int layer, int unit) {
    const int tid = opaque_tid() & 255, lane = tid & 63, wid = tid >> 6, r32 = lane & 31, hh = lane >> 5;
    float (*part)[36][32] = (float (*)[36][32])smem;
    float (*wss)[32] = (float (*)[32])(smem + 18432);
    int* lcnt = (int*)(smem + 18432 + 512);
    int* lbase = lcnt + 32;
    int* cnt = p.cnt + layer * NEXP;
    const int tok = unit * 32 + r32, kq = wid * 256 + 8 * hh;
    __syncthreads();
    if (tid < 32) lcnt[tid] = 0;
    const bf16_t* hrow = p.hb + (size_t)tok * DM + kq;
    const bf16_t* whi = p.wr_hi + ((size_t)layer * 96 + r32) * DM + kq;
    const bf16_t* wlo = p.wr_lo + ((size_t)layer * 96 + r32) * DM + kq;
    f32x16 c0, c1, c2;
#pragma unroll
    for (int i = 0; i < 16; ++i) { c0[i] = 0.f; c1[i] = 0.f; c2[i] = 0.f; }
    float ss = 0.f;
#pragma unroll 4
    for (int st = 0; st < 16; ++st) {
        const u32x4 hw = *(const u32x4*)(hrow + 16 * st);
        float f[8]; unpack8(hw, f);
#pragma unroll
        for (int j = 0; j < 8; ++j) ss += f[j] * f[j];
        const bf16x8 hhi = __builtin_bit_cast(bf16x8, hw);
        bf16x8 wh, wl;
        wh = *(const bf16x8*)(whi + 16 * st); wl = *(const bf16x8*)(wlo + 16 * st);
        c0 = MFMA32(wh, hhi, c0); c0 = MFMA32(wl, hhi, c0);
        wh = *(const bf16x8*)(whi + 32 * DM + 16 * st); wl = *(const bf16x8*)(wlo + 32 * DM + 16 * st);
        c1 = MFMA32(wh, hhi, c1); c1 = MFMA32(wl, hhi, c1);
        wh = *(const bf16x8*)(whi + 64 * DM + 16 * st); wl = *(const bf16x8*)(wlo + 64 * DM + 16 * st);
        c2 = MFMA32(wh, hhi, c2); c2 = MFMA32(wl, hhi, c2);
    }
    {
        auto rr = __builtin_amdgcn_permlane32_swap(__float_as_uint(ss), __float_as_uint(ss), false, false);
        ss = __uint_as_float(rr[0]) + __uint_as_float(rr[1]);
        if (hh == 0) {
#pragma unroll
            for (int i = 0; i < 16; ++i) { part[wid][i][r32] = c0[i]; part[wid][16 + i][r32] = c1[i]; }
#pragma unroll
            for (int i = 0; i < 4; ++i) part[wid][32 + i][r32] = c2[i];
            wss[wid][r32] = ss;
        }
    }
    __syncthreads();
    int e1 = 0, e2 = 0, r1 = 0, r2 = 0; float w1 = 0.f, w2 = 0.f, rstd = 0.f;
    const int mytok = unit * 32 + tid;
    if (tid < 32) {
        rstd = rsqrtf((wss[0][tid] + wss[1][tid] + wss[2][tid] + wss[3][tid]) * (1.0f / DM) + EPS);
        float gl[4], ev[8];
#pragma unroll
        for (int j = 0; j < 4; ++j) gl[j] = (part[0][32 + j][tid] + part[1][32 + j][tid] + part[2][32 + j][tid] + part[3][32 + j][tid]) * rstd;
        int gs = 0; float gm = gl[0];
#pragma unroll
        for (int j = 1; j < 4; ++j) if (gl[j] > gm) { gm = gl[j]; gs = j; }
        const float gw = 1.0f / (__expf(gl[0] - gm) + __expf(gl[1] - gm) + __expf(gl[2] - gm) + __expf(gl[3] - gm));
#pragma unroll
        for (int j = 0; j < 8; ++j) { const int s = gs * 8 + j; ev[j] = (part[0][s][tid] + part[1][s][tid] + part[2][s][tid] + part[3][s][tid]) * rstd; }
        int i1 = 0; float v1 = ev[0];
#pragma unroll
        for (int j = 1; j < 8; ++j) if (ev[j] > v1) { v1 = ev[j]; i1 = j; }
        int i2 = -1; float v2 = -3.0e38f;
#pragma unroll
        for (int j = 0; j < 8; ++j) if (j != i1 && ev[j] > v2) { v2 = ev[j]; i2 = j; }
        w1 = 1.0f / (1.0f + __expf(v2 - v1)); w2 = (1.0f - w1) * gw; w1 *= gw;
        e1 = gs * 8 + i1; e2 = gs * 8 + i2;
        r1 = atomicAdd(lcnt + e1, 1); r2 = atomicAdd(lcnt + e2, 1);
    }
    __syncthreads();
    if (tid < 32) { const int n = lcnt[tid]; lbase[tid] = n ? atomicAdd(cnt + tid, n) : 0; }
    __syncthreads();
    if (tid < 32) {
        p.plist[(size_t)e1 * LISTCAP + lbase[e1] + r1] = mytok * 2; p.plist[(size_t)e2 * LISTCAP + lbase[e2] + r2] = mytok * 2 + 1;
        p.pw[mytok * 2] = w1; p.pw[mytok * 2 + 1] = w2; p.rs[mytok] = rstd;
    }
}
DI void ph_combine(const P& p, int layer) {
    const int wave = threadIdx.x >> 6, lane = threadIdx.x & 63;
    for (int u = blockIdx.x; u < NTOK / 16; u += gridDim.x) {
        const size_t tok0 = (size_t)u * 16 + wave * 2;
        u32x2 hv[2][4], ya[2][4], yb[2][4];
#pragma unroll
        for (int r = 0; r < 2; ++r)
#pragma unroll
            for (int i = 0; i < 4; ++i) {
                const int c = i * 256 + lane * 4;
                hv[r][i] = *(const u32x2*)(p.hb + (tok0 + r) * DM + c);
                ya[r][i] = *(const u32x2*)(p.y + ((tok0 + r) * 2) * DM + c); yb[r][i] = *(const u32x2*)(p.y + ((tok0 + r) * 2 + 1) * DM + c);
            }
#pragma unroll
        for (int r = 0; r < 2; ++r) {
            float ss = 0.f;
#pragma unroll
            for (int i = 0; i < 4; ++i) {
                const u32x2 h0 = hv[r][i], a = ya[r][i], b = yb[r][i];
                f32x4 h;
                h[0] = __uint_as_float(h0.x << 16) + __uint_as_float(a.x << 16) + __uint_as_float(b.x << 16);
                h[1] = __uint_as_float(h0.x & 0xffff0000u) + __uint_as_float(a.x & 0xffff0000u) + __uint_as_float(b.x & 0xffff0000u);
                h[2] = __uint_as_float(h0.y << 16) + __uint_as_float(a.y << 16) + __uint_as_float(b.y << 16);
                h[3] = __uint_as_float(h0.y & 0xffff0000u) + __uint_as_float(a.y & 0xffff0000u) + __uint_as_float(b.y & 0xffff0000u);
                ss += h[0] * h[0] + h[1] * h[1] + h[2] * h[2] + h[3] * h[3];
                if (layer == 0) { u32x2 w; w.x = pack2(h[0], h[1]); w.y = pack2(h[2], h[3]); *(u32x2*)(p.hb + (tok0 + r) * DM + i * 256 + lane * 4) = w; }
                else *(f32x4*)(p.out + (tok0 + r) * DM + i * 256 + lane * 4) = h;
            }
            if (layer == 0) { ss = wave_sum(ss); if (lane == 0) p.rsm[tok0 + r] = rsqrtf(ss * (1.0f / DM) + EPS); }
        }
    }
}

DI void ph_mix_even(const P& p, char* smem) {
    const int half = threadIdx.x >> 8;
    const ConvPlan cv = conv_plan<4>(p, 0); int cslot = 0;
    const bool xcd = gridDim.x == 256;
    for (int u0 = blockIdx.x; u0 < NB * 4 * 32; u0 += gridDim.x) {
        const int u = xcd ? (((u0 & 7) * 2 + ((u0 >> 8) & 1)) << 5) | ((u0 >> 3) & 31) : u0;
        const int cp = u & 31, hp = (u >> 5) & 3, b = u >> 7;
        band_attn_unit(p, smem + half * HALF_LDS, (b << 8) | ((hp * 2 + half) << 5) | cp, cv, cslot);
    }
    for (; cslot < cv.nslots; ++cslot) { CONV_DECL4(cR); CONV_LOAD4(cR, cslot); CONV_STORE4(cR); }
    pool_items(p);
}
DI void ph_mix_odd(const P& p, char* smem) {
    const int half = threadIdx.x >> 8;
    volatile int* wdone = (volatile int*)(smem + 2 * HALF_LDS);
    const ConvPlan cv = conv_plan<2>(p, 1); int cslot = 0;
    const bool xcd = gridDim.x == 256;
    for (int u0 = blockIdx.x; u0 < NB * 4 * 32; u0 += gridDim.x) {
        const int grp = xcd ? (u0 & 7) * 2 + ((u0 >> 8) & 1) : (u0 & 15), qb = xcd ? 31 - ((u0 >> 3) & 31) : 31 - (u0 >> 4);
        const int hp = grp & 3, b = grp >> 2;
        sb_attn_unit(p, smem + half * HALF_LDS, wdone, (b << 8) | ((hp * 2 + half) << 5) | qb, cv, cslot);
    }
    for (; cslot < cv.nslots; ++cslot) { CONV_DECL2(cR); CONV_LOAD2(cR, cslot); CONV_STORE2(cR); }
    for (int u = blockIdx.x; u < (NTOK / 128) * 2; u += gridDim.x) sgu_unit(p, smem + half * HALF_LDS, u * 2 + half);
}
DI void ph_router(const P& p, char* smem, int layer) {
    const int half = threadIdx.x >> 8;
    for (int u = blockIdx.x; u < NTOK / 64; u += gridDim.x) router_unit(p, smem + half * HALF_LDS, layer, u * 2 + half);
}

constexpr int NPHASE = 13;
#ifndef REPS
#define REPS {1,1,1,1,1,1,1,1,1,1,1,1,1}
#endif
__device__ constexpr int REP[13] = REPS;
__global__ __launch_bounds__(512, 2) void mega(P p, int ph0, int ph1) {
    __shared__ __attribute__((aligned(16))) char smem[SMEM_BYTES + 64 + 16 + 16];
    volatile LDSAS unsigned* xst = (volatile LDSAS unsigned*)(smem + SMEM_BYTES + 64);
    if (threadIdx.x < 4) xst[threadIdx.x] = 0u;
    __syncthreads();
    const XcdBarrier xb = xcd_barrier_post(p.bar, xst);
#define PHASE(i, call) if (ph0 <= (i) && (i) < ph1) { for (int r_ = 0; r_ < REP[i]; ++r_) { call; if (r_ + 1 < REP[i] || (i) + 1 < ph1) xcd_barrier(xb); } }
    PHASE(0, ph_prologue(p, smem))
    PHASE(1, (ph_gemm_dense<EPI_IN_EVEN, 4>(p, smem, p.hb, DM, p.wb_in_even, DM, EVEN_IN, 0, 0, 8)))
    PHASE(2, ph_mix_even(p, smem))
    PHASE(3, (ph_gemm_dense<EPI_OUT, 4>(p, smem, p.mixed, DM, p.wb_out_even, DM, DM, 0, 0, 4)))
    PHASE(4, ph_router(p, smem, 0))
    PHASE(5, ph_moe(p, smem, 0))
    PHASE(6, ph_combine(p, 0))
    PHASE(7, (ph_gemm_dense<EPI_IN_ODD, 4>(p, smem, p.hb, DM, p.wb_in_odd, DM, ODD_IN, 1, 0, 8), ph_gemm_dense<EPI_IN_ODD, 2>(p, smem, p.hb, DM, p.wb_in_odd, DM, ODD_IN, 1, 8, 2)))
    PHASE(8, ph_mix_odd(p, smem))
    PHASE(9, (ph_gemm_dense<EPI_OUT, 4>(p, smem, p.mixed, DM, p.wb_out_odd, DM, DM, 1, 0, 4)))
    PHASE(10, ph_router(p, smem, 1))
    PHASE(11, ph_moe(p, smem, 1))
    PHASE(12, ph_combine(p, 1))
}

extern "C" void kernel_launch(void* const* d_in, const int* in_sizes, int n_in, void* d_out, int out_size, void* d_ws, size_t ws_size, hipStream_t stream) {
    P p{};
    p.x = (const float*)d_in[0]; p.mix_norm_even = (const float*)d_in[1]; p.w_in_even = (const float*)d_in[2]; p.att_q_norm = (const float*)d_in[3];
    p.att_k_norm = (const float*)d_in[4]; p.att_rel_bias = (const float*)d_in[5]; p.pool_w = (const float*)d_in[6]; p.pool_scale = (const float*)d_in[7];
    p.w_out_even = (const float*)d_in[8]; p.mix_norm_odd = (const float*)d_in[9]; p.w_in_odd = (const float*)d_in[10]; p.sgu_v_norm = (const float*)d_in[11];
    p.sgu_w = (const float*)d_in[12]; p.sgu_b = (const float*)d_in[13]; p.w_out_odd = (const float*)d_in[14]; p.ffn_norm = (const float*)d_in[15];
    p.w_rg = (const float*)d_in[16]; p.w_re = (const float*)d_in[17]; p.w_gate = (const float*)d_in[18]; p.w_up = (const float*)d_in[19]; p.w_down = (const float*)d_in[20];
    p.out = (float*)d_out;
    char* ws = (char*)d_ws; size_t off = 0;
    auto take = [&](size_t bytes) { char* r = ws + off; off += (bytes + 255) & ~(size_t)255; return r; };
    p.wb_in_even = (bf16_t*)take((size_t)EVEN_IN * DM * 2);
    p.wb_out_even = (bf16_t*)take((size_t)DM * DM * 2);
    p.wb_in_odd = (bf16_t*)take((size_t)ODD_IN * DM * 2);
    p.wb_out_odd = (bf16_t*)take((size_t)DM * DM * 2);
    p.wb_gate = (bf16_t*)take((size_t)2 * NEXP * DM * FF * 2);
    p.wb_up = (bf16_t*)take((size_t)2 * NEXP * DM * FF * 2);
    p.wb_down = (bf16_t*)take((size_t)2 * NEXP * DM * FF * 2);
    p.wr_hi = (bf16_t*)take((size_t)2 * 96 * DM * 2);
    p.wr_lo = (bf16_t*)take((size_t)2 * 96 * DM * 2);
    p.hb = (bf16_t*)take((size_t)NTOK * DM * 2);
    p.proj = (bf16_t*)take((size_t)NTOK * ODD_IN * 2);
    p.y = p.proj;
    p.mixed = (bf16_t*)take((size_t)NTOK * DM * 2);
    p.hid = p.mixed;
    p.pw = (float*)take((size_t)NTOK * 2 * 4);
    p.rs = (float*)take((size_t)NTOK * 4);
    p.rsm = (float*)take((size_t)NTOK * 4);
    p.vss = (float*)take((size_t)NTOK * 4);
    p.plist = (int*)take((size_t)NEXP * LISTCAP * 4);
    p.cnt = (int*)take(256);
    p.ones = (const float*)take(256);
    p.dump = (bf16_t*)take((size_t)512 * 512 * 32);
    p.gdone = (int*)take(640 * 4);
    p.bar = (unsigned*)take(XCD_BAR_WORDS * 4);
    (void)hipMemsetAsync(p.bar, 0, XCD_BAR_WORDS * 4, stream);
    for (int l = 0; l < 2; ++l) {
        const size_t o = (size_t)l * NEXP * DM * FF;
        p.cs[l * 5 + 0] = p.w_gate + o; p.cd[l * 5 + 0] = p.wb_gate + o;
        p.cs[l * 5 + 1] = p.w_up + o;   p.cd[l * 5 + 1] = p.wb_up + o;
        p.cs[l * 5 + 2] = p.w_down + o; p.cd[l * 5 + 2] = p.wb_down + o;
        p.cs[l * 5 + 3] = p.w_in_odd;   p.cd[l * 5 + 3] = p.wb_in_odd;
        p.cs[l * 5 + 4] = p.w_out_odd;  p.cd[l * 5 + 4] = p.wb_out_odd;
    }

    static int grid_blocks = 0;
    if (!grid_blocks) {
        int dev = 0, cus = 0, per_cu = 0;
        (void)hipGetDevice(&dev);
        (void)hipDeviceGetAttribute(&cus, hipDeviceAttributeMultiprocessorCount, dev);
        (void)hipOccupancyMaxActiveBlocksPerMultiprocessor(&per_cu, mega, 512, 0);
        if (per_cu < 1) per_cu = 1;
        grid_blocks = cus;
    }
    int ph0 = 0, ph1 = NPHASE;
    void* args[] = {&p, &ph0, &ph1};
    hipError_t e = hipLaunchCooperativeKernel((void*)mega, dim3(grid_blocks), dim3(512), args, 0, stream);
    if (e != hipSuccess) fprintf(stderr, "cooperative launch failed: %s (grid %d)\n", hipGetErrorString(e), grid_blocks);
}
```

```cpp
#include <hip/hip_runtime.h>
#include <hip/hip_cooperative_groups.h>
#include <stdint.h>
#include <stdio.h>

typedef unsigned short bf16_t;
typedef short bf16x8 __attribute__((ext_vector_type(8)));
typedef short s16x4 __attribute__((ext_vector_type(4)));
typedef float f32x2 __attribute__((ext_vector_type(2)));
typedef float f32x4 __attribute__((ext_vector_type(4)));
typedef float f32x16 __attribute__((ext_vector_type(16)));
typedef unsigned u32x4 __attribute__((ext_vector_type(4)));
typedef unsigned u32x2 __attribute__((ext_vector_type(2)));
typedef __bf16 bf16x2n __attribute__((ext_vector_type(2)));

#define DI __device__ __forceinline__
#define LDSAS __attribute__((address_space(3)))
#define MFMA32(a, b, c) __builtin_amdgcn_mfma_f32_32x32x16_bf16((a), (b), (c), 0, 0, 0)
#define MFMA16(a, b, c) __builtin_amdgcn_mfma_f32_16x16x32_bf16((a), (b), (c), 0, 0, 0)

constexpr int NB = 4, NS = 4096, NTOK = NB * NS, DM = 1024;
constexpr int EVEN_IN = 2048, ODD_IN = 2560;
constexpr int NEXP = 32, FF = 256;
constexpr int LISTCAP = NTOK;
constexpr float EPS = 1e-6f;
constexpr float LOG2E = 1.4426950408889634f;
constexpr float QSCALE = 0.125f * LOG2E;

DI int opaque_tid() { int t = threadIdx.x; asm volatile("" : "+v"(t)); return t; }
DI int band_unit(int u0, int U) { return gridDim.x == 256 ? (u0 & 7) * (U >> 3) + (((u0 >> 8) << 5) | ((u0 >> 3) & 31)) : u0; }
DI float bf2f(bf16_t b) { return __uint_as_float(((unsigned)b) << 16); }
DI unsigned pack2(float lo, float hi) { f32x2 v = {lo, hi}; bf16x2n r = __builtin_convertvector(v, bf16x2n); return __builtin_bit_cast(unsigned, r); }
DI float wave_sum(float v) { for (int o = 32; o > 0; o >>= 1) v += __shfl_xor(v, o); return v; }
DI float gelu_exact(float x) { return 0.5f * x * (1.0f + erff(x * 0.70710678118654752f)); }
DI s16x4 tr_read(const char* p) { return __builtin_bit_cast(s16x4, __builtin_amdgcn_ds_read_tr16_b64_v4i16((LDSAS s16x4*)p)); }
DI void unpack8(const u32x4 v, float* f) {
    f[0] = __uint_as_float(v.x << 16); f[1] = __uint_as_float(v.x & 0xffff0000u); f[2] = __uint_as_float(v.y << 16); f[3] = __uint_as_float(v.y & 0xffff0000u);
    f[4] = __uint_as_float(v.z << 16); f[5] = __uint_as_float(v.z & 0xffff0000u); f[6] = __uint_as_float(v.w << 16); f[7] = __uint_as_float(v.w & 0xffff0000u);
}
DI int kswz(int k) { return (k & 3) | ((k >> 1) & 4); }

struct P {
    const float *x, *mix_norm_even, *w_in_even, *att_q_norm, *att_k_norm, *att_rel_bias, *pool_w, *pool_scale, *w_out_even;
    const float *mix_norm_odd, *w_in_odd, *sgu_v_norm, *sgu_w, *sgu_b, *w_out_odd, *ffn_norm, *w_rg, *w_re, *w_gate, *w_up, *w_down;
    float* out;
    bf16_t *wb_in_even, *wb_out_even, *wb_in_odd, *wb_out_odd, *wb_gate, *wb_up, *wb_down, *wr_hi, *wr_lo;
    bf16_t *hb, *proj, *mixed, *hid, *y;
    float *pw, *rs, *rsm, *vss; int* plist; int* cnt; unsigned* bar; int* gdone;
    const float* cs[10]; bf16_t* cd[10]; const float* ones; bf16_t* dump;
};

enum { EPI_IN_EVEN = 0, EPI_IN_ODD = 1, EPI_OUT = 2, EPI_GU = 3, EPI_DOWN = 4 };
constexpr int G_ROWID = 131072;
constexpr int SMEM_BYTES = 131072 + 1024;
constexpr int HALF_LDS = 66048;

struct GemmArgs {
    const bf16_t* A; int lda; const int* gather; int mvalid; int gshift;
    const bf16_t* B0; const bf16_t* B1; int ldb; int gu;
    int K, m0, n0;
    bool rowid_ready;
};

DI f32x2 gelu_pk(f32x2 v) {
    const f32x2 av = __builtin_elementwise_abs(v), d = av * 0.2316418882f + 1.0f;
    f32x2 t; t.x = __builtin_amdgcn_rcpf(d.x); t.y = __builtin_amdgcn_rcpf(d.y);
    f32x2 q = t * 0.5307027145f + (-0.7265760135f); q = q * t + 0.7107068705f; q = q * t + (-0.142248368f); q = q * t + 0.127414796f; q = q * t;
    const f32x2 s = (v * v) * (-0.72134752044f);
    f32x2 e; e.x = __builtin_amdgcn_exp2f(s.x); e.y = __builtin_amdgcn_exp2f(s.y);
    const f32x2 m = v * (q * e), r = v - m;
    f32x2 o; o.x = v.x < 0.f ? m.x : r.x; o.y = v.y < 0.f ? m.y : r.y; return o;
}

DI void glds16(const void* gsrc, unsigned lds_dst) {
    unsigned keep;
    asm volatile("s_mov_b32 %0, m0\n\ts_mov_b32 m0, %2\n\ts_nop 0\n\tglobal_load_lds_dwordx4 %1, off\n\ts_mov_b32 m0, %0" : "=&s"(keep) : "v"(gsrc), "s"(lds_dst) : "memory");
}
DI void glds16_sc1(const void* gsrc, unsigned lds_dst) {
    unsigned keep;
    asm volatile("s_mov_b32 %0, m0\n\ts_mov_b32 m0, %2\n\ts_nop 0\n\tglobal_load_lds_dwordx4 %1, off sc1\n\ts_mov_b32 m0, %0" : "=&s"(keep) : "v"(gsrc), "s"(lds_dst) : "memory");
}
DI void st16_sc1(void* q, u32x4 v) { asm volatile("global_store_dwordx4 %0, %1, off sc1\n\ts_nop 1" :: "v"(q), "v"(v) : "memory"); }
DI void bl_lds(unsigned voff, __amdgpu_buffer_rsrc_t rs, unsigned soff, unsigned m0v) {
    unsigned keep;
    asm volatile("s_mov_b32 %0, m0\n\ts_mov_b32 m0, %1\n\ts_nop 0\n\tbuffer_load_dwordx4 %2, %3, %4 offen lds\n\ts_mov_b32 m0, %0" : "=&s"(keep) : "s"(m0v), "v"(voff), "s"(rs), "s"(soff) : "memory");
}
DI void bl_lds_sc1(unsigned voff, __amdgpu_buffer_rsrc_t rs, unsigned soff, unsigned m0v) {
    unsigned keep;
    asm volatile("s_mov_b32 %0, m0\n\ts_mov_b32 m0, %1\n\ts_nop 0\n\tbuffer_load_dwordx4 %2, %3, %4 offen sc1 lds\n\ts_mov_b32 m0, %0" : "=&s"(keep) : "s"(m0v), "v"(voff), "s"(rs), "s"(soff) : "memory");
}
DI const void* uniform_ptr(const void* q) {
    const unsigned long long v = (unsigned long long)q;
    const unsigned lo = (unsigned)__builtin_amdgcn_readfirstlane((int)(unsigned)v), hi = (unsigned)__builtin_amdgcn_readfirstlane((int)(unsigned)(v >> 32));
    return (const void*)(((unsigned long long)hi << 32) | lo);
}
template <int EPI, int MT>
DI void gemm_tile(const P& p, char* smem, const GemmArgs& g, int layer) {
    const int tid = opaque_tid(), lane = tid & 63, wid = tid >> 6, wm = wid >> 2, wn = wid & 3, r32 = lane & 31, hh = lane >> 5;
    int* rowid = (int*)(smem + G_ROWID);
    constexpr int NA = MT / 2;
    constexpr int IPT = NA + 2;
    unsigned avo[NA], bvo[2];
    if (g.gather && !g.rowid_ready) { if (tid < 64 * MT) rowid[tid] = (tid < g.mvalid) ? g.gather[tid] : -1; __syncthreads(); }
#pragma unroll
    for (int i = 0; i < NA; ++i) {
        const int r = (wid * NA + i) * 16 + (lane >> 2), kc = (lane & 3) ^ ((r >> 2) & 3);
        unsigned arow;
        if (g.gather) { int id = rowid[r]; if (id < 0) id = rowid[0]; arow = (unsigned)(id >> g.gshift); } else arow = (unsigned)(g.m0 + r);
        avo[i] = (arow * (unsigned)g.lda + kc * 8) * 2u;
    }
#pragma unroll
    for (int i = 0; i < 2; ++i) {
        const int k = (wid * 2 + i) * 2 + (lane >> 5), sl = lane & 31, ch = (((sl >> 2) ^ (k & 7)) << 2) | (sl & 3);
        const unsigned col = g.gu ? ((((ch >> 2) & 1) ? (unsigned)(g.B1 - g.B0) : 0u) + (g.n0 >> 1) + (ch >> 3) * 32 + (ch & 3) * 8) : (unsigned)(g.n0 + ch * 8);
        bvo[i] = (col + (unsigned)k * (unsigned)g.ldb) * 2u;
    }
    const __amdgpu_buffer_rsrc_t srA = __builtin_amdgcn_make_buffer_rsrc((void*)uniform_ptr(g.A), (short)0, 0x7ffffff0, 0x00020000);
    const __amdgpu_buffer_rsrc_t srB = __builtin_amdgcn_make_buffer_rsrc((void*)uniform_ptr(g.B0), (short)0, 0x7ffffff0, 0x00020000);
    const unsigned bstepb = 64u * (unsigned)g.ldb;
    float gu_w[MT], gu_rs[MT];
    if (EPI == EPI_GU) {
#pragma unroll
        for (int mt = 0; mt < MT; ++mt) { const int id = rowid[wm * 32 * MT + mt * 32 + r32]; gu_w[mt] = id >= 0 ? p.pw[id] : 0.f; gu_rs[mt] = id >= 0 ? p.rs[id >> 1] : 0.f; }
    } else if (EPI == EPI_IN_EVEN || EPI == EPI_IN_ODD) {
#pragma unroll
        for (int mt = 0; mt < MT; ++mt) gu_rs[mt] = p.rsm[g.m0 + wm * 32 * MT + mt * 32 + r32];
    }
    f32x16 acc[MT][2];
#pragma unroll
    for (int a = 0; a < MT; ++a)
#pragma unroll
        for (int b = 0; b < 2; ++b)
#pragma unroll
            for (int i = 0; i < 16; ++i) acc[a][b][i] = 0.f;
    const int nk = g.K / 32;
    const int arow0 = wm * 32 * MT + r32;
    const int asw = (r32 >> 2) & 3;
    const int g1 = (lane >> 4) & 1, qq = (lane & 15) >> 2, pp = lane & 3;
    const int bk0 = 8 * hh + qq;
    const unsigned ldsb = (unsigned)(size_t)(LDSAS char*)smem;
    const unsigned adst = (unsigned)__builtin_amdgcn_readfirstlane(ldsb + (wid * NA) * 1024), bdst = (unsigned)__builtin_amdgcn_readfirstlane(ldsb + 16384 + (wid * 2) * 1024);
#define G_LOAD(KT) do { const unsigned so_ = (unsigned)((KT) & 3) * 32768u, ka_ = (unsigned)(KT) * 64u, kb_ = (unsigned)(KT) * bstepb; \
        _Pragma("unroll") for (int i = 0; i < NA; ++i) { if (EPI == EPI_DOWN) bl_lds_sc1(avo[i], srA, ka_, adst + so_ + i * 1024); else bl_lds(avo[i], srA, ka_, adst + so_ + i * 1024); } \
        _Pragma("unroll") for (int i = 0; i < 2; ++i) bl_lds(bvo[i], srB, kb_, bdst + so_ + i * 1024); } while (0)
#define G_COMPUTE(KT) do { const char* Ac = smem + ((KT) & 3) * 32768; const char* Bc = Ac + 16384; \
        _Pragma("unroll") for (int st = 0; st < 2; ++st) { bf16x8 af[MT], bfv[2]; \
            _Pragma("unroll") for (int mt = 0; mt < MT; ++mt) af[mt] = *(const bf16x8*)(Ac + (arow0 + mt * 32) * 64 + (((2 * st + hh) ^ asw) << 4)); \
            _Pragma("unroll") for (int nt = 0; nt < 2; ++nt) { const int k = 16 * st + bk0; \
                const char* b0_ = Bc + k * 512 + (((wn * 2 + nt) ^ (k & 7)) << 6) + g1 * 32 + pp * 8; \
                const char* b1_ = Bc + (k + 4) * 512 + (((wn * 2 + nt) ^ ((k + 4) & 7)) << 6) + g1 * 32 + pp * 8; \
                const s16x4 lo = tr_read(b0_), hi = tr_read(b1_); \
                bfv[nt] = (bf16x8){lo[0], lo[1], lo[2], lo[3], hi[0], hi[1], hi[2], hi[3]}; } \
            _Pragma("unroll") for (int mt = 0; mt < MT; ++mt) _Pragma("unroll") for (int nt = 0; nt < 2; ++nt) acc[mt][nt] = MFMA32(bfv[nt], af[mt], acc[mt][nt]); } } while (0)
#define G_WAIT(N) do { if ((N) == 2) { if (IPT == 4) asm volatile("s_waitcnt vmcnt(8)" ::: "memory"); else asm volatile("s_waitcnt vmcnt(6)" ::: "memory"); } \
                       else if ((N) == 1) { if (IPT == 4) asm volatile("s_waitcnt vmcnt(4)" ::: "memory"); else asm volatile("s_waitcnt vmcnt(3)" ::: "memory"); } \
                       else asm volatile("s_waitcnt vmcnt(0)" ::: "memory"); } while (0)
    G_LOAD(0); G_LOAD(1); G_LOAD(2);
    G_WAIT(2); __syncthreads();
#pragma nounroll
    for (int kt = 0; kt < nk; ++kt) {
        if (kt + 3 < nk) G_LOAD(kt + 3);
        G_COMPUTE(kt);
        if (kt + 3 < nk) G_WAIT(2); else if (kt + 2 < nk) G_WAIT(1); else G_WAIT(0);
        __syncthreads();
    }
#undef G_LOAD
#undef G_COMPUTE
#undef G_WAIT
    const int colw = g.n0 + wn * 64;
    char* wsl = smem + wid * 16384;
    const int rowb = wm * 32 * MT;
    if (EPI == EPI_IN_EVEN || EPI == EPI_IN_ODD || EPI == EPI_DOWN) {
        const int region = colw >> 9;
        const float* gn = region == 0 ? p.att_q_norm : p.att_k_norm;
        const bool act = colw < 1024;
        const float qs = (colw >= 1024 && colw < 1536) ? QSCALE : 1.0f;
#pragma unroll
        for (int mt = 0; mt < MT; ++mt) {
            float sc = 1.f;
            if (EPI == EPI_IN_EVEN || EPI == EPI_IN_ODD) {
                const float rr_ = gu_rs[mt];
#pragma unroll
                for (int nt = 0; nt < 2; ++nt) acc[mt][nt] = acc[mt][nt] * rr_;
            }
            if (EPI == EPI_IN_EVEN && region < 2) {
                float ss = 0.f;
#pragma unroll
                for (int nt = 0; nt < 2; ++nt)
#pragma unroll
                    for (int i = 0; i < 16; ++i) ss += acc[mt][nt][i] * acc[mt][nt][i];
                auto rr = __builtin_amdgcn_permlane32_swap(__float_as_uint(ss), __float_as_uint(ss), false, false);
                ss = __uint_as_float(rr[0]) + __uint_as_float(rr[1]);
                sc = rsqrtf(ss * (1.0f / 64.0f) + EPS) * (region == 0 ? QSCALE : 1.0f);
            }
            float vsum = 0.f;
#pragma unroll
            for (int nt = 0; nt < 2; ++nt)
#pragma unroll
                for (int gq = 0; gq < 4; ++gq) {
                    f32x2 v0 = {acc[mt][nt][4 * gq], acc[mt][nt][4 * gq + 1]}, v1 = {acc[mt][nt][4 * gq + 2], acc[mt][nt][4 * gq + 3]};
                    if (EPI == EPI_IN_EVEN) { if (region < 2) { const f32x4 gg = *(const f32x4*)(gn + nt * 32 + 8 * gq + 4 * hh); v0.x *= sc * gg[0]; v0.y *= sc * gg[1]; v1.x *= sc * gg[2]; v1.y *= sc * gg[3]; } }
                    else if (EPI == EPI_IN_ODD) { if (act) { v0 = gelu_pk(v0); v1 = gelu_pk(v1); vsum += v0.x * v0.x + v0.y * v0.y + v1.x * v1.x + v1.y * v1.y; } else { v0 = v0 * qs; v1 = v1 * qs; } }
                    u32x2 w; w.x = pack2(v0.x, v0.y); w.y = pack2(v1.x, v1.y);
                    *(u32x2*)(wsl + r32 * 128 + (((nt * 4 + gq) ^ (r32 & 7)) << 4) + hh * 8) = w;
                }
            if (EPI == EPI_IN_ODD && colw >= 512 && colw < 1024) {
                auto rr = __builtin_amdgcn_permlane32_swap(__float_as_uint(vsum), __float_as_uint(vsum), false, false);
                vsum = __uint_as_float(rr[0]) + __uint_as_float(rr[1]);
                if (hh == 0) atomicAdd(p.vss + g.m0 + rowb + mt * 32 + r32, vsum);
            }
#pragma unroll
            for (int ps = 0; ps < 4; ++ps) {
                const int row = ps * 8 + (lane >> 3), chunk = lane & 7;
                const u32x4 v = *(const u32x4*)(wsl + row * 128 + ((chunk ^ (row & 7)) << 4));
                const int trow = rowb + mt * 32 + row;
                if (EPI == EPI_DOWN) { const int id = rowid[trow]; if (id >= 0) *(u32x4*)(p.y + (size_t)id * DM + colw + chunk * 8) = v; }
                else if (EPI == EPI_IN_EVEN) *(u32x4*)(p.proj + (size_t)(g.m0 + trow) * EVEN_IN + colw + chunk * 8) = v;
                else *(u32x4*)(p.proj + (size_t)(g.m0 + trow) * ODD_IN + colw + chunk * 8) = v;
            }
        }
    } else if (EPI == EPI_OUT) {
#pragma unroll
        for (int mt = 0; mt < MT; ++mt) {
            f32x4 rx[8]; u32x2 rh[8];
#pragma unroll
            for (int ps = 0; ps < 8; ++ps) {
                const size_t off = (size_t)(g.m0 + rowb + mt * 32 + ps * 4 + (lane >> 4)) * DM + colw + (lane & 15) * 4;
                if (layer == 0) rx[ps] = *(const f32x4*)(p.x + off); else rh[ps] = *(const u32x2*)(p.hb + off);
            }
#pragma unroll
            for (int nt = 0; nt < 2; ++nt)
#pragma unroll
                for (int gq = 0; gq < 4; ++gq) {
                    const f32x4 v = {acc[mt][nt][4 * gq], acc[mt][nt][4 * gq + 1], acc[mt][nt][4 * gq + 2], acc[mt][nt][4 * gq + 3]};
                    *(f32x4*)(wsl + r32 * 256 + (((nt * 8 + 2 * gq + hh) ^ (r32 & 15)) << 4)) = v;
                }
#pragma unroll
            for (int ps = 0; ps < 8; ++ps) {
                const int row = ps * 4 + (lane >> 4), chunk = lane & 15;
                const f32x4 v = *(const f32x4*)(wsl + row * 256 + ((chunk ^ (row & 15)) << 4));
                const size_t off = (size_t)(g.m0 + rowb + mt * 32 + row) * DM + colw + chunk * 4;
                f32x4 r;
                if (layer == 0) r = rx[ps];
                else r = (f32x4){__uint_as_float(rh[ps].x << 16), __uint_as_float(rh[ps].x & 0xffff0000u), __uint_as_float(rh[ps].y << 16), __uint_as_float(rh[ps].y & 0xffff0000u)};
                r = r + v;
                u32x2 w; w.x = pack2(r[0], r[1]); w.y = pack2(r[2], r[3]);
                *(u32x2*)(p.hb + off) = w;
            }
        }
    } else if (EPI == EPI_GU) {
        const int f0 = (g.n0 >> 1) + wn * 32;
#pragma unroll
        for (int mt = 0; mt < MT; ++mt) {
            const float w = gu_w[mt], rs = gu_rs[mt];
#pragma unroll
            for (int gq = 0; gq < 4; ++gq) {
                float h[4];
#pragma unroll
                for (int j = 0; j < 4; ++j) { const float gt = acc[mt][0][4 * gq + j] * rs, up = acc[mt][1][4 * gq + j] * (rs * w);
                    h[j] = gt * __builtin_amdgcn_rcpf(1.0f + __builtin_amdgcn_exp2f(-LOG2E * gt)) * up; }
                u32x2 ww; ww.x = pack2(h[0], h[1]); ww.y = pack2(h[2], h[3]);
                *(u32x2*)(wsl + r32 * 64 + ((gq ^ (r32 & 3)) << 4) + hh * 8) = ww;
            }
#pragma unroll
            for (int ps = 0; ps < 2; ++ps) {
                const int row = ps * 16 + (lane >> 2), chunk = lane & 3;
                const u32x4 v = *(const u32x4*)(wsl + row * 64 + ((chunk ^ (row & 3)) << 4));
                const int id2 = rowid[rowb + mt * 32 + row];
                if (id2 >= 0) st16_sc1(p.hid + (size_t)id2 * FF + f0 + chunk * 8, v);
            }
        }
        asm volatile("s_waitcnt vmcnt(0)" ::: "memory");
    }
    __syncthreads();
}

template <int EPI, int MT>
DI void ph_gemm_dense(const P& p, char* smem, const bf16_t* A, int lda, const bf16_t* B, int K, int N, int layer, int nt0, int ntc) {
    const int ntm = NTOK / (64 * MT), per_xcd = (ntm / 8) * ntc;
    const bool xcd = (gridDim.x & 7) == 0;
    const int x = blockIdx.x & 7, gx = gridDim.x >> 3;
    const int jend = xcd ? per_xcd : ntm * ntc, jstep = xcd ? gx : (int)gridDim.x;
    for (int j = xcd ? (int)(blockIdx.x >> 3) : (int)blockIdx.x; j < jend; j += jstep) {
        GemmArgs g; g.A = A; g.lda = lda; g.gather = nullptr; g.mvalid = 64 * MT; g.gshift = 0; g.rowid_ready = false; g.B0 = B; g.B1 = B; g.ldb = N; g.gu = 0; g.K = K;
        const int rot = ((j / jstep) & 1) * (ntc >> 1);
        g.m0 = ((xcd ? x * (ntm / 8) : 0) + j / ntc) * (64 * MT); g.n0 = (nt0 + (j % ntc + rot) % ntc) * 256;
        gemm_tile<EPI, MT>(p, smem, g, layer);
    }
}

DI void moe_locate(const int* cnt, int mt, int& e, int& c, int& mtl) {
    e = 0; c = 0;
    for (; e < NEXP; ++e) { c = cnt[e]; const int t = (c + 127) >> 7; if (mt < t) break; mt -= t; }
    mtl = mt;
}
DI void ph_moe(const P& p, char* smem, int layer) {
    const int* cnt = p.cnt + layer * NEXP;
    int* gdone = p.gdone + layer * 320;
    int* queue = p.gdone + 600 + layer;
    volatile int* s_next = (volatile int*)(smem + SMEM_BYTES + 80);
    int total = 0;
    for (int e = 0; e < NEXP; ++e) total += (cnt[e] + 127) >> 7;
    const int ngu = total * 2, nall = total * 6;
    int mine = 0;
    if (threadIdx.x == 0) mine = __hip_atomic_fetch_add(queue, 1, __ATOMIC_RELAXED, __HIP_MEMORY_SCOPE_AGENT);
    for (;;) {
        if (threadIdx.x == 0) s_next[0] = mine;
        __syncthreads();
        const int u = s_next[0];
        if (u >= nall) break;
        if (threadIdx.x == 0) mine = __hip_atomic_fetch_add(queue, 1, __ATOMIC_RELAXED, __HIP_MEMORY_SCOPE_AGENT);
        if (u < ngu) {
            int e, c, mt; moe_locate(cnt, u >> 1, e, c, mt);
            GemmArgs g; g.gather = p.plist + (size_t)e * LISTCAP + mt * 128; g.mvalid = c - mt * 128 < 128 ? c - mt * 128 : 128;
            g.m0 = 0; g.n0 = (u & 1) * 256;
            const size_t ex = (size_t)(layer * NEXP + e);
            g.rowid_ready = false; g.A = p.hb; g.lda = DM; g.gshift = 1; g.B0 = p.wb_gate + ex * DM * FF; g.B1 = p.wb_up + ex * DM * FF; g.ldb = FF; g.gu = 1; g.K = DM;
            gemm_tile<EPI_GU, 2>(p, smem, g, layer);
            if (threadIdx.x == 0) __hip_atomic_fetch_add(gdone + (u >> 1), 1, __ATOMIC_RELAXED, __HIP_MEMORY_SCOPE_AGENT);
        } else {
            const int v = u - ngu;
            int e, c, mt; moe_locate(cnt, v >> 2, e, c, mt);
            GemmArgs g; g.gather = p.plist + (size_t)e * LISTCAP + mt * 128; g.mvalid = c - mt * 128 < 128 ? c - mt * 128 : 128;
            {
                int* rowid = (int*)(smem + G_ROWID);
                const int rid = (threadIdx.x < 128 && (int)threadIdx.x < g.mvalid) ? g.gather[threadIdx.x] : -1;
                if (threadIdx.x == 0) { unsigned sp = 0;
                    while (__hip_atomic_load(gdone + (v >> 2), __ATOMIC_RELAXED, __HIP_MEMORY_SCOPE_AGENT) < 2) { __builtin_amdgcn_s_sleep(2); if (++sp > (1u << 22)) break; } }
                if (threadIdx.x < 128) rowid[threadIdx.x] = rid;
                __syncthreads();
            }
            g.m0 = 0; g.n0 = (v & 3) * 256;
            const size_t ex = (size_t)(layer * NEXP + e);
            g.rowid_ready = true; g.A = p.hid; g.lda = FF; g.gshift = 0; g.B0 = p.wb_down + ex * FF * DM; g.B1 = g.B0; g.ldb = DM; g.gu = 0; g.K = FF;
            gemm_tile<EPI_DOWN, 2>(p, smem, g, layer);
        }
    }
}

DI void convert_flat(const float* __restrict__ src, bf16_t* __restrict__ dst, size_t n8, const float* __restrict__ gain = nullptr, int rowlen = 1) {
    for (size_t i = (size_t)blockIdx.x * 512 + threadIdx.x; i < n8; i += (size_t)gridDim.x * 512) {
        f32x4 a = *(const f32x4*)(src + i * 8), b = *(const f32x4*)(src + i * 8 + 4);
        if (gain) { const float gk = gain[(i * 8) / (size_t)rowlen]; a = a * gk; b = b * gk; }
        u32x4 w; w.x = pack2(a[0], a[1]); w.y = pack2(a[2], a[3]); w.z = pack2(b[0], b[1]); w.w = pack2(b[2], b[3]);
        *(u32x4*)(dst + i * 8) = w;
    }
}
DI void poolfold_unit(const P& p, char* smem, int unit) {
    float (*At)[32] = (float (*)[32])smem;
    float (*Bs)[64] = (float (*)[64])(smem + 16384);
    const int tid = opaque_tid() & 255, g = unit >> 6, c0 = ((unit >> 4) & 3) * 32, n0 = (unit & 15) * 64;
    __syncthreads();
    for (int i = 0; i < 16; ++i) { const int idx = tid + 256 * i, d = idx >> 5, c = idx & 31;
        At[d][c] = p.pool_w[(size_t)(g * 128 + c0 + c) * 128 + d] * p.pool_scale[g * 128 + d]; }
    for (int i = 0; i < 8; ++i) { const int idx = tid + 256 * i, d = idx >> 4, n4 = (idx & 15) * 4;
        *(f32x4*)&Bs[d][n4] = *(const f32x4*)(p.w_out_even + (size_t)(512 + g * 128 + d) * DM + n0 + n4); }
    __syncthreads();
    const int tc = (tid >> 4) * 2, tn = (tid & 15) * 4;
    f32x4 acc[2] = {(f32x4){0.f, 0.f, 0.f, 0.f}, (f32x4){0.f, 0.f, 0.f, 0.f}};
#pragma unroll 8
    for (int d = 0; d < 128; ++d) {
        const f32x2 a = *(const f32x2*)&At[d][tc]; const f32x4 b = *(const f32x4*)&Bs[d][tn];
        acc[0] += a.x * b; acc[1] += a.y * b;
    }
#pragma unroll
    for (int i = 0; i < 2; ++i) { u32x2 w; w.x = pack2(acc[i][0], acc[i][1]); w.y = pack2(acc[i][2], acc[i][3]);
        *(u32x2*)(p.wb_out_even + (size_t)(512 + g * 128 + c0 + tc + i) * DM + n0 + tn) = w; }
}
DI void cast_rows2(const P& p, int tok, int lane) {
    f32x4 v[2][4];
#pragma unroll
    for (int r = 0; r < 2; ++r)
#pragma unroll
        for (int i = 0; i < 4; ++i) v[r][i] = *(const f32x4*)(p.x + (size_t)(tok + r) * DM + i * 256 + lane * 4);
#pragma unroll
    for (int r = 0; r < 2; ++r) {
        float ss = 0.f;
#pragma unroll
        for (int i = 0; i < 4; ++i) { ss += v[r][i][0] * v[r][i][0] + v[r][i][1] * v[r][i][1] + v[r][i][2] * v[r][i][2] + v[r][i][3] * v[r][i][3];
            u32x2 w; w.x = pack2(v[r][i][0], v[r][i][1]); w.y = pack2(v[r][i][2], v[r][i][3]);
            *(u32x2*)(p.hb + (size_t)(tok + r) * DM + i * 256 + lane * 4) = w; }
        ss = wave_sum(ss);
        if (lane == 0) p.rsm[tok + r] = rsqrtf(ss * (1.0f / DM) + EPS);
    }
}
DI void ph_prologue(const P& p, char* smem) {
    if (blockIdx.x == 0 && threadIdx.x < 64) p.cnt[threadIdx.x] = 0;
    if (blockIdx.x == 2 && threadIdx.x == 0) ((float*)p.ones)[0] = 1.0f;
    if (blockIdx.x == 1) for (int i = threadIdx.x; i < 640; i += 512) p.gdone[i] = 0;
    for (int i = blockIdx.x * 512 + threadIdx.x; i < NTOK; i += gridDim.x * 512) p.vss[i] = 0.f;
    for (int u = blockIdx.x; u < 128; u += gridDim.x) poolfold_unit(p, smem + (threadIdx.x >> 8) * HALF_LDS, u * 2 + (threadIdx.x >> 8));
    for (int i = blockIdx.x * 512 + threadIdx.x; i < 2 * 96 * DM; i += gridDim.x * 512) {
        const int k = i & (DM - 1), R = (i >> 10) % 96, layer = i / (96 * DM);
        const int T = R >> 5, r = R & 31, L = 16 * T + (r & 3) + 4 * (r >> 3);
        float w = 0.f;
        if (L < 32) w = p.w_re[((size_t)layer * DM + k) * 32 + L]; else if (L < 36) w = p.w_rg[((size_t)layer * DM + k) * 4 + (L - 32)];
        w *= p.ffn_norm[layer * DM + k];
        const unsigned hi = pack2(w, 0.f) & 0xffffu;
        p.wr_hi[i] = (bf16_t)hi; p.wr_lo[i] = (bf16_t)(pack2(w - __uint_as_float(hi << 16), 0.f) & 0xffffu);
    }
    const int wave = threadIdx.x >> 6, lane = threadIdx.x & 63;
    for (int u = blockIdx.x; u < NTOK / 16; u += gridDim.x) {
        const int tok = u * 16 + wave * 2;
        cast_rows2(p, tok, lane);
    }
    convert_flat(p.w_in_even, p.wb_in_even, (size_t)DM * EVEN_IN / 8, p.mix_norm_even, EVEN_IN);
    convert_flat(p.w_out_even, p.wb_out_even, (size_t)512 * DM / 8);
}
DI void convert_experts(const P& p, int layer) {
    const size_t o = (size_t)layer * NEXP * DM * FF;
    convert_flat(p.w_gate + o, p.wb_gate + o, (size_t)NEXP * DM * FF / 8);
    convert_flat(p.w_up + o, p.wb_up + o, (size_t)NEXP * DM * FF / 8);
    convert_flat(p.w_down + o, p.wb_down + o, (size_t)NEXP * DM * FF / 8);
}

DI int crow(int i, int h) { return (i & 3) + 8 * (i >> 2) + 4 * h; }
DI float swap_max(float v) { auto rr = __builtin_amdgcn_permlane32_swap(__float_as_uint(v), __float_as_uint(v), false, false); return fmaxf(__uint_as_float(rr[0]), __uint_as_float(rr[1])); }
DI float swap_sum(float v) { auto rr = __builtin_amdgcn_permlane32_swap(__float_as_uint(v), __float_as_uint(v), false, false); return __uint_as_float(rr[0]) + __uint_as_float(rr[1]); }
DI float bcast_lo(float v) { auto rr = __builtin_amdgcn_permlane32_swap(__float_as_uint(v), __float_as_uint(v), false, false); return __uint_as_float(rr[0]); }
DI bf16x8 pack8(const f32x16& x, int s) {
    u32x4 w; w.x = pack2(x[8 * s], x[8 * s + 1]); w.y = pack2(x[8 * s + 2], x[8 * s + 3]); w.z = pack2(x[8 * s + 4], x[8 * s + 5]); w.w = pack2(x[8 * s + 6], x[8 * s + 7]);
    return __builtin_bit_cast(bf16x8, w);
}
constexpr int KV_TILE = 8192;
struct KVStage { u32x4 k[2], v[2]; };
DI void kv_load(KVStage& st, const bf16_t* kbase, const bf16_t* vbase, int ld, int key0) {
    const int tid = opaque_tid() & 255, c = tid & 7, r0 = tid >> 3;
#pragma unroll
    for (int i = 0; i < 2; ++i) { const size_t off = (size_t)(key0 + r0 + 32 * i) * ld + c * 8; st.k[i] = *(const u32x4*)(kbase + off); st.v[i] = *(const u32x4*)(vbase + off); }
}
DI void kv_store(const KVStage& st, char* kt, char* vt) {
    const int tid = opaque_tid() & 255, c = tid & 7, r0 = tid >> 3;
#pragma unroll
    for (int i = 0; i < 2; ++i) { const int r = r0 + 32 * i;
        *(u32x4*)(kt + r * 128 + ((c ^ ((r >> 1) & 7)) << 4)) = st.k[i];
        *(u32x4*)(vt + r * 128 + ((((c >> 2) ^ ((r >> 1) & 1))) << 6) + ((c & 3) << 4)) = st.v[i]; }
}
DI bf16x8 k_frag(const char* kt, int sb, int st, int r32, int hh) {
    const int row = sb * 32 + r32;
    return *(const bf16x8*)(kt + row * 128 + (((2 * st + hh) ^ ((row >> 1) & 7)) << 4));
}
DI bf16x8 vt_frag(const char* vt, int sb, int st, int dh, int lane) {
    const int hh = lane >> 5, g1 = (lane >> 4) & 1, pp = lane & 3, q = (lane & 15) >> 2;
    const int key = sb * 32 + 16 * st + 4 * hh + q;
    const char* a = vt + key * 128 + ((dh ^ ((q >> 1) & 1)) << 6) + g1 * 32 + pp * 8;
    const s16x4 lo = tr_read(a), hi = tr_read(a + 8 * 128);
    return (bf16x8){lo[0], lo[1], lo[2], lo[3], hi[0], hi[1], hi[2], hi[3]};
}


#define XB_TMO      128
#define XB_XCNT(j)  (256  + 64 * (j))
#define XB_XSUB(j)  (1280 + 64 * (j))
#define XB_XGEN(j)  (2304 + 64 * (j))
#define XB_TOP      3328
#define XB_TOPGEN   3392
#define XCD_BAR_WORDS 3456
#define XB_SPIN_CAP (1u << 22)
DI unsigned xb_ld(unsigned* q)              { return __hip_atomic_load(q, __ATOMIC_RELAXED, __HIP_MEMORY_SCOPE_AGENT); }
DI unsigned xb_add(unsigned* q, unsigned v) { return __hip_atomic_fetch_add(q, v, __ATOMIC_RELAXED, __HIP_MEMORY_SCOPE_AGENT); }
DI unsigned xb_xcc_id() { return (unsigned)__builtin_amdgcn_s_getreg((3 << 11) | 20) & 0xFu; }
#define XB_SPIN(cond, bar) do { unsigned _sp = 0; while (cond) { __builtin_amdgcn_s_sleep(1); \
    if ((++_sp & 255u) == 0u) { if (xb_ld(&(bar)[XB_TMO])) break; if (_sp > XB_SPIN_CAP) { atomicAdd(&(bar)[XB_TMO], 1u); break; } } } } while (0)
struct XcdBarrier { unsigned* bar; unsigned x; volatile LDSAS unsigned* st; };
DI XcdBarrier xcd_barrier_post(unsigned* bar, volatile LDSAS unsigned* st) {
    XcdBarrier b; b.bar = bar; b.x = xb_xcc_id(); b.st = st;
    if (threadIdx.x == 0) (void)xb_add(&bar[XB_XCNT(b.x)], 1u);
    return b;
}
DI void xcd_barrier_complete(unsigned* bar, unsigned x, unsigned& nloc, unsigned& nx) {
    const unsigned G = gridDim.x * gridDim.y * gridDim.z;
    unsigned sum, cnt, mine, sp = 0u;
    for (;;) {
        sum = 0u; cnt = 0u; mine = 0u;
#pragma unroll
        for (unsigned j = 0; j < 16; ++j) { const unsigned c = xb_ld(&bar[XB_XCNT(j)]); sum += c; cnt += (c > 0u) ? 1u : 0u; mine = (j == x) ? c : mine; }
        if (sum == G) break;
        __builtin_amdgcn_s_sleep(1);
        if ((++sp & 255u) == 0u) { if (xb_ld(&bar[XB_TMO])) break; if (sp > XB_SPIN_CAP) { atomicAdd(&bar[XB_TMO], 1u); break; } }
    }
    nloc = mine > 0u ? mine : 1u; nx = cnt > 0u ? cnt : 1u;
}
DI void xcd_barrier(const XcdBarrier& b) {
    asm volatile("s_waitcnt vmcnt(0)" ::: "memory");
    __syncthreads();
    if (threadIdx.x == 0) {
        unsigned* bar = b.bar;
        __builtin_amdgcn_s_waitcnt(0);
        unsigned nloc = b.st[0], nx = b.st[1];
        if (nloc == 0u) { xcd_barrier_complete(bar, b.x, nloc, nx); b.st[0] = nloc; b.st[1] = nx; }
        const unsigned old = xb_add(&bar[XB_XSUB(b.x)], 1u);
        const unsigned gen = old / nloc;
        if (old + 1u == (gen + 1u) * nloc) {
            __builtin_amdgcn_fence(__ATOMIC_RELEASE, "agent");
            asm volatile("s_waitcnt vmcnt(0)" ::: "memory");
            const unsigned og = xb_add(&bar[XB_TOP], 1u);
            const unsigned tg = og / nx;
            if (og + 1u == (tg + 1u) * nx) xb_add(&bar[XB_TOPGEN], 1u);
            else XB_SPIN(xb_ld(&bar[XB_TOPGEN]) == tg, bar);
            __builtin_amdgcn_fence(__ATOMIC_ACQUIRE, "agent");
            xb_add(&bar[XB_XGEN(b.x)], 1u);
            asm volatile("s_waitcnt vmcnt(0)" ::: "memory");
        } else {
            XB_SPIN(xb_ld(&bar[XB_XGEN(b.x)]) == gen, bar);
            __builtin_amdgcn_fence(__ATOMIC_ACQUIRE, "agent");
            asm volatile("s_waitcnt vmcnt(0)" ::: "memory");
        }
    }
    __syncthreads();
}


struct ConvPlan { int layer; int sl_e, sl_in, sl_out, nslots; };
template <int NV> DI ConvPlan conv_plan(const P& p, int layer) {
    ConvPlan c; c.layer = layer;
    const unsigned per = gridDim.x * 512u, gsz = 4 * NV;
    c.sl_e = (int)((NEXP * DM * FF / gsz + per - 1) / per);
    c.sl_in = layer == 0 ? (int)((DM * ODD_IN / gsz + per - 1) / per) : 0;
    c.sl_out = layer == 0 ? (int)((DM * DM / gsz + per - 1) / per) : 0;
    c.nslots = 3 * c.sl_e + c.sl_in + c.sl_out;
    return c;
}
template <int NV> DI void conv_locate(const P& p, const ConvPlan& c, int slot, const float*& s, bf16_t*& d, const float*& gp) {
    constexpr unsigned gsz = 4 * NV;
    int seg = 0, ls = slot;
    if (ls < 3 * c.sl_e) { seg = ls / c.sl_e; ls -= seg * c.sl_e; }
    else if ((ls -= 3 * c.sl_e) < c.sl_in) seg = 3;
    else { ls -= c.sl_in; seg = 4; }
    const unsigned ng = seg < 3 ? NEXP * DM * FF / gsz : (seg == 3 ? DM * ODD_IN / gsz : DM * DM / gsz);
    const unsigned gi = ((unsigned)ls * gridDim.x + blockIdx.x) * 512u + threadIdx.x;
    const bool live = slot < c.nslots && gi < ng;
    const size_t e = live ? (size_t)gi * gsz : 0;
    const int tix = c.layer * 5 + __builtin_amdgcn_readfirstlane(seg);
    s = p.cs[tix] + e;
    d = live ? p.cd[tix] + e : p.dump + ((size_t)blockIdx.x * 512 + threadIdx.x) * 16;
    gp = p.ones;
    if (live && seg < 2) gp = p.ffn_norm + c.layer * DM + ((e >> 8) & (DM - 1));
    else if (live && seg == 3) gp = p.mix_norm_odd + e / ODD_IN;
}
#define CONV_DECL4(N) f32x4 N##0, N##1, N##2, N##3; float N##g; bf16_t* N##d
#define CONV_DECL2(N) f32x4 N##0, N##1; float N##g; bf16_t* N##d
#define CONV_LOAD4(N, SLOT) do { const float* s_; const float* g_; conv_locate<4>(p, cv, (SLOT), s_, N##d, g_); \
        N##g = *g_; N##0 = *(const f32x4*)s_; N##1 = *(const f32x4*)(s_ + 4); N##2 = *(const f32x4*)(s_ + 8); N##3 = *(const f32x4*)(s_ + 12); } while (0)
#define CONV_LOAD2(N, SLOT) do { const float* s_; const float* g_; conv_locate<2>(p, cv, (SLOT), s_, N##d, g_); \
        N##g = *g_; N##0 = *(const f32x4*)s_; N##1 = *(const f32x4*)(s_ + 4); } while (0)
#define CONV_STORE4(N) do { const f32x4 a_ = N##0 * N##g, b_ = N##1 * N##g, c_ = N##2 * N##g, e_ = N##3 * N##g; u32x4 w_; \
        w_.x = pack2(a_[0], a_[1]); w_.y = pack2(a_[2], a_[3]); w_.z = pack2(b_[0], b_[1]); w_.w = pack2(b_[2], b_[3]); *(u32x4*)N##d = w_; \
        w_.x = pack2(c_[0], c_[1]); w_.y = pack2(c_[2], c_[3]); w_.z = pack2(e_[0], e_[1]); w_.w = pack2(e_[2], e_[3]); *(u32x4*)(N##d + 8) = w_; } while (0)
#define CONV_STORE2(N) do { const f32x4 a_ = N##0 * N##g, b_ = N##1 * N##g; u32x4 w_; \
        w_.x = pack2(a_[0], a_[1]); w_.y = pack2(a_[2], a_[3]); w_.z = pack2(b_[0], b_[1]); w_.w = pack2(b_[2], b_[3]); *(u32x4*)N##d = w_; } while (0)

DI void band_attn_unit(const P& p, char* smem, int unit, const ConvPlan& cv, int& cslot) {
    const int tid = opaque_tid() & 255, lane = tid & 63, wid = tid >> 6, r32 = lane & 31, hh = lane >> 5;
    const int cp = unit & 31, h = (unit >> 5) & 7, b = unit >> 8;
    const int c = 2 * cp + (wid >> 1);
    const int tq = c * 64 + (wid & 1) * 32 + r32;
    const size_t rowb = (size_t)b * NS;
    const bf16_t* kbase = p.proj + rowb * EVEN_IN + 512 + h * 64;
    const bf16_t* vbase = p.proj + rowb * EVEN_IN + 1024 + h * 64;
    float* sbias = (float*)(smem + 4 * KV_TILE);
    __syncthreads();
    bf16x8 qf[4];
#pragma unroll
    for (int st = 0; st < 4; ++st) qf[st] = *(const bf16x8*)(p.proj + (rowb + tq) * EVEN_IN + h * 64 + st * 16 + hh * 8);
    const int ck0 = (2 * cp - 8) > 0 ? (2 * cp - 8) : 0, nt = 2 * cp + 2 - ck0;
    float m = -3.0e38f, lsum = 0.f;
    f32x16 o0, o1;
#pragma unroll
    for (int i = 0; i < 16; ++i) { o0[i] = 0.f; o1[i] = 0.f; }
    KVStage stg;
    kv_load(stg, kbase, vbase, EVEN_IN, ck0 * 64);
    {
        const float b0 = p.att_rel_bias[h * 257 + tid], b1 = p.att_rel_bias[h * 257 + 256];
        sbias[tid] = b0 * LOG2E; if (tid == 0) sbias[256] = b1 * LOG2E;
    }
    kv_store(stg, smem, smem + 2 * KV_TILE);
    __syncthreads();
    CONV_DECL4(cA); CONV_DECL4(cB);
    CONV_LOAD4(cA, cslot++); CONV_LOAD4(cB, cslot++);
#define BAND_ITER(it, CRX) do { \
        const int ck = ck0 + it, cur = it & 1; \
        kv_load(stg, kbase, vbase, EVEN_IN, ((it + 1 < nt) ? ck + 1 : ck) * 64); \
        CONV_STORE4(CRX); CONV_LOAD4(CRX, cslot++); \
        __builtin_amdgcn_sched_barrier(0); \
        const char* kt = smem + cur * KV_TILE; const char* vt = smem + (2 + cur) * KV_TILE; \
        if (ck >= c - 8 && ck <= c) { \
            f32x16 s0, s1; \
_Pragma("unroll") \
            for (int i = 0; i < 16; ++i) { s0[i] = 0.f; s1[i] = 0.f; } \
_Pragma("unroll") \
            for (int st = 0; st < 4; ++st) { s0 = MFMA32(k_frag(kt, 0, st, r32, hh), qf[st], s0); s1 = MFMA32(k_frag(kt, 1, st, r32, hh), qf[st], s1); } \
            if (c - ck >= 3) { const float bb = sbias[256]; \
_Pragma("unroll") \
                for (int i = 0; i < 16; ++i) { s0[i] += bb; s1[i] += bb; } \
            } else { \
                const int d0 = tq - ck * 64 - 4 * hh; \
_Pragma("unroll") \
                for (int i = 0; i < 16; ++i) { \
                    int da = d0 - ((i & 3) + 8 * (i >> 2)), db = da - 32; \
                    da = da > 128 ? 128 : da; db = db > 128 ? 128 : db; \
                    s0[i] += sbias[da + 128]; s1[i] += sbias[db + 128]; \
                } \
            } \
            float tm = fmaxf(s0[0], s1[0]); \
_Pragma("unroll") \
            for (int i = 1; i < 16; ++i) tm = fmaxf(tm, fmaxf(s0[i], s1[i])); \
            tm = swap_max(tm); \
            const float mn = fmaxf(m, tm); \
            const float alpha = __builtin_amdgcn_exp2f(m - mn); \
            m = mn; \
            float ps = 0.f; \
_Pragma("unroll") \
            for (int i = 0; i < 16; ++i) { s0[i] = __builtin_amdgcn_exp2f(s0[i] - mn); s1[i] = __builtin_amdgcn_exp2f(s1[i] - mn); ps += s0[i] + s1[i]; } \
            lsum = lsum * alpha + ps; \
_Pragma("unroll") \
            for (int i = 0; i < 16; ++i) { o0[i] *= alpha; o1[i] *= alpha; } \
_Pragma("unroll") \
            for (int st = 0; st < 2; ++st) { \
                const bf16x8 pa = pack8(s0, st), pb = pack8(s1, st); \
                o0 = MFMA32(vt_frag(vt, 0, st, 0, lane), pa, o0); o1 = MFMA32(vt_frag(vt, 0, st, 1, lane), pa, o1); \
                o0 = MFMA32(vt_frag(vt, 1, st, 0, lane), pb, o0); o1 = MFMA32(vt_frag(vt, 1, st, 1, lane), pb, o1); \
            } \
        } \
        __builtin_amdgcn_sched_barrier(0); \
        kv_store(stg, smem + (cur ^ 1) * KV_TILE, smem + (2 + (cur ^ 1)) * KV_TILE); \
        __syncthreads(); \
    } while (0)
    for (int it = 0; it < nt; it += 2) {
        BAND_ITER(it, cA);
        if (it + 1 >= nt) break;
        BAND_ITER(it + 1, cB);
    }
#undef BAND_ITER
    CONV_STORE4(cA); CONV_STORE4(cB);
    const float inv = 1.0f / swap_sum(lsum);
    bf16_t* orow = p.mixed + (rowb + tq) * DM + h * 64 + 4 * hh;
#pragma unroll
    for (int g = 0; g < 4; ++g) {
        u32x2 w0, w1;
        w0.x = pack2(o0[4 * g] * inv, o0[4 * g + 1] * inv); w0.y = pack2(o0[4 * g + 2] * inv, o0[4 * g + 3] * inv);
        w1.x = pack2(o1[4 * g] * inv, o1[4 * g + 1] * inv); w1.y = pack2(o1[4 * g + 2] * inv, o1[4 * g + 3] * inv);
        *(u32x2*)(orow + 8 * g) = w0; *(u32x2*)(orow + 32 + 8 * g) = w1;
    }
}

DI void sb_attn_unit(const P& p, char* smem, volatile int* wdone, int unit, const ConvPlan& cv, int& cslot) {
    const int tid8 = opaque_tid(), tid = tid8 & 255, lane = tid & 63, wid = tid >> 6, r32 = lane & 31, hh = lane >> 5, wid8 = tid8 >> 6;
    const int qb = unit & 31, h = (unit >> 5) & 7, b = unit >> 8;
    const int tw = qb * 128 + wid * 32, t = tw + r32;
    const size_t rowb = (size_t)b * NS;
    const bf16_t* kbase = p.proj + rowb * ODD_IN + 1536 + h * 64;
    const bf16_t* vbase = p.proj + rowb * ODD_IN + 2048 + h * 64;
    __syncthreads();
    bf16x8 qf[4];
#pragma unroll
    for (int st = 0; st < 4; ++st) qf[st] = *(const bf16x8*)(p.proj + (rowb + t) * ODD_IN + 1024 + h * 64 + st * 16 + hh * 8);
    bf16x8 tf[2];
#pragma unroll
    for (int st = 0; st < 2; ++st)
#pragma unroll
        for (int j = 0; j < 8; ++j) tf[st][j] = (16 * st + 8 * (j >> 2) + 4 * hh + (j & 3)) >= r32 ? (short)0x3F80 : (short)0;
    f32x16 o0, o1;
#pragma unroll
    for (int i = 0; i < 16; ++i) { o0[i] = 0.f; o1[i] = 0.f; }
    float carry = 0.f; bool done = false;
    const int kt0 = 2 * qb + 1;
    KVStage stg;
    kv_load(stg, kbase, vbase, ODD_IN, kt0 * 64);
    kv_store(stg, smem, smem + 2 * KV_TILE);
    __syncthreads();
    bool all_done = false;
    CONV_DECL2(cA);
    CONV_LOAD2(cA, cslot++);
#define SB_ITER(it, CRX) do { \
        const int kt = kt0 - it, cur = it & 1; \
        kv_load(stg, kbase, vbase, ODD_IN, (kt > 0 ? kt - 1 : 0) * 64); \
        CONV_STORE2(CRX); CONV_LOAD2(CRX, cslot++); \
        __builtin_amdgcn_sched_barrier(0); \
        const char* ktile = smem + cur * KV_TILE; const char* vtile = smem + (2 + cur) * KV_TILE; \
        if (!done && kt * 64 < tw + 31) { \
_Pragma("unroll") \
            for (int sbi = 0; sbi < 2; ++sbi) { \
                const int sb = 1 - sbi; \
                f32x16 x; \
_Pragma("unroll") \
                for (int i = 0; i < 16; ++i) x[i] = 0.f; \
_Pragma("unroll") \
                for (int st = 0; st < 4; ++st) x = MFMA32(k_frag(ktile, sb, st, r32, hh), qf[st], x); \
                const int kb = kt * 64 + sb * 32 + 4 * hh; \
                f32x16 L; \
_Pragma("unroll") \
                for (int i = 0; i < 16; ++i) { \
                    const bool valid = kb + (i & 3) + 8 * (i >> 2) < t; \
                    const float z = x[i]; \
                    const float sp = fmaxf(z, 0.f) + __builtin_amdgcn_logf(1.0f + __builtin_amdgcn_exp2f(-fabsf(z))); \
                    L[i] = valid ? -sp : 0.f; \
                    x[i] = valid ? z : -1.0e30f; \
                } \
                f32x16 cum; \
_Pragma("unroll") \
                for (int i = 0; i < 16; ++i) cum[i] = carry; \
_Pragma("unroll") \
                for (int st = 0; st < 2; ++st) cum = MFMA32(tf[st], pack8(L, st), cum); \
                carry = bcast_lo(cum[0]); \
_Pragma("unroll") \
                for (int i = 0; i < 16; ++i) x[i] = __builtin_amdgcn_exp2f(x[i] + cum[i]); \
_Pragma("unroll") \
                for (int st = 0; st < 2; ++st) { \
                    const bf16x8 pa = pack8(x, st); \
                    o0 = MFMA32(vt_frag(vtile, sb, st, 0, lane), pa, o0); o1 = MFMA32(vt_frag(vtile, sb, st, 1, lane), pa, o1); \
                } \
            } \
            done = __all(carry < -150.0f); \
        } \
        __builtin_amdgcn_sched_barrier(0); \
        if (lane == 0) wdone[cur * 8 + wid8] = done ? 1 : 0; \
        kv_store(stg, smem + (cur ^ 1) * KV_TILE, smem + (2 + (cur ^ 1)) * KV_TILE); \
        __syncthreads(); \
        all_done = (wdone[cur * 8] + wdone[cur * 8 + 1] + wdone[cur * 8 + 2] + wdone[cur * 8 + 3] + wdone[cur * 8 + 4] + wdone[cur * 8 + 5] + wdone[cur * 8 + 6] + wdone[cur * 8 + 7] == 8); \
    } while (0)
#pragma nounroll
    for (int it = 0; it <= kt0; ++it) {
        SB_ITER(it, cA);
        if (all_done) break;
    }
#undef SB_ITER
    CONV_STORE2(cA);
    bf16_t* orow = p.mixed + (rowb + t) * DM + 512 + h * 64 + 4 * hh;
#pragma unroll
    for (int g = 0; g < 4; ++g) {
        u32x2 w0, w1;
        w0.x = pack2(o0[4 * g], o0[4 * g + 1]); w0.y = pack2(o0[4 * g + 2], o0[4 * g + 3]);
        w1.x = pack2(o1[4 * g], o1[4 * g + 1]); w1.y = pack2(o1[4 * g + 2], o1[4 * g + 3]);
        *(u32x2*)(orow + 8 * g) = w0; *(u32x2*)(orow + 32 + 8 * g) = w1;
    }
}

DI void pool_items(const P& p) {
    for (int it = blockIdx.x * 512 + threadIdx.x; it < (NTOK / 8) * 64; it += gridDim.x * 512) {
        const int run = it >> 6, ch8 = it & 63, g = ch8 >> 4, w = 2 << g;
        const int tok0 = run * 8, s0 = tok0 & (NS - 1);
        const bf16_t* src = p.proj + (size_t)tok0 * EVEN_IN + 1536 + ch8 * 8;
        u32x4 rows[23];
#pragma unroll
        for (int k = 0; k < 23; ++k) { const int ds = k - 15; const bool ok = s0 + ds >= 0;
            rows[k] = *(const u32x4*)(src + (ptrdiff_t)(ok ? ds : 0) * EVEN_IN); if (!ok) rows[k] = (u32x4){0u, 0u, 0u, 0u}; }
        float sum[8], f[8];
#pragma unroll
        for (int j = 0; j < 8; ++j) sum[j] = 0.f;
#pragma unroll
        for (int k = 0; k < 15; ++k) { unpack8(rows[k], f); const float mk = (15 - k) < w ? 1.f : 0.f;
#pragma unroll
            for (int j = 0; j < 8; ++j) sum[j] += f[j] * mk; }
#pragma unroll
        for (int t = 0; t < 8; ++t) {
            unpack8(rows[15 + t], f);
#pragma unroll
            for (int j = 0; j < 8; ++j) sum[j] += f[j];
            const int s = s0 + t; const float inv = 1.0f / (float)((s + 1 < w) ? s + 1 : w);
            u32x4 o; o.x = pack2(sum[0] * inv - f[0], sum[1] * inv - f[1]); o.y = pack2(sum[2] * inv - f[2], sum[3] * inv - f[3]);
            o.z = pack2(sum[4] * inv - f[4], sum[5] * inv - f[5]); o.w = pack2(sum[6] * inv - f[6], sum[7] * inv - f[7]);
            *(u32x4*)(p.mixed + (size_t)(tok0 + t) * DM + 512 + ch8 * 8) = o;
            float d[8];
            const u32x4 r2 = rows[15 + t - 1], r4 = rows[15 + t - 3], r8 = rows[15 + t - 7], r16 = rows[t];
            const u32x4 rd = g == 0 ? r2 : (g == 1 ? r4 : (g == 2 ? r8 : r16));
            unpack8(rd, d);
#pragma unroll
            for (int j = 0; j < 8; ++j) sum[j] -= d[j];
        }
    }
}

DI void sgu_unit(const P& p, char* smem, int unit) {
    const int tid = opaque_tid() & 255, lane = tid & 63, wid = tid >> 6, wm = wid >> 1, wn = wid & 1, fr = lane & 15, fq = lane >> 4;
    const int g = unit & 3; const size_t tok0 = (size_t)(unit >> 2) * 128;
    char* As = smem; char* Gs = smem + 32768; float* srstd = (float*)(smem + 65536);
    __syncthreads();
    if (tid < 128) srstd[tid] = rsqrtf(p.vss[tok0 + tid] * (1.0f / 512.0f) + EPS);
#pragma unroll
    for (int i = 0; i < 8; ++i) {
        const int idx = tid + 256 * i, s = idx >> 4, ch = idx & 15;
        const u32x4 v = *(const u32x4*)(p.proj + (tok0 + s) * ODD_IN + 512 + g * 128 + ch * 8);
        *(u32x4*)(Gs + s * 256 + (((ch >> 1) ^ kswz(s)) << 5) + ((ch & 1) << 4)) = v;
    }
    __syncthreads();
#pragma unroll
    for (int i = 0; i < 8; ++i) {
        const int idx = tid + 256 * i, t = idx >> 4, c8 = idx & 15, s0 = c8 * 8;
        const float* wr = p.sgu_w + ((size_t)g * 128 + t) * 128 + s0;
        const f32x4 a = *(const f32x4*)wr, b = *(const f32x4*)(wr + 4);
        float f[8] = {a[0], a[1], a[2], a[3], b[0], b[1], b[2], b[3]};
#pragma unroll
        for (int j = 0; j < 8; ++j) f[j] = (s0 + j <= t) ? f[j] * srstd[s0 + j] : 0.f;
        u32x4 w; w.x = pack2(f[0], f[1]); w.y = pack2(f[2], f[3]); w.z = pack2(f[4], f[5]); w.w = pack2(f[6], f[7]);
        *(u32x4*)(As + (c8 >> 3) * 16384 + t * 128 + (((c8 & 7) ^ (t & 7)) << 4)) = w;
    }
    __syncthreads();
    f32x4 acc[4][4];
#pragma unroll
    for (int a = 0; a < 4; ++a)
#pragma unroll
        for (int b = 0; b < 4; ++b) acc[a][b] = (f32x4){0.f, 0.f, 0.f, 0.f};
    const int qq = fr >> 2, pp = fr & 3;
#pragma unroll
    for (int kt = 0; kt < 2; ++kt) {
        if (kt == 1 && wm == 0) continue;
#pragma unroll
        for (int s2 = 0; s2 < 2; ++s2) {
            bf16x8 af[4], bfv[4];
#pragma unroll
            for (int i = 0; i < 4; ++i) {
                const int ra_ = wm * 64 + i * 16 + fr;
                af[i] = *(const bf16x8*)(As + kt * 16384 + ra_ * 128 + (((s2 * 4 + fq) ^ (fr & 7)) << 4));
                const int srow = kt * 64 + s2 * 32 + 8 * fq + qq, blk = wn * 4 + i;
                const s16x4 lo = tr_read(Gs + srow * 256 + ((blk ^ kswz(srow)) << 5) + pp * 8);
                const s16x4 hi = tr_read(Gs + (srow + 4) * 256 + ((blk ^ kswz(srow + 4)) << 5) + pp * 8);
                bfv[i] = (bf16x8){lo[0], lo[1], lo[2], lo[3], hi[0], hi[1], hi[2], hi[3]};
            }
#pragma unroll
            for (int mi = 0; mi < 4; ++mi)
#pragma unroll
                for (int ni = 0; ni < 4; ++ni) acc[mi][ni] = MFMA16(bfv[ni], af[mi], acc[mi][ni]);
        }
    }
#pragma unroll
    for (int mi = 0; mi < 4; ++mi) {
        const int t = wm * 64 + mi * 16 + fr;
        const float bias = p.sgu_b[g * 128 + t];
#pragma unroll
        for (int ni = 0; ni < 4; ++ni) {
            const int c = g * 128 + wn * 64 + ni * 16 + fq * 4;
            const f32x4 gn = *(const f32x4*)(p.sgu_v_norm + c);
            const u32x2 uu = *(const u32x2*)(p.proj + (tok0 + t) * ODD_IN + c);
            const float u0 = __uint_as_float(uu.x << 16), u1 = __uint_as_float(uu.x & 0xffff0000u), u2 = __uint_as_float(uu.y << 16), u3 = __uint_as_float(uu.y & 0xffff0000u);
            const f32x4 a = acc[mi][ni];
            u32x2 w; w.x = pack2(u0 * (gn[0] * a[0] + bias), u1 * (gn[1] * a[1] + bias)); w.y = pack2(u2 * (gn[2] * a[2] + bias), u3 * (gn[3] * a[3] + bias));
            *(u32x2*)(p.mixed + (tok0 + t) * DM + c) = w;
        }
    }
}

DI void router_unit(const P& p, char* smem, int layer, int unit) {
    const int tid = opaque_tid() & 255, lane = tid & 63, wid = tid >> 6, r32 = lane & 31, hh = lane >> 5;
    float (*part)[36][32] = (float (*)[36][32])smem;
    float (*wss)[32] = (float (*)[32])(smem + 18432);
    int* lcnt = (int*)(smem + 18432 + 512);
    int* lbase = lcnt + 32;
    int* cnt = p.cnt + layer * NEXP;
    const int tok = unit * 32 + r32, kq = wid * 256 + 8 * hh;
    __syncthreads();
    if (tid < 32) lcnt[tid] = 0;
    const bf16_t* hrow = p.hb + (size_t)tok * DM + kq;
    const bf16_t* whi = p.wr_hi + ((size_t)layer * 96 + r32) * DM + kq;
    const bf16_t* wlo = p.wr_lo + ((size_t)layer * 96 + r32) * DM + kq;
    f32x16 c0, c1, c2;
#pragma unroll
    for (int i = 0; i < 16; ++i) { c0[i] = 0.f; c1[i] = 0.f; c2[i] = 0.f; }
    float ss = 0.f;
#pragma unroll 4
    for (int st = 0; st < 16; ++st) {
        const u32x4 hw = *(const u32x4*)(hrow + 16 * st);
        float f[8]; unpack8(hw, f);
#pragma unroll
        for (int j = 0; j < 8; ++j) ss += f[j] * f[j];
        const bf16x8 hhi = __builtin_bit_cast(bf16x8, hw);
        bf16x8 wh, wl;
        wh = *(const bf16x8*)(whi + 16 * st); wl = *(const bf16x8*)(wlo + 16 * st);
        c0 = MFMA32(wh, hhi, c0); c0 = MFMA32(wl, hhi, c0);
        wh = *(const bf16x8*)(whi + 32 * DM + 16 * st); wl = *(const bf16x8*)(wlo + 32 * DM + 16 * st);
        c1 = MFMA32(wh, hhi, c1); c1 = MFMA32(wl, hhi, c1);
        wh = *(const bf16x8*)(whi + 64 * DM + 16 * st); wl = *(const bf16x8*)(wlo + 64 * DM + 16 * st);
        c2 = MFMA32(wh, hhi, c2); c2 = MFMA32(wl, hhi, c2);
    }
    {
        auto rr = __builtin_amdgcn_permlane32_swap(__float_as_uint(ss), __float_as_uint(ss), false, false);
        ss = __uint_as_float(rr[0]) + __uint_as_float(rr[1]);
        if (hh == 0) {
#pragma unroll
            for (int i = 0; i < 16; ++i) { part[wid][i][r32] = c0[i]; part[wid][16 + i][r32] = c1[i]; }
#pragma unroll
            for (int i = 0; i < 4; ++i) part[wid][32 + i][r32] = c2[i];
            wss[wid][r32] = ss;
        }
    }
    __syncthreads();
    int e1 = 0, e2 = 0, r1 = 0, r2 = 0; float w1 = 0.f, w2 = 0.f, rstd = 0.f;
    const int mytok = unit * 32 + tid;
    if (tid < 32) {
        rstd = rsqrtf((wss[0][tid] + wss[1][tid] + wss[2][tid] + wss[3][tid]) * (1.0f / DM) + EPS);
        float gl[4], ev[8];
#pragma unroll
        for (int j = 0; j < 4; ++j) gl[j] = (part[0][32 + j][tid] + part[1][32 + j][tid] + part[2][32 + j][tid] + part[3][32 + j][tid]) * rstd;
        int gs = 0; float gm = gl[0];
#pragma unroll
        for (int j = 1; j < 4; ++j) if (gl[j] > gm) { gm = gl[j]; gs = j; }
        const float gw = 1.0f / (__expf(gl[0] - gm) + __expf(gl[1] - gm) + __expf(gl[2] - gm) + __expf(gl[3] - gm));
#pragma unroll
        for (int j = 0; j < 8; ++j) { const int s = gs * 8 + j; ev[j] = (part[0][s][tid] + part[1][s][tid] + part[2][s][tid] + part[3][s][tid]) * rstd; }
        int i1 = 0; float v1 = ev[0];
#pragma unroll
        for (int j = 1; j < 8; ++j) if (ev[j] > v1) { v1 = ev[j]; i1 = j; }
        int i2 = -1; float v2 = -3.0e38f;
#pragma unroll
        for (int j = 0; j < 8; ++j) if (j != i1 && ev[j] > v2) { v2 = ev[j]; i2 = j; }
        w1 = 1.0f / (1.0f + __expf(v2 - v1)); w2 = (1.0f - w1) * gw; w1 *= gw;
        e1 = gs * 8 + i1; e2 = gs * 8 + i2;
        r1 = atomicAdd(lcnt + e1, 1); r2 = atomicAdd(lcnt + e2, 1);
    }
    __syncthreads();
    if (tid < 32) { const int n = lcnt[tid]; lbase[tid] = n ? atomicAdd(cnt + tid, n) : 0; }
    __syncthreads();
    if (tid < 32) {
        p.plist[(size_t)e1 * LISTCAP + lbase[e1] + r1] = mytok * 2; p.plist[(size_t)e2 * LISTCAP + lbase[e2] + r2] = mytok * 2 + 1;
        p.pw[mytok * 2] = w1; p.pw[mytok * 2 + 1] = w2; p.rs[mytok] = rstd;
    }
}
DI void ph_combine(const P& p, int layer) {
    const int wave = threadIdx.x >> 6, lane = threadIdx.x & 63;
    for (int u = blockIdx.x; u < NTOK / 16; u += gridDim.x) {
        const size_t tok0 = (size_t)u * 16 + wave * 2;
        u32x2 hv[2][4], ya[2][4], yb[2][4];
#pragma unroll
        for (int r = 0; r < 2; ++r)
#pragma unroll
            for (int i = 0; i < 4; ++i) {
                const int c = i * 256 + lane * 4;
                hv[r][i] = *(const u32x2*)(p.hb + (tok0 + r) * DM + c);
                ya[r][i] = *(const u32x2*)(p.y + ((tok0 + r) * 2) * DM + c); yb[r][i] = *(const u32x2*)(p.y + ((tok0 + r) * 2 + 1) * DM + c);
            }
#pragma unroll
        for (int r = 0; r < 2; ++r) {
            float ss = 0.f;
#pragma unroll
            for (int i = 0; i < 4; ++i) {
                const u32x2 h0 = hv[r][i], a = ya[r][i], b = yb[r][i];
                f32x4 h;
                h[0] = __uint_as_float(h0.x << 16) + __uint_as_float(a.x << 16) + __uint_as_float(b.x << 16);
                h[1] = __uint_as_float(h0.x & 0xffff0000u) + __uint_as_float(a.x & 0xffff0000u) + __uint_as_float(b.x & 0xffff0000u);
                h[2] = __uint_as_float(h0.y << 16) + __uint_as_float(a.y << 16) + __uint_as_float(b.y << 16);
                h[3] = __uint_as_float(h0.y & 0xffff0000u) + __uint_as_float(a.y & 0xffff0000u) + __uint_as_float(b.y & 0xffff0000u);
                ss += h[0] * h[0] + h[1] * h[1] + h[2] * h[2] + h[3] * h[3];
                if (layer == 0) { u32x2 w; w.x = pack2(h[0], h[1]); w.y = pack2(h[2], h[3]); *(u32x2*)(p.hb + (tok0 + r) * DM + i * 256 + lane * 4) = w; }
                else *(f32x4*)(p.out + (tok0 + r) * DM + i * 256 + lane * 4) = h;
            }
            if (layer == 0) { ss = wave_sum(ss); if (lane == 0) p.rsm[tok0 + r] = rsqrtf(ss * (1.0f / DM) + EPS); }
        }
    }
}

DI void ph_mix_even(const P& p, char* smem) {
    const int half = threadIdx.x >> 8;
    const ConvPlan cv = conv_plan<4>(p, 0); int cslot = 0;
    const bool xcd = gridDim.x == 256;
    for (int u0 = blockIdx.x; u0 < NB * 4 * 32; u0 += gridDim.x) {
        const int u = xcd ? (((u0 & 7) * 2 + ((u0 >> 8) & 1)) << 5) | ((u0 >> 3) & 31) : u0;
        const int cp = u & 31, hp = (u >> 5) & 3, b = u >> 7;
        band_attn_unit(p, smem + half * HALF_LDS, (b << 8) | ((hp * 2 + half) << 5) | cp, cv, cslot);
    }
    for (; cslot < cv.nslots; ++cslot) { CONV_DECL4(cR); CONV_LOAD4(cR, cslot); CONV_STORE4(cR); }
    pool_items(p);
}
DI void ph_mix_odd(const P& p, char* smem) {
    const int half = threadIdx.x >> 8;
    volatile int* wdone = (volatile int*)(smem + 2 * HALF_LDS);
    const ConvPlan cv = conv_plan<2>(p, 1); int cslot = 0;
    const bool xcd = gridDim.x == 256;
    for (int u0 = blockIdx.x; u0 < NB * 4 * 32; u0 += gridDim.x) {
        const int grp = xcd ? (u0 & 7) * 2 + ((u0 >> 8) & 1) : (u0 & 15), qb = xcd ? 31 - ((u0 >> 3) & 31) : 31 - (u0 >> 4);
        const int hp = grp & 3, b = grp >> 2;
        sb_attn_unit(p, smem + half * HALF_LDS, wdone, (b << 8) | ((hp * 2 + half) << 5) | qb, cv, cslot);
    }
    for (; cslot < cv.nslots; ++cslot) { CONV_DECL2(cR); CONV_LOAD2(cR, cslot); CONV_STORE2(cR); }
    for (int u = blockIdx.x; u < (NTOK / 128) * 2; u += gridDim.x) sgu_unit(p, smem + half * HALF_LDS, u * 2 + half);
}
DI void ph_router(const P& p, char* smem, int layer) {
    const int half = threadIdx.x >> 8;
    for (int u0 = blockIdx.x; u0 < NTOK / 64; u0 += gridDim.x) router_unit(p, smem + half * HALF_LDS, layer, band_unit(u0, NTOK / 64) * 2 + half);
}

constexpr int NPHASE = 13;
#ifndef REPS
#define REPS {1,1,1,1,1,1,1,1,1,1,1,1,1}
#endif
__device__ constexpr int REP[13] = REPS;
__global__ __launch_bounds__(512, 2) void mega(P p, int ph0, int ph1) {
    __shared__ __attribute__((aligned(16))) char smem[SMEM_BYTES + 64 + 16 + 16];
    volatile LDSAS unsigned* xst = (volatile LDSAS unsigned*)(smem + SMEM_BYTES + 64);
    if (threadIdx.x < 4) xst[threadIdx.x] = 0u;
    __syncthreads();
    const XcdBarrier xb = xcd_barrier_post(p.bar, xst);
#define PHASE(i, call) if (ph0 <= (i) && (i) < ph1) { for (int r_ = 0; r_ < REP[i]; ++r_) { call; if (r_ + 1 < REP[i] || (i) + 1 < ph1) xcd_barrier(xb); } }
    PHASE(0, ph_prologue(p, smem))
    PHASE(1, (ph_gemm_dense<EPI_IN_EVEN, 4>(p, smem, p.hb, DM, p.wb_in_even, DM, EVEN_IN, 0, 0, 8)))
    PHASE(2, ph_mix_even(p, smem))
    PHASE(3, (ph_gemm_dense<EPI_OUT, 4>(p, smem, p.mixed, DM, p.wb_out_even, DM, DM, 0, 0, 4)))
    PHASE(4, ph_router(p, smem, 0))
    PHASE(5, ph_moe(p, smem, 0))
    PHASE(6, ph_combine(p, 0))
    PHASE(7, (ph_gemm_dense<EPI_IN_ODD, 4>(p, smem, p.hb, DM, p.wb_in_odd, DM, ODD_IN, 1, 0, 8), ph_gemm_dense<EPI_IN_ODD, 2>(p, smem, p.hb, DM, p.wb_in_odd, DM, ODD_IN, 1, 8, 2)))
    PHASE(8, ph_mix_odd(p, smem))
    PHASE(9, (ph_gemm_dense<EPI_OUT, 4>(p, smem, p.mixed, DM, p.wb_out_odd, DM, DM, 1, 0, 4)))
    PHASE(10, ph_router(p, smem, 1))
    PHASE(11, ph_moe(p, smem, 1))
    PHASE(12, ph_combine(p, 1))
}

extern "C" void kernel_launch(void* const* d_in, const int* in_sizes, int n_in, void* d_out, int out_size, void* d_ws, size_t ws_size, hipStream_t stream) {
    P p{};
    p.x = (const float*)d_in[0]; p.mix_norm_even = (const float*)d_in[1]; p.w_in_even = (const float*)d_in[2]; p.att_q_norm = (const float*)d_in[3];
    p.att_k_norm = (const float*)d_in[4]; p.att_rel_bias = (const float*)d_in[5]; p.pool_w = (const float*)d_in[6]; p.pool_scale = (const float*)d_in[7];
    p.w_out_even = (const float*)d_in[8]; p.mix_norm_odd = (const float*)d_in[9]; p.w_in_odd = (const float*)d_in[10]; p.sgu_v_norm = (const float*)d_in[11];
    p.sgu_w = (const float*)d_in[12]; p.sgu_b = (const float*)d_in[13]; p.w_out_odd = (const float*)d_in[14]; p.ffn_norm = (const float*)d_in[15];
    p.w_rg = (const float*)d_in[16]; p.w_re = (const float*)d_in[17]; p.w_gate = (const float*)d_in[18]; p.w_up = (const float*)d_in[19]; p.w_down = (const float*)d_in[20];
    p.out = (float*)d_out;
    char* ws = (char*)d_ws; size_t off = 0;
    auto take = [&](size_t bytes) { char* r = ws + off; off += (bytes + 255) & ~(size_t)255; return r; };
    p.wb_in_even = (bf16_t*)take((size_t)EVEN_IN * DM * 2);
    p.wb_out_even = (bf16_t*)take((size_t)DM * DM * 2);
    p.wb_in_odd = (bf16_t*)take((size_t)ODD_IN * DM * 2);
    p.wb_out_odd = (bf16_t*)take((size_t)DM * DM * 2);
    p.wb_gate = (bf16_t*)take((size_t)2 * NEXP * DM * FF * 2);
    p.wb_up = (bf16_t*)take((size_t)2 * NEXP * DM * FF * 2);
    p.wb_down = (bf16_t*)take((size_t)2 * NEXP * DM * FF * 2);
    p.wr_hi = (bf16_t*)take((size_t)2 * 96 * DM * 2);
    p.wr_lo = (bf16_t*)take((size_t)2 * 96 * DM * 2);
    p.hb = (bf16_t*)take((size_t)NTOK * DM * 2);
    p.proj = (bf16_t*)take((size_t)NTOK * ODD_IN * 2);
    p.y = p.proj;
    p.mixed = (bf16_t*)take((size_t)NTOK * DM * 2);
    p.hid = p.mixed;
    p.pw = (float*)take((size_t)NTOK * 2 * 4);
    p.rs = (float*)take((size_t)NTOK * 4);
    p.rsm = (float*)take((size_t)NTOK * 4);
    p.vss = (float*)take((size_t)NTOK * 4);
    p.plist = (int*)take((size_t)NEXP * LISTCAP * 4);
    p.cnt = (int*)take(256);
    p.ones = (const float*)take(256);
    p.dump = (bf16_t*)take((size_t)512 * 512 * 32);
    p.gdone = (int*)take(640 * 4);
    p.bar = (unsigned*)take(XCD_BAR_WORDS * 4);
    (void)hipMemsetAsync(p.bar, 0, XCD_BAR_WORDS * 4, stream);
    for (int l = 0; l < 2; ++l) {
        const size_t o = (size_t)l * NEXP * DM * FF;
        p.cs[l * 5 + 0] = p.w_gate + o; p.cd[l * 5 + 0] = p.wb_gate + o;
        p.cs[l * 5 + 1] = p.w_up + o;   p.cd[l * 5 + 1] = p.wb_up + o;
        p.cs[l * 5 + 2] = p.w_down + o; p.cd[l * 5 + 2] = p.wb_down + o;
        p.cs[l * 5 + 3] = p.w_in_odd;   p.cd[l * 5 + 3] = p.wb_in_odd;
        p.cs[l * 5 + 4] = p.w_out_odd;  p.cd[l * 5 + 4] = p.wb_out_odd;
    }

    static int grid_blocks = 0;
    if (!grid_blocks) {
        int dev = 0, cus = 0, per_cu = 0;
        (void)hipGetDevice(&dev);
        (void)hipDeviceGetAttribute(&cus, hipDeviceAttributeMultiprocessorCount, dev);
        (void)hipOccupancyMaxActiveBlocksPerMultiprocessor(&per_cu, mega, 512, 0);
        if (per_cu < 1) per_cu = 1;
        grid_blocks = cus;
    }
    int ph0 = 0, ph1 = NPHASE;
    void* args[] = {&p, &ph0, &ph1};
    hipError_t e = hipLaunchCooperativeKernel((void*)mega, dim3(grid_blocks), dim3(512), args, 0, stream);
    if (e != hipSuccess) fprintf(stderr, "cooperative launch failed: %s (grid %d)\n", hipGetErrorString(e), grid_blocks);
}
```
